# Optimizing an MI355X kernel written in HIP

```python
import numpy as np
import jax
import jax.numpy as jnp
from jax import lax

D_MODEL = 1024
BATCH = 32
SEQ = 256
DEPTH = 2
DEC_BATCH = 8
DEC_SEQ = 1024
PAST_LEN = 256

GRID_W = 64
N_HEADS = 4
HEAD_DIM = 64
MIX_W = N_HEADS * HEAD_DIM
N_BRANCH = 4
CHUNK = 64
GLA_RANK = 16
GLA_TAU = 16.0
RWKV_W_RANK = 32
RWKV_A_RANK = 32
RWKV_G_RANK = 64
SHIFT_TAPS = 3
NA_WIN_R = 8
NA_WIN_C = 16
NA_QCB = 16
NA_KCB = 32
N_EXPERTS = 16
EC_CAPACITY = 2
EXPERT_FF = 2048
ROPE_BASE = 10000.0
LN_EPS = 1e-5
DEEPNORM_ALPHA = (2 * DEPTH) ** 0.25
DEEPNORM_BETA = (8 * DEPTH) ** -0.25
F32 = jnp.float32

IN_COLUMNS = (
    ('m_q', MIX_W), ('m_k', MIX_W), ('m_v', MIX_W), ('m_o', MIX_W),
    ('m_i', 2 * N_HEADS), ('m_f', 2 * N_HEADS),
    ('g_q', MIX_W), ('g_k', MIX_W), ('g_v', MIX_W), ('g_g', MIX_W), ('g_a', 2 * GLA_RANK),
    ('r_rkv', 3 * MIX_W), ('r_w', 2 * RWKV_W_RANK), ('r_a', 2 * RWKV_A_RANK), ('r_g', RWKV_G_RANK),
    ('n_qkv', 3 * MIX_W),
    ('merge', N_BRANCH * D_MODEL),
)

kernel_name = 'hybrid_diffusion_prefix_trunk_step'


def _split_columns(proj):
    cols, off = {}, 0
    for name, width in IN_COLUMNS:
        cols[name] = proj[..., off:off + width]
        off += width
    return cols


def _heads(a):
    return a.reshape(a.shape[0], a.shape[1], N_HEADS, HEAD_DIM)


def _orient(a2, t_axis):
    return jnp.stack([a2[0], jnp.flip(a2[1], t_axis)])


def _both_dirs(a, t_axis):
    return jnp.stack([a, jnp.flip(a, t_axis)])


def _merge_dirs(a2, t_axis):
    return a2[0] + jnp.flip(a2[1], t_axis)


def _head_norm(x, centre):
    if centre:
        x = x - x.mean(-1, keepdims=True)
    return x * lax.rsqrt(jnp.mean(x * x, -1, keepdims=True) + LN_EPS)


def _layer_norm(x, g, b):
    x32 = x.astype(F32)
    mu = x32.mean(-1, keepdims=True)
    xc = x32 - mu
    var = jnp.mean(xc * xc, -1, keepdims=True)
    return (xc * lax.rsqrt(var + LN_EPS) * g + b).astype(x.dtype)


def _axial_rope(x):
    t = jnp.arange(x.shape[1])
    half = HEAD_DIM // 2
    nf = half // 2
    inv = ROPE_BASE ** (-jnp.arange(nf, dtype=F32) / nf)

    def rot(xs, pos):
        ang = pos.astype(F32)[:, None] * inv[None, :]
        cos = jnp.cos(ang)[None, :, None, :]
        sin = jnp.sin(ang)[None, :, None, :]
        x1, x2 = xs[..., :nf], xs[..., nf:]
        return jnp.concatenate([x1 * cos - x2 * sin, x1 * sin + x2 * cos], -1)

    return jnp.concatenate([rot(x[..., :half], t // GRID_W), rot(x[..., half:], t % GRID_W)], -1)


def _token_shift(x, taps):
    T = x.shape[1]
    xp = jnp.pad(x, ((0, 0), (1, 1), (0, 0)))
    return taps[0] * xp[:, :T] + taps[1] * xp[:, 1:T + 1] + taps[2] * xp[:, 2:T + 2]


def _mlstm_chunkwise(q, k, v, ig, lf, C0, n0, m0):
    B, H, T, d = q.shape
    nc = T // CHUNK
    causal = jnp.tril(jnp.ones((CHUNK, CHUNK), dtype=bool))

    def to_chunks(a):
        return jnp.moveaxis(a.reshape(B, H, nc, CHUNK, *a.shape[3:]), 2, 0)

    def step(carry, inp):
        C, n, m = carry
        qc, kc, vc, ic, fc = inp
        b = jnp.cumsum(fc, axis=-1)
        log_d = jnp.where(causal, b[..., :, None] - b[..., None, :] + ic[..., None, :], -jnp.inf)
        m_inter = b + m[..., None]
        m_t = jnp.maximum(m_inter, log_d.max(-1))
        s = jnp.einsum('bhtd,bhsd->bhts', qc, kc) * jnp.exp(log_d - m_t[..., None])
        w_inter = jnp.exp(m_inter - m_t)
        num = jnp.einsum('bhts,bhsd->bhtd', s, vc) + w_inter[..., None] * jnp.einsum('bhtk,bhkv->bhtv', qc, C)
        den = s.sum(-1) + w_inter * jnp.einsum('bhtk,bhk->bht', qc, n)
        h = num / jnp.maximum(jnp.abs(den), jnp.exp(-m_t))[..., None]
        b_end = b[..., -1]
        log_w = b_end[..., None] - b + ic
        m_new = jnp.maximum(b_end + m, log_w.max(-1))
        carry_w = jnp.exp(b_end + m - m_new)
        wk = jnp.exp(log_w - m_new[..., None])[..., None] * kc
        C_new = carry_w[..., None, None] * C + jnp.einsum('bhtk,bhtv->bhkv', wk, vc)
        n_new = carry_w[..., None] * n + wk.sum(2)
        return (C_new, n_new, m_new), h

    (C, n, m), hs = lax.scan(step, (C0, n0, m0), tuple(to_chunks(a) for a in (q, k, v, ig, lf)))
    return jnp.moveaxis(hs, 0, 2).reshape(B, H, T, d), C, n, m


def _gla_chunkwise(q, k, v, g, S0):
    B, H, T, dk = q.shape
    nc = T // CHUNK
    causal = jnp.tril(jnp.ones((CHUNK, CHUNK), dtype=bool))[:, :, None]

    def to_chunks(a):
        return jnp.moveaxis(a.reshape(B, H, nc, CHUNK, a.shape[-1]), 2, 0)

    def step(S, inp):
        qc, kc, vc, gc = inp
        G = jnp.cumsum(gc, axis=2)
        rel = jnp.exp(jnp.where(causal, G[:, :, :, None, :] - G[:, :, None, :, :], -jnp.inf))
        att = jnp.einsum('bhtk,bhsk,bhtsk->bhts', qc, kc, rel)
        o = jnp.einsum('bhts,bhsv->bhtv', att, vc) + jnp.einsum('bhtk,bhkv->bhtv', qc * jnp.exp(G), S)
        G_end = G[:, :, -1]
        S_new = jnp.exp(G_end)[..., None] * S + jnp.einsum('bhtk,bhtv->bhkv', kc * jnp.exp(G_end[:, :, None] - G), vc)
        return S_new, o

    S, outs = lax.scan(step, S0, tuple(to_chunks(a) for a in (q, k, v, g)))
    return jnp.moveaxis(outs, 0, 2).reshape(B, H, T, v.shape[-1]), S


def _rwkv7_scan(r, w, kap, a, khat, v, S0):
    def step(S, inp):
        rt, wt, kt, at, kht, vt = inp
        sk = jnp.einsum('bhvk,bhk->bhv', S, kt)
        S = S * wt[:, :, None, :] - sk[..., None] * (at * kt)[:, :, None, :] + vt[..., None] * kht[:, :, None, :]
        return S, jnp.einsum('bhvk,bhk->bhv', S, rt)

    S, ys = lax.scan(step, S0, tuple(jnp.moveaxis(t, 1, 0) for t in (r, w, kap, a, khat, v)))
    return jnp.moveaxis(ys, 0, 1), S


def _mlstm_branch(cols, b_ig, b_fg, C0, n0, m0, latent):
    B, T, _ = cols['m_q'].shape
    q, k, v = _heads(cols['m_q']), _heads(cols['m_k']), _heads(cols['m_v'])
    if latent:
        q, k = _axial_rope(q), _axial_rope(k)
    k = k * HEAD_DIM ** -0.5
    ig = jnp.transpose(cols['m_i'].reshape(B, T, 2, N_HEADS) + b_ig, (2, 0, 3, 1))
    lf = jnp.transpose(jax.nn.log_sigmoid(cols['m_f'].reshape(B, T, 2, N_HEADS) + b_fg), (2, 0, 3, 1))
    bhtd = lambda a: jnp.transpose(a, (0, 2, 1, 3))
    h2, C, n, m = jax.vmap(_mlstm_chunkwise, in_axes=(0, 0, 0, 0, 0, 1, 1, 1), out_axes=(0, 1, 1, 1))(
        _both_dirs(bhtd(q), 2), _both_dirs(bhtd(k), 2), _both_dirs(bhtd(v), 2),
        _orient(ig, 2), _orient(lf, 2), C0.astype(F32), n0.astype(F32), m0.astype(F32))
    h = _head_norm(bhtd(_merge_dirs(h2, 2)), True).reshape(B, T, MIX_W)
    return h * jax.nn.sigmoid(cols['m_o']), C, n, m


def _gla_branch(cols, w_gla_a2, b_gla_a, S0, latent):
    B, T, _ = cols['g_q'].shape
    q, k, v = _heads(cols['g_q']), _heads(cols['g_k']), _heads(cols['g_v'])
    if latent:
        q, k = _axial_rope(q), _axial_rope(k)
    q = q * HEAD_DIM ** -0.5
    g = jax.nn.log_sigmoid(jnp.einsum('btzr,zrc->btzc', cols['g_a'].reshape(B, T, 2, GLA_RANK), w_gla_a2) + b_gla_a) / GLA_TAU
    g = jnp.transpose(g.reshape(B, T, 2, N_HEADS, HEAD_DIM), (2, 0, 3, 1, 4))
    bhtd = lambda a: jnp.transpose(a, (0, 2, 1, 3))
    o2, S = jax.vmap(_gla_chunkwise, in_axes=(0, 0, 0, 0, 1), out_axes=(0, 1))(
        _both_dirs(bhtd(q), 2), _both_dirs(bhtd(k), 2), _both_dirs(bhtd(v), 2), _orient(g, 2), S0.astype(F32))
    o = _head_norm(bhtd(_merge_dirs(o2, 2)), False).reshape(B, T, MIX_W)
    return o * jax.nn.silu(cols['g_g']), S


def _rwkv7_branch(cols, shift, w0, w_w2, a0, w_a2, w_g2, k_k, k_a, r_k, S0):
    B, T, _ = cols['r_rkv'].shape
    rkv = _token_shift(cols['r_rkv'], shift)
    r, k, v = (_heads(t) for t in jnp.split(rkv, 3, axis=-1))
    lora_w = jnp.einsum('btzr,zrc->btzc', jnp.tanh(cols['r_w'].reshape(B, T, 2, RWKV_W_RANK)), w_w2)
    decay = jnp.exp(-jnp.exp(-jax.nn.softplus(-(w0 + lora_w)) - 0.5))
    a = jax.nn.sigmoid(a0 + jnp.einsum('btzr,zrc->btzc', cols['r_a'].reshape(B, T, 2, RWKV_A_RANK), w_a2))
    decay = decay.reshape(B, T, 2, N_HEADS, HEAD_DIM)
    a = a.reshape(B, T, 2, N_HEADS, HEAD_DIM)
    kap = k * k_k.reshape(N_HEADS, HEAD_DIM)
    kap = kap * lax.rsqrt(jnp.sum(kap * kap, -1, keepdims=True) + LN_EPS)
    khat = k[:, :, None] * (1.0 + (a - 1.0) * k_a.reshape(N_HEADS, HEAD_DIM))
    per_dir = lambda t: _orient(jnp.moveaxis(t, 2, 0), 1)
    y2, S = jax.vmap(_rwkv7_scan, in_axes=(0, 0, 0, 0, 0, 0, 1), out_axes=(0, 1))(
        _both_dirs(r, 1), per_dir(decay), _both_dirs(kap, 1), per_dir(a), per_dir(khat), _both_dirs(v, 1), S0.astype(F32))
    y = _head_norm(_merge_dirs(y2, 1), True)
    bonus = jnp.sum(r * k * r_k.reshape(N_HEADS, HEAD_DIM), -1, keepdims=True) * v
    gate = jnp.einsum('btr,rc->btc', jax.nn.sigmoid(cols['r_g']), w_g2)
    return (y + bonus).reshape(B, T, MIX_W) * gate, S


def _ctx_attention(q, k, v):
    s = jnp.einsum('bthd,bhsd->bhts', q, k) * HEAD_DIM ** -0.5
    p = jax.nn.softmax(s.astype(F32), axis=-1)
    return jnp.einsum('bhts,bhsd->bthd', p, v)


def _na_latent(q, k, v, k_ctx, v_ctx, rpb):
    B, T, H, d = q.shape
    rows = T // GRID_W
    kr = min(NA_WIN_R, rows)
    ncb = GRID_W // NA_QCB
    r_q = np.arange(rows)
    row_gather = np.clip(r_q - kr // 2, 0, rows - kr)[:, None] + np.arange(kr)
    c_start = np.clip(np.arange(GRID_W) - NA_WIN_C // 2, 0, GRID_W - NA_WIN_C)
    blk = np.arange(ncb)
    col_gather = np.clip(blk * NA_QCB - (NA_KCB - NA_QCB) // 2, 0, GRID_W - NA_KCB)[:, None] + np.arange(NA_KCB)
    q_cols = blk[:, None] * NA_QCB + np.arange(NA_QCB)
    cs = c_start[q_cols][:, :, None]
    col_ok = (col_gather[:, None, :] >= cs) & (col_gather[:, None, :] < cs + NA_WIN_C)
    d_row = row_gather - r_q[:, None] + NA_WIN_R - 1
    d_col = col_gather[:, None, :] - q_cols[:, :, None] + NA_WIN_C - 1
    bias = rpb[:, d_row[:, None, None, :, None], d_col[None, :, :, None, :]]
    kg = k.reshape(B, rows, GRID_W, H, d)[:, row_gather][:, :, :, col_gather]
    vg = v.reshape(B, rows, GRID_W, H, d)[:, row_gather][:, :, :, col_gather]
    qg = q.reshape(B, rows, ncb, NA_QCB, H, d)
    scale = d ** -0.5
    s_loc = jnp.einsum('brjuhd,brijwhd->bhrjuiw', qg, kg) * scale + bias[None]
    s_loc = jnp.where(col_ok[:, :, None, :], s_loc, -jnp.inf)
    s_ctx = jnp.einsum('brjuhd,bhcd->bhrjuc', qg, k_ctx) * scale
    n_loc = kr * NA_KCB
    s_all = jnp.concatenate([s_loc.reshape(*s_loc.shape[:5], n_loc), s_ctx], axis=-1).astype(F32)
    p = jax.nn.softmax(s_all, axis=-1)
    p_loc = p[..., :n_loc].reshape(s_loc.shape)
    p_ctx = p[..., n_loc:]
    o = jnp.einsum('bhrjuiw,brijwhd->brjuhd', p_loc, vg) + jnp.einsum('bhrjuc,bhcd->brjuhd', p_ctx, v_ctx)
    return o.reshape(B, T, H, d)


def _na_branch(cols, rpb, ctx_kv, latent):
    B, T, _ = cols['n_qkv'].shape
    q, k, v = (_heads(t) for t in jnp.split(cols['n_qkv'], 3, axis=-1))
    if latent:
        return _na_latent(q, k, v, ctx_kv[0], ctx_kv[1], rpb).reshape(B, T, MIX_W), None
    kt, vt = jnp.transpose(k, (0, 2, 1, 3)), jnp.transpose(v, (0, 2, 1, 3))
    return _ctx_attention(q, kt, vt).reshape(B, T, MIX_W), (kt, vt)


def _mixing_sublayer(h, lp, init, ctx_kv, latent):
    B, T, _ = h.shape
    cols = _split_columns(jnp.einsum('btd,dn->btn', h, lp['w_in']).astype(F32))
    C0, n0, m0, Sg0, Sr0 = init
    m_out, C, n, m = _mlstm_branch(cols, lp['b_ig'], lp['b_fg'], C0, n0, m0, latent)
    g_out, Sg = _gla_branch(cols, lp['w_gla_a2'], lp['b_gla_a'], Sg0, latent)
    r_out, Sr = _rwkv7_branch(cols, lp['shift_rwkv'], lp['w0_rwkv'], lp['w_w2'], lp['a0_rwkv'], lp['w_a2'],
                              lp['w_g2'], lp['k_k'], lp['k_a'], lp['r_k'], Sr0)
    n_out, kv = _na_branch(cols, lp['rpb'], ctx_kv, latent)
    branches = jnp.stack([m_out, g_out, r_out, n_out], axis=2).astype(h.dtype)
    widened = jnp.einsum('btzc,zcd->btzd', branches, lp['w_br'])
    gates = jax.nn.sigmoid(cols['merge'].reshape(B, T, N_BRANCH, D_MODEL)).astype(h.dtype)
    out = jnp.einsum('btd,de->bte', jnp.sum(gates * widened, axis=2), lp['w_out'])
    return out, (C, n, m, Sg, Sr), kv


def _expert_choice_moe(h, w_router, w_up, w_down):
    B, T, _ = h.shape
    cap = EC_CAPACITY * T // N_EXPERTS
    aff = jax.nn.softmax(jnp.einsum('btd,de->bte', h, w_router).astype(F32), axis=-1)
    gate, idx = lax.top_k(jnp.swapaxes(aff, 1, 2), cap)
    bidx = jnp.arange(B)[:, None, None]
    xe = h[bidx, idx]
    up = jnp.einsum('becd,edf->becf', xe, w_up)
    a, b = jnp.split(up, 2, axis=-1)
    ye = jnp.einsum('becf,efd->becd', jax.nn.silu(a) * b, w_down)
    return jnp.zeros_like(h).at[bidx, idx].add(gate[..., None].astype(h.dtype) * ye)


def _trunk_layer(x, mod, lp, init, ctx_kv, latent):
    sh1, sc1, g1, sh2, sc2, g2 = jnp.split(mod[:, None, :].astype(x.dtype), 6, axis=-1)
    h = x * (1 + sc1) + sh1
    mix, states, kv = _mixing_sublayer(h, lp, init, ctx_kv, latent)
    x = _layer_norm(DEEPNORM_ALPHA * x + g1 * mix, lp['ln_g'][0], lp['ln_b'][0])
    h = x * (1 + sc2) + sh2
    ff = _expert_choice_moe(h, lp['w_router'], lp['w_up'], lp['w_down'])
    x = _layer_norm(DEEPNORM_ALPHA * x + g2 * ff, lp['ln_g'][1], lp['ln_b'][1])
    return x, states, kv


def setup_inputs(seed: int = 0) -> dict:
    key = jax.random.key(seed)
    ks = iter(jax.random.split(key, 48))

    def nrm(shape, scale=1.0):
        return scale * jax.random.normal(next(ks), shape, F32)

    H, d = N_HEADS, HEAD_DIM
    n_in = sum(width for _, width in IN_COLUMNS)
    taps = jnp.array([0.25, 0.5, 0.25], F32)[None, :, None]
    return {
        'x_prompt': nrm((BATCH, SEQ, D_MODEL)),
        'x_sample': nrm((DEC_BATCH, DEC_SEQ, D_MODEL)),
        'state_mlstm_C': nrm((DEC_BATCH, DEPTH, 2, H, d, d), 0.1),
        'state_mlstm_n': nrm((DEC_BATCH, DEPTH, 2, H, d), 0.1),
        'state_mlstm_m': nrm((DEC_BATCH, DEPTH, 2, H)),
        'state_gla': nrm((DEC_BATCH, DEPTH, 2, H, d, d), 0.1),
        'state_rwkv': nrm((DEC_BATCH, DEPTH, 2, H, d, d), 0.1),
        'cache_na_k': nrm((DEC_BATCH, DEPTH, H, PAST_LEN, d)),
        'cache_na_v': nrm((DEC_BATCH, DEPTH, H, PAST_LEN, d)),
        'c': nrm((DEC_BATCH, D_MODEL)),
        'c_ctx': nrm((D_MODEL,)),
        'w_ada': nrm((DEPTH, D_MODEL, 6 * D_MODEL), 0.5 * D_MODEL ** -0.5),
        'b_ada': nrm((DEPTH, 6 * D_MODEL), 0.02),
        'w_in': nrm((DEPTH, D_MODEL, n_in), D_MODEL ** -0.5),
        'b_ig': nrm((DEPTH, 2, H), 0.1),
        'b_fg': 3.0 + 3.0 * jax.random.uniform(next(ks), (DEPTH, 2, H), F32),
        'w_gla_a2': nrm((DEPTH, 2, GLA_RANK, MIX_W), GLA_RANK ** -0.5),
        'b_gla_a': nrm((DEPTH, 2, MIX_W), 0.1),
        'shift_rwkv': taps + nrm((DEPTH, SHIFT_TAPS, 3 * MIX_W), 0.05),
        'w0_rwkv': nrm((DEPTH, 2, MIX_W), 0.5),
        'w_w2': nrm((DEPTH, 2, RWKV_W_RANK, MIX_W), 0.1),
        'a0_rwkv': nrm((DEPTH, 2, MIX_W), 0.5),
        'w_a2': nrm((DEPTH, 2, RWKV_A_RANK, MIX_W), RWKV_A_RANK ** -0.5),
        'w_g2': nrm((DEPTH, RWKV_G_RANK, MIX_W), RWKV_G_RANK ** -0.5),
        'k_k': 0.85 + nrm((DEPTH, MIX_W), 0.05),
        'k_a': 1.0 + nrm((DEPTH, MIX_W), 0.05),
        'r_k': nrm((DEPTH, MIX_W), 0.1),
        'rpb': nrm((DEPTH, H, 2 * NA_WIN_R - 1, 2 * NA_WIN_C - 1), 0.1),
        'w_br': nrm((DEPTH, N_BRANCH, MIX_W, D_MODEL), MIX_W ** -0.5),
        'w_out': nrm((DEPTH, D_MODEL, D_MODEL), DEEPNORM_BETA * D_MODEL ** -0.5),
        'ln_g': 1.0 + nrm((DEPTH, 2, D_MODEL), 0.05),
        'ln_b': nrm((DEPTH, 2, D_MODEL), 0.02),
        'w_router': nrm((DEPTH, D_MODEL, N_EXPERTS), D_MODEL ** -0.5),
        'w_up': nrm((DEPTH, N_EXPERTS, D_MODEL, 2 * EXPERT_FF), D_MODEL ** -0.5),
        'w_down': nrm((DEPTH, N_EXPERTS, EXPERT_FF, D_MODEL), DEEPNORM_BETA * EXPERT_FF ** -0.5),
    }


def reference(x_prompt, x_sample, state_mlstm_C, state_mlstm_n, state_mlstm_m, state_gla, state_rwkv,
              cache_na_k, cache_na_v, c, c_ctx, w_ada, b_ada, w_in, b_ig, b_fg, w_gla_a2, b_gla_a,
              shift_rwkv, w0_rwkv, w_w2, a0_rwkv, w_a2, w_g2, k_k, k_a, r_k, rpb, w_br, w_out,
              ln_g, ln_b, w_router, w_up, w_down):
    def layer_params(l):
        return {'w_in': w_in[l], 'b_ig': b_ig[l], 'b_fg': b_fg[l], 'w_gla_a2': w_gla_a2[l],
                'b_gla_a': b_gla_a[l], 'shift_rwkv': shift_rwkv[l], 'w0_rwkv': w0_rwkv[l], 'w_w2': w_w2[l],
                'a0_rwkv': a0_rwkv[l], 'w_a2': w_a2[l], 'w_g2': w_g2[l], 'k_k': k_k[l], 'k_a': k_a[l],
                'r_k': r_k[l], 'rpb': rpb[l], 'w_br': w_br[l], 'w_out': w_out[l], 'ln_g': ln_g[l],
                'ln_b': ln_b[l], 'w_router': w_router[l], 'w_up': w_up[l], 'w_down': w_down[l]}

    bp = x_prompt.shape[0]
    zero_state = (jnp.zeros((bp, 2, N_HEADS, HEAD_DIM, HEAD_DIM), F32),
                  jnp.zeros((bp, 2, N_HEADS, HEAD_DIM), F32),
                  jnp.zeros((bp, 2, N_HEADS), F32),
                  jnp.zeros((bp, 2, N_HEADS, HEAD_DIM, HEAD_DIM), F32),
                  jnp.zeros((bp, 2, N_HEADS, HEAD_DIM, HEAD_DIM), F32))
    cond_ctx = jax.nn.silu(c_ctx)[None, :]
    y_prompt = x_prompt
    l_C, l_n, l_m, l_g, l_r, l_k, l_v = [], [], [], [], [], [], []
    for l in range(DEPTH):
        mod = cond_ctx @ w_ada[l] + b_ada[l]
        y_prompt, (C, n, m, Sg, Sr), (kc, vc) = _trunk_layer(y_prompt, mod, layer_params(l), zero_state, None, False)
        l_C.append(C)
        l_n.append(n)
        l_m.append(m)
        l_g.append(Sg)
        l_r.append(Sr)
        l_k.append(kc)
        l_v.append(vc)
    new_mlstm_C = jnp.stack(l_C, axis=1)
    new_mlstm_n = jnp.stack(l_n, axis=1)
    new_mlstm_m = jnp.stack(l_m, axis=1)
    new_gla = jnp.stack(l_g, axis=1)
    new_rwkv = jnp.stack(l_r, axis=1)
    new_na_k = jnp.stack(l_k, axis=1)
    new_na_v = jnp.stack(l_v, axis=1)

    cond = jax.nn.silu(c)
    y_sample = x_sample
    for l in range(DEPTH):
        mod = cond @ w_ada[l] + b_ada[l]
        init = (state_mlstm_C[:, l], state_mlstm_n[:, l], state_mlstm_m[:, l], state_gla[:, l], state_rwkv[:, l])
        y_sample, _, _ = _trunk_layer(y_sample, mod, layer_params(l), init,
                                      (cache_na_k[:, l], cache_na_v[:, l]), True)

    return (y_prompt, y_sample, new_mlstm_C, new_mlstm_n, new_mlstm_m, new_gla, new_rwkv, new_na_k, new_na_v)
```

```cpp
#ifndef CPU_EMU
#include <hip/hip_runtime.h>
#include <cstdio>
typedef float f32x16 __attribute__((ext_vector_type(16)));
typedef float f32x4 __attribute__((ext_vector_type(4)));
typedef float f32x2 __attribute__((ext_vector_type(2)));
typedef unsigned u32x4 __attribute__((ext_vector_type(4)));
typedef unsigned u32x2 __attribute__((ext_vector_type(2)));
#define LAS __attribute__((address_space(3)))
#define WAVE_SYNC() asm volatile("s_waitcnt lgkmcnt(0)" ::: "memory")
#else
#define LAS
#define WAVE_SYNC() emu::wave_sync()
#endif
#define UNR _Pragma("unroll")
typedef short bf16x8 __attribute__((ext_vector_type(8)));
typedef unsigned short bf16_t;

constexpr int D = 1024, NH = 4, HD = 64, MIXW = 256, NEXP = 16, FF = 2048, DEPTH = 2, PAST = 256, GRIDW = 64;
constexpr int NIN = 7920, NINP = 7936, NCF = 3840, NGATE = 4096, NMOD = 6 * D;
constexpr float ALPHA = 1.4142135623730951f, LN_EPS = 1e-5f;
constexpr int NTHREADS = 512, NWAVES = 8;
constexpr int CB_MQ = 0, CB_MK = 1, CB_MV = 2, CB_MO = 3, CB_GQ = 4, CB_GK = 5, CB_GV = 6, CB_GG = 7, CB_RR = 8, CB_RK = 9, CB_RV = 10, CB_NQ = 11, CB_NK = 12, CB_NV = 13;
constexpr int SM_MI = 3584, SM_MF = 3592, SM_GA = 3600, SM_RW = 3632, SM_RA = 3696, SM_RG = 3760;
enum { I_XP = 0, I_XS, I_SC, I_SN, I_SM, I_SG, I_SR, I_CK, I_CV, I_C, I_CCTX, I_WADA, I_BADA, I_WIN, I_BIG, I_BFG, I_WGLA, I_BGLA, I_SHIFT, I_W0, I_WW2, I_A0, I_WA2, I_WG2, I_KK, I_KA, I_RKK,
       I_RPB, I_WBR, I_WOUT, I_LNG, I_LNB, I_WROUTER, I_WUP, I_WDOWN, N_INPUTS };

__host__ __device__ __forceinline__ int win_col(int p) {
    if (p < 3584) { const int b = p >> 8, w = p & 255; const int base = b < 4 ? b * 256 : (b < 8 ? 1040 + (b - 4) * 256 : (b < 11 ? 2096 + (b - 8) * 256 : 3056 + (b - 11) * 256)); return base + w; }
    if (p < 3840) { const int s = p - 3584; return s < 16 ? 1024 + s : (s < 48 ? 2064 + (s - 16) : (s < 240 ? 2864 + (s - 48) : -1)); }
    return p - 16;
}

struct Params {
    const float* in[N_INPUTS];
    float* out; unsigned char* ws;
    int Bc, Tc, Bl, Tl;
    int ph_lo, ph_hi;
    int use_bar, pad;
};
struct Dims {
    int Bc, Tc, Bl, Tl, NTc, NTl, NT, capc, capl, RPE, TPE, NPR;
    unsigned o_yp, o_ys, o_C, o_n, o_m, o_g, o_r, o_nk, o_nv, o_end;
    unsigned w_ctl, w_win, w_wbr, w_wout, w_wup, w_wdn, w_mods, w_hb, w_cols, w_gates, w_br, w_scr, w_merged, w_v, w_aff, w_inv, w_pgate, w_xe, w_act, w_y, w_end;
};
constexpr size_t CTL_BYTES = 1u << 20;
constexpr int CW_BAR = 4096, CW_QUEUE = 1024;
__host__ __device__ __forceinline__ unsigned al256(size_t x) { return (unsigned)((x + 255) >> 8); }
__host__ __device__ __forceinline__ Dims make_dims(int Bc, int Tc, int Bl, int Tl) {
    Dims d; d.Bc = Bc; d.Tc = Tc; d.Bl = Bl; d.Tl = Tl; d.NTc = Bc * Tc; d.NTl = Bl * Tl; d.NT = d.NTc + d.NTl;
    d.capc = Tc / 8; d.capl = Tl / 8; d.RPE = ((Bc * d.capc + Bl * d.capl + 255) / 256) * 256; d.TPE = d.RPE / 256; d.NPR = NEXP * d.RPE;
    unsigned o = 0; d.o_yp = o; o += (unsigned)d.NTc * D; d.o_ys = o; o += (unsigned)d.NTl * D;
    d.o_C = o; o += (unsigned)Bc * DEPTH * 2 * NH * HD * HD; d.o_n = o; o += (unsigned)Bc * DEPTH * 2 * NH * HD; d.o_m = o; o += (unsigned)Bc * DEPTH * 2 * NH;
    d.o_g = o; o += (unsigned)Bc * DEPTH * 2 * NH * HD * HD; d.o_r = o; o += (unsigned)Bc * DEPTH * 2 * NH * HD * HD;
    d.o_nk = o; o += (unsigned)Bc * DEPTH * NH * Tc * HD; d.o_nv = o; o += (unsigned)Bc * DEPTH * NH * Tc * HD; d.o_end = o;
    unsigned w = 0; d.w_ctl = w; w += (unsigned)(CTL_BYTES >> 8);
    d.w_win = w; w += al256((size_t)DEPTH * NINP * D * 2); d.w_wbr = w; w += al256((size_t)DEPTH * D * D * 2); d.w_wout = w; w += al256((size_t)DEPTH * D * D * 2);
    d.w_wup = w; w += al256((size_t)DEPTH * NEXP * 2 * FF * D * 2); d.w_wdn = w; w += al256((size_t)DEPTH * NEXP * D * FF * 2);
    d.w_mods = w; w += al256((size_t)DEPTH * (1 + Bl) * NMOD * 4);
    d.w_hb = w; w += al256((size_t)d.NT * D * 2); d.w_cols = w; w += al256((size_t)d.NT * NCF * 4); d.w_gates = w; w += al256((size_t)d.NT * NGATE * 2);
    d.w_br = w; w += al256((size_t)d.NT * D * 2); d.w_scr = w; w += al256((size_t)d.NT * 4 * MIXW * 4); d.w_merged = w; w += al256((size_t)d.NT * D * 2);
    d.w_v = w; w += al256((size_t)d.NT * D * 4); d.w_aff = w; w += al256((size_t)d.NT * NEXP * 4); d.w_inv = w; w += al256((size_t)d.NT * NEXP * 4);
    d.w_pgate = w; w += al256((size_t)d.NPR * 4); d.w_xe = w; w += al256((size_t)d.NPR * D * 2); d.w_act = w; w += al256((size_t)d.NPR * FF * 2); d.w_y = w; w += al256((size_t)d.NPR * D * 4);
    d.w_end = w; return d;
}

__device__ __forceinline__ unsigned f2bf(float f) { unsigned u = __builtin_bit_cast(unsigned, f); return (u + 0x7fffu + ((u >> 16) & 1u)) >> 16; }
__device__ __forceinline__ unsigned pk2(float lo, float hi) { return f2bf(lo) | (f2bf(hi) << 16); }
__device__ __forceinline__ float sigmoidf_(float x) { return 1.0f / (1.0f + expf(-x)); }
__device__ __forceinline__ float logsigmoidf_(float x) { return fminf(x, 0.0f) - log1pf(expf(-fabsf(x))); }
__device__ __forceinline__ float softplusf_(float x) { return fmaxf(x, 0.0f) + log1pf(expf(-fabsf(x))); }
__device__ __forceinline__ float siluf_(float x) { return x / (1.0f + expf(-x)); }
__device__ __forceinline__ float wave_sum(float v) {
#pragma unroll
    for (int o = 1; o < 64; o <<= 1) v += __shfl_xor(v, o);
    return v;
}
__device__ __forceinline__ unsigned pkh2(float a, float b) { const _Float16 x = (_Float16)a, y = (_Float16)b; return (unsigned)__builtin_bit_cast(unsigned short, x) | ((unsigned)__builtin_bit_cast(unsigned short, y) << 16); }
#ifndef CPU_EMU
__device__ __forceinline__ float frcp(float x) { return __builtin_amdgcn_rcpf(x); }
#else
inline float frcp(float x) { return 1.0f / x; }
#endif
__device__ __forceinline__ float h2f(unsigned short h) { return (float)__builtin_bit_cast(_Float16, h); }

#ifndef CPU_EMU
__device__ __forceinline__ int opqv(int x) { asm volatile("" : "+v"(x)); return x; }
__device__ __forceinline__ int opqs(int x) { asm volatile("" : "+s"(x)); return x; }
#else
inline int opqv(int x) { return x; }
inline int opqs(int x) { return x; }
#endif
namespace pg8 {
constexpr int BM = 256, BK = 64, HALF = 128, HTB = HALF * BK * 2, STAGE_BYTES = 8 * HTB, NXCD = 8, WGM = 8;
__host__ __device__ __forceinline__ int lds_byte(int r, int c) { const int st = (r >> 4) * 2 + (c >> 5), rr = r & 15, cc = c & 31, ob = rr * 64 + cc * 2; return st * 1024 + (ob ^ (((ob >> 9) & 1) << 5)); }
__host__ __device__ __forceinline__ void stage_rc(int b, int& R, int& C) { const int st = b / 1024, sb = b % 1024, swz = sb ^ (((sb >> 9) & 1) << 5); R = (st >> 1) * 16 + swz / 64; C = (st & 1) * 32 + (swz % 64) / 2; }
struct Unit { int pm, pn, ta, tb; };
struct Gemm { const bf16_t* A; const bf16_t* Bt; int K; };
struct StaticOrder {
    int nM, nN, nwg, G, c;
    __device__ __forceinline__ void init(int M, int N, int G_, int c_) { nM = M / BM; nN = N / BM; nwg = nM * nN; G = G_; c = c_; }
    __device__ __forceinline__ bool next(int i, Unit& u) const {
        const long L = (long)i * G + c; if (L >= nwg) return false;
        int wgid = (int)L; { const int q = nwg / NXCD, r = nwg % NXCD, xcd = wgid % NXCD, off = wgid / NXCD; wgid = (xcd < r ? xcd * (q + 1) : r * (q + 1) + (xcd - r) * q) + off; }
        const int nig = WGM * nN, gid = wgid / nig, fm = gid * WGM, gsz = (nM - fm) < WGM ? (nM - fm) : WGM;
        u.pm = fm + ((wgid % nig) % gsz); u.pn = (wgid % nig) / gsz; u.ta = u.pm; u.tb = u.pn; return true;
    }
};
struct GroupOrder {
    int tpe, nN, nE, G, c;
    __device__ __forceinline__ void init(int tpe_, int nN_, int nE_, int G_, int c_) { tpe = tpe_; nN = nN_; nE = nE_; G = G_; c = c_; }
    __device__ __forceinline__ bool next(int i, Unit& u) const {
        const long L = (long)i * G + c; if (L >= (long)nE * tpe * nN) return false;
        const int per = tpe * nN, e = (int)(L / per), r = (int)(L % per), pn = r / tpe, pm = r % tpe;
        u.ta = e * tpe + pm; u.tb = e * nN + pn; u.pm = u.ta; u.pn = pn; return true;
    }
};
#ifndef CPU_EMU
template <class Epi, class Sched>
__device__ __forceinline__ void gemm_phase(LAS unsigned char* lds, const Gemm g, const Sched& S, const Epi& E) {
    const int tid = opqv((int)threadIdx.x), wid = __builtin_amdgcn_readfirstlane(tid >> 6), lane = tid & 63, wr = wid >> 2, wc = wid & 3, fr = lane & 15, fq = lane >> 4;
    const int K = g.K, nt = K / BK;
    unsigned voffA[2];
#pragma unroll
    for (int i = 0; i < 2; ++i) { int R, C; stage_rc(tid * 16 + i * 8192, R, C); voffA[i] = (unsigned)(R * K + C) * 2u; }
    const size_t kstep = (size_t)(BK * 2), hstep = (size_t)HALF * K * 2, tstep = 2 * hstep;
    const unsigned ldsw = (unsigned)wid * 1024u;
    const int aoff = lds_byte(wr * 64 + fr, fq * 8), boff = lds_byte(wc * 32 + fr, fq * 8);
#define PG8_SA(b, h) (((b) * 2 + (h)) * HTB)
#define PG8_SB(b, h) ((4 + (b) * 2 + (h)) * HTB)
#define PG8_STAGE(bufoff, gbase) do { _Pragma("unroll") for (int _i = 0; _i < 2; ++_i) \
        __builtin_amdgcn_global_load_lds((const unsigned*)((const char*)(gbase) + voffA[_i]), (LAS unsigned*)(lds + (bufoff) + ldsw + _i * 8192), 16, 0, 0); } while (0)
#define PG8_LDA(dst, b, h) do { _Pragma("unroll") for (int m = 0; m < 4; ++m) _Pragma("unroll") for (int k = 0; k < 2; ++k) dst[m][k] = *(const LAS bf16x8*)(lds + PG8_SA(b, h) + aoff + m * 2048 + k * 1024); } while (0)
#define PG8_LDB(dst, b, h) do { _Pragma("unroll") for (int n = 0; n < 2; ++n) _Pragma("unroll") for (int k = 0; k < 2; ++k) dst[n][k] = *(const LAS bf16x8*)(lds + PG8_SB(b, h) + boff + n * 2048 + k * 1024); } while (0)
#define PG8_MMA(ai, bj, At, Bt) do { __builtin_amdgcn_s_setprio(1); _Pragma("unroll") for (int m = 0; m < 4; ++m) _Pragma("unroll") for (int n = 0; n < 2; ++n) _Pragma("unroll") for (int k = 0; k < 2; ++k) \
        acc[ai][bj][m][n] = __builtin_amdgcn_mfma_f32_16x16x32_bf16(Bt[n][k], At[m][k], acc[ai][bj][m][n], 0, 0, 0); __builtin_amdgcn_s_setprio(0); } while (0)
#define PG8_WAIT_V(n) asm volatile("s_waitcnt vmcnt(" #n ")" ::: "memory")
#define PG8_WAIT_L(n) asm volatile("s_waitcnt lgkmcnt(" #n ")" ::: "memory")
#define PG8_BAR __builtin_amdgcn_s_barrier()
#define PG8_SCHED __builtin_amdgcn_sched_barrier(0)
    Unit cur, nxt; int ui = 0;
    if (!S.next(0, cur)) return;
    f32x4 acc[2][2][4][2];
#pragma unroll
    for (int a = 0; a < 2; ++a)
#pragma unroll
        for (int b = 0; b < 2; ++b)
#pragma unroll
            for (int m = 0; m < 4; ++m)
#pragma unroll
                for (int n = 0; n < 2; ++n) acc[a][b][m][n] = (f32x4){0.f, 0.f, 0.f, 0.f};
    bf16x8 At[4][2], B0[2][2], B1[2][2];
    const char* cA = (const char*)g.A + (size_t)cur.ta * tstep; const char* cB = (const char*)g.Bt + (size_t)cur.tb * tstep;
    PG8_STAGE(PG8_SB(0, 0), cB); PG8_STAGE(PG8_SB(0, 1), cB + hstep); PG8_STAGE(PG8_SA(0, 0), cA); PG8_STAGE(PG8_SA(0, 1), cA + hstep);
    if (wr == 1) PG8_BAR;
    PG8_WAIT_V(2); PG8_BAR;
    PG8_STAGE(PG8_SB(1, 0), cB + kstep); PG8_STAGE(PG8_SA(1, 0), cA + kstep); PG8_STAGE(PG8_SB(1, 1), cB + hstep + kstep);
    PG8_WAIT_V(6); PG8_BAR;
    for (;;) {
        const bool has_next = S.next(ui + 1, nxt);
        const char* nA = has_next ? (const char*)g.A + (size_t)nxt.ta * tstep : cA; const char* nB = has_next ? (const char*)g.Bt + (size_t)nxt.tb * tstep : cB;
        for (int t = 0; t < nt; t += 2) {
            const bool last = (t == nt - 2);
            const char* a1 = cA + (size_t)(t + 1) * kstep;
            const char* a2 = last ? nA : cA + (size_t)(t + 2) * kstep; const char* b2 = last ? nB : cB + (size_t)(t + 2) * kstep;
            const char* a3 = a2 + kstep; const char* b3 = b2 + kstep;
            if constexpr (Epi::MID) { if (t != 0 && (t & 3) == 0) E.mid(acc, cur, t >> 2, wr, wc, fr, fq); }
            PG8_LDB(B0, 0, 0); PG8_LDB(B1, 0, 1); PG8_SCHED; PG8_LDA(At, 0, 0); PG8_STAGE(PG8_SA(1, 1), a1 + hstep);
            PG8_WAIT_V(8); PG8_WAIT_L(0); PG8_BAR; PG8_MMA(0, 0, At, B0); PG8_MMA(0, 1, At, B1); PG8_BAR; PG8_SCHED;
            PG8_LDA(At, 0, 1); PG8_STAGE(PG8_SB(0, 0), b2); PG8_STAGE(PG8_SB(0, 1), b2 + hstep); PG8_STAGE(PG8_SA(0, 0), a2);
            PG8_WAIT_V(8); PG8_WAIT_L(0); PG8_BAR; PG8_MMA(1, 0, At, B0); PG8_MMA(1, 1, At, B1); PG8_BAR; PG8_SCHED;
            PG8_LDB(B0, 1, 0); PG8_LDB(B1, 1, 1); PG8_SCHED; PG8_LDA(At, 1, 0); PG8_STAGE(PG8_SA(0, 1), a2 + hstep);
            PG8_WAIT_V(8); PG8_WAIT_L(0); PG8_BAR; PG8_MMA(0, 0, At, B0); PG8_MMA(0, 1, At, B1); PG8_BAR; PG8_SCHED;
            PG8_LDA(At, 1, 1); PG8_STAGE(PG8_SB(1, 0), b3); PG8_STAGE(PG8_SB(1, 1), b3 + hstep); PG8_STAGE(PG8_SA(1, 0), a3);
            PG8_WAIT_V(8); PG8_WAIT_L(0); PG8_BAR; PG8_MMA(1, 0, At, B0); PG8_MMA(1, 1, At, B1); PG8_BAR; PG8_SCHED;
        }
        if (wr == 0) PG8_BAR;
        E(acc, cur, wr, wc, fr, fq);
        if (!has_next) break;
#pragma unroll
        for (int a = 0; a < 2; ++a)
#pragma unroll
            for (int b = 0; b < 2; ++b)
#pragma unroll
                for (int m = 0; m < 4; ++m)
#pragma unroll
                    for (int n = 0; n < 2; ++n) acc[a][b][m][n] = (f32x4){0.f, 0.f, 0.f, 0.f};
        cur = nxt; cA = nA; cB = nB; ++ui;
        if (wr == 1) PG8_BAR;
    }
    PG8_WAIT_V(0);
    PG8_BAR;
#undef PG8_SA
#undef PG8_SB
#undef PG8_STAGE
#undef PG8_LDA
#undef PG8_LDB
#undef PG8_MMA
#undef PG8_WAIT_V
#undef PG8_WAIT_L
#undef PG8_BAR
#undef PG8_SCHED
}
#else
template <class Epi, class Sched> void gemm_phase(unsigned char* lds, const Gemm g, const Sched& S, const Epi& E);
#endif
}
typedef f32x4 AccT[2][2][4][2];

struct Ctx {
    const Params* p; Dims d; unsigned char* lds; int tid, lane, wave, G, vcu;
    template <class T> __device__ __forceinline__ T* ws(unsigned off) const { return (T*)(p->ws + ((size_t)off << 8)); }
    __device__ __forceinline__ const float* in(int i) const { return p->in[i]; }
    __device__ __forceinline__ int modrow(int tok) const { return tok < d.NTc ? 0 : 1 + (tok - d.NTc) / d.Tl; }
    __device__ __forceinline__ const float* mods(int l) const { return ws<float>(d.w_mods) + (size_t)l * (1 + d.Bl) * NMOD; }
    __device__ __forceinline__ float* X() const { return p->out; }
};

__device__ __forceinline__ Ctx fresh(const Ctx& c0) {
    Ctx c; c.p = c0.p; c.lds = c0.lds; c.tid = opqv(c0.tid); c.lane = c.tid & 63; c.wave = opqs(c0.wave); c.G = opqs(c0.G); c.vcu = opqs(c0.vcu);
    c.d = make_dims(opqs(c0.p->Bc), opqs(c0.p->Tc), opqs(c0.p->Bl), opqs(c0.p->Tl)); return c;
}

struct EpiCols {
    static constexpr bool MID = false;
    float* cols; unsigned short* gates;
    __device__ __forceinline__ void operator()(const AccT& acc, const pg8::Unit& u, int wr, int wc, int fr, int fq) const {
        const int row0 = u.pm * 256 + wr * 64 + fr;
        if (u.pn < 15) {
            const int col0 = u.pn * 256 + wc * 32 + 4 * fq;
#pragma unroll
            for (int ai = 0; ai < 2; ++ai)
#pragma unroll
                for (int m = 0; m < 4; ++m) { float* rp = cols + (size_t)(row0 + ai * 128 + m * 16) * NCF + col0;
#pragma unroll
                    for (int bj = 0; bj < 2; ++bj)
#pragma unroll
                        for (int n = 0; n < 2; ++n) *(f32x4*)(rp + bj * 128 + n * 16) = acc[ai][bj][m][n]; }
        } else {
            const int col0 = (u.pn - 15) * 256 + wc * 32 + 4 * fq;
#pragma unroll
            for (int ai = 0; ai < 2; ++ai)
#pragma unroll
                for (int m = 0; m < 4; ++m) { unsigned short* rp = gates + (size_t)(row0 + ai * 128 + m * 16) * NGATE + col0;
#pragma unroll
                    for (int bj = 0; bj < 2; ++bj)
#pragma unroll
                        for (int n = 0; n < 2; ++n) { const f32x4 a = acc[ai][bj][m][n]; u32x2 w;
                            w.x = pkh2(fmaxf(sigmoidf_(a[0]), 6.2e-5f), fmaxf(sigmoidf_(a[1]), 6.2e-5f)); w.y = pkh2(fmaxf(sigmoidf_(a[2]), 6.2e-5f), fmaxf(sigmoidf_(a[3]), 6.2e-5f));
                            *(u32x2*)(rp + bj * 128 + n * 16) = w; } }
        }
    }
};
struct EpiWiden {
    static constexpr bool MID = true;
    const unsigned short* gates; bf16_t* merged;
    __device__ __forceinline__ void mid(AccT& acc, const pg8::Unit& u, int z1, int wr, int wc, int fr, int fq) const {
        const int row0 = opqv(u.pm * 256 + wr * 64 + fr), col0 = opqv(u.pn * 256 + wc * 32 + 4 * fq);
#pragma unroll
        for (int ai = 0; ai < 2; ++ai)
#pragma unroll
            for (int m = 0; m < 4; ++m) { const unsigned short* rp = gates + (size_t)(row0 + ai * 128 + m * 16) * NGATE + col0;
#pragma unroll
                for (int bj = 0; bj < 2; ++bj)
#pragma unroll
                    for (int n = 0; n < 2; ++n) { const u32x2 a = *(const u32x2*)(rp + (z1 - 1) * 1024 + bj * 128 + n * 16), b = *(const u32x2*)(rp + z1 * 1024 + bj * 128 + n * 16);
                        f32x4 r; r[0] = h2f(a.x & 0xffff) * frcp(h2f(b.x & 0xffff)); r[1] = h2f(a.x >> 16) * frcp(h2f(b.x >> 16)); r[2] = h2f(a.y & 0xffff) * frcp(h2f(b.y & 0xffff)); r[3] = h2f(a.y >> 16) * frcp(h2f(b.y >> 16));
                        acc[ai][bj][m][n] *= r;
#ifndef CPU_EMU
                        asm volatile("" ::: "memory");
#endif
                    } }
    }
    __device__ __forceinline__ void operator()(const AccT& acc, const pg8::Unit& u, int wr, int wc, int fr, int fq) const {
        const int row0 = u.pm * 256 + wr * 64 + fr, col0 = u.pn * 256 + wc * 32 + 4 * fq;
#pragma unroll
        for (int ai = 0; ai < 2; ++ai)
#pragma unroll
            for (int m = 0; m < 4; ++m) { const size_t ro = (size_t)(row0 + ai * 128 + m * 16);
#pragma unroll
                for (int bj = 0; bj < 2; ++bj)
#pragma unroll
                    for (int n = 0; n < 2; ++n) { const u32x2 b = *(const u32x2*)(gates + ro * NGATE + 3 * 1024 + col0 + bj * 128 + n * 16); const f32x4 a = acc[ai][bj][m][n]; u32x2 w;
                        w.x = pk2(a[0] * h2f(b.x & 0xffff), a[1] * h2f(b.x >> 16)); w.y = pk2(a[2] * h2f(b.y & 0xffff), a[3] * h2f(b.y >> 16));
                        *(u32x2*)(merged + ro * D + col0 + bj * 128 + n * 16) = w; } }
    }
};
struct EpiPreLN {
    static constexpr bool MID = false;
    const float* x; const float* mods; float* v; int NTc, Tl;
    __device__ __forceinline__ void operator()(const AccT& acc, const pg8::Unit& u, int wr, int wc, int fr, int fq) const {
        const int row0 = u.pm * 256 + wr * 64 + fr, col0 = u.pn * 256 + wc * 32 + 4 * fq;
#pragma unroll
        for (int ai = 0; ai < 2; ++ai)
#pragma unroll
            for (int m = 0; m < 4; ++m) { const int row = row0 + ai * 128 + m * 16; const int mr = row < NTc ? 0 : 1 + (row - NTc) / Tl; const float* g1 = mods + (size_t)mr * NMOD + 2 * D + col0;
                const size_t ro = (size_t)row * D + col0;
#pragma unroll
                for (int bj = 0; bj < 2; ++bj)
#pragma unroll
                    for (int n = 0; n < 2; ++n) { const int o = bj * 128 + n * 16; const f32x4 xv = *(const f32x4*)(x + ro + o), gv = *(const f32x4*)(g1 + o);
                        *(f32x4*)(v + ro + o) = ALPHA * xv + gv * acc[ai][bj][m][n]; } }
    }
};
struct EpiSwiGLU {
    static constexpr bool MID = false;
    bf16_t* act;
    __device__ __forceinline__ void operator()(const AccT& acc, const pg8::Unit& u, int wr, int wc, int fr, int fq) const {
        const int row0 = u.pm * 256 + wr * 64 + fr, col0 = u.pn * 128 + wc * 32 + 4 * fq;
#pragma unroll
        for (int ai = 0; ai < 2; ++ai)
#pragma unroll
            for (int m = 0; m < 4; ++m) { bf16_t* rp = act + (size_t)(row0 + ai * 128 + m * 16) * FF + col0;
#pragma unroll
                for (int n = 0; n < 2; ++n) { const f32x4 a = acc[ai][0][m][n], b = acc[ai][1][m][n]; u32x2 w;
                    w.x = pk2(siluf_(a[0]) * b[0], siluf_(a[1]) * b[1]); w.y = pk2(siluf_(a[2]) * b[2], siluf_(a[3]) * b[3]); *(u32x2*)(rp + n * 16) = w; } }
    }
};
struct EpiDown {
    static constexpr bool MID = false;
    const float* pgate; float* y;
    __device__ __forceinline__ void operator()(const AccT& acc, const pg8::Unit& u, int wr, int wc, int fr, int fq) const {
        const int row0 = u.pm * 256 + wr * 64 + fr, col0 = u.pn * 256 + wc * 32 + 4 * fq;
#pragma unroll
        for (int ai = 0; ai < 2; ++ai)
#pragma unroll
            for (int m = 0; m < 4; ++m) { const int row = row0 + ai * 128 + m * 16; const float gt = pgate[row]; float* rp = y + (size_t)row * D + col0;
#pragma unroll
                for (int bj = 0; bj < 2; ++bj)
#pragma unroll
                    for (int n = 0; n < 2; ++n) *(f32x4*)(rp + bj * 128 + n * 16) = gt * acc[ai][bj][m][n]; }
    }
};

template <class ColMap>
__device__ __forceinline__ void tr_item(const float* src, int src_ld, const ColMap& cm, bf16_t* dst, int dst_ld, int dst_koff, int n0, int k0, float* scr, int lane) {
    const int sc = cm(n0 + (lane & 31));
#pragma unroll 8
    for (int i = 0; i < 32; ++i) { const int kk = 2 * i + (lane >> 5); scr[kk * 33 + (lane & 31)] = sc >= 0 ? src[(size_t)(k0 + kk) * src_ld + sc] : 0.0f; }
    WAVE_SYNC();
    const int c = lane & 7;
#pragma unroll
    for (int j = 0; j < 4; ++j) { const int n = (lane >> 3) + 8 * j; const float* s = scr + (8 * c) * 33 + n;
        u32x4 o; o.x = pk2(s[0 * 33], s[1 * 33]); o.y = pk2(s[2 * 33], s[3 * 33]); o.z = pk2(s[4 * 33], s[5 * 33]); o.w = pk2(s[6 * 33], s[7 * 33]);
        *(u32x4*)(dst + (size_t)(n0 + n) * dst_ld + dst_koff + k0 + 8 * c) = o; }
    WAVE_SYNC();
}
struct CmId { __device__ __forceinline__ int operator()(int n) const { return n; } };
struct CmWin { __device__ __forceinline__ int operator()(int n) const { return win_col(n); } };
struct CmUp { __device__ __forceinline__ int operator()(int n) const { const int u = n >> 8, w = n & 255; return (w < 128 ? 0 : FF) + u * 128 + (w & 127); } };

__device__ __forceinline__ void phase_prep(const Ctx& c0) {
    const Ctx c = fresh(c0);
    const Dims& d = c.d;
    float* L = (float*)c.lds;
    const int nrow = 1 + d.Bl;
    const int gw = c.vcu * NWAVES + c.wave, NGW = c.G * NWAVES;
    const int nmod_items = DEPTH * (NMOD / 64);
    if (c.vcu < nmod_items) {
        float* cond = L + NWAVES * 2112;
        for (int i = c.tid; i < 9 * D; i += NTHREADS) { const int r = i / D, k = i % D; const float v = r == 0 ? c.in(I_CCTX)[k] : (r < nrow ? c.in(I_C)[(size_t)(r - 1) * D + k] : 0.0f); cond[i] = siluf_(v); }
        __syncthreads();
        if (c.wave == 0) {
            const int l = c.vcu / (NMOD / 64), j = (c.vcu % (NMOD / 64)) * 64 + c.lane;
            const float* w = c.in(I_WADA) + (size_t)l * D * NMOD + j;
            float* mo = c.ws<float>(d.w_mods) + (size_t)l * nrow * NMOD + j;
            const float bias = c.in(I_BADA)[(size_t)l * NMOD + j];
            float a[9];
            UNR for (int r = 0; r < 9; ++r) a[r] = bias;
#pragma unroll 4
            for (int k = 0; k < D; ++k) { const float wv = w[(size_t)k * NMOD]; UNR for (int r = 0; r < 9; ++r) a[r] += cond[r * D + k] * wv; }
            UNR for (int r = 0; r < 9; ++r) if (r < nrow) mo[(size_t)r * NMOD] = a[r];
        }
    }
    float* scr = L + c.wave * 2112;
    const int I_IN = (D / 64) * (NINP / 32), I_BR = 4 * (MIXW / 64) * (D / 32), I_OUT = (D / 64) * (D / 32), I_UP = NEXP * (D / 64) * (2 * FF / 32), I_DN = NEXP * (FF / 64) * (D / 32);
    const int PER_L = I_IN + I_BR + I_OUT + I_UP + I_DN;
    for (int it = gw; it < DEPTH * PER_L; it += NGW) {
        const int l = it / PER_L; int r = it % PER_L;
        if (r < I_IN) { const int nb = NINP / 32, kb = r / nb, n0 = (r % nb) * 32;
            tr_item(c.in(I_WIN) + (size_t)l * D * NIN, NIN, CmWin(), c.ws<bf16_t>(d.w_win) + (size_t)l * NINP * D, D, 0, n0, kb * 64, scr, c.lane); continue; } r -= I_IN;
        if (r < I_BR) { const int per = (MIXW / 64) * (D / 32), z = r / per, q = r % per, kb = q / (D / 32), n0 = (q % (D / 32)) * 32;
            tr_item(c.in(I_WBR) + ((size_t)l * 4 + z) * MIXW * D, D, CmId(), c.ws<bf16_t>(d.w_wbr) + (size_t)l * D * D, D, z * MIXW, n0, kb * 64, scr, c.lane); continue; } r -= I_BR;
        if (r < I_OUT) { const int kb = r / (D / 32), n0 = (r % (D / 32)) * 32;
            tr_item(c.in(I_WOUT) + (size_t)l * D * D, D, CmId(), c.ws<bf16_t>(d.w_wout) + (size_t)l * D * D, D, 0, n0, kb * 64, scr, c.lane); continue; } r -= I_OUT;
        if (r < I_UP) { const int per = (D / 64) * (2 * FF / 32), e = r / per, q = r % per, kb = q / (2 * FF / 32), n0 = (q % (2 * FF / 32)) * 32;
            tr_item(c.in(I_WUP) + ((size_t)l * NEXP + e) * D * 2 * FF, 2 * FF, CmUp(), c.ws<bf16_t>(d.w_wup) + ((size_t)l * NEXP + e) * 2 * FF * D, D, 0, n0, kb * 64, scr, c.lane); continue; } r -= I_UP;
        { const int per = (FF / 64) * (D / 32), e = r / per, q = r % per, kb = q / (D / 32), n0 = (q % (D / 32)) * 32;
            tr_item(c.in(I_WDOWN) + ((size_t)l * NEXP + e) * FF * D, D, CmId(), c.ws<bf16_t>(d.w_wdn) + ((size_t)l * NEXP + e) * D * FF, FF, 0, n0, kb * 64, scr, c.lane); }
    }
}

__device__ __forceinline__ void phase_init(const Ctx& c0) {
    const Ctx c = fresh(c0);
    const Dims& d = c.d; const float* mods = c.mods(0); bf16_t* hb = c.ws<bf16_t>(d.w_hb);
    const int gw = c.vcu * NWAVES + c.wave, NGW = c.G * NWAVES;
    for (int tok = gw; tok < d.NT; tok += NGW) {
        const float* xr = tok < d.NTc ? c.in(I_XP) + (size_t)tok * D : c.in(I_XS) + (size_t)(tok - d.NTc) * D;
        const float* mr = mods + (size_t)c.modrow(tok) * NMOD;
#pragma unroll
        for (int j = 0; j < 4; ++j) { const int col = 4 * c.lane + 256 * j; const f32x4 x = *(const f32x4*)(xr + col), sh = *(const f32x4*)(mr + col), sc = *(const f32x4*)(mr + D + col);
            *(f32x4*)(c.X() + (size_t)tok * D + col) = x; const f32x4 h = x * (1.0f + sc) + sh;
            u32x2 w; w.x = pk2(h[0], h[1]); w.y = pk2(h[2], h[3]); *(u32x2*)(hb + (size_t)tok * D + col) = w; }
    }
}

__device__ __forceinline__ f32x16 mm32(int lane, f32x16 acc, const float* A, int sai, int sak, const float* Bm, int sbk, int sbj, int K) {
    const int i = lane & 31, kk = lane >> 5;
    const float* ap = A + i * sai + kk * sak; const float* bp = Bm + kk * sbk + i * sbj;
#pragma unroll 8
    for (int k = 0; k < K; k += 2) acc = __builtin_amdgcn_mfma_f32_32x32x2f32(ap[k * sak], bp[k * sbk], acc, 0, 0, 0);
    return acc;
}
#define ACC_ROW(r, lane) (((r) & 3) + 8 * ((r) >> 2) + 4 * ((lane) >> 5))
__device__ __forceinline__ f32x16 zero16() { f32x16 z; UNR for (int r = 0; r < 16; ++r) z[r] = 0.0f; return z; }
constexpr int S65 = 65, MSZ = 64 * 65;

__device__ __forceinline__ void build_rope(float* cosT, float* sinT, int tid) {
    for (int i = tid; i < 1024; i += NTHREADS) { const int pos = i >> 4, f = i & 15; const float inv = powf(10000.0f, -(float)f / 16.0f); const float ang = (float)pos * inv; cosT[i] = cosf(ang); sinT[i] = sinf(ang); }
}
__device__ __forceinline__ float rope_elem(const float* rowp, int dd, int t, const float* cosT, const float* sinT) {
    const int f = dd & 15, second = (dd >> 4) & 1, pos = (dd < 32) ? (t / GRIDW) : (t % GRIDW);
    const float x = rowp[dd], xp = rowp[second ? dd - 16 : dd + 16], cs = cosT[pos * 16 + f], sn = sinT[pos * 16 + f];
    return second ? (xp * sn + x * cs) : (x * cs - xp * sn);
}

__device__ __forceinline__ void mix_mlstm(const Ctx& c0, int l, int pass, int b, int h) {
    const Ctx c = fresh(c0);
    const Dims& d = c.d; const int T = pass ? d.Tl : d.Tc, tok0 = pass ? d.NTc + b * d.Tl : b * d.Tc, nc = T / 64, tid = c.tid, lane = c.lane, wave = c.wave;
    float* L = (float*)c.lds;
    float *Q = L, *K = L + MSZ, *V = L + 2 * MSZ, *C = L + 3 * MSZ, *Sm = L + 4 * MSZ, *QC = L + 5 * MSZ, *vec = L + 6 * MSZ;
    float *nv = vec, *ig = vec + 64, *lf = vec + 128, *bc = vec + 192, *lw = vec + 256, *wint = vec + 320, *rden = vec + 384, *scal = vec + 448, *cosT = vec + 512, *sinT = vec + 512 + 1024;
    const float* cols = c.ws<float>(d.w_cols); float* scr = c.ws<float>(d.w_scr); bf16_t* br = c.ws<bf16_t>(d.w_br);
    if (pass) build_rope(cosT, sinT, tid);
    for (int dir = 1; dir >= 0; --dir) {
        __syncthreads();
        if (pass) {
            const float* C0 = c.in(I_SC) + ((((size_t)b * DEPTH + l) * 2 + dir) * NH + h) * HD * HD;
            _Pragma("unroll 2") for (int i = tid; i < 4096; i += NTHREADS) C[(i >> 6) * S65 + (i & 63)] = C0[i];
            if (tid < 64) nv[tid] = c.in(I_SN)[((((size_t)b * DEPTH + l) * 2 + dir) * NH + h) * HD + tid];
            if (tid == 0) scal[0] = c.in(I_SM)[(((size_t)b * DEPTH + l) * 2 + dir) * NH + h];
        } else {
            _Pragma("unroll 2") for (int i = tid; i < 4096; i += NTHREADS) C[(i >> 6) * S65 + (i & 63)] = 0.0f;
            if (tid < 64) nv[tid] = 0.0f;
            if (tid == 0) scal[0] = 0.0f;
        }
        const float big = c.in(I_BIG)[((size_t)l * 2 + dir) * NH + h], bfg = c.in(I_BFG)[((size_t)l * 2 + dir) * NH + h];
        for (int ci = 0; ci < nc; ++ci) {
            _Pragma("unroll 2") for (int i = tid; i < 4096; i += NTHREADS) { const int j = i >> 6, dd = i & 63, t = dir ? T - 1 - (ci * 64 + j) : ci * 64 + j; const float* rp = cols + (size_t)(tok0 + t) * NCF + h * 64;
                float q, k; if (pass) { q = rope_elem(rp + CB_MQ * 256, dd, t, cosT, sinT); k = rope_elem(rp + CB_MK * 256, dd, t, cosT, sinT); } else { q = rp[CB_MQ * 256 + dd]; k = rp[CB_MK * 256 + dd]; }
                Q[j * S65 + dd] = q; K[j * S65 + dd] = k * 0.125f; V[j * S65 + dd] = rp[CB_MV * 256 + dd]; }
            if (tid < 64) { const int t = dir ? T - 1 - (ci * 64 + tid) : ci * 64 + tid; const float* rp = cols + (size_t)(tok0 + t) * NCF;
                ig[tid] = rp[SM_MI + dir * 4 + h] + big; lf[tid] = logsigmoidf_(rp[SM_MF + dir * 4 + h] + bfg); }
            __syncthreads();
            if (tid == 0) { float run = 0.0f; for (int j = 0; j < 64; ++j) { run += lf[j]; bc[j] = run; } const float bend = run, m = scal[0]; float mx = -3.0e38f;
                for (int j = 0; j < 64; ++j) { const float w = bend - bc[j] + ig[j]; lw[j] = w; mx = fmaxf(mx, w); }
                const float mnew = fmaxf(bend + m, mx); scal[1] = mnew; scal[2] = expf(bend + m - mnew); }
            { const int ti = (wave >> 1) & 1, tj = wave & 1; f32x16 acc = zero16();
              if (wave < 4) { acc = mm32(lane, acc, Q + ti * 32 * S65, S65, 1, K + tj * 32 * S65, 1, S65, 64); UNR for (int r = 0; r < 16; ++r) Sm[(ti * 32 + ACC_ROW(r, lane)) * S65 + tj * 32 + (lane & 31)] = acc[r]; }
              else { acc = mm32(lane, acc, Q + ti * 32 * S65, S65, 1, C + tj * 32, S65, 1, 64); UNR for (int r = 0; r < 16; ++r) QC[(ti * 32 + ACC_ROW(r, lane)) * S65 + tj * 32 + (lane & 31)] = acc[r]; } }
            __syncthreads();
            { const int t = tid >> 3, g = tid & 7; const float m = scal[0], mnew = scal[1], bt = bc[t]; float mx = -3.0e38f;
              for (int s = g * 8; s < g * 8 + 8; ++s) if (s <= t) mx = fmaxf(mx, bt - bc[s] + ig[s]);
              mx = fmaxf(mx, __shfl_xor(mx, 1)); mx = fmaxf(mx, __shfl_xor(mx, 2)); mx = fmaxf(mx, __shfl_xor(mx, 4));
              const float minter = bt + m, mt = fmaxf(minter, mx); float den = 0.0f, qn = 0.0f;
              for (int s = g * 8; s < g * 8 + 8; ++s) { float sv = 0.0f; if (s <= t) sv = Sm[t * S65 + s] * expf(bt - bc[s] + ig[s] - mt); Sm[t * S65 + s] = sv; den += sv; qn += Q[t * S65 + s] * nv[s]; }
              den += __shfl_xor(den, 1); den += __shfl_xor(den, 2); den += __shfl_xor(den, 4); qn += __shfl_xor(qn, 1); qn += __shfl_xor(qn, 2); qn += __shfl_xor(qn, 4);
              const float wi = expf(minter - mt); den += wi * qn;
              if (g == 0) { wint[t] = wi; rden[t] = 1.0f / fmaxf(fabsf(den), expf(-mt)); }
              const float ks = expf(lw[t] - mnew); for (int s = g * 8; s < g * 8 + 8; ++s) K[t * S65 + s] *= ks; }
            __syncthreads();
            { const int ti = (wave >> 1) & 1, tj = wave & 1;
              if (wave < 4) { f32x16 acc = zero16(); acc = mm32(lane, acc, Sm + ti * 32 * S65, S65, 1, V + tj * 32, S65, 1, 64);
                  UNR for (int r = 0; r < 16; ++r) { const int row = ti * 32 + ACC_ROW(r, lane), o = row * S65 + tj * 32 + (lane & 31); QC[o] = (acc[r] + wint[row] * QC[o]) * rden[row]; } }
              else { const float carry = scal[2]; f32x16 acc; UNR for (int r = 0; r < 16; ++r) acc[r] = carry * C[(ti * 32 + ACC_ROW(r, lane)) * S65 + tj * 32 + (lane & 31)];
                  acc = mm32(lane, acc, K + ti * 32, 1, S65, V + tj * 32, S65, 1, 64);
                  UNR for (int r = 0; r < 16; ++r) C[(ti * 32 + ACC_ROW(r, lane)) * S65 + tj * 32 + (lane & 31)] = acc[r]; } }
            __syncthreads();
            if (tid < 64) { float s = 0.0f; for (int j = 0; j < 64; ++j) s += K[j * S65 + tid]; nv[tid] = scal[2] * nv[tid] + s; }
            { const int j = tid >> 3, g = tid & 7, t = dir ? T - 1 - (ci * 64 + j) : ci * 64 + j; const size_t tok = (size_t)(tok0 + t); float* sp = scr + (tok * 4 + 0) * MIXW + h * 64 + g * 8;
              if (dir) { UNR for (int e = 0; e < 8; ++e) sp[e] = QC[j * S65 + g * 8 + e]; }
              else { float x[8], s = 0.0f; UNR for (int e = 0; e < 8; ++e) { x[e] = QC[j * S65 + g * 8 + e] + sp[e]; s += x[e]; }
                  s += __shfl_xor(s, 1); s += __shfl_xor(s, 2); s += __shfl_xor(s, 4); const float mean = s * (1.0f / 64.0f); float q = 0.0f;
                  UNR for (int e = 0; e < 8; ++e) { x[e] -= mean; q += x[e] * x[e]; }
                  q += __shfl_xor(q, 1); q += __shfl_xor(q, 2); q += __shfl_xor(q, 4); const float rs = 1.0f / sqrtf(q * (1.0f / 64.0f) + LN_EPS);
                  const float* og = cols + tok * NCF + CB_MO * 256 + h * 64 + g * 8; bf16_t* bp = br + tok * D + 0 * MIXW + h * 64 + g * 8;
                  u32x4 w; w.x = pk2(x[0] * rs * sigmoidf_(og[0]), x[1] * rs * sigmoidf_(og[1])); w.y = pk2(x[2] * rs * sigmoidf_(og[2]), x[3] * rs * sigmoidf_(og[3]));
                  w.z = pk2(x[4] * rs * sigmoidf_(og[4]), x[5] * rs * sigmoidf_(og[5])); w.w = pk2(x[6] * rs * sigmoidf_(og[6]), x[7] * rs * sigmoidf_(og[7])); *(u32x4*)bp = w; } }
            __syncthreads();
            if (tid == 0) scal[0] = scal[1];
        }
        __syncthreads();
        if (!pass) {
            float* Co = c.p->out + d.o_C + ((((size_t)b * DEPTH + l) * 2 + dir) * NH + h) * HD * HD;
            _Pragma("unroll 2") for (int i = tid; i < 4096; i += NTHREADS) Co[i] = C[(i >> 6) * S65 + (i & 63)];
            if (tid < 64) c.p->out[d.o_n + ((((size_t)b * DEPTH + l) * 2 + dir) * NH + h) * HD + tid] = nv[tid];
            if (tid == 0) c.p->out[d.o_m + (((size_t)b * DEPTH + l) * 2 + dir) * NH + h] = scal[0];
        }
        __threadfence();
    }
    __syncthreads();
}

__device__ __forceinline__ void mix_gla(const Ctx& c0, int l, int pass, int b, int h) {
    const Ctx c = fresh(c0);
    const Dims& d = c.d; const int T = pass ? d.Tl : d.Tc, tok0 = pass ? d.NTc + b * d.Tl : b * d.Tc, nc = T / 64, tid = c.tid, lane = c.lane, wave = c.wave;
    float* L = (float*)c.lds;
    float *Q = L, *K = L + MSZ, *V = L + 2 * MSZ, *S = L + 3 * MSZ, *Gm = L + 4 * MSZ, *O2 = L + 5 * MSZ, *vec = L + 6 * MSZ;
    float *gend = vec, *bA = vec + 64, *wA = vec + 128, *cosT = vec + 128 + 1024, *sinT = vec + 128 + 2048;
    const float* cols = c.ws<float>(d.w_cols); float* scr = c.ws<float>(d.w_scr); bf16_t* br = c.ws<bf16_t>(d.w_br);
    if (pass) build_rope(cosT, sinT, tid);
    for (int dir = 1; dir >= 0; --dir) {
        __syncthreads();
        if (pass) { const float* S0 = c.in(I_SG) + ((((size_t)b * DEPTH + l) * 2 + dir) * NH + h) * HD * HD; _Pragma("unroll 2") for (int i = tid; i < 4096; i += NTHREADS) S[(i >> 6) * S65 + (i & 63)] = S0[i]; }
        else _Pragma("unroll 2") for (int i = tid; i < 4096; i += NTHREADS) S[(i >> 6) * S65 + (i & 63)] = 0.0f;
        for (int i = tid; i < 1024; i += NTHREADS) wA[i] = c.in(I_WGLA)[(((size_t)l * 2 + dir) * 16 + (i >> 6)) * MIXW + h * 64 + (i & 63)];
        if (tid < 64) bA[tid] = c.in(I_BGLA)[((size_t)l * 2 + dir) * MIXW + h * 64 + tid];
        __syncthreads();
        for (int ci = 0; ci < nc; ++ci) {
            _Pragma("unroll 2") for (int i = tid; i < 4096; i += NTHREADS) { const int j = i >> 6, dd = i & 63, t = dir ? T - 1 - (ci * 64 + j) : ci * 64 + j; const float* rp = cols + (size_t)(tok0 + t) * NCF;
                const float* hp = rp + h * 64; float q, k; if (pass) { q = rope_elem(hp + CB_GQ * 256, dd, t, cosT, sinT); k = rope_elem(hp + CB_GK * 256, dd, t, cosT, sinT); } else { q = hp[CB_GQ * 256 + dd]; k = hp[CB_GK * 256 + dd]; }
                Q[j * S65 + dd] = q * 0.125f; K[j * S65 + dd] = k; V[j * S65 + dd] = hp[CB_GV * 256 + dd];
                float a = bA[dd]; const float* ga = rp + SM_GA + dir * 16; UNR for (int r = 0; r < 16; ++r) a += ga[r] * wA[r * 64 + dd];
                Gm[j * S65 + dd] = logsigmoidf_(a) * (1.0f / 16.0f); }
            __syncthreads();
            if (tid < 64) { float run = 0.0f; for (int j = 0; j < 64; ++j) { run += Gm[j * S65 + tid]; Gm[j * S65 + tid] = run; } gend[tid] = run; }
            __syncthreads();
            _Pragma("unroll 2") for (int i = tid; i < 4096; i += NTHREADS) { const int o = (i >> 6) * S65 + (i & 63); const float g = Gm[o]; Q[o] *= expf(g); K[o] *= expf(-g); }
            __syncthreads();
            { const int ti = (wave >> 1) & 1, tj = wave & 1; f32x16 acc = zero16();
              if (wave < 4) { acc = mm32(lane, acc, Q + ti * 32 * S65, S65, 1, K + tj * 32 * S65, 1, S65, 64);
                  UNR for (int r = 0; r < 16; ++r) { const int row = ti * 32 + ACC_ROW(r, lane), col = tj * 32 + (lane & 31); Gm[row * S65 + col] = col <= row ? acc[r] : 0.0f; } }
              else { acc = mm32(lane, acc, Q + ti * 32 * S65, S65, 1, S + tj * 32, S65, 1, 64); UNR for (int r = 0; r < 16; ++r) O2[(ti * 32 + ACC_ROW(r, lane)) * S65 + tj * 32 + (lane & 31)] = acc[r]; } }
            __syncthreads();
            { const int ti = (wave >> 1) & 1, tj = wave & 1;
              if (wave < 4) { f32x16 acc; UNR for (int r = 0; r < 16; ++r) acc[r] = O2[(ti * 32 + ACC_ROW(r, lane)) * S65 + tj * 32 + (lane & 31)];
                  acc = mm32(lane, acc, Gm + ti * 32 * S65, S65, 1, V + tj * 32, S65, 1, 64);
                  UNR for (int r = 0; r < 16; ++r) O2[(ti * 32 + ACC_ROW(r, lane)) * S65 + tj * 32 + (lane & 31)] = acc[r]; }
              else { f32x16 acc; UNR for (int r = 0; r < 16; ++r) acc[r] = S[(ti * 32 + ACC_ROW(r, lane)) * S65 + tj * 32 + (lane & 31)];
                  acc = mm32(lane, acc, K + ti * 32, 1, S65, V + tj * 32, S65, 1, 64);
                  UNR for (int r = 0; r < 16; ++r) { const int row = ti * 32 + ACC_ROW(r, lane); S[row * S65 + tj * 32 + (lane & 31)] = expf(gend[row]) * acc[r]; } } }
            __syncthreads();
            { const int j = tid >> 3, g = tid & 7, t = dir ? T - 1 - (ci * 64 + j) : ci * 64 + j; const size_t tok = (size_t)(tok0 + t); float* sp = scr + (tok * 4 + 1) * MIXW + h * 64 + g * 8;
              if (dir) { UNR for (int e = 0; e < 8; ++e) sp[e] = O2[j * S65 + g * 8 + e]; }
              else { float x[8], q = 0.0f; UNR for (int e = 0; e < 8; ++e) { x[e] = O2[j * S65 + g * 8 + e] + sp[e]; q += x[e] * x[e]; }
                  q += __shfl_xor(q, 1); q += __shfl_xor(q, 2); q += __shfl_xor(q, 4); const float rs = 1.0f / sqrtf(q * (1.0f / 64.0f) + LN_EPS);
                  const float* og = cols + tok * NCF + CB_GG * 256 + h * 64 + g * 8; bf16_t* bp = br + tok * D + 1 * MIXW + h * 64 + g * 8;
                  u32x4 w; w.x = pk2(x[0] * rs * siluf_(og[0]), x[1] * rs * siluf_(og[1])); w.y = pk2(x[2] * rs * siluf_(og[2]), x[3] * rs * siluf_(og[3]));
                  w.z = pk2(x[4] * rs * siluf_(og[4]), x[5] * rs * siluf_(og[5])); w.w = pk2(x[6] * rs * siluf_(og[6]), x[7] * rs * siluf_(og[7])); *(u32x4*)bp = w; } }
            __syncthreads();
        }
        if (!pass) { float* So = c.p->out + d.o_g + ((((size_t)b * DEPTH + l) * 2 + dir) * NH + h) * HD * HD; _Pragma("unroll 2") for (int i = tid; i < 4096; i += NTHREADS) So[i] = S[(i >> 6) * S65 + (i & 63)]; }
        __threadfence();
    }
    __syncthreads();
}

__device__ __forceinline__ float rwkv_shift(const float* cols, size_t tok0, int t, int T, int cb, int ch, const float* taps, int l, int which) {
    const float* tp = taps + (size_t)l * 3 * 768 + which * 256 + ch;
    const float xm = t > 0 ? cols[(tok0 + t - 1) * NCF + cb * 256 + ch] : 0.0f, x0 = cols[(tok0 + t) * NCF + cb * 256 + ch], xp = t + 1 < T ? cols[(tok0 + t + 1) * NCF + cb * 256 + ch] : 0.0f;
    return tp[0] * xm + tp[768] * x0 + tp[1536] * xp;
}
__device__ __forceinline__ void mix_rwkv(const Ctx& c0, int l, int pass, int b, int h) {
    const Ctx c = fresh(c0);
    const Dims& d = c.d; const int T = pass ? d.Tl : d.Tc, tid = c.tid, lane = c.lane, wave = c.wave; const size_t tok0 = pass ? d.NTc + (size_t)b * d.Tl : (size_t)b * d.Tc;
    float* L = (float*)c.lds;
    const float* cols = c.ws<float>(d.w_cols); float* scr = c.ws<float>(d.w_scr); bf16_t* br = c.ws<bf16_t>(d.w_br);
    constexpr int TB = 32, VS = TB * 64;
    const int dirw = wave >> 2, td = tid & 255, vrow = td >> 2, q = td & 3;
    float Sr[16];
    if (pass) { const float* S0 = c.in(I_SR) + ((((size_t)b * DEPTH + l) * 2 + dirw) * NH + h) * HD * HD + vrow * 64 + q * 16; UNR for (int j = 0; j < 16; ++j) Sr[j] = S0[j]; }
    else UNR for (int j = 0; j < 16; ++j) Sr[j] = 0.0f;
    const int ch = h * 64 + lane;
    for (int jb = 0; jb < T / TB; ++jb) {
        __syncthreads();
        for (int pi = wave; pi < 2 * TB; pi += NWAVES) {
            const int dir = pi / TB, i = pi % TB, t = dir ? T - 1 - (jb * TB + i) : jb * TB + i; const float* rp = cols + (tok0 + t) * NCF;
            const float r = rwkv_shift(cols, tok0, t, T, CB_RR, ch, c.in(I_SHIFT), l, 0), k = rwkv_shift(cols, tok0, t, T, CB_RK, ch, c.in(I_SHIFT), l, 1), v = rwkv_shift(cols, tok0, t, T, CB_RV, ch, c.in(I_SHIFT), l, 2);
            const float tw = tanhf(rp[SM_RW + dir * 32 + (lane & 31)]), ra = rp[SM_RA + dir * 32 + (lane & 31)];
            float lw = 0.0f, la = 0.0f; const float* w2 = c.in(I_WW2) + ((size_t)l * 2 + dir) * 32 * MIXW + ch; const float* a2 = c.in(I_WA2) + ((size_t)l * 2 + dir) * 32 * MIXW + ch;
            for (int rr = 0; rr < 32; ++rr) { lw += __shfl(tw, rr) * w2[(size_t)rr * MIXW]; la += __shfl(ra, rr) * a2[(size_t)rr * MIXW]; }
            const float decay = expf(-expf(-softplusf_(-(c.in(I_W0)[((size_t)l * 2 + dir) * MIXW + ch] + lw)) - 0.5f));
            const float a = sigmoidf_(c.in(I_A0)[((size_t)l * 2 + dir) * MIXW + ch] + la);
            float kap = k * c.in(I_KK)[(size_t)l * MIXW + ch]; const float ss = wave_sum(kap * kap); kap *= 1.0f / sqrtf(ss + LN_EPS);
            const float khat = k * (1.0f + (a - 1.0f) * c.in(I_KA)[(size_t)l * MIXW + ch]);
            float* P = L + dir * 6 * VS + i * 64 + lane;
            P[0] = r; P[VS] = kap; P[2 * VS] = v; P[3 * VS] = decay; P[4 * VS] = a * kap; P[5 * VS] = khat;
        }
        __syncthreads();
        { const float* P = L + dirw * 6 * VS + q * 16;
          for (int i = 0; i < TB; ++i) { const float* Pi = P + i * 64; const int t = dirw ? T - 1 - (jb * TB + i) : jb * TB + i;
              float sk = 0.0f; UNR for (int j = 0; j < 16; ++j) sk += Sr[j] * Pi[VS + j];
              sk += __shfl_xor(sk, 1); sk += __shfl_xor(sk, 2);
              const float vv = L[dirw * 6 * VS + 2 * VS + i * 64 + vrow]; float y = 0.0f;
              UNR for (int j = 0; j < 16; ++j) { const float s = Sr[j] * Pi[3 * VS + j] - sk * Pi[4 * VS + j] + vv * Pi[5 * VS + j]; Sr[j] = s; y += s * Pi[j]; }
              y += __shfl_xor(y, 1); y += __shfl_xor(y, 2);
              if (q == 0) scr[((tok0 + t) * 4 + 2 + dirw) * MIXW + h * 64 + vrow] = y; } }
    }
    if (!pass) { float* So = c.p->out + d.o_r + ((((size_t)b * DEPTH + l) * 2 + dirw) * NH + h) * HD * HD + vrow * 64 + q * 16; UNR for (int j = 0; j < 16; ++j) So[j] = Sr[j]; }
    __threadfence();
    __syncthreads();
    float* G2 = L;
    _Pragma("unroll 2") for (int i = tid; i < 4096; i += NTHREADS) G2[i] = c.in(I_WG2)[((size_t)l * 64 + (i >> 6)) * MIXW + h * 64 + (i & 63)];
    __syncthreads();
    for (int t = wave; t < T; t += NWAVES) {
        const size_t tok = tok0 + t; const float* rp = cols + tok * NCF;
        float y = scr[(tok * 4 + 2) * MIXW + ch] + scr[(tok * 4 + 3) * MIXW + ch];
        const float mean = wave_sum(y) * (1.0f / 64.0f); y -= mean; const float var = wave_sum(y * y) * (1.0f / 64.0f); y *= 1.0f / sqrtf(var + LN_EPS);
        const float r = rwkv_shift(cols, tok0, t, T, CB_RR, ch, c.in(I_SHIFT), l, 0), k = rwkv_shift(cols, tok0, t, T, CB_RK, ch, c.in(I_SHIFT), l, 1), v = rwkv_shift(cols, tok0, t, T, CB_RV, ch, c.in(I_SHIFT), l, 2);
        const float bonus = wave_sum(r * k * c.in(I_RKK)[(size_t)l * MIXW + ch]) * v;
        const float sg = sigmoidf_(rp[SM_RG + lane]); float gate = 0.0f;
        for (int j = 0; j < 64; ++j) gate += __shfl(sg, j) * G2[j * 64 + lane];
        br[tok * D + 2 * MIXW + ch] = (bf16_t)f2bf((y + bonus) * gate);
    }
    __syncthreads();
}

__device__ __forceinline__ void mix_na(const Ctx& c0, int l, int pass, int b, int h, int qb) {
    const Ctx c = fresh(c0);
    const Dims& d = c.d; const int tid = c.tid, lane = c.lane, wave = c.wave; const size_t tok0 = pass ? d.NTc + (size_t)b * d.Tl : (size_t)b * d.Tc;
    float* L = (float*)c.lds;
    float *Q = L, *Kt = L + MSZ, *Vt = L + 2 * MSZ, *Sm = L + 3 * MSZ, *vec = L + 4 * MSZ;
    float *mrow = vec, *lrow = vec + 64, *arow = vec + 128, *rpbs = vec + 192;
    const float* cols = c.ws<float>(d.w_cols); bf16_t* br = c.ws<bf16_t>(d.w_br);
    const int rows = d.Tl / GRIDW, kr = rows < 8 ? rows : 8; int rs = qb - kr / 2; rs = rs < 0 ? 0 : (rs > rows - kr ? rows - kr : rs);
    const int ntile = pass ? kr + PAST / 64 : d.Tc / 64;
    __syncthreads();
    _Pragma("unroll 2") for (int i = tid; i < 4096; i += NTHREADS) { const int j = i >> 6, dd = i & 63; const size_t tok = tok0 + qb * 64 + j; const float* rp = cols + tok * NCF + h * 64;
        Q[j * S65 + dd] = rp[CB_NQ * 256 + dd] * 0.125f;
        if (!pass) { const size_t o = ((((size_t)b * DEPTH + l) * NH + h) * d.Tc + qb * 64 + j) * HD + dd; c.p->out[d.o_nk + o] = rp[CB_NK * 256 + dd]; c.p->out[d.o_nv + o] = rp[CB_NV * 256 + dd]; } }
    if (tid < 64) { mrow[tid] = -1.0e30f; lrow[tid] = 0.0f; }
    if (pass) for (int i = tid; i < 15 * 31; i += NTHREADS) rpbs[i] = c.in(I_RPB)[((size_t)l * NH + h) * 15 * 31 + i];
    f32x16 oacc = zero16();
    const int ti = (wave >> 1) & 1, tj = wave & 1;
    for (int kt = 0; kt < ntile; ++kt) {
        const bool local = pass && kt < kr; const int krow = rs + kt;
        __syncthreads();
        _Pragma("unroll 2") for (int i = tid; i < 4096; i += NTHREADS) { const int j = i >> 6, dd = i & 63; float kv, vv;
            if (!pass) { const float* rp = cols + (tok0 + kt * 64 + j) * NCF + h * 64; kv = rp[CB_NK * 256 + dd]; vv = rp[CB_NV * 256 + dd]; }
            else if (local) { const float* rp = cols + (tok0 + krow * 64 + j) * NCF + h * 64; kv = rp[CB_NK * 256 + dd]; vv = rp[CB_NV * 256 + dd]; }
            else { const size_t o = ((((size_t)b * DEPTH + l) * NH + h) * PAST + (kt - kr) * 64 + j) * HD + dd; kv = c.in(I_CK)[o]; vv = c.in(I_CV)[o]; }
            Kt[j * S65 + dd] = kv; Vt[j * S65 + dd] = vv; }
        __syncthreads();
        if (wave < 4) { f32x16 acc = zero16(); acc = mm32(lane, acc, Q + ti * 32 * S65, S65, 1, Kt + tj * 32 * S65, 1, S65, 64);
            UNR for (int r = 0; r < 16; ++r) { const int qi = ti * 32 + ACC_ROW(r, lane), kj = tj * 32 + (lane & 31); float s = acc[r];
                if (local) { int cs = qi - 8; cs = cs < 0 ? 0 : (cs > 48 ? 48 : cs); s = (kj >= cs && kj < cs + 16) ? s + rpbs[(krow - qb + 7) * 31 + (kj - qi + 15)] : -1.0e30f; }
                Sm[qi * S65 + kj] = s; } }
        __syncthreads();
        { const int t = tid >> 3, g = tid & 7; float mx = -1.0e30f; for (int s = g * 8; s < g * 8 + 8; ++s) mx = fmaxf(mx, Sm[t * S65 + s]);
          mx = fmaxf(mx, __shfl_xor(mx, 1)); mx = fmaxf(mx, __shfl_xor(mx, 2)); mx = fmaxf(mx, __shfl_xor(mx, 4));
          const float mo = mrow[t], mn = fmaxf(mo, mx); float sum = 0.0f;
          for (int s = g * 8; s < g * 8 + 8; ++s) { const float sv = Sm[t * S65 + s]; const float p = sv <= -1.0e29f ? 0.0f : expf(sv - mn); Sm[t * S65 + s] = p; sum += p; }
          sum += __shfl_xor(sum, 1); sum += __shfl_xor(sum, 2); sum += __shfl_xor(sum, 4);
          const float al = expf(mo - mn);
          __syncthreads();
          if (g == 0) { mrow[t] = mn; lrow[t] = lrow[t] * al + sum; arow[t] = al; } }
        __syncthreads();
        if (wave < 4) { UNR for (int r = 0; r < 16; ++r) oacc[r] *= arow[ti * 32 + ACC_ROW(r, lane)];
            oacc = mm32(lane, oacc, Sm + ti * 32 * S65, S65, 1, Vt + tj * 32, S65, 1, 64); }
    }
    __syncthreads();
    if (wave < 4) UNR for (int r = 0; r < 16; ++r) { const int qi = ti * 32 + ACC_ROW(r, lane); Sm[qi * S65 + tj * 32 + (lane & 31)] = oacc[r] / lrow[qi]; }
    __syncthreads();
    { const int j = tid >> 3, g = tid & 7; const size_t tok = tok0 + qb * 64 + j; const float* sp = Sm + j * S65 + g * 8; bf16_t* bp = br + tok * D + 3 * MIXW + h * 64 + g * 8;
      u32x4 w; w.x = pk2(sp[0], sp[1]); w.y = pk2(sp[2], sp[3]); w.z = pk2(sp[4], sp[5]); w.w = pk2(sp[6], sp[7]); *(u32x4*)bp = w; }
    __syncthreads();
}

__device__ __forceinline__ void phase_mixers(const Ctx& c0, int l) {
    const Ctx c = fresh(c0);
    const Dims& d = c.d; const int rows = d.Tl / GRIDW;
    const int nL = d.Bl * NH, nC = d.Bc * NH, nNAl = nL * rows, nq = d.Tc / 64, nNAc = nC * nq;
    const int e0 = nL + nC, e1 = e0 + nL + nC, e2 = e1 + nL + nC, e3 = e2 + nNAl + nNAc;
    unsigned* qctr = c.ws<unsigned>(c.d.w_ctl) + CW_QUEUE + 64 * l;
    int* slot = (int*)(c.lds + 163840 - 128);
#ifndef MIX_MASK
#define MIX_MASK 15
#endif
#define MIX_FETCH() do { __syncthreads(); if (c.tid == 0) *slot = (int)atomicAdd(qctr, 1u); __syncthreads(); it = __builtin_amdgcn_readfirstlane(*slot); } while (0)
    int it; MIX_FETCH();
    while (it < e0) { const int r = it, ps = r < nL ? 1 : 0, q = ps ? r : r - nL; if (MIX_MASK & 1) mix_rwkv(c, l, opqs(__builtin_amdgcn_readfirstlane(ps)), q / NH, q % NH); MIX_FETCH(); }
    while (it < e1) { const int r = it - e0, ps = r < nL ? 1 : 0, q = ps ? r : r - nL; if (MIX_MASK & 2) mix_mlstm(c, l, opqs(__builtin_amdgcn_readfirstlane(ps)), q / NH, q % NH); MIX_FETCH(); }
    while (it < e2) { const int r = it - e1, ps = r < nL ? 1 : 0, q = ps ? r : r - nL; if (MIX_MASK & 4) mix_gla(c, l, opqs(__builtin_amdgcn_readfirstlane(ps)), q / NH, q % NH); MIX_FETCH(); }
    while (it < e3) { const int r = it - e2, ps = r < nNAl ? 1 : 0, q = ps ? r : r - nNAl, nr = ps ? rows : nq; if (MIX_MASK & 8) mix_na(c, l, opqs(__builtin_amdgcn_readfirstlane(ps)), q / (NH * nr), (q / nr) % NH, q % nr); MIX_FETCH(); }
#undef MIX_FETCH
}

__device__ __forceinline__ void phase_ln1(const Ctx& c0, int l) {
    const Ctx c = fresh(c0);
    const Dims& d = c.d; const float* mods = c.mods(l); const float* v = c.ws<float>(d.w_v); bf16_t* hb = c.ws<bf16_t>(d.w_hb); float* aff = c.ws<float>(d.w_aff);
    const float* lg = c.in(I_LNG) + ((size_t)l * 2 + 0) * D; const float* lb = c.in(I_LNB) + ((size_t)l * 2 + 0) * D;
    float* WR = (float*)c.lds;
    for (int i = c.tid; i < D * NEXP; i += NTHREADS) WR[(i & 15) * D + (i >> 4)] = c.in(I_WROUTER)[(size_t)l * D * NEXP + i];
    __syncthreads();
    const int gw = c.vcu * NWAVES + c.wave, NGW = c.G * NWAVES;
    for (int tok = gw; tok < d.NT; tok += NGW) {
        const float* mr = mods + (size_t)c.modrow(tok) * NMOD; f32x4 x[4]; float s = 0.0f;
#pragma unroll
        for (int j = 0; j < 4; ++j) { x[j] = *(const f32x4*)(v + (size_t)tok * D + 4 * c.lane + 256 * j); s += (x[j][0] + x[j][1]) + (x[j][2] + x[j][3]); }
        const float mean = wave_sum(s) * (1.0f / D); float q = 0.0f;
#pragma unroll
        for (int j = 0; j < 4; ++j) { x[j] = x[j] - mean; q += (x[j][0] * x[j][0] + x[j][1] * x[j][1]) + (x[j][2] * x[j][2] + x[j][3] * x[j][3]); }
        const float rstd = 1.0f / sqrtf(wave_sum(q) * (1.0f / D) + LN_EPS);
        f32x4 hh[4];
#pragma unroll
        for (int j = 0; j < 4; ++j) { const int col = 4 * c.lane + 256 * j; const f32x4 g = *(const f32x4*)(lg + col), bb = *(const f32x4*)(lb + col);
            const f32x4 x1 = x[j] * rstd * g + bb; *(f32x4*)(c.X() + (size_t)tok * D + col) = x1;
            const f32x4 sh = *(const f32x4*)(mr + 3 * D + col), sc = *(const f32x4*)(mr + 4 * D + col); hh[j] = x1 * (1.0f + sc) + sh;
            u32x2 w; w.x = pk2(hh[j][0], hh[j][1]); w.y = pk2(hh[j][2], hh[j][3]); *(u32x2*)(hb + (size_t)tok * D + col) = w; }
        float lg16[16];
#pragma unroll
        for (int e = 0; e < 16; ++e) { float a = 0.0f;
#pragma unroll
            for (int j = 0; j < 4; ++j) { const f32x4 wv = *(const f32x4*)(WR + e * D + 4 * c.lane + 256 * j); a += (hh[j][0] * wv[0] + hh[j][1] * wv[1]) + (hh[j][2] * wv[2] + hh[j][3] * wv[3]); }
            lg16[e] = a;
#ifndef CPU_EMU
            asm volatile("" ::: "memory");
#endif
        }
        float mx = -3.0e38f;
#pragma unroll
        for (int e = 0; e < 16; ++e) { lg16[e] = wave_sum(lg16[e]); mx = fmaxf(mx, lg16[e]); }
        float se = 0.0f;
#pragma unroll
        for (int e = 0; e < 16; ++e) { lg16[e] = expf(lg16[e] - mx); se += lg16[e]; }
        const float inv = 1.0f / se; float mine = 0.0f;
#pragma unroll
        for (int e = 0; e < 16; ++e) mine = (c.lane == e) ? lg16[e] * inv : mine;
        if (c.lane < 16) aff[(size_t)tok * NEXP + c.lane] = mine;
    }
}

__device__ __forceinline__ void phase_select(const Ctx& c0) {
    const Ctx c = fresh(c0);
    const Dims& d = c.d; const float* aff = c.ws<float>(d.w_aff); int* inv = c.ws<int>(d.w_inv); float* pgate = c.ws<float>(d.w_pgate);
    const bf16_t* hb = c.ws<bf16_t>(d.w_hb); bf16_t* xe = c.ws<bf16_t>(d.w_xe);
    float* A = (float*)c.lds; int* sel = (int*)(A + 1024);
    const int nitems = (d.Bc + d.Bl) * NEXP;
    for (int it = c.vcu; it < nitems; it += c.G) {
        const int e = it % NEXP, bb = it / NEXP, pass = bb >= d.Bc, b = pass ? bb - d.Bc : bb, T = pass ? d.Tl : d.Tc, cap = pass ? d.capl : d.capc;
        const int tok0 = pass ? d.NTc + b * d.Tl : b * d.Tc, row0 = e * d.RPE + (pass ? d.Bc * d.capc + b * d.capl : b * d.capc);
        __syncthreads();
        for (int t = c.tid; t < T; t += NTHREADS) A[t] = aff[(size_t)(tok0 + t) * NEXP + e];
        __syncthreads();
        for (int t = c.tid; t < T; t += NTHREADS) { const float a = A[t]; int rank = 0;
            for (int s = 0; s < T; ++s) { const float o = A[s]; rank += (o > a || (o == a && s < t)) ? 1 : 0; }
            if (rank < cap) { sel[rank] = t; pgate[row0 + rank] = a; inv[(size_t)(tok0 + t) * NEXP + e] = row0 + rank; } else inv[(size_t)(tok0 + t) * NEXP + e] = -1; }
        __syncthreads();
        for (int r = c.wave; r < cap; r += NWAVES) { const u32x4* src = (const u32x4*)(hb + (size_t)(tok0 + sel[r]) * D); u32x4* dst = (u32x4*)(xe + (size_t)(row0 + r) * D);
            dst[c.lane] = src[c.lane]; dst[c.lane + 64] = src[c.lane + 64]; }
    }
}

__device__ __forceinline__ void phase_ln2(const Ctx& c0, int l) {
    const Ctx c = fresh(c0);
    const Dims& d = c.d; const float* mods = c.mods(l); const float* y = c.ws<float>(d.w_y); const int* inv = c.ws<int>(d.w_inv); bf16_t* hb = c.ws<bf16_t>(d.w_hb);
    const float* lg = c.in(I_LNG) + ((size_t)l * 2 + 1) * D; const float* lb = c.in(I_LNB) + ((size_t)l * 2 + 1) * D;
    const float* modn = (l + 1 < DEPTH) ? c.mods(l + 1) : nullptr;
    const int gw = c.vcu * NWAVES + c.wave, NGW = c.G * NWAVES;
    for (int tok = gw; tok < d.NT; tok += NGW) {
        const int mrow = c.modrow(tok); const float* mr = mods + (size_t)mrow * NMOD; f32x4 ff[4];
#pragma unroll
        for (int j = 0; j < 4; ++j) ff[j] = (f32x4){0.f, 0.f, 0.f, 0.f};
        for (int e = 0; e < NEXP; ++e) { const int row = inv[(size_t)tok * NEXP + e]; if (row >= 0) {
#pragma unroll
            for (int j = 0; j < 4; ++j) ff[j] += *(const f32x4*)(y + (size_t)row * D + 4 * c.lane + 256 * j); } }
        f32x4 x[4]; float s = 0.0f;
#pragma unroll
        for (int j = 0; j < 4; ++j) { const int col = 4 * c.lane + 256 * j; const f32x4 x1 = *(const f32x4*)(c.X() + (size_t)tok * D + col), g2 = *(const f32x4*)(mr + 5 * D + col);
            x[j] = ALPHA * x1 + g2 * ff[j]; s += (x[j][0] + x[j][1]) + (x[j][2] + x[j][3]); }
        const float mean = wave_sum(s) * (1.0f / D); float q = 0.0f;
#pragma unroll
        for (int j = 0; j < 4; ++j) { x[j] = x[j] - mean; q += (x[j][0] * x[j][0] + x[j][1] * x[j][1]) + (x[j][2] * x[j][2] + x[j][3] * x[j][3]); }
        const float rstd = 1.0f / sqrtf(wave_sum(q) * (1.0f / D) + LN_EPS);
#pragma unroll
        for (int j = 0; j < 4; ++j) { const int col = 4 * c.lane + 256 * j; const f32x4 g = *(const f32x4*)(lg + col), bb = *(const f32x4*)(lb + col);
            const f32x4 x2 = x[j] * rstd * g + bb; *(f32x4*)(c.X() + (size_t)tok * D + col) = x2;
            if (modn) { const float* mn = modn + (size_t)mrow * NMOD; const f32x4 sh = *(const f32x4*)(mn + col), sc = *(const f32x4*)(mn + D + col); const f32x4 hh = x2 * (1.0f + sc) + sh;
                u32x2 w; w.x = pk2(hh[0], hh[1]); w.y = pk2(hh[2], hh[3]); *(u32x2*)(hb + (size_t)tok * D + col) = w; } }
    }
}

constexpr int N_PHASES = 2 + 9 * DEPTH;
__device__ __forceinline__ void run_phase(const Ctx& c0, int ph) {
    const Ctx c = fresh(c0); const Dims& d = c.d;
#ifndef PHASE_MASK
#define PHASE_MASK 0xFFFF
#endif
    if (ph == 0) { if (PHASE_MASK & 0x200) phase_prep(c); return; }
    if (ph == 1) { if (PHASE_MASK & 0x400) phase_init(c); return; }
    const int l = (ph - 2) / 9, s = (ph - 2) % 9;
    LAS unsigned char* ldsp = (LAS unsigned char*)c.lds;
    if (!((PHASE_MASK >> s) & 1)) return;
    switch (s) {
    case 0: { pg8::Gemm g{c.ws<bf16_t>(d.w_hb), c.ws<bf16_t>(d.w_win) + (size_t)l * NINP * D, D}; pg8::StaticOrder S; S.init(d.NT, NINP, c.G, (int)blockIdx.x);
              EpiCols E{c.ws<float>(d.w_cols), c.ws<unsigned short>(d.w_gates)}; pg8::gemm_phase<EpiCols, pg8::StaticOrder>(ldsp, g, S, E); } break;
    case 1: phase_mixers(c, l); break;
    case 2: { pg8::Gemm g{c.ws<bf16_t>(d.w_br), c.ws<bf16_t>(d.w_wbr) + (size_t)l * D * D, D}; pg8::StaticOrder S; S.init(d.NT, D, c.G, (int)blockIdx.x);
              EpiWiden E{c.ws<unsigned short>(d.w_gates), c.ws<bf16_t>(d.w_merged)}; pg8::gemm_phase<EpiWiden, pg8::StaticOrder>(ldsp, g, S, E); } break;
    case 3: { pg8::Gemm g{c.ws<bf16_t>(d.w_merged), c.ws<bf16_t>(d.w_wout) + (size_t)l * D * D, D}; pg8::StaticOrder S; S.init(d.NT, D, c.G, (int)blockIdx.x);
              EpiPreLN E{c.X(), c.mods(l), c.ws<float>(d.w_v), d.NTc, d.Tl}; pg8::gemm_phase<EpiPreLN, pg8::StaticOrder>(ldsp, g, S, E); } break;
    case 4: phase_ln1(c, l); break;
    case 5: phase_select(c); break;
    case 6: { pg8::Gemm g{c.ws<bf16_t>(d.w_xe), c.ws<bf16_t>(d.w_wup) + (size_t)l * NEXP * 2 * FF * D, D}; pg8::GroupOrder S; S.init(d.TPE, 2 * FF / 256, NEXP, c.G, c.vcu);
              EpiSwiGLU E{c.ws<bf16_t>(d.w_act)}; pg8::gemm_phase<EpiSwiGLU, pg8::GroupOrder>(ldsp, g, S, E); } break;
    case 7: { pg8::Gemm g{c.ws<bf16_t>(d.w_act), c.ws<bf16_t>(d.w_wdn) + (size_t)l * NEXP * D * FF, FF}; pg8::GroupOrder S; S.init(d.TPE, D / 256, NEXP, c.G, c.vcu);
              EpiDown E{c.ws<float>(d.w_pgate), c.ws<float>(d.w_y)}; pg8::gemm_phase<EpiDown, pg8::GroupOrder>(ldsp, g, S, E); } break;
    default: phase_ln2(c, l); break;
    }
}

#ifndef CPU_EMU
#define XB_TMO      128
#define XB_XCNT(j)  (256  + 64 * (j))
#define XB_XSUB(j)  (1280 + 64 * (j))
#define XB_XGEN(j)  (2304 + 64 * (j))
#define XB_TOP      3328
#define XB_TOPGEN   3392
#define XB_SPIN_CAP (1u << 20)
__device__ __forceinline__ unsigned xb_ld(unsigned* p)              { return __hip_atomic_load(p, __ATOMIC_RELAXED, __HIP_MEMORY_SCOPE_AGENT); }
__device__ __forceinline__ unsigned xb_add(unsigned* p, unsigned v) { return __hip_atomic_fetch_add(p, v, __ATOMIC_RELAXED, __HIP_MEMORY_SCOPE_AGENT); }
__device__ __forceinline__ unsigned xb_xcc_id() { return (unsigned)__builtin_amdgcn_s_getreg((3 << 11) | 20) & 0xFu; }
#define XB_SPIN(cond, bar) do { unsigned _sp = 0; while (cond) { __builtin_amdgcn_s_sleep(1); \
    if ((++_sp & 255u) == 0u) { if (xb_ld(&(bar)[XB_TMO])) break; if (_sp > XB_SPIN_CAP) { atomicAdd(&(bar)[XB_TMO], 1u); break; } } } } while (0)
struct XcdBarrier { unsigned* bar; unsigned x; volatile LAS unsigned* st; };
__device__ __forceinline__ XcdBarrier xcd_barrier_post(unsigned* bar, volatile LAS unsigned* st) {
    XcdBarrier b; b.bar = bar; b.x = xb_xcc_id(); b.st = st;
    if (threadIdx.x == 0) (void)xb_add(&bar[XB_XCNT(b.x)], 1u);
    return b;
}
__device__ __forceinline__ void xcd_barrier_complete(unsigned* bar, unsigned x, unsigned& nloc, unsigned& nx) {
    const unsigned G = gridDim.x * gridDim.y * gridDim.z;
    unsigned sum, cnt, mine, sp = 0u;
    for (;;) {
        sum = 0u; cnt = 0u; mine = 0u;
#pragma unroll
        for (unsigned j = 0; j < 16; ++j) { const unsigned cc = xb_ld(&bar[XB_XCNT(j)]); sum += cc; cnt += (cc > 0u) ? 1u : 0u; mine = (j == x) ? cc : mine; }
        if (sum == G) break;
        __builtin_amdgcn_s_sleep(1);
        if ((++sp & 255u) == 0u) { if (xb_ld(&bar[XB_TMO])) break; if (sp > XB_SPIN_CAP) { atomicAdd(&bar[XB_TMO], 1u); break; } }
    }
    nloc = mine > 0u ? mine : 1u; nx = cnt > 0u ? cnt : 1u;
}
__device__ __forceinline__ void xcd_barrier(const XcdBarrier& b) {
    asm volatile("s_waitcnt vmcnt(0)" ::: "memory");
    __syncthreads();
    if (threadIdx.x == 0) {
        unsigned* bar = b.bar;
        __builtin_amdgcn_s_waitcnt(0);
        unsigned nloc = b.st[0], nx = b.st[1];
        if (nloc == 0u) { xcd_barrier_complete(bar, b.x, nloc, nx); b.st[0] = nloc; b.st[1] = nx; }
        const unsigned old = xb_add(&bar[XB_XSUB(b.x)], 1u);
        const unsigned gen = old / nloc;
        if (old + 1u == (gen + 1u) * nloc) {
            __builtin_amdgcn_fence(__ATOMIC_RELEASE, "agent");
            asm volatile("s_waitcnt vmcnt(0)" ::: "memory");
            const unsigned og = xb_add(&bar[XB_TOP], 1u);
            const unsigned tg = og / nx;
            if (og + 1u == (tg + 1u) * nx) xb_add(&bar[XB_TOPGEN], 1u);
            else XB_SPIN(xb_ld(&bar[XB_TOPGEN]) == tg, bar);
            __builtin_amdgcn_fence(__ATOMIC_ACQUIRE, "agent");
            xb_add(&bar[XB_XGEN(b.x)], 1u);
            asm volatile("s_waitcnt vmcnt(0)" ::: "memory");
        } else {
            XB_SPIN(xb_ld(&bar[XB_XGEN(b.x)]) == gen, bar);
            __builtin_amdgcn_fence(__ATOMIC_ACQUIRE, "agent");
            asm volatile("s_waitcnt vmcnt(0)" ::: "memory");
        }
    }
    __syncthreads();
}

constexpr int LDS_BYTES = 163840;
__global__ void __launch_bounds__(NTHREADS, 2) trunk_fwd(Params p) {
    extern __shared__ __attribute__((aligned(16))) unsigned char lds[];
    Ctx c; c.p = &p; c.d = make_dims(p.Bc, p.Tc, p.Bl, p.Tl); c.lds = lds;
    c.tid = threadIdx.x; c.lane = c.tid & 63; c.wave = __builtin_amdgcn_readfirstlane(c.tid >> 6);
    c.G = gridDim.x; { const int bx = blockIdx.x; c.vcu = (c.G % 8 == 0) ? (bx % 8) * (c.G / 8) + bx / 8 : bx; }
    volatile LAS unsigned* st = (volatile LAS unsigned*)((LAS unsigned char*)lds + LDS_BYTES - 64);
    XcdBarrier bar; bar.bar = nullptr; bar.x = 0; bar.st = st;
    if (p.use_bar) { if (c.tid < 2) st[c.tid] = 0u; __syncthreads(); bar = xcd_barrier_post((unsigned*)(p.ws) + CW_BAR, st); }
    for (int ph = p.ph_lo; ph < p.ph_hi; ++ph) {
        run_phase(c, ph);
        if (ph + 1 < p.ph_hi) xcd_barrier(bar);
    }
}

#ifndef N_LAUNCH_MODE
#define N_LAUNCH_MODE 0
#endif
extern "C" void kernel_launch(void* const* d_in, const int* in_sizes, int n_in, void* d_out, int out_size, void* d_ws, size_t ws_size, hipStream_t stream) {
    static int grid = 0;
    const Dims d = make_dims(32, 256, 8, 1024);
    if (grid == 0) {
        int dev = 0, cus = 0;
        if (n_in != N_INPUTS || (size_t)out_size != d.o_end || ws_size < ((size_t)d.w_end << 8)) { fprintf(stderr, "kernel_launch: unexpected sizes: n_in %d out %d ws %zu (need %zu / %zu)\n", n_in, out_size, ws_size, (size_t)d.o_end, (size_t)d.w_end << 8); grid = -1; return; }
        if (hipGetDevice(&dev) != hipSuccess || hipDeviceGetAttribute(&cus, hipDeviceAttributeMultiprocessorCount, dev) != hipSuccess) { grid = -1; return; }
        if (hipFuncSetAttribute((const void*)trunk_fwd, hipFuncAttributeMaxDynamicSharedMemorySize, LDS_BYTES) != hipSuccess) { fprintf(stderr, "kernel_launch: hipFuncSetAttribute failed\n"); grid = -1; return; }
        int per_cu = 0;
        if (hipOccupancyMaxActiveBlocksPerMultiprocessor(&per_cu, (const void*)trunk_fwd, NTHREADS, LDS_BYTES) != hipSuccess || per_cu < 1) fprintf(stderr, "kernel_launch: occupancy query says %d\n", per_cu);
        (void)hipGetLastError();
        grid = cus;
    }
    if (grid < 0) return;
    (void)hipMemsetAsync((char*)d_ws, 0, CTL_BYTES, stream);
    Params p{};
    for (int i = 0; i < N_INPUTS; ++i) p.in[i] = (const float*)d_in[i];
    p.out = (float*)d_out; p.ws = (unsigned char*)d_ws; p.Bc = 32; p.Tc = 256; p.Bl = 8; p.Tl = 1024;
#if N_LAUNCH_MODE == 1
    p.ph_lo = 0; p.ph_hi = N_PHASES; p.use_bar = 1;
    hipLaunchKernelGGL(trunk_fwd, dim3(grid), dim3(NTHREADS), LDS_BYTES, stream, p);
#else
    for (int ph = 0; ph < N_PHASES; ++ph) { p.ph_lo = ph; p.ph_hi = ph + 1; p.use_bar = 0; hipLaunchKernelGGL(trunk_fwd, dim3(grid), dim3(NTHREADS), LDS_BYTES, stream, p); }
#endif
}
#endif
```

```cpp
#ifndef CPU_EMU
#include <hip/hip_runtime.h>
#include <cstdio>
typedef float f32x16 __attribute__((ext_vector_type(16)));
typedef float f32x4 __attribute__((ext_vector_type(4)));
typedef float f32x2 __attribute__((ext_vector_type(2)));
typedef unsigned u32x4 __attribute__((ext_vector_type(4)));
typedef unsigned u32x2 __attribute__((ext_vector_type(2)));
#define LAS __attribute__((address_space(3)))
#define WAVE_SYNC() asm volatile("s_waitcnt lgkmcnt(0)" ::: "memory")
#else
#define LAS
#define WAVE_SYNC() emu::wave_sync()
#endif
#define UNR _Pragma("unroll")
typedef short bf16x8 __attribute__((ext_vector_type(8)));
typedef unsigned short bf16_t;

constexpr int D = 1024, NH = 4, HD = 64, MIXW = 256, NEXP = 16, FF = 2048, DEPTH = 2, PAST = 256, GRIDW = 64;
constexpr int NIN = 7920, NINP = 7936, NCF = 3840, NGATE = 4096, NMOD = 6 * D;
constexpr float ALPHA = 1.4142135623730951f, LN_EPS = 1e-5f;
constexpr int NTHREADS = 512, NWAVES = 8;
constexpr int CB_MQ = 0, CB_MK = 1, CB_MV = 2, CB_MO = 3, CB_GQ = 4, CB_GK = 5, CB_GV = 6, CB_GG = 7, CB_RR = 8, CB_RK = 9, CB_RV = 10, CB_NQ = 11, CB_NK = 12, CB_NV = 13;
constexpr int SM_MI = 3584, SM_MF = 3592, SM_GA = 3600, SM_RW = 3632, SM_RA = 3696, SM_RG = 3760;
enum { I_XP = 0, I_XS, I_SC, I_SN, I_SM, I_SG, I_SR, I_CK, I_CV, I_C, I_CCTX, I_WADA, I_BADA, I_WIN, I_BIG, I_BFG, I_WGLA, I_BGLA, I_SHIFT, I_W0, I_WW2, I_A0, I_WA2, I_WG2, I_KK, I_KA, I_RKK,
       I_RPB, I_WBR, I_WOUT, I_LNG, I_LNB, I_WROUTER, I_WUP, I_WDOWN, N_INPUTS };

__host__ __device__ __forceinline__ int win_col(int p) {
    if (p < 3584) { const int b = p >> 8, w = p & 255; const int base = b < 4 ? b * 256 : (b < 8 ? 1040 + (b - 4) * 256 : (b < 11 ? 2096 + (b - 8) * 256 : 3056 + (b - 11) * 256)); return base + w; }
    if (p < 3840) { const int s = p - 3584; return s < 16 ? 1024 + s : (s < 48 ? 2064 + (s - 16) : (s < 240 ? 2864 + (s - 48) : -1)); }
    return p - 16;
}

struct Params {
    const float* in[N_INPUTS];
    float* out; unsigned char* ws;
    int Bc, Tc, Bl, Tl;
    int ph_lo, ph_hi;
    int use_bar, pad;
};
struct Dims {
    int Bc, Tc, Bl, Tl, NTc, NTl, NT, capc, capl, RPE, TPE, NPR;
    unsigned o_yp, o_ys, o_C, o_n, o_m, o_g, o_r, o_nk, o_nv, o_end;
    unsigned w_ctl, w_win, w_wbr, w_wout, w_wup, w_wdn, w_mods, w_hb, w_cols, w_gates, w_br, w_scr, w_merged, w_v, w_aff, w_inv, w_pgate, w_xe, w_act, w_y, w_end;
};
constexpr size_t CTL_BYTES = 1u << 20;
constexpr int CW_BAR = 4096, CW_QUEUE = 1024;
__host__ __device__ __forceinline__ unsigned al256(size_t x) { return (unsigned)((x + 255) >> 8); }
__host__ __device__ __forceinline__ Dims make_dims(int Bc, int Tc, int Bl, int Tl) {
    Dims d; d.Bc = Bc; d.Tc = Tc; d.Bl = Bl; d.Tl = Tl; d.NTc = Bc * Tc; d.NTl = Bl * Tl; d.NT = d.NTc + d.NTl;
    d.capc = Tc / 8; d.capl = Tl / 8; d.RPE = ((Bc * d.capc + Bl * d.capl + 255) / 256) * 256; d.TPE = d.RPE / 256; d.NPR = NEXP * d.RPE;
    unsigned o = 0; d.o_yp = o; o += (unsigned)d.NTc * D; d.o_ys = o; o += (unsigned)d.NTl * D;
    d.o_C = o; o += (unsigned)Bc * DEPTH * 2 * NH * HD * HD; d.o_n = o; o += (unsigned)Bc * DEPTH * 2 * NH * HD; d.o_m = o; o += (unsigned)Bc * DEPTH * 2 * NH;
    d.o_g = o; o += (unsigned)Bc * DEPTH * 2 * NH * HD * HD; d.o_r = o; o += (unsigned)Bc * DEPTH * 2 * NH * HD * HD;
    d.o_nk = o; o += (unsigned)Bc * DEPTH * NH * Tc * HD; d.o_nv = o; o += (unsigned)Bc * DEPTH * NH * Tc * HD; d.o_end = o;
    unsigned w = 0; d.w_ctl = w; w += (unsigned)(CTL_BYTES >> 8);
    d.w_win = w; w += al256((size_t)DEPTH * NINP * D * 2); d.w_wbr = w; w += al256((size_t)DEPTH * D * D * 2); d.w_wout = w; w += al256((size_t)DEPTH * D * D * 2);
    d.w_wup = w; w += al256((size_t)DEPTH * NEXP * 2 * FF * D * 2); d.w_wdn = w; w += al256((size_t)DEPTH * NEXP * D * FF * 2);
    d.w_mods = w; w += al256((size_t)DEPTH * (1 + Bl) * NMOD * 4);
    d.w_hb = w; w += al256((size_t)d.NT * D * 2); d.w_cols = w; w += al256((size_t)d.NT * NCF * 4); d.w_gates = w; w += al256((size_t)d.NT * NGATE * 2);
    d.w_br = w; w += al256((size_t)d.NT * D * 2); d.w_scr = w; w += al256((size_t)d.NT * 4 * MIXW * 4); d.w_merged = w; w += al256((size_t)d.NT * D * 2);
    d.w_v = w; w += al256((size_t)d.NT * D * 4); d.w_aff = w; w += al256((size_t)d.NT * NEXP * 4); d.w_inv = w; w += al256((size_t)d.NT * NEXP * 4);
    d.w_pgate = w; w += al256((size_t)d.NPR * 4); d.w_xe = w; w += al256((size_t)d.NPR * D * 2); d.w_act = w; w += al256((size_t)d.NPR * FF * 2); d.w_y = w; w += al256((size_t)d.NPR * D * 4);
    d.w_end = w; return d;
}

__device__ __forceinline__ unsigned f2bf(float f) { unsigned u = __builtin_bit_cast(unsigned, f); return (u + 0x7fffu + ((u >> 16) & 1u)) >> 16; }
__device__ __forceinline__ unsigned pk2(float lo, float hi) { return f2bf(lo) | (f2bf(hi) << 16); }
__device__ __forceinline__ float sigmoidf_(float x) { return 1.0f / (1.0f + expf(-x)); }
__device__ __forceinline__ float logsigmoidf_(float x) { return fminf(x, 0.0f) - log1pf(expf(-fabsf(x))); }
__device__ __forceinline__ float softplusf_(float x) { return fmaxf(x, 0.0f) + log1pf(expf(-fabsf(x))); }
__device__ __forceinline__ float siluf_(float x) { return x / (1.0f + expf(-x)); }
__device__ __forceinline__ float wave_sum(float v) {
#pragma unroll
    for (int o = 1; o < 64; o <<= 1) v += __shfl_xor(v, o);
    return v;
}
__device__ __forceinline__ unsigned pkh2(float a, float b) { const _Float16 x = (_Float16)a, y = (_Float16)b; return (unsigned)__builtin_bit_cast(unsigned short, x) | ((unsigned)__builtin_bit_cast(unsigned short, y) << 16); }
#ifndef CPU_EMU
__device__ __forceinline__ float frcp(float x) { return __builtin_amdgcn_rcpf(x); }
#else
inline float frcp(float x) { return 1.0f / x; }
#endif
__device__ __forceinline__ float h2f(unsigned short h) { return (float)__builtin_bit_cast(_Float16, h); }

#ifndef CPU_EMU
__device__ __forceinline__ int opqv(int x) { asm volatile("" : "+v"(x)); return x; }
__device__ __forceinline__ int opqs(int x) { asm volatile("" : "+s"(x)); return x; }
#else
inline int opqv(int x) { return x; }
inline int opqs(int x) { return x; }
#endif
namespace pg8 {
constexpr int BM = 256, BK = 64, HALF = 128, HTB = HALF * BK * 2, STAGE_BYTES = 8 * HTB, NXCD = 8, WGM = 8;
__host__ __device__ __forceinline__ int lds_byte(int r, int c) { const int st = (r >> 4) * 2 + (c >> 5), rr = r & 15, cc = c & 31, ob = rr * 64 + cc * 2; return st * 1024 + (ob ^ (((ob >> 9) & 1) << 5)); }
__host__ __device__ __forceinline__ void stage_rc(int b, int& R, int& C) { const int st = b / 1024, sb = b % 1024, swz = sb ^ (((sb >> 9) & 1) << 5); R = (st >> 1) * 16 + swz / 64; C = (st & 1) * 32 + (swz % 64) / 2; }
struct Unit { int pm, pn, ta, tb; };
struct Gemm { const bf16_t* A; const bf16_t* Bt; int K; };
struct StaticOrder {
    int nM, nN, nwg, G, c;
    __device__ __forceinline__ void init(int M, int N, int G_, int c_) { nM = M / BM; nN = N / BM; nwg = nM * nN; G = G_; c = c_; }
    __device__ __forceinline__ bool next(int i, Unit& u) const {
        const long L = (long)i * G + c; if (L >= nwg) return false;
        int wgid = (int)L; { const int q = nwg / NXCD, r = nwg % NXCD, xcd = wgid % NXCD, off = wgid / NXCD; wgid = (xcd < r ? xcd * (q + 1) : r * (q + 1) + (xcd - r) * q) + off; }
        const int nig = WGM * nN, gid = wgid / nig, fm = gid * WGM, gsz = (nM - fm) < WGM ? (nM - fm) : WGM;
        u.pm = fm + ((wgid % nig) % gsz); u.pn = (wgid % nig) / gsz; u.ta = u.pm; u.tb = u.pn; return true;
    }
};
struct GroupOrder {
    int tpe, nN, nE, G, c;
    __device__ __forceinline__ void init(int tpe_, int nN_, int nE_, int G_, int c_) { tpe = tpe_; nN = nN_; nE = nE_; G = G_; c = c_; }
    __device__ __forceinline__ bool next(int i, Unit& u) const {
        const long L = (long)i * G + c; if (L >= (long)nE * tpe * nN) return false;
        const int per = tpe * nN, e = (int)(L / per), r = (int)(L % per), pn = r / tpe, pm = r % tpe;
        u.ta = e * tpe + pm; u.tb = e * nN + pn; u.pm = u.ta; u.pn = pn; return true;
    }
};
#ifndef CPU_EMU
template <class Epi, class Sched>
__device__ __forceinline__ void gemm_phase(LAS unsigned char* lds, const Gemm g, const Sched& S, const Epi& E) {
    const int tid = opqv((int)threadIdx.x), wid = __builtin_amdgcn_readfirstlane(tid >> 6), lane = tid & 63, wr = wid >> 2, wc = wid & 3, fr = lane & 15, fq = lane >> 4;
    const int K = g.K, nt = K / BK;
    unsigned voffA[2];
#pragma unroll
    for (int i = 0; i < 2; ++i) { int R, C; stage_rc(tid * 16 + i * 8192, R, C); voffA[i] = (unsigned)(R * K + C) * 2u; }
    const size_t kstep = (size_t)(BK * 2), hstep = (size_t)HALF * K * 2, tstep = 2 * hstep;
    const unsigned ldsw = (unsigned)wid * 1024u;
    const int aoff = lds_byte(wr * 64 + fr, fq * 8), boff = lds_byte(wc * 32 + fr, fq * 8);
#define PG8_SA(b, h) (((b) * 2 + (h)) * HTB)
#define PG8_SB(b, h) ((4 + (b) * 2 + (h)) * HTB)
#define PG8_STAGE(bufoff, gbase) do { _Pragma("unroll") for (int _i = 0; _i < 2; ++_i) \
        __builtin_amdgcn_global_load_lds((const unsigned*)((const char*)(gbase) + voffA[_i]), (LAS unsigned*)(lds + (bufoff) + ldsw + _i * 8192), 16, 0, 0); } while (0)
#define PG8_LDA(dst, b, h) do { _Pragma("unroll") for (int m = 0; m < 4; ++m) _Pragma("unroll") for (int k = 0; k < 2; ++k) dst[m][k] = *(const LAS bf16x8*)(lds + PG8_SA(b, h) + aoff + m * 2048 + k * 1024); } while (0)
#define PG8_LDB(dst, b, h) do { _Pragma("unroll") for (int n = 0; n < 2; ++n) _Pragma("unroll") for (int k = 0; k < 2; ++k) dst[n][k] = *(const LAS bf16x8*)(lds + PG8_SB(b, h) + boff + n * 2048 + k * 1024); } while (0)
#define PG8_MMA(ai, bj, At, Bt) do { __builtin_amdgcn_s_setprio(1); _Pragma("unroll") for (int m = 0; m < 4; ++m) _Pragma("unroll") for (int n = 0; n < 2; ++n) _Pragma("unroll") for (int k = 0; k < 2; ++k) \
        acc[ai][bj][m][n] = __builtin_amdgcn_mfma_f32_16x16x32_bf16(Bt[n][k], At[m][k], acc[ai][bj][m][n], 0, 0, 0); __builtin_amdgcn_s_setprio(0); } while (0)
#define PG8_WAIT_V(n) asm volatile("s_waitcnt vmcnt(" #n ")" ::: "memory")
#define PG8_WAIT_L(n) asm volatile("s_waitcnt lgkmcnt(" #n ")" ::: "memory")
#define PG8_BAR __builtin_amdgcn_s_barrier()
#define PG8_SCHED __builtin_amdgcn_sched_barrier(0)
    Unit cur, nxt; int ui = 0;
    if (!S.next(0, cur)) return;
    f32x4 acc[2][2][4][2];
#pragma unroll
    for (int a = 0; a < 2; ++a)
#pragma unroll
        for (int b = 0; b < 2; ++b)
#pragma unroll
            for (int m = 0; m < 4; ++m)
#pragma unroll
                for (int n = 0; n < 2; ++n) acc[a][b][m][n] = (f32x4){0.f, 0.f, 0.f, 0.f};
    bf16x8 At[4][2], B0[2][2], B1[2][2];
    const char* cA = (const char*)g.A + (size_t)cur.ta * tstep; const char* cB = (const char*)g.Bt + (size_t)cur.tb * tstep;
    PG8_STAGE(PG8_SB(0, 0), cB); PG8_STAGE(PG8_SB(0, 1), cB + hstep); PG8_STAGE(PG8_SA(0, 0), cA); PG8_STAGE(PG8_SA(0, 1), cA + hstep);
    if (wr == 1) PG8_BAR;
    PG8_WAIT_V(2); PG8_BAR;
    PG8_STAGE(PG8_SB(1, 0), cB + kstep); PG8_STAGE(PG8_SA(1, 0), cA + kstep); PG8_STAGE(PG8_SB(1, 1), cB + hstep + kstep);
    PG8_WAIT_V(6); PG8_BAR;
    for (;;) {
        const bool has_next = S.next(ui + 1, nxt);
        const char* nA = has_next ? (const char*)g.A + (size_t)nxt.ta * tstep : cA; const char* nB = has_next ? (const char*)g.Bt + (size_t)nxt.tb * tstep : cB;
        for (int t = 0; t < nt; t += 2) {
            const bool last = (t == nt - 2);
            const char* a1 = cA + (size_t)(t + 1) * kstep;
            const char* a2 = last ? nA : cA + (size_t)(t + 2) * kstep; const char* b2 = last ? nB : cB + (size_t)(t + 2) * kstep;
            const char* a3 = a2 + kstep; const char* b3 = b2 + kstep;
            if constexpr (Epi::MID) { if (t != 0 && (t & 3) == 0) E.mid(acc, cur, t >> 2, wr, wc, fr, fq); }
            PG8_LDB(B0, 0, 0); PG8_LDB(B1, 0, 1); PG8_SCHED; PG8_LDA(At, 0, 0); PG8_STAGE(PG8_SA(1, 1), a1 + hstep);
            PG8_WAIT_V(8); PG8_WAIT_L(0); PG8_BAR; PG8_MMA(0, 0, At, B0); PG8_MMA(0, 1, At, B1); PG8_BAR; PG8_SCHED;
            PG8_LDA(At, 0, 1); PG8_STAGE(PG8_SB(0, 0), b2); PG8_STAGE(PG8_SB(0, 1), b2 + hstep); PG8_STAGE(PG8_SA(0, 0), a2);
            PG8_WAIT_V(8); PG8_WAIT_L(0); PG8_BAR; PG8_MMA(1, 0, At, B0); PG8_MMA(1, 1, At, B1); PG8_BAR; PG8_SCHED;
            PG8_LDB(B0, 1, 0); PG8_LDB(B1, 1, 1); PG8_SCHED; PG8_LDA(At, 1, 0); PG8_STAGE(PG8_SA(0, 1), a2 + hstep);
            PG8_WAIT_V(8); PG8_WAIT_L(0); PG8_BAR; PG8_MMA(0, 0, At, B0); PG8_MMA(0, 1, At, B1); PG8_BAR; PG8_SCHED;
            PG8_LDA(At, 1, 1); PG8_STAGE(PG8_SB(1, 0), b3); PG8_STAGE(PG8_SB(1, 1), b3 + hstep); PG8_STAGE(PG8_SA(1, 0), a3);
            PG8_WAIT_V(8); PG8_WAIT_L(0); PG8_BAR; PG8_MMA(1, 0, At, B0); PG8_MMA(1, 1, At, B1); PG8_BAR; PG8_SCHED;
        }
        if (wr == 0) PG8_BAR;
        E(acc, cur, wr, wc, fr, fq);
        if (!has_next) break;
#pragma unroll
        for (int a = 0; a < 2; ++a)
#pragma unroll
            for (int b = 0; b < 2; ++b)
#pragma unroll
                for (int m = 0; m < 4; ++m)
#pragma unroll
                    for (int n = 0; n < 2; ++n) acc[a][b][m][n] = (f32x4){0.f, 0.f, 0.f, 0.f};
        cur = nxt; cA = nA; cB = nB; ++ui;
        if (wr == 1) PG8_BAR;
    }
    PG8_WAIT_V(0);
    PG8_BAR;
#undef PG8_SA
#undef PG8_SB
#undef PG8_STAGE
#undef PG8_LDA
#undef PG8_LDB
#undef PG8_MMA
#undef PG8_WAIT_V
#undef PG8_WAIT_L
#undef PG8_BAR
#undef PG8_SCHED
}
#else
template <class Epi, class Sched> void gemm_phase(unsigned char* lds, const Gemm g, const Sched& S, const Epi& E);
#endif
}
typedef f32x4 AccT[2][2][4][2];

struct Ctx {
    const Params* p; Dims d; unsigned char* lds; int tid, lane, wave, G, vcu;
    template <class T> __device__ __forceinline__ T* ws(unsigned off) const { return (T*)(p->ws + ((size_t)off << 8)); }
    __device__ __forceinline__ const float* in(int i) const { return p->in[i]; }
    __device__ __forceinline__ int modrow(int tok) const { return tok < d.NTc ? 0 : 1 + (tok - d.NTc) / d.Tl; }
    __device__ __forceinline__ const float* mods(int l) const { return ws<float>(d.w_mods) + (size_t)l * (1 + d.Bl) * NMOD; }
    __device__ __forceinline__ float* X() const { return p->out; }
};

__device__ __forceinline__ Ctx fresh(const Ctx& c0) {
    Ctx c; c.p = c0.p; c.lds = c0.lds; c.tid = opqv(c0.tid); c.lane = c.tid & 63; c.wave = opqs(c0.wave); c.G = opqs(c0.G); c.vcu = opqs(c0.vcu);
    c.d = make_dims(opqs(c0.p->Bc), opqs(c0.p->Tc), opqs(c0.p->Bl), opqs(c0.p->Tl)); return c;
}

struct EpiCols {
    static constexpr bool MID = false;
    float* cols; unsigned short* gates;
    __device__ __forceinline__ void operator()(const AccT& acc, const pg8::Unit& u, int wr, int wc, int fr, int fq) const {
        const int row0 = u.pm * 256 + wr * 64 + fr;
        if (u.pn < 15) {
            const int col0 = u.pn * 256 + wc * 32 + 4 * fq;
#pragma unroll
            for (int ai = 0; ai < 2; ++ai)
#pragma unroll
                for (int m = 0; m < 4; ++m) { float* rp = cols + (size_t)(row0 + ai * 128 + m * 16) * NCF + col0;
#pragma unroll
                    for (int bj = 0; bj < 2; ++bj)
#pragma unroll
                        for (int n = 0; n < 2; ++n) *(f32x4*)(rp + bj * 128 + n * 16) = acc[ai][bj][m][n]; }
        } else {
            const int col0 = (u.pn - 15) * 256 + wc * 32 + 4 * fq;
#pragma unroll
            for (int ai = 0; ai < 2; ++ai)
#pragma unroll
                for (int m = 0; m < 4; ++m) { unsigned short* rp = gates + (size_t)(row0 + ai * 128 + m * 16) * NGATE + col0;
#pragma unroll
                    for (int bj = 0; bj < 2; ++bj)
#pragma unroll
                        for (int n = 0; n < 2; ++n) { const f32x4 a = acc[ai][bj][m][n]; u32x2 w;
                            w.x = pkh2(fmaxf(sigmoidf_(a[0]), 6.2e-5f), fmaxf(sigmoidf_(a[1]), 6.2e-5f)); w.y = pkh2(fmaxf(sigmoidf_(a[2]), 6.2e-5f), fmaxf(sigmoidf_(a[3]), 6.2e-5f));
                            *(u32x2*)(rp + bj * 128 + n * 16) = w; } }
        }
    }
};
struct EpiWiden {
    static constexpr bool MID = true;
    const unsigned short* gates; bf16_t* merged;
    __device__ __forceinline__ void mid(AccT& acc, const pg8::Unit& u, int z1, int wr, int wc, int fr, int fq) const {
        const int row0 = opqv(u.pm * 256 + wr * 64 + fr), col0 = opqv(u.pn * 256 + wc * 32 + 4 * fq);
#pragma unroll
        for (int ai = 0; ai < 2; ++ai)
#pragma unroll
            for (int m = 0; m < 4; ++m) { const unsigned short* rp = gates + (size_t)(row0 + ai * 128 + m * 16) * NGATE + col0;
#pragma unroll
                for (int bj = 0; bj < 2; ++bj)
#pragma unroll
                    for (int n = 0; n < 2; ++n) { const u32x2 a = *(const u32x2*)(rp + (z1 - 1) * 1024 + bj * 128 + n * 16), b = *(const u32x2*)(rp + z1 * 1024 + bj * 128 + n * 16);
                        f32x4 r; r[0] = h2f(a.x & 0xffff) * frcp(h2f(b.x & 0xffff)); r[1] = h2f(a.x >> 16) * frcp(h2f(b.x >> 16)); r[2] = h2f(a.y & 0xffff) * frcp(h2f(b.y & 0xffff)); r[3] = h2f(a.y >> 16) * frcp(h2f(b.y >> 16));
                        acc[ai][bj][m][n] *= r;
#ifndef CPU_EMU
                        asm volatile("" ::: "memory");
#endif
                    } }
    }
    __device__ __forceinline__ void operator()(const AccT& acc, const pg8::Unit& u, int wr, int wc, int fr, int fq) const {
        const int row0 = u.pm * 256 + wr * 64 + fr, col0 = u.pn * 256 + wc * 32 + 4 * fq;
#pragma unroll
        for (int ai = 0; ai < 2; ++ai)
#pragma unroll
            for (int m = 0; m < 4; ++m) { const size_t ro = (size_t)(row0 + ai * 128 + m * 16);
#pragma unroll
                for (int bj = 0; bj < 2; ++bj)
#pragma unroll
                    for (int n = 0; n < 2; ++n) { const u32x2 b = *(const u32x2*)(gates + ro * NGATE + 3 * 1024 + col0 + bj * 128 + n * 16); const f32x4 a = acc[ai][bj][m][n]; u32x2 w;
                        w.x = pk2(a[0] * h2f(b.x & 0xffff), a[1] * h2f(b.x >> 16)); w.y = pk2(a[2] * h2f(b.y & 0xffff), a[3] * h2f(b.y >> 16));
                        *(u32x2*)(merged + ro * D + col0 + bj * 128 + n * 16) = w; } }
    }
};
struct EpiPreLN {
    static constexpr bool MID = false;
    const float* x; const float* mods; float* v; int NTc, Tl;
    __device__ __forceinline__ void operator()(const AccT& acc, const pg8::Unit& u, int wr, int wc, int fr, int fq) const {
        const int row0 = u.pm * 256 + wr * 64 + fr, col0 = u.pn * 256 + wc * 32 + 4 * fq;
#pragma unroll
        for (int ai = 0; ai < 2; ++ai)
#pragma unroll
            for (int m = 0; m < 4; ++m) { const int row = row0 + ai * 128 + m * 16; const int mr = row < NTc ? 0 : 1 + (row - NTc) / Tl; const float* g1 = mods + (size_t)mr * NMOD + 2 * D + col0;
                const size_t ro = (size_t)row * D + col0;
#pragma unroll
                for (int bj = 0; bj < 2; ++bj)
#pragma unroll
                    for (int n = 0; n < 2; ++n) { const int o = bj * 128 + n * 16; const f32x4 xv = *(const f32x4*)(x + ro + o), gv = *(const f32x4*)(g1 + o);
                        *(f32x4*)(v + ro + o) = ALPHA * xv + gv * acc[ai][bj][m][n]; } }
    }
};
struct EpiSwiGLU {
    static constexpr bool MID = false;
    bf16_t* act;
    __device__ __forceinline__ void operator()(const AccT& acc, const pg8::Unit& u, int wr, int wc, int fr, int fq) const {
        const int row0 = u.pm * 256 + wr * 64 + fr, col0 = u.pn * 128 + wc * 32 + 4 * fq;
#pragma unroll
        for (int ai = 0; ai < 2; ++ai)
#pragma unroll
            for (int m = 0; m < 4; ++m) { bf16_t* rp = act + (size_t)(row0 + ai * 128 + m * 16) * FF + col0;
#pragma unroll
                for (int n = 0; n < 2; ++n) { const f32x4 a = acc[ai][0][m][n], b = acc[ai][1][m][n]; u32x2 w;
                    w.x = pk2(siluf_(a[0]) * b[0], siluf_(a[1]) * b[1]); w.y = pk2(siluf_(a[2]) * b[2], siluf_(a[3]) * b[3]); *(u32x2*)(rp + n * 16) = w; } }
    }
};
struct EpiDown {
    static constexpr bool MID = false;
    const float* pgate; float* y;
    __device__ __forceinline__ void operator()(const AccT& acc, const pg8::Unit& u, int wr, int wc, int fr, int fq) const {
        const int row0 = u.pm * 256 + wr * 64 + fr, col0 = u.pn * 256 + wc * 32 + 4 * fq;
#pragma unroll
        for (int ai = 0; ai < 2; ++ai)
#pragma unroll
            for (int m = 0; m < 4; ++m) { const int row = row0 + ai * 128 + m * 16; const float gt = pgate[row]; float* rp = y + (size_t)row * D + col0;
#pragma unroll
                for (int bj = 0; bj < 2; ++bj)
#pragma unroll
                    for (int n = 0; n < 2; ++n) *(f32x4*)(rp + bj * 128 + n * 16) = gt * acc[ai][bj][m][n]; }
    }
};

template <class ColMap>
__device__ __forceinline__ void tr_item(const float* src, int src_ld, const ColMap& cm, bf16_t* dst, int dst_ld, int dst_koff, int n0, int k0, float* scr, int lane) {
    const int sc = cm(n0 + (lane & 31));
#pragma unroll 8
    for (int i = 0; i < 32; ++i) { const int kk = 2 * i + (lane >> 5); scr[kk * 33 + (lane & 31)] = sc >= 0 ? src[(size_t)(k0 + kk) * src_ld + sc] : 0.0f; }
    WAVE_SYNC();
    const int c = lane & 7;
#pragma unroll
    for (int j = 0; j < 4; ++j) { const int n = (lane >> 3) + 8 * j; const float* s = scr + (8 * c) * 33 + n;
        u32x4 o; o.x = pk2(s[0 * 33], s[1 * 33]); o.y = pk2(s[2 * 33], s[3 * 33]); o.z = pk2(s[4 * 33], s[5 * 33]); o.w = pk2(s[6 * 33], s[7 * 33]);
        *(u32x4*)(dst + (size_t)(n0 + n) * dst_ld + dst_koff + k0 + 8 * c) = o; }
    WAVE_SYNC();
}
struct CmId { __device__ __forceinline__ int operator()(int n) const { return n; } };
struct CmWin { __device__ __forceinline__ int operator()(int n) const { return win_col(n); } };
struct CmUp { __device__ __forceinline__ int operator()(int n) const { const int u = n >> 8, w = n & 255; return (w < 128 ? 0 : FF) + u * 128 + (w & 127); } };

__device__ __forceinline__ void phase_prep(const Ctx& c0) {
    const Ctx c = fresh(c0);
    const Dims& d = c.d;
    float* L = (float*)c.lds;
    const int nrow = 1 + d.Bl;
    const int gw = c.vcu * NWAVES + c.wave, NGW = c.G * NWAVES;
    const int nmod_items = DEPTH * (NMOD / 64);
    if (c.vcu < nmod_items) {
        float* cond = L + NWAVES * 2112;
        for (int i = c.tid; i < 9 * D; i += NTHREADS) { const int r = i / D, k = i % D; const float v = r == 0 ? c.in(I_CCTX)[k] : (r < nrow ? c.in(I_C)[(size_t)(r - 1) * D + k] : 0.0f); cond[i] = siluf_(v); }
        __syncthreads();
        if (c.wave == 0) {
            const int l = c.vcu / (NMOD / 64), j = (c.vcu % (NMOD / 64)) * 64 + c.lane;
            const float* w = c.in(I_WADA) + (size_t)l * D * NMOD + j;
            float* mo = c.ws<float>(d.w_mods) + (size_t)l * nrow * NMOD + j;
            const float bias = c.in(I_BADA)[(size_t)l * NMOD + j];
            float a[9];
            UNR for (int r = 0; r < 9; ++r) a[r] = bias;
#pragma unroll 4
            for (int k = 0; k < D; ++k) { const float wv = w[(size_t)k * NMOD]; UNR for (int r = 0; r < 9; ++r) a[r] += cond[r * D + k] * wv; }
            UNR for (int r = 0; r < 9; ++r) if (r < nrow) mo[(size_t)r * NMOD] = a[r];
        }
    }
    float* scr = L + c.wave * 2112;
    const int I_IN = (D / 64) * (NINP / 32), I_BR = 4 * (MIXW / 64) * (D / 32), I_OUT = (D / 64) * (D / 32), I_UP = NEXP * (D / 64) * (2 * FF / 32), I_DN = NEXP * (FF / 64) * (D / 32);
    const int PER_L = I_IN + I_BR + I_OUT + I_UP + I_DN;
    for (int it = gw; it < DEPTH * PER_L; it += NGW) {
        const int l = it / PER_L; int r = it % PER_L;
        if (r < I_IN) { const int nb = NINP / 32, kb = r / nb, n0 = (r % nb) * 32;
            tr_item(c.in(I_WIN) + (size_t)l * D * NIN, NIN, CmWin(), c.ws<bf16_t>(d.w_win) + (size_t)l * NINP * D, D, 0, n0, kb * 64, scr, c.lane); continue; } r -= I_IN;
        if (r < I_BR) { const int per = (MIXW / 64) * (D / 32), z = r / per, q = r % per, kb = q / (D / 32), n0 = (q % (D / 32)) * 32;
            tr_item(c.in(I_WBR) + ((size_t)l * 4 + z) * MIXW * D, D, CmId(), c.ws<bf16_t>(d.w_wbr) + (size_t)l * D * D, D, z * MIXW, n0, kb * 64, scr, c.lane); continue; } r -= I_BR;
        if (r < I_OUT) { const int kb = r / (D / 32), n0 = (r % (D / 32)) * 32;
            tr_item(c.in(I_WOUT) + (size_t)l * D * D, D, CmId(), c.ws<bf16_t>(d.w_wout) + (size_t)l * D * D, D, 0, n0, kb * 64, scr, c.lane); continue; } r -= I_OUT;
        if (r < I_UP) { const int per = (D / 64) * (2 * FF / 32), e = r / per, q = r % per, kb = q / (2 * FF / 32), n0 = (q % (2 * FF / 32)) * 32;
            tr_item(c.in(I_WUP) + ((size_t)l * NEXP + e) * D * 2 * FF, 2 * FF, CmUp(), c.ws<bf16_t>(d.w_wup) + ((size_t)l * NEXP + e) * 2 * FF * D, D, 0, n0, kb * 64, scr, c.lane); continue; } r -= I_UP;
        { const int per = (FF / 64) * (D / 32), e = r / per, q = r % per, kb = q / (D / 32), n0 = (q % (D / 32)) * 32;
            tr_item(c.in(I_WDOWN) + ((size_t)l * NEXP + e) * FF * D, D, CmId(), c.ws<bf16_t>(d.w_wdn) + ((size_t)l * NEXP + e) * D * FF, FF, 0, n0, kb * 64, scr, c.lane); }
    }
}

__device__ __forceinline__ void phase_init(const Ctx& c0) {
    const Ctx c = fresh(c0);
    const Dims& d = c.d; const float* mods = c.mods(0); bf16_t* hb = c.ws<bf16_t>(d.w_hb);
    const int gw = c.vcu * NWAVES + c.wave, NGW = c.G * NWAVES;
    for (int tok = gw; tok < d.NT; tok += NGW) {
        const float* xr = tok < d.NTc ? c.in(I_XP) + (size_t)tok * D : c.in(I_XS) + (size_t)(tok - d.NTc) * D;
        const float* mr = mods + (size_t)c.modrow(tok) * NMOD;
#pragma unroll
        for (int j = 0; j < 4; ++j) { const int col = 4 * c.lane + 256 * j; const f32x4 x = *(const f32x4*)(xr + col), sh = *(const f32x4*)(mr + col), sc = *(const f32x4*)(mr + D + col);
            *(f32x4*)(c.X() + (size_t)tok * D + col) = x; const f32x4 h = x * (1.0f + sc) + sh;
            u32x2 w; w.x = pk2(h[0], h[1]); w.y = pk2(h[2], h[3]); *(u32x2*)(hb + (size_t)tok * D + col) = w; }
    }
}

__device__ __forceinline__ f32x16 mm32(int lane, f32x16 acc, const float* A, int sai, int sak, const float* Bm, int sbk, int sbj, int K) {
    const int i = lane & 31, kk = lane >> 5;
    const float* ap = A + i * sai + kk * sak; const float* bp = Bm + kk * sbk + i * sbj;
#pragma unroll 8
    for (int k = 0; k < K; k += 2) acc = __builtin_amdgcn_mfma_f32_32x32x2f32(ap[k * sak], bp[k * sbk], acc, 0, 0, 0);
    return acc;
}
#define ACC_ROW(r, lane) (((r) & 3) + 8 * ((r) >> 2) + 4 * ((lane) >> 5))
__device__ __forceinline__ f32x16 zero16() { f32x16 z; UNR for (int r = 0; r < 16; ++r) z[r] = 0.0f; return z; }
constexpr int S65 = 65, MSZ = 64 * 65;

__device__ __forceinline__ void build_rope(float* cosT, float* sinT, int tid) {
    for (int i = tid; i < 1024; i += NTHREADS) { const int pos = i >> 4, f = i & 15; const float inv = powf(10000.0f, -(float)f / 16.0f); const float ang = (float)pos * inv; cosT[i] = cosf(ang); sinT[i] = sinf(ang); }
}
__device__ __forceinline__ float rope_elem(const float* rowp, int dd, int t, const float* cosT, const float* sinT) {
    const int f = dd & 15, second = (dd >> 4) & 1, pos = (dd < 32) ? (t / GRIDW) : (t % GRIDW);
    const float x = rowp[dd], xp = rowp[second ? dd - 16 : dd + 16], cs = cosT[pos * 16 + f], sn = sinT[pos * 16 + f];
    return second ? (xp * sn + x * cs) : (x * cs - xp * sn);
}

__device__ __forceinline__ void mix_mlstm(const Ctx& c0, int l, int pass, int b, int h) {
    const Ctx c = fresh(c0);
    const Dims& d = c.d; const int T = pass ? d.Tl : d.Tc, tok0 = pass ? d.NTc + b * d.Tl : b * d.Tc, nc = T / 64, tid = c.tid, lane = c.lane, wave = c.wave;
    float* L = (float*)c.lds;
    float *Q = L, *K = L + MSZ, *V = L + 2 * MSZ, *C = L + 3 * MSZ, *Sm = L + 4 * MSZ, *QC = L + 5 * MSZ, *vec = L + 6 * MSZ;
    float *nv = vec, *ig = vec + 64, *lf = vec + 128, *bc = vec + 192, *lw = vec + 256, *wint = vec + 320, *rden = vec + 384, *scal = vec + 448, *cosT = vec + 512, *sinT = vec + 512 + 1024;
    const float* cols = c.ws<float>(d.w_cols); float* scr = c.ws<float>(d.w_scr); bf16_t* br = c.ws<bf16_t>(d.w_br);
    if (pass) build_rope(cosT, sinT, tid);
    for (int dir = 1; dir >= 0; --dir) {
        __syncthreads();
        if (pass) {
            const float* C0 = c.in(I_SC) + ((((size_t)b * DEPTH + l) * 2 + dir) * NH + h) * HD * HD;
            _Pragma("unroll 2") for (int i = tid; i < 4096; i += NTHREADS) C[(i >> 6) * S65 + (i & 63)] = C0[i];
            if (tid < 64) nv[tid] = c.in(I_SN)[((((size_t)b * DEPTH + l) * 2 + dir) * NH + h) * HD + tid];
            if (tid == 0) scal[0] = c.in(I_SM)[(((size_t)b * DEPTH + l) * 2 + dir) * NH + h];
        } else {
            _Pragma("unroll 2") for (int i = tid; i < 4096; i += NTHREADS) C[(i >> 6) * S65 + (i & 63)] = 0.0f;
            if (tid < 64) nv[tid] = 0.0f;
            if (tid == 0) scal[0] = 0.0f;
        }
        const float big = c.in(I_BIG)[((size_t)l * 2 + dir) * NH + h], bfg = c.in(I_BFG)[((size_t)l * 2 + dir) * NH + h];
        for (int ci = 0; ci < nc; ++ci) {
            _Pragma("unroll 2") for (int i = tid; i < 4096; i += NTHREADS) { const int j = i >> 6, dd = i & 63, t = dir ? T - 1 - (ci * 64 + j) : ci * 64 + j; const float* rp = cols + (size_t)(tok0 + t) * NCF + h * 64;
                float q, k; if (pass) { q = rope_elem(rp + CB_MQ * 256, dd, t, cosT, sinT); k = rope_elem(rp + CB_MK * 256, dd, t, cosT, sinT); } else { q = rp[CB_MQ * 256 + dd]; k = rp[CB_MK * 256 + dd]; }
                Q[j * S65 + dd] = q; K[j * S65 + dd] = k * 0.125f; V[j * S65 + dd] = rp[CB_MV * 256 + dd]; }
            if (tid < 64) { const int t = dir ? T - 1 - (ci * 64 + tid) : ci * 64 + tid; const float* rp = cols + (size_t)(tok0 + t) * NCF;
                ig[tid] = rp[SM_MI + dir * 4 + h] + big; lf[tid] = logsigmoidf_(rp[SM_MF + dir * 4 + h] + bfg); }
            __syncthreads();
            if (tid == 0) { float run = 0.0f; for (int j = 0; j < 64; ++j) { run += lf[j]; bc[j] = run; } const float bend = run, m = scal[0]; float mx = -3.0e38f;
                for (int j = 0; j < 64; ++j) { const float w = bend - bc[j] + ig[j]; lw[j] = w; mx = fmaxf(mx, w); }
                const float mnew = fmaxf(bend + m, mx); scal[1] = mnew; scal[2] = expf(bend + m - mnew); }
            { const int ti = (wave >> 1) & 1, tj = wave & 1; f32x16 acc = zero16();
              if (wave < 4) { acc = mm32(lane, acc, Q + ti * 32 * S65, S65, 1, K + tj * 32 * S65, 1, S65, 64); UNR for (int r = 0; r < 16; ++r) Sm[(ti * 32 + ACC_ROW(r, lane)) * S65 + tj * 32 + (lane & 31)] = acc[r]; }
              else { acc = mm32(lane, acc, Q + ti * 32 * S65, S65, 1, C + tj * 32, S65, 1, 64); UNR for (int r = 0; r < 16; ++r) QC[(ti * 32 + ACC_ROW(r, lane)) * S65 + tj * 32 + (lane & 31)] = acc[r]; } }
            __syncthreads();
            { const int t = tid >> 3, g = tid & 7; const float m = scal[0], mnew = scal[1], bt = bc[t]; float mx = -3.0e38f;
              for (int s = g * 8; s < g * 8 + 8; ++s) if (s <= t) mx = fmaxf(mx, bt - bc[s] + ig[s]);
              mx = fmaxf(mx, __shfl_xor(mx, 1)); mx = fmaxf(mx, __shfl_xor(mx, 2)); mx = fmaxf(mx, __shfl_xor(mx, 4));
              const float minter = bt + m, mt = fmaxf(minter, mx); float den = 0.0f, qn = 0.0f;
              for (int s = g * 8; s < g * 8 + 8; ++s) { float sv = 0.0f; if (s <= t) sv = Sm[t * S65 + s] * expf(bt - bc[s] + ig[s] - mt); Sm[t * S65 + s] = sv; den += sv; qn += Q[t * S65 + s] * nv[s]; }
              den += __shfl_xor(den, 1); den += __shfl_xor(den, 2); den += __shfl_xor(den, 4); qn += __shfl_xor(qn, 1); qn += __shfl_xor(qn, 2); qn += __shfl_xor(qn, 4);
              const float wi = expf(minter - mt); den += wi * qn;
              if (g == 0) { wint[t] = wi; rden[t] = 1.0f / fmaxf(fabsf(den), expf(-mt)); }
              const float ks = expf(lw[t] - mnew); for (int s = g * 8; s < g * 8 + 8; ++s) K[t * S65 + s] *= ks; }
            __syncthreads();
            { const int ti = (wave >> 1) & 1, tj = wave & 1;
              if (wave < 4) { f32x16 acc = zero16(); acc = mm32(lane, acc, Sm + ti * 32 * S65, S65, 1, V + tj * 32, S65, 1, 64);
                  UNR for (int r = 0; r < 16; ++r) { const int row = ti * 32 + ACC_ROW(r, lane), o = row * S65 + tj * 32 + (lane & 31); QC[o] = (acc[r] + wint[row] * QC[o]) * rden[row]; } }
              else { const float carry = scal[2]; f32x16 acc; UNR for (int r = 0; r < 16; ++r) acc[r] = carry * C[(ti * 32 + ACC_ROW(r, lane)) * S65 + tj * 32 + (lane & 31)];
                  acc = mm32(lane, acc, K + ti * 32, 1, S65, V + tj * 32, S65, 1, 64);
                  UNR for (int r = 0; r < 16; ++r) C[(ti * 32 + ACC_ROW(r, lane)) * S65 + tj * 32 + (lane & 31)] = acc[r]; } }
            __syncthreads();
            if (tid < 64) { float s = 0.0f; for (int j = 0; j < 64; ++j) s += K[j * S65 + tid]; nv[tid] = scal[2] * nv[tid] + s; }
            { const int j = tid >> 3, g = tid & 7, t = dir ? T - 1 - (ci * 64 + j) : ci * 64 + j; const size_t tok = (size_t)(tok0 + t); float* sp = scr + (tok * 4 + 0) * MIXW + h * 64 + g * 8;
              if (dir) { UNR for (int e = 0; e < 8; ++e) sp[e] = QC[j * S65 + g * 8 + e]; }
              else { float x[8], s = 0.0f; UNR for (int e = 0; e < 8; ++e) { x[e] = QC[j * S65 + g * 8 + e] + sp[e]; s += x[e]; }
                  s += __shfl_xor(s, 1); s += __shfl_xor(s, 2); s += __shfl_xor(s, 4); const float mean = s * (1.0f / 64.0f); float q = 0.0f;
                  UNR for (int e = 0; e < 8; ++e) { x[e] -= mean; q += x[e] * x[e]; }
                  q += __shfl_xor(q, 1); q += __shfl_xor(q, 2); q += __shfl_xor(q, 4); const float rs = 1.0f / sqrtf(q * (1.0f / 64.0f) + LN_EPS);
                  const float* og = cols + tok * NCF + CB_MO * 256 + h * 64 + g * 8; bf16_t* bp = br + tok * D + 0 * MIXW + h * 64 + g * 8;
                  u32x4 w; w.x = pk2(x[0] * rs * sigmoidf_(og[0]), x[1] * rs * sigmoidf_(og[1])); w.y = pk2(x[2] * rs * sigmoidf_(og[2]), x[3] * rs * sigmoidf_(og[3]));
                  w.z = pk2(x[4] * rs * sigmoidf_(og[4]), x[5] * rs * sigmoidf_(og[5])); w.w = pk2(x[6] * rs * sigmoidf_(og[6]), x[7] * rs * sigmoidf_(og[7])); *(u32x4*)bp = w; } }
            __syncthreads();
            if (tid == 0) scal[0] = scal[1];
        }
        __syncthreads();
        if (!pass) {
            float* Co = c.p->out + d.o_C + ((((size_t)b * DEPTH + l) * 2 + dir) * NH + h) * HD * HD;
            _Pragma("unroll 2") for (int i = tid; i < 4096; i += NTHREADS) Co[i] = C[(i >> 6) * S65 + (i & 63)];
            if (tid < 64) c.p->out[d.o_n + ((((size_t)b * DEPTH + l) * 2 + dir) * NH + h) * HD + tid] = nv[tid];
            if (tid == 0) c.p->out[d.o_m + (((size_t)b * DEPTH + l) * 2 + dir) * NH + h] = scal[0];
        }
        __threadfence();
    }
    __syncthreads();
}

__device__ __forceinline__ void mix_gla(const Ctx& c0, int l, int pass, int b, int h) {
    const Ctx c = fresh(c0);
    const Dims& d = c.d; const int T = pass ? d.Tl : d.Tc, tok0 = pass ? d.NTc + b * d.Tl : b * d.Tc, nc = T / 64, tid = c.tid, lane = c.lane, wave = c.wave;
    float* L = (float*)c.lds;
    float *Q = L, *K = L + MSZ, *V = L + 2 * MSZ, *S = L + 3 * MSZ, *Gm = L + 4 * MSZ, *O2 = L + 5 * MSZ, *vec = L + 6 * MSZ;
    float *gend = vec, *bA = vec + 64, *wA = vec + 128, *cosT = vec + 128 + 1024, *sinT = vec + 128 + 2048;
    const float* cols = c.ws<float>(d.w_cols); float* scr = c.ws<float>(d.w_scr); bf16_t* br = c.ws<bf16_t>(d.w_br);
    if (pass) build_rope(cosT, sinT, tid);
    for (int dir = 1; dir >= 0; --dir) {
        __syncthreads();
        if (pass) { const float* S0 = c.in(I_SG) + ((((size_t)b * DEPTH + l) * 2 + dir) * NH + h) * HD * HD; _Pragma("unroll 2") for (int i = tid; i < 4096; i += NTHREADS) S[(i >> 6) * S65 + (i & 63)] = S0[i]; }
        else _Pragma("unroll 2") for (int i = tid; i < 4096; i += NTHREADS) S[(i >> 6) * S65 + (i & 63)] = 0.0f;
        for (int i = tid; i < 1024; i += NTHREADS) wA[i] = c.in(I_WGLA)[(((size_t)l * 2 + dir) * 16 + (i >> 6)) * MIXW + h * 64 + (i & 63)];
        if (tid < 64) bA[tid] = c.in(I_BGLA)[((size_t)l * 2 + dir) * MIXW + h * 64 + tid];
        __syncthreads();
        for (int ci = 0; ci < nc; ++ci) {
            _Pragma("unroll 2") for (int i = tid; i < 4096; i += NTHREADS) { const int j = i >> 6, dd = i & 63, t = dir ? T - 1 - (ci * 64 + j) : ci * 64 + j; const float* rp = cols + (size_t)(tok0 + t) * NCF;
                const float* hp = rp + h * 64; float q, k; if (pass) { q = rope_elem(hp + CB_GQ * 256, dd, t, cosT, sinT); k = rope_elem(hp + CB_GK * 256, dd, t, cosT, sinT); } else { q = hp[CB_GQ * 256 + dd]; k = hp[CB_GK * 256 + dd]; }
                Q[j * S65 + dd] = q * 0.125f; K[j * S65 + dd] = k; V[j * S65 + dd] = hp[CB_GV * 256 + dd];
                float a = bA[dd]; const float* ga = rp + SM_GA + dir * 16; UNR for (int r = 0; r < 16; ++r) a += ga[r] * wA[r * 64 + dd];
                Gm[j * S65 + dd] = logsigmoidf_(a) * (1.0f / 16.0f); }
            __syncthreads();
            if (tid < 64) { float run = 0.0f; for (int j = 0; j < 64; ++j) { run += Gm[j * S65 + tid]; Gm[j * S65 + tid] = run; } gend[tid] = run; }
            __syncthreads();
            _Pragma("unroll 2") for (int i = tid; i < 4096; i += NTHREADS) { const int o = (i >> 6) * S65 + (i & 63); const float g = Gm[o]; Q[o] *= expf(g); K[o] *= expf(-g); }
            __syncthreads();
            { const int ti = (wave >> 1) & 1, tj = wave & 1; f32x16 acc = zero16();
              if (wave < 4) { acc = mm32(lane, acc, Q + ti * 32 * S65, S65, 1, K + tj * 32 * S65, 1, S65, 64);
                  UNR for (int r = 0; r < 16; ++r) { const int row = ti * 32 + ACC_ROW(r, lane), col = tj * 32 + (lane & 31); Gm[row * S65 + col] = col <= row ? acc[r] : 0.0f; } }
              else { acc = mm32(lane, acc, Q + ti * 32 * S65, S65, 1, S + tj * 32, S65, 1, 64); UNR for (int r = 0; r < 16; ++r) O2[(ti * 32 + ACC_ROW(r, lane)) * S65 + tj * 32 + (lane & 31)] = acc[r]; } }
            __syncthreads();
            { const int ti = (wave >> 1) & 1, tj = wave & 1;
              if (wave < 4) { f32x16 acc; UNR for (int r = 0; r < 16; ++r) acc[r] = O2[(ti * 32 + ACC_ROW(r, lane)) * S65 + tj * 32 + (lane & 31)];
                  acc = mm32(lane, acc, Gm + ti * 32 * S65, S65, 1, V + tj * 32, S65, 1, 64);
                  UNR for (int r = 0; r < 16; ++r) O2[(ti * 32 + ACC_ROW(r, lane)) * S65 + tj * 32 + (lane & 31)] = acc[r]; }
              else { f32x16 acc; UNR for (int r = 0; r < 16; ++r) acc[r] = S[(ti * 32 + ACC_ROW(r, lane)) * S65 + tj * 32 + (lane & 31)];
                  acc = mm32(lane, acc, K + ti * 32, 1, S65, V + tj * 32, S65, 1, 64);
                  UNR for (int r = 0; r < 16; ++r) { const int row = ti * 32 + ACC_ROW(r, lane); S[row * S65 + tj * 32 + (lane & 31)] = expf(gend[row]) * acc[r]; } } }
            __syncthreads();
            { const int j = tid >> 3, g = tid & 7, t = dir ? T - 1 - (ci * 64 + j) : ci * 64 + j; const size_t tok = (size_t)(tok0 + t); float* sp = scr + (tok * 4 + 1) * MIXW + h * 64 + g * 8;
              if (dir) { UNR for (int e = 0; e < 8; ++e) sp[e] = O2[j * S65 + g * 8 + e]; }
              else { float x[8], q = 0.0f; UNR for (int e = 0; e < 8; ++e) { x[e] = O2[j * S65 + g * 8 + e] + sp[e]; q += x[e] * x[e]; }
                  q += __shfl_xor(q, 1); q += __shfl_xor(q, 2); q += __shfl_xor(q, 4); const float rs = 1.0f / sqrtf(q * (1.0f / 64.0f) + LN_EPS);
                  const float* og = cols + tok * NCF + CB_GG * 256 + h * 64 + g * 8; bf16_t* bp = br + tok * D + 1 * MIXW + h * 64 + g * 8;
                  u32x4 w; w.x = pk2(x[0] * rs * siluf_(og[0]), x[1] * rs * siluf_(og[1])); w.y = pk2(x[2] * rs * siluf_(og[2]), x[3] * rs * siluf_(og[3]));
                  w.z = pk2(x[4] * rs * siluf_(og[4]), x[5] * rs * siluf_(og[5])); w.w = pk2(x[6] * rs * siluf_(og[6]), x[7] * rs * siluf_(og[7])); *(u32x4*)bp = w; } }
            __syncthreads();
        }
        if (!pass) { float* So = c.p->out + d.o_g + ((((size_t)b * DEPTH + l) * 2 + dir) * NH + h) * HD * HD; _Pragma("unroll 2") for (int i = tid; i < 4096; i += NTHREADS) So[i] = S[(i >> 6) * S65 + (i & 63)]; }
        __threadfence();
    }
    __syncthreads();
}

__device__ __forceinline__ float rwkv_shift(const float* cols, size_t tok0, int t, int T, int cb, int ch, const float* taps, int l, int which) {
    const float* tp = taps + (size_t)l * 3 * 768 + which * 256 + ch;
    const float xm = t > 0 ? cols[(tok0 + t - 1) * NCF + cb * 256 + ch] : 0.0f, x0 = cols[(tok0 + t) * NCF + cb * 256 + ch], xp = t + 1 < T ? cols[(tok0 + t + 1) * NCF + cb * 256 + ch] : 0.0f;
    return tp[0] * xm + tp[768] * x0 + tp[1536] * xp;
}
__device__ __forceinline__ void mix_rwkv(const Ctx& c0, int l, int pass, int b, int h) {
    const Ctx c = fresh(c0);
    const Dims& d = c.d; const int T = pass ? d.Tl : d.Tc, tid = c.tid, lane = c.lane, wave = c.wave; const size_t tok0 = pass ? d.NTc + (size_t)b * d.Tl : (size_t)b * d.Tc;
    float* L = (float*)c.lds;
    const float* cols = c.ws<float>(d.w_cols); float* scr = c.ws<float>(d.w_scr); bf16_t* br = c.ws<bf16_t>(d.w_br);
    constexpr int TB = 32, VS = TB * 64;
    const int dirw = wave >> 2, td = tid & 255, vrow = td >> 2, q = td & 3;
    float Sr[16];
    if (pass) { const float* S0 = c.in(I_SR) + ((((size_t)b * DEPTH + l) * 2 + dirw) * NH + h) * HD * HD + vrow * 64 + q * 16; UNR for (int j = 0; j < 16; ++j) Sr[j] = S0[j]; }
    else UNR for (int j = 0; j < 16; ++j) Sr[j] = 0.0f;
    const int ch = h * 64 + lane;
    for (int jb = 0; jb < T / TB; ++jb) {
        __syncthreads();
        for (int pi = wave; pi < 2 * TB; pi += NWAVES) {
            const int dir = pi / TB, i = pi % TB, t = dir ? T - 1 - (jb * TB + i) : jb * TB + i; const float* rp = cols + (tok0 + t) * NCF;
            const float r = rwkv_shift(cols, tok0, t, T, CB_RR, ch, c.in(I_SHIFT), l, 0), k = rwkv_shift(cols, tok0, t, T, CB_RK, ch, c.in(I_SHIFT), l, 1), v = rwkv_shift(cols, tok0, t, T, CB_RV, ch, c.in(I_SHIFT), l, 2);
            const float tw = tanhf(rp[SM_RW + dir * 32 + (lane & 31)]), ra = rp[SM_RA + dir * 32 + (lane & 31)];
            float lw = 0.0f, la = 0.0f; const float* w2 = c.in(I_WW2) + ((size_t)l * 2 + dir) * 32 * MIXW + ch; const float* a2 = c.in(I_WA2) + ((size_t)l * 2 + dir) * 32 * MIXW + ch;
            for (int rr = 0; rr < 32; ++rr) { lw += __shfl(tw, rr) * w2[(size_t)rr * MIXW]; la += __shfl(ra, rr) * a2[(size_t)rr * MIXW]; }
            const float decay = expf(-expf(-softplusf_(-(c.in(I_W0)[((size_t)l * 2 + dir) * MIXW + ch] + lw)) - 0.5f));
            const float a = sigmoidf_(c.in(I_A0)[((size_t)l * 2 + dir) * MIXW + ch] + la);
            float kap = k * c.in(I_KK)[(size_t)l * MIXW + ch]; const float ss = wave_sum(kap * kap); kap *= 1.0f / sqrtf(ss + LN_EPS);
            const float khat = k * (1.0f + (a - 1.0f) * c.in(I_KA)[(size_t)l * MIXW + ch]);
            float* P = L + dir * 6 * VS + i * 64 + lane;
            P[0] = r; P[VS] = kap; P[2 * VS] = v; P[3 * VS] = decay; P[4 * VS] = a * kap; P[5 * VS] = khat;
        }
        __syncthreads();
        { const float* P = L + dirw * 6 * VS + q * 16;
          for (int i = 0; i < TB; ++i) { const float* Pi = P + i * 64; const int t = dirw ? T - 1 - (jb * TB + i) : jb * TB + i;
              float sk = 0.0f; UNR for (int j = 0; j < 16; ++j) sk += Sr[j] * Pi[VS + j];
              sk += __shfl_xor(sk, 1); sk += __shfl_xor(sk, 2);
              const float vv = L[dirw * 6 * VS + 2 * VS + i * 64 + vrow]; float y = 0.0f;
              UNR for (int j = 0; j < 16; ++j) { const float s = Sr[j] * Pi[3 * VS + j] - sk * Pi[4 * VS + j] + vv * Pi[5 * VS + j]; Sr[j] = s; y += s * Pi[j]; }
              y += __shfl_xor(y, 1); y += __shfl_xor(y, 2);
              if (q == 0) scr[((tok0 + t) * 4 + 2 + dirw) * MIXW + h * 64 + vrow] = y; } }
    }
    if (!pass) { float* So = c.p->out + d.o_r + ((((size_t)b * DEPTH + l) * 2 + dirw) * NH + h) * HD * HD + vrow * 64 + q * 16; UNR for (int j = 0; j < 16; ++j) So[j] = Sr[j]; }
    __threadfence();
    __syncthreads();
    float* G2 = L;
    _Pragma("unroll 2") for (int i = tid; i < 4096; i += NTHREADS) G2[i] = c.in(I_WG2)[((size_t)l * 64 + (i >> 6)) * MIXW + h * 64 + (i & 63)];
    __syncthreads();
    for (int t = wave; t < T; t += NWAVES) {
        const size_t tok = tok0 + t; const float* rp = cols + tok * NCF;
        float y = scr[(tok * 4 + 2) * MIXW + ch] + scr[(tok * 4 + 3) * MIXW + ch];
        const float mean = wave_sum(y) * (1.0f / 64.0f); y -= mean; const float var = wave_sum(y * y) * (1.0f / 64.0f); y *= 1.0f / sqrtf(var + LN_EPS);
        const float r = rwkv_shift(cols, tok0, t, T, CB_RR, ch, c.in(I_SHIFT), l, 0), k = rwkv_shift(cols, tok0, t, T, CB_RK, ch, c.in(I_SHIFT), l, 1), v = rwkv_shift(cols, tok0, t, T, CB_RV, ch, c.in(I_SHIFT), l, 2);
        const float bonus = wave_sum(r * k * c.in(I_RKK)[(size_t)l * MIXW + ch]) * v;
        const float sg = sigmoidf_(rp[SM_RG + lane]); float gate = 0.0f;
        for (int j = 0; j < 64; ++j) gate += __shfl(sg, j) * G2[j * 64 + lane];
        br[tok * D + 2 * MIXW + ch] = (bf16_t)f2bf((y + bonus) * gate);
    }
    __syncthreads();
}

__device__ __forceinline__ void mix_na(const Ctx& c0, int l, int pass, int b, int h, int qb) {
    const Ctx c = fresh(c0);
    const Dims& d = c.d; const int tid = c.tid, lane = c.lane, wave = c.wave; const size_t tok0 = pass ? d.NTc + (size_t)b * d.Tl : (size_t)b * d.Tc;
    float* L = (float*)c.lds;
    float *Q = L, *Kt = L + MSZ, *Vt = L + 2 * MSZ, *Sm = L + 3 * MSZ, *vec = L + 4 * MSZ;
    float *mrow = vec, *lrow = vec + 64, *arow = vec + 128, *rpbs = vec + 192;
    const float* cols = c.ws<float>(d.w_cols); bf16_t* br = c.ws<bf16_t>(d.w_br);
    const int rows = d.Tl / GRIDW, kr = rows < 8 ? rows : 8; int rs = qb - kr / 2; rs = rs < 0 ? 0 : (rs > rows - kr ? rows - kr : rs);
    const int ntile = pass ? kr + PAST / 64 : d.Tc / 64;
    __syncthreads();
    _Pragma("unroll 2") for (int i = tid; i < 4096; i += NTHREADS) { const int j = i >> 6, dd = i & 63; const size_t tok = tok0 + qb * 64 + j; const float* rp = cols + tok * NCF + h * 64;
        Q[j * S65 + dd] = rp[CB_NQ * 256 + dd] * 0.125f;
        if (!pass) { const size_t o = ((((size_t)b * DEPTH + l) * NH + h) * d.Tc + qb * 64 + j) * HD + dd; c.p->out[d.o_nk + o] = rp[CB_NK * 256 + dd]; c.p->out[d.o_nv + o] = rp[CB_NV * 256 + dd]; } }
    if (tid < 64) { mrow[tid] = -1.0e30f; lrow[tid] = 0.0f; }
    if (pass) for (int i = tid; i < 15 * 31; i += NTHREADS) rpbs[i] = c.in(I_RPB)[((size_t)l * NH + h) * 15 * 31 + i];
    f32x16 oacc = zero16();
    const int ti = (wave >> 1) & 1, tj = wave & 1;
    for (int kt = 0; kt < ntile; ++kt) {
        const bool local = pass && kt < kr; const int krow = rs + kt;
        __syncthreads();
        _Pragma("unroll 2") for (int i = tid; i < 4096; i += NTHREADS) { const int j = i >> 6, dd = i & 63; float kv, vv;
            if (!pass) { const float* rp = cols + (tok0 + kt * 64 + j) * NCF + h * 64; kv = rp[CB_NK * 256 + dd]; vv = rp[CB_NV * 256 + dd]; }
            else if (local) { const float* rp = cols + (tok0 + krow * 64 + j) * NCF + h * 64; kv = rp[CB_NK * 256 + dd]; vv = rp[CB_NV * 256 + dd]; }
            else { const size_t o = ((((size_t)b * DEPTH + l) * NH + h) * PAST + (kt - kr) * 64 + j) * HD + dd; kv = c.in(I_CK)[o]; vv = c.in(I_CV)[o]; }
            Kt[j * S65 + dd] = kv; Vt[j * S65 + dd] = vv; }
        __syncthreads();
        if (wave < 4) { f32x16 acc = zero16(); acc = mm32(lane, acc, Q + ti * 32 * S65, S65, 1, Kt + tj * 32 * S65, 1, S65, 64);
            UNR for (int r = 0; r < 16; ++r) { const int qi = ti * 32 + ACC_ROW(r, lane), kj = tj * 32 + (lane & 31); float s = acc[r];
                if (local) { int cs = qi - 8; cs = cs < 0 ? 0 : (cs > 48 ? 48 : cs); s = (kj >= cs && kj < cs + 16) ? s + rpbs[(krow - qb + 7) * 31 + (kj - qi + 15)] : -1.0e30f; }
                Sm[qi * S65 + kj] = s; } }
        __syncthreads();
        { const int t = tid >> 3, g = tid & 7; float mx = -1.0e30f; for (int s = g * 8; s < g * 8 + 8; ++s) mx = fmaxf(mx, Sm[t * S65 + s]);
          mx = fmaxf(mx, __shfl_xor(mx, 1)); mx = fmaxf(mx, __shfl_xor(mx, 2)); mx = fmaxf(mx, __shfl_xor(mx, 4));
          const float mo = mrow[t], mn = fmaxf(mo, mx); float sum = 0.0f;
          for (int s = g * 8; s < g * 8 + 8; ++s) { const float sv = Sm[t * S65 + s]; const float p = sv <= -1.0e29f ? 0.0f : expf(sv - mn); Sm[t * S65 + s] = p; sum += p; }
          sum += __shfl_xor(sum, 1); sum += __shfl_xor(sum, 2); sum += __shfl_xor(sum, 4);
          const float al = expf(mo - mn);
          __syncthreads();
          if (g == 0) { mrow[t] = mn; lrow[t] = lrow[t] * al + sum; arow[t] = al; } }
        __syncthreads();
        if (wave < 4) { UNR for (int r = 0; r < 16; ++r) oacc[r] *= arow[ti * 32 + ACC_ROW(r, lane)];
            oacc = mm32(lane, oacc, Sm + ti * 32 * S65, S65, 1, Vt + tj * 32, S65, 1, 64); }
    }
    __syncthreads();
    if (wave < 4) UNR for (int r = 0; r < 16; ++r) { const int qi = ti * 32 + ACC_ROW(r, lane); Sm[qi * S65 + tj * 32 + (lane & 31)] = oacc[r] / lrow[qi]; }
    __syncthreads();
    { const int j = tid >> 3, g = tid & 7; const size_t tok = tok0 + qb * 64 + j; const float* sp = Sm + j * S65 + g * 8; bf16_t* bp = br + tok * D + 3 * MIXW + h * 64 + g * 8;
      u32x4 w; w.x = pk2(sp[0], sp[1]); w.y = pk2(sp[2], sp[3]); w.z = pk2(sp[4], sp[5]); w.w = pk2(sp[6], sp[7]); *(u32x4*)bp = w; }
    __syncthreads();
}

__device__ __forceinline__ void phase_mixers(const Ctx& c0, int l) {
    const Ctx c = fresh(c0);
    const Dims& d = c.d; const int rows = d.Tl / GRIDW;
    const int nL = d.Bl * NH, nC = d.Bc * NH, nNAl = nL * rows, nq = d.Tc / 64, nNAc = nC * nq;
    const int e0 = nL + nC, e1 = e0 + nL + nC, e2 = e1 + nL + nC, e3 = e2 + nNAl + nNAc;
    unsigned* qctr = c.ws<unsigned>(c.d.w_ctl) + CW_QUEUE + 64 * l;
    int* slot = (int*)(c.lds + 163840 - 128);
#ifndef MIX_MASK
#define MIX_MASK 15
#endif
#define MIX_FETCH() do { __syncthreads(); if (c.tid == 0) *slot = (int)atomicAdd(qctr, 1u); __syncthreads(); it = __builtin_amdgcn_readfirstlane(*slot); } while (0)
    int it; MIX_FETCH();
    while (it < e0) { const int r = it, ps = r < nL ? 1 : 0, q = ps ? r : r - nL; if (MIX_MASK & 1) mix_rwkv(c, l, opqs(__builtin_amdgcn_readfirstlane(ps)), q / NH, q % NH); MIX_FETCH(); }
    while (it < e1) { const int r = it - e0, ps = r < nL ? 1 : 0, q = ps ? r : r - nL; if (MIX_MASK & 2) mix_mlstm(c, l, opqs(__builtin_amdgcn_readfirstlane(ps)), q / NH, q % NH); MIX_FETCH(); }
    while (it < e2) { const int r = it - e1, ps = r < nL ? 1 : 0, q = ps ? r : r - nL; if (MIX_MASK & 4) mix_gla(c, l, opqs(__builtin_amdgcn_readfirstlane(ps)), q / NH, q % NH); MIX_FETCH(); }
    while (it < e3) { const int r = it - e2, ps = r < nNAl ? 1 : 0, q = ps ? r : r - nNAl, nr = ps ? rows : nq; if (MIX_MASK & 8) mix_na(c, l, opqs(__builtin_amdgcn_readfirstlane(ps)), q / (NH * nr), (q / nr) % NH, q % nr); MIX_FETCH(); }
#undef MIX_FETCH
}

__device__ __forceinline__ void phase_ln1(const Ctx& c0, int l) {
    const Ctx c = fresh(c0);
    const Dims& d = c.d; const float* mods = c.mods(l); const float* v = c.ws<float>(d.w_v); bf16_t* hb = c.ws<bf16_t>(d.w_hb); float* aff = c.ws<float>(d.w_aff);
    const float* lg = c.in(I_LNG) + ((size_t)l * 2 + 0) * D; const float* lb = c.in(I_LNB) + ((size_t)l * 2 + 0) * D;
    float* WR = (float*)c.lds;
    for (int i = c.tid; i < D * NEXP; i += NTHREADS) WR[(i & 15) * D + (i >> 4)] = c.in(I_WROUTER)[(size_t)l * D * NEXP + i];
    __syncthreads();
    const int gw = c.vcu * NWAVES + c.wave, NGW = c.G * NWAVES;
    for (int tok = gw; tok < d.NT; tok += NGW) {
        const float* mr = mods + (size_t)c.modrow(tok) * NMOD; f32x4 x[4]; float s = 0.0f;
#pragma unroll
        for (int j = 0; j < 4; ++j) { x[j] = *(const f32x4*)(v + (size_t)tok * D + 4 * c.lane + 256 * j); s += (x[j][0] + x[j][1]) + (x[j][2] + x[j][3]); }
        const float mean = wave_sum(s) * (1.0f / D); float q = 0.0f;
#pragma unroll
        for (int j = 0; j < 4; ++j) { x[j] = x[j] - mean; q += (x[j][0] * x[j][0] + x[j][1] * x[j][1]) + (x[j][2] * x[j][2] + x[j][3] * x[j][3]); }
        const float rstd = 1.0f / sqrtf(wave_sum(q) * (1.0f / D) + LN_EPS);
        f32x4 hh[4];
#pragma unroll
        for (int j = 0; j < 4; ++j) { const int col = 4 * c.lane + 256 * j; const f32x4 g = *(const f32x4*)(lg + col), bb = *(const f32x4*)(lb + col);
            const f32x4 x1 = x[j] * rstd * g + bb; *(f32x4*)(c.X() + (size_t)tok * D + col) = x1;
            const f32x4 sh = *(const f32x4*)(mr + 3 * D + col), sc = *(const f32x4*)(mr + 4 * D + col); hh[j] = x1 * (1.0f + sc) + sh;
            u32x2 w; w.x = pk2(hh[j][0], hh[j][1]); w.y = pk2(hh[j][2], hh[j][3]); *(u32x2*)(hb + (size_t)tok * D + col) = w; }
        float lg16[16];
#pragma unroll
        for (int e = 0; e < 16; ++e) { float a = 0.0f;
#pragma unroll
            for (int j = 0; j < 4; ++j) { const f32x4 wv = *(const f32x4*)(WR + e * D + 4 * c.lane + 256 * j); a += (hh[j][0] * wv[0] + hh[j][1] * wv[1]) + (hh[j][2] * wv[2] + hh[j][3] * wv[3]); }
            lg16[e] = a;
#ifndef CPU_EMU
            asm volatile("" ::: "memory");
#endif
        }
        float mx = -3.0e38f;
#pragma unroll
        for (int e = 0; e < 16; ++e) { lg16[e] = wave_sum(lg16[e]); mx = fmaxf(mx, lg16[e]); }
        float se = 0.0f;
#pragma unroll
        for (int e = 0; e < 16; ++e) { lg16[e] = expf(lg16[e] - mx); se += lg16[e]; }
        const float inv = 1.0f / se; float mine = 0.0f;
#pragma unroll
        for (int e = 0; e < 16; ++e) mine = (c.lane == e) ? lg16[e] * inv : mine;
        if (c.lane < 16) aff[(size_t)tok * NEXP + c.lane] = mine;
    }
}

__device__ __forceinline__ void phase_select(const Ctx& c0) {
    const Ctx c = fresh(c0);
    const Dims& d = c.d; const float* aff = c.ws<float>(d.w_aff); int* inv = c.ws<int>(d.w_inv); float* pgate = c.ws<float>(d.w_pgate);
    const bf16_t* hb = c.ws<bf16_t>(d.w_hb); bf16_t* xe = c.ws<bf16_t>(d.w_xe);
    float* A = (float*)c.lds; int* sel = (int*)(A + 1024);
    const int nitems = (d.Bc + d.Bl) * NEXP;
    for (int it = c.vcu; it < nitems; it += c.G) {
        const int e = it % NEXP, bb = it / NEXP, pass = bb >= d.Bc, b = pass ? bb - d.Bc : bb, T = pass ? d.Tl : d.Tc, cap = pass ? d.capl : d.capc;
        const int tok0 = pass ? d.NTc + b * d.Tl : b * d.Tc, row0 = e * d.RPE + (pass ? d.Bc * d.capc + b * d.capl : b * d.capc);
        __syncthreads();
        for (int t = c.tid; t < T; t += NTHREADS) A[t] = aff[(size_t)(tok0 + t) * NEXP + e];
        __syncthreads();
        for (int t = c.tid; t < T; t += NTHREADS) { const float a = A[t]; int rank = 0;
            for (int s = 0; s < T; ++s) { const float o = A[s]; rank += (o > a || (o == a && s < t)) ? 1 : 0; }
            if (rank < cap) { sel[rank] = t; pgate[row0 + rank] = a; inv[(size_t)(tok0 + t) * NEXP + e] = row0 + rank; } else inv[(size_t)(tok0 + t) * NEXP + e] = -1; }
        __syncthreads();
        for (int r = c.wave; r < cap; r += NWAVES) { const u32x4* src = (const u32x4*)(hb + (size_t)(tok0 + sel[r]) * D); u32x4* dst = (u32x4*)(xe + (size_t)(row0 + r) * D);
            dst[c.lane] = src[c.lane]; dst[c.lane + 64] = src[c.lane + 64]; }
    }
}

__device__ __forceinline__ void phase_ln2(const Ctx& c0, int l) {
    const Ctx c = fresh(c0);
    const Dims& d = c.d; const float* mods = c.mods(l); const float* y = c.ws<float>(d.w_y); const int* inv = c.ws<int>(d.w_inv); bf16_t* hb = c.ws<bf16_t>(d.w_hb);
    const float* lg = c.in(I_LNG) + ((size_t)l * 2 + 1) * D; const float* lb = c.in(I_LNB) + ((size_t)l * 2 + 1) * D;
    const float* modn = (l + 1 < DEPTH) ? c.mods(l + 1) : nullptr;
    const int gw = c.vcu * NWAVES + c.wave, NGW = c.G * NWAVES;
    for (int tok = gw; tok < d.NT; tok += NGW) {
        const int mrow = c.modrow(tok); const float* mr = mods + (size_t)mrow * NMOD; f32x4 ff[4];
#pragma unroll
        for (int j = 0; j < 4; ++j) ff[j] = (f32x4){0.f, 0.f, 0.f, 0.f};
        for (int e = 0; e < NEXP; ++e) { const int row = inv[(size_t)tok * NEXP + e]; if (row >= 0) {
#pragma unroll
            for (int j = 0; j < 4; ++j) ff[j] += *(const f32x4*)(y + (size_t)row * D + 4 * c.lane + 256 * j); } }
        f32x4 x[4]; float s = 0.0f;
#pragma unroll
        for (int j = 0; j < 4; ++j) { const int col = 4 * c.lane + 256 * j; const f32x4 x1 = *(const f32x4*)(c.X() + (size_t)tok * D + col), g2 = *(const f32x4*)(mr + 5 * D + col);
            x[j] = ALPHA * x1 + g2 * ff[j]; s += (x[j][0] + x[j][1]) + (x[j][2] + x[j][3]); }
        const float mean = wave_sum(s) * (1.0f / D); float q = 0.0f;
#pragma unroll
        for (int j = 0; j < 4; ++j) { x[j] = x[j] - mean; q += (x[j][0] * x[j][0] + x[j][1] * x[j][1]) + (x[j][2] * x[j][2] + x[j][3] * x[j][3]); }
        const float rstd = 1.0f / sqrtf(wave_sum(q) * (1.0f / D) + LN_EPS);
#pragma unroll
        for (int j = 0; j < 4; ++j) { const int col = 4 * c.lane + 256 * j; const f32x4 g = *(const f32x4*)(lg + col), bb = *(const f32x4*)(lb + col);
            const f32x4 x2 = x[j] * rstd * g + bb; *(f32x4*)(c.X() + (size_t)tok * D + col) = x2;
            if (modn) { const float* mn = modn + (size_t)mrow * NMOD; const f32x4 sh = *(const f32x4*)(mn + col), sc = *(const f32x4*)(mn + D + col); const f32x4 hh = x2 * (1.0f + sc) + sh;
                u32x2 w; w.x = pk2(hh[0], hh[1]); w.y = pk2(hh[2], hh[3]); *(u32x2*)(hb + (size_t)tok * D + col) = w; } }
    }
}

constexpr int N_PHASES = 2 + 9 * DEPTH;
__device__ __forceinline__ void run_phase(const Ctx& c0, int ph) {
    const Ctx c = fresh(c0); const Dims& d = c.d;
#ifndef PHASE_MASK
#define PHASE_MASK 0xFFFF
#endif
    if (ph == 0) { if (PHASE_MASK & 0x200) phase_prep(c); return; }
    if (ph == 1) { if (PHASE_MASK & 0x400) phase_init(c); return; }
    const int l = (ph - 2) / 9, s = (ph - 2) % 9;
    LAS unsigned char* ldsp = (LAS unsigned char*)c.lds;
    if (!((PHASE_MASK >> s) & 1)) return;
    switch (s) {
    case 0: { pg8::Gemm g{c.ws<bf16_t>(d.w_hb), c.ws<bf16_t>(d.w_win) + (size_t)l * NINP * D, D}; pg8::StaticOrder S; S.init(d.NT, NINP, c.G, (int)blockIdx.x);
              EpiCols E{c.ws<float>(d.w_cols), c.ws<unsigned short>(d.w_gates)}; pg8::gemm_phase<EpiCols, pg8::StaticOrder>(ldsp, g, S, E); } break;
    case 1: phase_mixers(c, l); break;
    case 2: { pg8::Gemm g{c.ws<bf16_t>(d.w_br), c.ws<bf16_t>(d.w_wbr) + (size_t)l * D * D, D}; pg8::StaticOrder S; S.init(d.NT, D, c.G, (int)blockIdx.x);
              EpiWiden E{c.ws<unsigned short>(d.w_gates), c.ws<bf16_t>(d.w_merged)}; pg8::gemm_phase<EpiWiden, pg8::StaticOrder>(ldsp, g, S, E); } break;
    case 3: { pg8::Gemm g{c.ws<bf16_t>(d.w_merged), c.ws<bf16_t>(d.w_wout) + (size_t)l * D * D, D}; pg8::StaticOrder S; S.init(d.NT, D, c.G, (int)blockIdx.x);
              EpiPreLN E{c.X(), c.mods(l), c.ws<float>(d.w_v), d.NTc, d.Tl}; pg8::gemm_phase<EpiPreLN, pg8::StaticOrder>(ldsp, g, S, E); } break;
    case 4: phase_ln1(c, l); break;
    case 5: phase_select(c); break;
    case 6: { pg8::Gemm g{c.ws<bf16_t>(d.w_xe), c.ws<bf16_t>(d.w_wup) + (size_t)l * NEXP * 2 * FF * D, D}; pg8::GroupOrder S; S.init(d.TPE, 2 * FF / 256, NEXP, c.G, c.vcu);
              EpiSwiGLU E{c.ws<bf16_t>(d.w_act)}; pg8::gemm_phase<EpiSwiGLU, pg8::GroupOrder>(ldsp, g, S, E); } break;
    case 7: { pg8::Gemm g{c.ws<bf16_t>(d.w_act), c.ws<bf16_t>(d.w_wdn) + (size_t)l * NEXP * D * FF, FF}; pg8::GroupOrder S; S.init(d.TPE, D / 256, NEXP, c.G, c.vcu);
              EpiDown E{c.ws<float>(d.w_pgate), c.ws<float>(d.w_y)}; pg8::gemm_phase<EpiDown, pg8::GroupOrder>(ldsp, g, S, E); } break;
    default: phase_ln2(c, l); break;
    }
}

#ifndef CPU_EMU
#define XB_TMO      128
#define XB_XCNT(j)  (256  + 64 * (j))
#define XB_XSUB(j)  (1280 + 64 * (j))
#define XB_XGEN(j)  (2304 + 64 * (j))
#define XB_TOP      3328
#define XB_TOPGEN   3392
#define XB_SPIN_CAP (1u << 20)
__device__ __forceinline__ unsigned xb_ld(unsigned* p)              { return __hip_atomic_load(p, __ATOMIC_RELAXED, __HIP_MEMORY_SCOPE_AGENT); }
__device__ __forceinline__ unsigned xb_add(unsigned* p, unsigned v) { return __hip_atomic_fetch_add(p, v, __ATOMIC_RELAXED, __HIP_MEMORY_SCOPE_AGENT); }
__device__ __forceinline__ unsigned xb_xcc_id() { return (unsigned)__builtin_amdgcn_s_getreg((3 << 11) | 20) & 0xFu; }
#define XB_SPIN(cond, bar) do { unsigned _sp = 0; while (cond) { __builtin_amdgcn_s_sleep(1); \
    if ((++_sp & 255u) == 0u) { if (xb_ld(&(bar)[XB_TMO])) break; if (_sp > XB_SPIN_CAP) { atomicAdd(&(bar)[XB_TMO], 1u); break; } } } } while (0)
struct XcdBarrier { unsigned* bar; unsigned x; volatile LAS unsigned* st; };
__device__ __forceinline__ XcdBarrier xcd_barrier_post(unsigned* bar, volatile LAS unsigned* st) {
    XcdBarrier b; b.bar = bar; b.x = xb_xcc_id(); b.st = st;
    if (threadIdx.x == 0) (void)xb_add(&bar[XB_XCNT(b.x)], 1u);
    return b;
}
__device__ __forceinline__ void xcd_barrier_complete(unsigned* bar, unsigned x, unsigned& nloc, unsigned& nx) {
    const unsigned G = gridDim.x * gridDim.y * gridDim.z;
    unsigned sum, cnt, mine, sp = 0u;
    for (;;) {
        sum = 0u; cnt = 0u; mine = 0u;
#pragma unroll
        for (unsigned j = 0; j < 16; ++j) { const unsigned cc = xb_ld(&bar[XB_XCNT(j)]); sum += cc; cnt += (cc > 0u) ? 1u : 0u; mine = (j == x) ? cc : mine; }
        if (sum == G) break;
        __builtin_amdgcn_s_sleep(1);
        if ((++sp & 255u) == 0u) { if (xb_ld(&bar[XB_TMO])) break; if (sp > XB_SPIN_CAP) { atomicAdd(&bar[XB_TMO], 1u); break; } }
    }
    nloc = mine > 0u ? mine : 1u; nx = cnt > 0u ? cnt : 1u;
}
__device__ __forceinline__ void xcd_barrier(const XcdBarrier& b) {
    asm volatile("s_waitcnt vmcnt(0)" ::: "memory");
    __syncthreads();
    if (threadIdx.x == 0) {
        unsigned* bar = b.bar;
        __builtin_amdgcn_s_waitcnt(0);
        unsigned nloc = b.st[0], nx = b.st[1];
        if (nloc == 0u) { xcd_barrier_complete(bar, b.x, nloc, nx); b.st[0] = nloc; b.st[1] = nx; }
        const unsigned old = xb_add(&bar[XB_XSUB(b.x)], 1u);
        const unsigned gen = old / nloc;
        if (old + 1u == (gen + 1u) * nloc) {
            __builtin_amdgcn_fence(__ATOMIC_RELEASE, "agent");
            asm volatile("s_waitcnt vmcnt(0)" ::: "memory");
            const unsigned og = xb_add(&bar[XB_TOP], 1u);
            const unsigned tg = og / nx;
            if (og + 1u == (tg + 1u) * nx) xb_add(&bar[XB_TOPGEN], 1u);
            else XB_SPIN(xb_ld(&bar[XB_TOPGEN]) == tg, bar);
            __builtin_amdgcn_fence(__ATOMIC_ACQUIRE, "agent");
            xb_add(&bar[XB_XGEN(b.x)], 1u);
            asm volatile("s_waitcnt vmcnt(0)" ::: "memory");
        } else {
            XB_SPIN(xb_ld(&bar[XB_XGEN(b.x)]) == gen, bar);
            __builtin_amdgcn_fence(__ATOMIC_ACQUIRE, "agent");
            asm volatile("s_waitcnt vmcnt(0)" ::: "memory");
        }
    }
    __syncthreads();
}

constexpr int LDS_BYTES = 163840;
__global__ void __launch_bounds__(NTHREADS, 2) trunk_fwd(Params p) {
    extern __shared__ __attribute__((aligned(16))) unsigned char lds[];
    Ctx c; c.p = &p; c.d = make_dims(p.Bc, p.Tc, p.Bl, p.Tl); c.lds = lds;
    c.tid = threadIdx.x; c.lane = c.tid & 63; c.wave = __builtin_amdgcn_readfirstlane(c.tid >> 6);
    c.G = gridDim.x; { const int bx = blockIdx.x; c.vcu = (c.G % 8 == 0) ? (bx % 8) * (c.G / 8) + bx / 8 : bx; }
    volatile LAS unsigned* st = (volatile LAS unsigned*)((LAS unsigned char*)lds + LDS_BYTES - 64);
    XcdBarrier bar; bar.bar = nullptr; bar.x = 0; bar.st = st;
    if (p.use_bar) { if (c.tid < 2) st[c.tid] = 0u; __syncthreads(); bar = xcd_barrier_post((unsigned*)(p.ws) + CW_BAR, st); }
    for (int ph = p.ph_lo; ph < p.ph_hi; ++ph) {
        run_phase(c, ph);
        if (ph + 1 < p.ph_hi) xcd_barrier(bar);
    }
}

#ifndef N_LAUNCH_MODE
#define N_LAUNCH_MODE 1
#endif
extern "C" void kernel_launch(void* const* d_in, const int* in_sizes, int n_in, void* d_out, int out_size, void* d_ws, size_t ws_size, hipStream_t stream) {
    static int grid = 0;
    const Dims d = make_dims(32, 256, 8, 1024);
    if (grid == 0) {
        int dev = 0, cus = 0;
        if (n_in != N_INPUTS || (size_t)out_size != d.o_end || ws_size < ((size_t)d.w_end << 8)) { fprintf(stderr, "kernel_launch: unexpected sizes: n_in %d out %d ws %zu (need %zu / %zu)\n", n_in, out_size, ws_size, (size_t)d.o_end, (size_t)d.w_end << 8); grid = -1; return; }
        if (hipGetDevice(&dev) != hipSuccess || hipDeviceGetAttribute(&cus, hipDeviceAttributeMultiprocessorCount, dev) != hipSuccess) { grid = -1; return; }
        if (hipFuncSetAttribute((const void*)trunk_fwd, hipFuncAttributeMaxDynamicSharedMemorySize, LDS_BYTES) != hipSuccess) { fprintf(stderr, "kernel_launch: hipFuncSetAttribute failed\n"); grid = -1; return; }
        int per_cu = 0;
        if (hipOccupancyMaxActiveBlocksPerMultiprocessor(&per_cu, (const void*)trunk_fwd, NTHREADS, LDS_BYTES) != hipSuccess || per_cu < 1) fprintf(stderr, "kernel_launch: occupancy query says %d\n", per_cu);
        (void)hipGetLastError();
        grid = cus;
    }
    if (grid < 0) return;
    (void)hipMemsetAsync((char*)d_ws, 0, CTL_BYTES, stream);
    Params p{};
    for (int i = 0; i < N_INPUTS; ++i) p.in[i] = (const float*)d_in[i];
    p.out = (float*)d_out; p.ws = (unsigned char*)d_ws; p.Bc = 32; p.Tc = 256; p.Bl = 8; p.Tl = 1024;
#if N_LAUNCH_MODE == 1
    p.ph_lo = 0; p.ph_hi = N_PHASES; p.use_bar = 1;
    hipLaunchKernelGGL(trunk_fwd, dim3(grid), dim3(NTHREADS), LDS_BYTES, stream, p);
#else
    for (int ph = 0; ph < N_PHASES; ++ph) { p.ph_lo = ph; p.ph_hi = ph + 1; p.use_bar = 0; hipLaunchKernelGGL(trunk_fwd, dim3(grid), dim3(NTHREADS), LDS_BYTES, stream, p); }
#endif
}
#endif
```

```cpp
#ifndef CPU_EMU
#include <hip/hip_runtime.h>
#include <cstdio>
typedef float f32x16 __attribute__((ext_vector_type(16)));
typedef float f32x4 __attribute__((ext_vector_type(4)));
typedef float f32x2 __attribute__((ext_vector_type(2)));
typedef unsigned u32x4 __attribute__((ext_vector_type(4)));
typedef unsigned u32x2 __attribute__((ext_vector_type(2)));
#define LAS __attribute__((address_space(3)))
#define WAVE_SYNC() asm volatile("s_waitcnt lgkmcnt(0)" ::: "memory")
#else
#define LAS
#define WAVE_SYNC() emu::wave_sync()
#endif
#define UNR _Pragma("unroll")
typedef short bf16x8 __attribute__((ext_vector_type(8)));
typedef unsigned short bf16_t;

constexpr int D = 1024, NH = 4, HD = 64, MIXW = 256, NEXP = 16, FF = 2048, DEPTH = 2, PAST = 256, GRIDW = 64;
constexpr int NIN = 7920, NINP = 7936, NCF = 3840, NGATE = 4096, NMOD = 6 * D;
constexpr float ALPHA = 1.4142135623730951f, LN_EPS = 1e-5f;
constexpr int NTHREADS = 512, NWAVES = 8;
constexpr int CB_MQ = 0, CB_MK = 1, CB_MV = 2, CB_MO = 3, CB_GQ = 4, CB_GK = 5, CB_GV = 6, CB_GG = 7, CB_RR = 8, CB_RK = 9, CB_RV = 10, CB_NQ = 11, CB_NK = 12, CB_NV = 13;
constexpr int SM_MI = 3584, SM_MF = 3592, SM_GA = 3600, SM_RW = 3632, SM_RA = 3696, SM_RG = 3760;
enum { I_XP = 0, I_XS, I_SC, I_SN, I_SM, I_SG, I_SR, I_CK, I_CV, I_C, I_CCTX, I_WADA, I_BADA, I_WIN, I_BIG, I_BFG, I_WGLA, I_BGLA, I_SHIFT, I_W0, I_WW2, I_A0, I_WA2, I_WG2, I_KK, I_KA, I_RKK,
       I_RPB, I_WBR, I_WOUT, I_LNG, I_LNB, I_WROUTER, I_WUP, I_WDOWN, N_INPUTS };

__host__ __device__ __forceinline__ int win_col(int p) {
    if (p < 3584) { const int b = p >> 8, w = p & 255; const int base = b < 4 ? b * 256 : (b < 8 ? 1040 + (b - 4) * 256 : (b < 11 ? 2096 + (b - 8) * 256 : 3056 + (b - 11) * 256)); return base + w; }
    if (p < 3840) { const int s = p - 3584; return s < 16 ? 1024 + s : (s < 48 ? 2064 + (s - 16) : (s < 240 ? 2864 + (s - 48) : -1)); }
    return p - 16;
}

struct Params {
    const float* in[N_INPUTS];
    float* out; unsigned char* ws;
    int Bc, Tc, Bl, Tl;
    int ph_lo, ph_hi;
    int use_bar, pad;
};
struct Dims {
    int Bc, Tc, Bl, Tl, NTc, NTl, NT, capc, capl, RPE, TPE, NPR;
    unsigned o_yp, o_ys, o_C, o_n, o_m, o_g, o_r, o_nk, o_nv, o_end;
    unsigned w_ctl, w_win, w_wbr, w_wout, w_wup, w_wdn, w_mods, w_hb, w_cols, w_gates, w_br, w_scr, w_merged, w_v, w_aff, w_inv, w_pgate, w_xe, w_act, w_y, w_end;
};
constexpr size_t CTL_BYTES = 1u << 20;
constexpr int CW_BAR = 4096, CW_QUEUE = 1024;
__host__ __device__ __forceinline__ unsigned al256(size_t x) { return (unsigned)((x + 255) >> 8); }
__host__ __device__ __forceinline__ Dims make_dims(int Bc, int Tc, int Bl, int Tl) {
    Dims d; d.Bc = Bc; d.Tc = Tc; d.Bl = Bl; d.Tl = Tl; d.NTc = Bc * Tc; d.NTl = Bl * Tl; d.NT = d.NTc + d.NTl;
    d.capc = Tc / 8; d.capl = Tl / 8; d.RPE = ((Bc * d.capc + Bl * d.capl + 255) / 256) * 256; d.TPE = d.RPE / 256; d.NPR = NEXP * d.RPE;
    unsigned o = 0; d.o_yp = o; o += (unsigned)d.NTc * D; d.o_ys = o; o += (unsigned)d.NTl * D;
    d.o_C = o; o += (unsigned)Bc * DEPTH * 2 * NH * HD * HD; d.o_n = o; o += (unsigned)Bc * DEPTH * 2 * NH * HD; d.o_m = o; o += (unsigned)Bc * DEPTH * 2 * NH;
    d.o_g = o; o += (unsigned)Bc * DEPTH * 2 * NH * HD * HD; d.o_r = o; o += (unsigned)Bc * DEPTH * 2 * NH * HD * HD;
    d.o_nk = o; o += (unsigned)Bc * DEPTH * NH * Tc * HD; d.o_nv = o; o += (unsigned)Bc * DEPTH * NH * Tc * HD; d.o_end = o;
    unsigned w = 0; d.w_ctl = w; w += (unsigned)(CTL_BYTES >> 8);
    d.w_win = w; w += al256((size_t)DEPTH * NINP * D * 2); d.w_wbr = w; w += al256((size_t)DEPTH * D * D * 2); d.w_wout = w; w += al256((size_t)DEPTH * D * D * 2);
    d.w_wup = w; w += al256((size_t)DEPTH * NEXP * 2 * FF * D * 2); d.w_wdn = w; w += al256((size_t)DEPTH * NEXP * D * FF * 2);
    d.w_mods = w; w += al256((size_t)DEPTH * (1 + Bl) * NMOD * 4);
    d.w_hb = w; w += al256((size_t)d.NT * D * 2); d.w_cols = w; w += al256((size_t)d.NT * NCF * 4); d.w_gates = w; w += al256((size_t)d.NT * NGATE * 2);
    d.w_br = w; w += al256((size_t)d.NT * D * 2); d.w_scr = w; w += al256((size_t)d.NT * 7 * MIXW * 4); d.w_merged = w; w += al256((size_t)d.NT * D * 2);
    d.w_v = w; w += al256((size_t)d.NT * D * 4); d.w_aff = w; w += al256((size_t)d.NT * NEXP * 4); d.w_inv = w; w += al256((size_t)d.NT * NEXP * 4);
    d.w_pgate = w; w += al256((size_t)d.NPR * 4); d.w_xe = w; w += al256((size_t)d.NPR * D * 2); d.w_act = w; w += al256((size_t)d.NPR * FF * 2); d.w_y = w; w += al256((size_t)d.NPR * D * 4);
    d.w_end = w; return d;
}

__device__ __forceinline__ unsigned f2bf(float f) { unsigned u = __builtin_bit_cast(unsigned, f); return (u + 0x7fffu + ((u >> 16) & 1u)) >> 16; }
__device__ __forceinline__ unsigned pk2(float lo, float hi) { return f2bf(lo) | (f2bf(hi) << 16); }
__device__ __forceinline__ float sigmoidf_(float x) { return 1.0f / (1.0f + expf(-x)); }
__device__ __forceinline__ float logsigmoidf_(float x) { return fminf(x, 0.0f) - log1pf(expf(-fabsf(x))); }
__device__ __forceinline__ float softplusf_(float x) { return fmaxf(x, 0.0f) + log1pf(expf(-fabsf(x))); }
__device__ __forceinline__ float siluf_(float x) { return x / (1.0f + expf(-x)); }
__device__ __forceinline__ float wave_sum(float v) {
#pragma unroll
    for (int o = 1; o < 64; o <<= 1) v += __shfl_xor(v, o);
    return v;
}
__device__ __forceinline__ unsigned pkh2(float a, float b) { const _Float16 x = (_Float16)a, y = (_Float16)b; return (unsigned)__builtin_bit_cast(unsigned short, x) | ((unsigned)__builtin_bit_cast(unsigned short, y) << 16); }
#ifndef CPU_EMU
__device__ __forceinline__ float frcp(float x) { return __builtin_amdgcn_rcpf(x); }
#else
inline float frcp(float x) { return 1.0f / x; }
#endif
__device__ __forceinline__ float h2f(unsigned short h) { return (float)__builtin_bit_cast(_Float16, h); }

#ifndef CPU_EMU
__device__ __forceinline__ int opqv(int x) { asm volatile("" : "+v"(x)); return x; }
__device__ __forceinline__ int opqs(int x) { asm volatile("" : "+s"(x)); return x; }
#else
inline int opqv(int x) { return x; }
inline int opqs(int x) { return x; }
#endif
namespace pg8 {
constexpr int BM = 256, BK = 64, HALF = 128, HTB = HALF * BK * 2, STAGE_BYTES = 8 * HTB, NXCD = 8, WGM = 8;
__host__ __device__ __forceinline__ int lds_byte(int r, int c) { const int st = (r >> 4) * 2 + (c >> 5), rr = r & 15, cc = c & 31, ob = rr * 64 + cc * 2; return st * 1024 + (ob ^ (((ob >> 9) & 1) << 5)); }
__host__ __device__ __forceinline__ void stage_rc(int b, int& R, int& C) { const int st = b / 1024, sb = b % 1024, swz = sb ^ (((sb >> 9) & 1) << 5); R = (st >> 1) * 16 + swz / 64; C = (st & 1) * 32 + (swz % 64) / 2; }
struct Unit { int pm, pn, ta, tb; };
struct Gemm { const bf16_t* A; const bf16_t* Bt; int K; };
struct StaticOrder {
    int nM, nN, nwg, G, c;
    __device__ __forceinline__ void init(int M, int N, int G_, int c_) { nM = M / BM; nN = N / BM; nwg = nM * nN; G = G_; c = c_; }
    __device__ __forceinline__ bool next(int i, Unit& u) const {
        const long L = (long)i * G + c; if (L >= nwg) return false;
        int wgid = (int)L; { const int q = nwg / NXCD, r = nwg % NXCD, xcd = wgid % NXCD, off = wgid / NXCD; wgid = (xcd < r ? xcd * (q + 1) : r * (q + 1) + (xcd - r) * q) + off; }
        const int nig = WGM * nN, gid = wgid / nig, fm = gid * WGM, gsz = (nM - fm) < WGM ? (nM - fm) : WGM;
        u.pm = fm + ((wgid % nig) % gsz); u.pn = (wgid % nig) / gsz; u.ta = u.pm; u.tb = u.pn; return true;
    }
};
struct GroupOrder {
    int tpe, nN, nE, G, c;
    __device__ __forceinline__ void init(int tpe_, int nN_, int nE_, int G_, int c_) { tpe = tpe_; nN = nN_; nE = nE_; G = G_; c = c_; }
    __device__ __forceinline__ bool next(int i, Unit& u) const {
        const long L = (long)i * G + c; if (L >= (long)nE * tpe * nN) return false;
        const int per = tpe * nN, e = (int)(L / per), r = (int)(L % per), pn = r / tpe, pm = r % tpe;
        u.ta = e * tpe + pm; u.tb = e * nN + pn; u.pm = u.ta; u.pn = pn; return true;
    }
};
#ifndef CPU_EMU
template <class Epi, class Sched>
__device__ __forceinline__ void gemm_phase(LAS unsigned char* lds, const Gemm g, const Sched& S, const Epi& E) {
    const int tid = opqv((int)threadIdx.x), wid = __builtin_amdgcn_readfirstlane(tid >> 6), lane = tid & 63, wr = wid >> 2, wc = wid & 3, fr = lane & 15, fq = lane >> 4;
    const int K = g.K, nt = K / BK;
    unsigned voffA[2];
#pragma unroll
    for (int i = 0; i < 2; ++i) { int R, C; stage_rc(tid * 16 + i * 8192, R, C); voffA[i] = (unsigned)(R * K + C) * 2u; }
    const size_t kstep = (size_t)(BK * 2), hstep = (size_t)HALF * K * 2, tstep = 2 * hstep;
    const unsigned ldsw = (unsigned)wid * 1024u;
    const int aoff = lds_byte(wr * 64 + fr, fq * 8), boff = lds_byte(wc * 32 + fr, fq * 8);
#define PG8_SA(b, h) (((b) * 2 + (h)) * HTB)
#define PG8_SB(b, h) ((4 + (b) * 2 + (h)) * HTB)
#define PG8_STAGE(bufoff, gbase) do { _Pragma("unroll") for (int _i = 0; _i < 2; ++_i) \
        __builtin_amdgcn_global_load_lds((const unsigned*)((const char*)(gbase) + voffA[_i]), (LAS unsigned*)(lds + (bufoff) + ldsw + _i * 8192), 16, 0, 0); } while (0)
#define PG8_LDA(dst, b, h) do { _Pragma("unroll") for (int m = 0; m < 4; ++m) _Pragma("unroll") for (int k = 0; k < 2; ++k) dst[m][k] = *(const LAS bf16x8*)(lds + PG8_SA(b, h) + aoff + m * 2048 + k * 1024); } while (0)
#define PG8_LDB(dst, b, h) do { _Pragma("unroll") for (int n = 0; n < 2; ++n) _Pragma("unroll") for (int k = 0; k < 2; ++k) dst[n][k] = *(const LAS bf16x8*)(lds + PG8_SB(b, h) + boff + n * 2048 + k * 1024); } while (0)
#define PG8_MMA(ai, bj, At, Bt) do { __builtin_amdgcn_s_setprio(1); _Pragma("unroll") for (int m = 0; m < 4; ++m) _Pragma("unroll") for (int n = 0; n < 2; ++n) _Pragma("unroll") for (int k = 0; k < 2; ++k) \
        acc[ai][bj][m][n] = __builtin_amdgcn_mfma_f32_16x16x32_bf16(Bt[n][k], At[m][k], acc[ai][bj][m][n], 0, 0, 0); __builtin_amdgcn_s_setprio(0); } while (0)
#define PG8_WAIT_V(n) asm volatile("s_waitcnt vmcnt(" #n ")" ::: "memory")
#define PG8_WAIT_L(n) asm volatile("s_waitcnt lgkmcnt(" #n ")" ::: "memory")
#define PG8_BAR __builtin_amdgcn_s_barrier()
#define PG8_SCHED __builtin_amdgcn_sched_barrier(0)
    Unit cur, nxt; int ui = 0;
    if (!S.next(0, cur)) return;
    f32x4 acc[2][2][4][2];
#pragma unroll
    for (int a = 0; a < 2; ++a)
#pragma unroll
        for (int b = 0; b < 2; ++b)
#pragma unroll
            for (int m = 0; m < 4; ++m)
#pragma unroll
                for (int n = 0; n < 2; ++n) acc[a][b][m][n] = (f32x4){0.f, 0.f, 0.f, 0.f};
    bf16x8 At[4][2], B0[2][2], B1[2][2];
    const char* cA = (const char*)g.A + (size_t)cur.ta * tstep; const char* cB = (const char*)g.Bt + (size_t)cur.tb * tstep;
    PG8_STAGE(PG8_SB(0, 0), cB); PG8_STAGE(PG8_SB(0, 1), cB + hstep); PG8_STAGE(PG8_SA(0, 0), cA); PG8_STAGE(PG8_SA(0, 1), cA + hstep);
    if (wr == 1) PG8_BAR;
    PG8_WAIT_V(2); PG8_BAR;
    PG8_STAGE(PG8_SB(1, 0), cB + kstep); PG8_STAGE(PG8_SA(1, 0), cA + kstep); PG8_STAGE(PG8_SB(1, 1), cB + hstep + kstep);
    PG8_WAIT_V(6); PG8_BAR;
    for (;;) {
        const bool has_next = S.next(ui + 1, nxt);
        const char* nA = has_next ? (const char*)g.A + (size_t)nxt.ta * tstep : cA; const char* nB = has_next ? (const char*)g.Bt + (size_t)nxt.tb * tstep : cB;
        for (int t = 0; t < nt; t += 2) {
            const bool last = (t == nt - 2);
            const char* a1 = cA + (size_t)(t + 1) * kstep;
            const char* a2 = last ? nA : cA + (size_t)(t + 2) * kstep; const char* b2 = last ? nB : cB + (size_t)(t + 2) * kstep;
            const char* a3 = a2 + kstep; const char* b3 = b2 + kstep;
            if constexpr (Epi::MID) { if (t != 0 && (t & 3) == 0) E.mid(acc, cur, t >> 2, wr, wc, fr, fq); }
            PG8_LDB(B0, 0, 0); PG8_LDB(B1, 0, 1); PG8_SCHED; PG8_LDA(At, 0, 0); PG8_STAGE(PG8_SA(1, 1), a1 + hstep);
            PG8_WAIT_V(8); PG8_WAIT_L(0); PG8_BAR; PG8_MMA(0, 0, At, B0); PG8_MMA(0, 1, At, B1); PG8_BAR; PG8_SCHED;
            PG8_LDA(At, 0, 1); PG8_STAGE(PG8_SB(0, 0), b2); PG8_STAGE(PG8_SB(0, 1), b2 + hstep); PG8_STAGE(PG8_SA(0, 0), a2);
            PG8_WAIT_V(8); PG8_WAIT_L(0); PG8_BAR; PG8_MMA(1, 0, At, B0); PG8_MMA(1, 1, At, B1); PG8_BAR; PG8_SCHED;
            PG8_LDB(B0, 1, 0); PG8_LDB(B1, 1, 1); PG8_SCHED; PG8_LDA(At, 1, 0); PG8_STAGE(PG8_SA(0, 1), a2 + hstep);
            PG8_WAIT_V(8); PG8_WAIT_L(0); PG8_BAR; PG8_MMA(0, 0, At, B0); PG8_MMA(0, 1, At, B1); PG8_BAR; PG8_SCHED;
            PG8_LDA(At, 1, 1); PG8_STAGE(PG8_SB(1, 0), b3); PG8_STAGE(PG8_SB(1, 1), b3 + hstep); PG8_STAGE(PG8_SA(1, 0), a3);
            PG8_WAIT_V(8); PG8_WAIT_L(0); PG8_BAR; PG8_MMA(1, 0, At, B0); PG8_MMA(1, 1, At, B1); PG8_BAR; PG8_SCHED;
        }
        if (wr == 0) PG8_BAR;
        E(acc, cur, wr, wc, fr, fq);
        if (!has_next) break;
#pragma unroll
        for (int a = 0; a < 2; ++a)
#pragma unroll
            for (int b = 0; b < 2; ++b)
#pragma unroll
                for (int m = 0; m < 4; ++m)
#pragma unroll
                    for (int n = 0; n < 2; ++n) acc[a][b][m][n] = (f32x4){0.f, 0.f, 0.f, 0.f};
        cur = nxt; cA = nA; cB = nB; ++ui;
        if (wr == 1) PG8_BAR;
    }
    PG8_WAIT_V(0);
    PG8_BAR;
#undef PG8_SA
#undef PG8_SB
#undef PG8_STAGE
#undef PG8_LDA
#undef PG8_LDB
#undef PG8_MMA
#undef PG8_WAIT_V
#undef PG8_WAIT_L
#undef PG8_BAR
#undef PG8_SCHED
}
#else
template <class Epi, class Sched> void gemm_phase(unsigned char* lds, const Gemm g, const Sched& S, const Epi& E);
#endif
}
typedef f32x4 AccT[2][2][4][2];

struct Ctx {
    const Params* p; Dims d; unsigned char* lds; int tid, lane, wave, G, vcu;
    template <class T> __device__ __forceinline__ T* ws(unsigned off) const { return (T*)(p->ws + ((size_t)off << 8)); }
    __device__ __forceinline__ const float* in(int i) const { return p->in[i]; }
    __device__ __forceinline__ int modrow(int tok) const { return tok < d.NTc ? 0 : 1 + (tok - d.NTc) / d.Tl; }
    __device__ __forceinline__ const float* mods(int l) const { return ws<float>(d.w_mods) + (size_t)l * (1 + d.Bl) * NMOD; }
    __device__ __forceinline__ float* X() const { return p->out; }
};

__device__ __forceinline__ Ctx fresh(const Ctx& c0) {
    Ctx c; c.p = c0.p; c.lds = c0.lds; c.tid = opqv(c0.tid); c.lane = c.tid & 63; c.wave = opqs(c0.wave); c.G = opqs(c0.G); c.vcu = opqs(c0.vcu);
    c.d = make_dims(opqs(c0.p->Bc), opqs(c0.p->Tc), opqs(c0.p->Bl), opqs(c0.p->Tl)); return c;
}

struct EpiCols {
    static constexpr bool MID = false;
    float* cols; unsigned short* gates;
    __device__ __forceinline__ void operator()(const AccT& acc, const pg8::Unit& u, int wr, int wc, int fr, int fq) const {
        const int row0 = u.pm * 256 + wr * 64 + fr;
        if (u.pn < 15) {
            const int col0 = u.pn * 256 + wc * 32 + 4 * fq;
#pragma unroll
            for (int ai = 0; ai < 2; ++ai)
#pragma unroll
                for (int m = 0; m < 4; ++m) { float* rp = cols + (size_t)(row0 + ai * 128 + m * 16) * NCF + col0;
#pragma unroll
                    for (int bj = 0; bj < 2; ++bj)
#pragma unroll
                        for (int n = 0; n < 2; ++n) *(f32x4*)(rp + bj * 128 + n * 16) = acc[ai][bj][m][n]; }
        } else {
            const int col0 = (u.pn - 15) * 256 + wc * 32 + 4 * fq;
#pragma unroll
            for (int ai = 0; ai < 2; ++ai)
#pragma unroll
                for (int m = 0; m < 4; ++m) { unsigned short* rp = gates + (size_t)(row0 + ai * 128 + m * 16) * NGATE + col0;
#pragma unroll
                    for (int bj = 0; bj < 2; ++bj)
#pragma unroll
                        for (int n = 0; n < 2; ++n) { const f32x4 a = acc[ai][bj][m][n]; u32x2 w;
                            w.x = pkh2(fmaxf(sigmoidf_(a[0]), 6.2e-5f), fmaxf(sigmoidf_(a[1]), 6.2e-5f)); w.y = pkh2(fmaxf(sigmoidf_(a[2]), 6.2e-5f), fmaxf(sigmoidf_(a[3]), 6.2e-5f));
                            *(u32x2*)(rp + bj * 128 + n * 16) = w; } }
        }
    }
};
struct EpiWiden {
    static constexpr bool MID = true;
    const unsigned short* gates; bf16_t* merged;
    __device__ __forceinline__ void mid(AccT& acc, const pg8::Unit& u, int z1, int wr, int wc, int fr, int fq) const {
        const int row0 = opqv(u.pm * 256 + wr * 64 + fr), col0 = opqv(u.pn * 256 + wc * 32 + 4 * fq);
#pragma unroll
        for (int ai = 0; ai < 2; ++ai)
#pragma unroll
            for (int m = 0; m < 4; ++m) { const unsigned short* rp = gates + (size_t)(row0 + ai * 128 + m * 16) * NGATE + col0;
#pragma unroll
                for (int bj = 0; bj < 2; ++bj)
#pragma unroll
                    for (int n = 0; n < 2; ++n) { const u32x2 a = *(const u32x2*)(rp + (z1 - 1) * 1024 + bj * 128 + n * 16), b = *(const u32x2*)(rp + z1 * 1024 + bj * 128 + n * 16);
                        f32x4 r; r[0] = h2f(a.x & 0xffff) * frcp(h2f(b.x & 0xffff)); r[1] = h2f(a.x >> 16) * frcp(h2f(b.x >> 16)); r[2] = h2f(a.y & 0xffff) * frcp(h2f(b.y & 0xffff)); r[3] = h2f(a.y >> 16) * frcp(h2f(b.y >> 16));
                        acc[ai][bj][m][n] *= r;
#ifndef CPU_EMU
                        asm volatile("" ::: "memory");
#endif
                    } }
    }
    __device__ __forceinline__ void operator()(const AccT& acc, const pg8::Unit& u, int wr, int wc, int fr, int fq) const {
        const int row0 = u.pm * 256 + wr * 64 + fr, col0 = u.pn * 256 + wc * 32 + 4 * fq;
#pragma unroll
        for (int ai = 0; ai < 2; ++ai)
#pragma unroll
            for (int m = 0; m < 4; ++m) { const size_t ro = (size_t)(row0 + ai * 128 + m * 16);
#pragma unroll
                for (int bj = 0; bj < 2; ++bj)
#pragma unroll
                    for (int n = 0; n < 2; ++n) { const u32x2 b = *(const u32x2*)(gates + ro * NGATE + 3 * 1024 + col0 + bj * 128 + n * 16); const f32x4 a = acc[ai][bj][m][n]; u32x2 w;
                        w.x = pk2(a[0] * h2f(b.x & 0xffff), a[1] * h2f(b.x >> 16)); w.y = pk2(a[2] * h2f(b.y & 0xffff), a[3] * h2f(b.y >> 16));
                        *(u32x2*)(merged + ro * D + col0 + bj * 128 + n * 16) = w; } }
    }
};
struct EpiPreLN {
    static constexpr bool MID = false;
    const float* x; const float* mods; float* v; int NTc, Tl;
    __device__ __forceinline__ void operator()(const AccT& acc, const pg8::Unit& u, int wr, int wc, int fr, int fq) const {
        const int row0 = u.pm * 256 + wr * 64 + fr, col0 = u.pn * 256 + wc * 32 + 4 * fq;
#pragma unroll
        for (int ai = 0; ai < 2; ++ai)
#pragma unroll
            for (int m = 0; m < 4; ++m) { const int row = row0 + ai * 128 + m * 16; const int mr = row < NTc ? 0 : 1 + (row - NTc) / Tl; const float* g1 = mods + (size_t)mr * NMOD + 2 * D + col0;
                const size_t ro = (size_t)row * D + col0;
#pragma unroll
                for (int bj = 0; bj < 2; ++bj)
#pragma unroll
                    for (int n = 0; n < 2; ++n) { const int o = bj * 128 + n * 16; const f32x4 xv = *(const f32x4*)(x + ro + o), gv = *(const f32x4*)(g1 + o);
                        *(f32x4*)(v + ro + o) = ALPHA * xv + gv * acc[ai][bj][m][n]; } }
    }
};
struct EpiSwiGLU {
    static constexpr bool MID = false;
    bf16_t* act;
    __device__ __forceinline__ void operator()(const AccT& acc, const pg8::Unit& u, int wr, int wc, int fr, int fq) const {
        const int row0 = u.pm * 256 + wr * 64 + fr, col0 = u.pn * 128 + wc * 32 + 4 * fq;
#pragma unroll
        for (int ai = 0; ai < 2; ++ai)
#pragma unroll
            for (int m = 0; m < 4; ++m) { bf16_t* rp = act + (size_t)(row0 + ai * 128 + m * 16) * FF + col0;
#pragma unroll
                for (int n = 0; n < 2; ++n) { const f32x4 a = acc[ai][0][m][n], b = acc[ai][1][m][n]; u32x2 w;
                    w.x = pk2(siluf_(a[0]) * b[0], siluf_(a[1]) * b[1]); w.y = pk2(siluf_(a[2]) * b[2], siluf_(a[3]) * b[3]); *(u32x2*)(rp + n * 16) = w; } }
    }
};
struct EpiDown {
    static constexpr bool MID = false;
    const float* pgate; float* y;
    __device__ __forceinline__ void operator()(const AccT& acc, const pg8::Unit& u, int wr, int wc, int fr, int fq) const {
        const int row0 = u.pm * 256 + wr * 64 + fr, col0 = u.pn * 256 + wc * 32 + 4 * fq;
#pragma unroll
        for (int ai = 0; ai < 2; ++ai)
#pragma unroll
            for (int m = 0; m < 4; ++m) { const int row = row0 + ai * 128 + m * 16; const float gt = pgate[row]; float* rp = y + (size_t)row * D + col0;
#pragma unroll
                for (int bj = 0; bj < 2; ++bj)
#pragma unroll
                    for (int n = 0; n < 2; ++n) *(f32x4*)(rp + bj * 128 + n * 16) = gt * acc[ai][bj][m][n]; }
    }
};

template <class ColMap>
__device__ __forceinline__ void tr_item(const float* src, int src_ld, const ColMap& cm, bf16_t* dst, int dst_ld, int dst_koff, int n0, int k0, float* scr, int lane) {
    const int sc = cm(n0 + (lane & 31));
#pragma unroll 8
    for (int i = 0; i < 32; ++i) { const int kk = 2 * i + (lane >> 5); scr[kk * 33 + (lane & 31)] = sc >= 0 ? src[(size_t)(k0 + kk) * src_ld + sc] : 0.0f; }
    WAVE_SYNC();
    const int c = lane & 7;
#pragma unroll
    for (int j = 0; j < 4; ++j) { const int n = (lane >> 3) + 8 * j; const float* s = scr + (8 * c) * 33 + n;
        u32x4 o; o.x = pk2(s[0 * 33], s[1 * 33]); o.y = pk2(s[2 * 33], s[3 * 33]); o.z = pk2(s[4 * 33], s[5 * 33]); o.w = pk2(s[6 * 33], s[7 * 33]);
        *(u32x4*)(dst + (size_t)(n0 + n) * dst_ld + dst_koff + k0 + 8 * c) = o; }
    WAVE_SYNC();
}
struct CmId { __device__ __forceinline__ int operator()(int n) const { return n; } };
struct CmWin { __device__ __forceinline__ int operator()(int n) const { return win_col(n); } };
struct CmUp { __device__ __forceinline__ int operator()(int n) const { const int u = n >> 8, w = n & 255; return (w < 128 ? 0 : FF) + u * 128 + (w & 127); } };

__device__ __forceinline__ void phase_prep(const Ctx& c0) {
    const Ctx c = fresh(c0);
    const Dims& d = c.d;
    float* L = (float*)c.lds;
    const int nrow = 1 + d.Bl;
    const int gw = c.vcu * NWAVES + c.wave, NGW = c.G * NWAVES;
    const int nmod_items = DEPTH * (NMOD / 64);
    if (c.vcu < nmod_items) {
        float* cond = L + NWAVES * 2112;
        for (int i = c.tid; i < 9 * D; i += NTHREADS) { const int r = i / D, k = i % D; const float v = r == 0 ? c.in(I_CCTX)[k] : (r < nrow ? c.in(I_C)[(size_t)(r - 1) * D + k] : 0.0f); cond[i] = siluf_(v); }
        __syncthreads();
        if (c.wave == 0) {
            const int l = c.vcu / (NMOD / 64), j = (c.vcu % (NMOD / 64)) * 64 + c.lane;
            const float* w = c.in(I_WADA) + (size_t)l * D * NMOD + j;
            float* mo = c.ws<float>(d.w_mods) + (size_t)l * nrow * NMOD + j;
            const float bias = c.in(I_BADA)[(size_t)l * NMOD + j];
            float a[9];
            UNR for (int r = 0; r < 9; ++r) a[r] = bias;
#pragma unroll 4
            for (int k = 0; k < D; ++k) { const float wv = w[(size_t)k * NMOD]; UNR for (int r = 0; r < 9; ++r) a[r] += cond[r * D + k] * wv; }
            UNR for (int r = 0; r < 9; ++r) if (r < nrow) mo[(size_t)r * NMOD] = a[r];
        }
    }
    float* scr = L + c.wave * 2112;
    const int I_IN = (D / 64) * (NINP / 32), I_BR = 4 * (MIXW / 64) * (D / 32), I_OUT = (D / 64) * (D / 32), I_UP = NEXP * (D / 64) * (2 * FF / 32), I_DN = NEXP * (FF / 64) * (D / 32);
    const int PER_L = I_IN + I_BR + I_OUT + I_UP + I_DN;
    for (int it = gw; it < DEPTH * PER_L; it += NGW) {
        const int l = it / PER_L; int r = it % PER_L;
        if (r < I_IN) { const int nb = NINP / 32, kb = r / nb, n0 = (r % nb) * 32;
            tr_item(c.in(I_WIN) + (size_t)l * D * NIN, NIN, CmWin(), c.ws<bf16_t>(d.w_win) + (size_t)l * NINP * D, D, 0, n0, kb * 64, scr, c.lane); continue; } r -= I_IN;
        if (r < I_BR) { const int per = (MIXW / 64) * (D / 32), z = r / per, q = r % per, kb = q / (D / 32), n0 = (q % (D / 32)) * 32;
            tr_item(c.in(I_WBR) + ((size_t)l * 4 + z) * MIXW * D, D, CmId(), c.ws<bf16_t>(d.w_wbr) + (size_t)l * D * D, D, z * MIXW, n0, kb * 64, scr, c.lane); continue; } r -= I_BR;
        if (r < I_OUT) { const int kb = r / (D / 32), n0 = (r % (D / 32)) * 32;
            tr_item(c.in(I_WOUT) + (size_t)l * D * D, D, CmId(), c.ws<bf16_t>(d.w_wout) + (size_t)l * D * D, D, 0, n0, kb * 64, scr, c.lane); continue; } r -= I_OUT;
        if (r < I_UP) { const int per = (D / 64) * (2 * FF / 32), e = r / per, q = r % per, kb = q / (2 * FF / 32), n0 = (q % (2 * FF / 32)) * 32;
            tr_item(c.in(I_WUP) + ((size_t)l * NEXP + e) * D * 2 * FF, 2 * FF, CmUp(), c.ws<bf16_t>(d.w_wup) + ((size_t)l * NEXP + e) * 2 * FF * D, D, 0, n0, kb * 64, scr, c.lane); continue; } r -= I_UP;
        { const int per = (FF / 64) * (D / 32), e = r / per, q = r % per, kb = q / (D / 32), n0 = (q % (D / 32)) * 32;
            tr_item(c.in(I_WDOWN) + ((size_t)l * NEXP + e) * FF * D, D, CmId(), c.ws<bf16_t>(d.w_wdn) + ((size_t)l * NEXP + e) * D * FF, FF, 0, n0, kb * 64, scr, c.lane); }
    }
}

__device__ __forceinline__ void phase_init(const Ctx& c0) {
    const Ctx c = fresh(c0);
    const Dims& d = c.d; const float* mods = c.mods(0); bf16_t* hb = c.ws<bf16_t>(d.w_hb);
    const int gw = c.vcu * NWAVES + c.wave, NGW = c.G * NWAVES;
    for (int tok = gw; tok < d.NT; tok += NGW) {
        const float* xr = tok < d.NTc ? c.in(I_XP) + (size_t)tok * D : c.in(I_XS) + (size_t)(tok - d.NTc) * D;
        const float* mr = mods + (size_t)c.modrow(tok) * NMOD;
#pragma unroll
        for (int j = 0; j < 4; ++j) { const int col = 4 * c.lane + 256 * j; const f32x4 x = *(const f32x4*)(xr + col), sh = *(const f32x4*)(mr + col), sc = *(const f32x4*)(mr + D + col);
            *(f32x4*)(c.X() + (size_t)tok * D + col) = x; const f32x4 h = x * (1.0f + sc) + sh;
            u32x2 w; w.x = pk2(h[0], h[1]); w.y = pk2(h[2], h[3]); *(u32x2*)(hb + (size_t)tok * D + col) = w; }
    }
}

__device__ __forceinline__ f32x16 mm32(int lane, f32x16 acc, const float* A, int sai, int sak, const float* Bm, int sbk, int sbj, int K) {
    const int i = lane & 31, kk = lane >> 5;
    const float* ap = A + i * sai + kk * sak; const float* bp = Bm + kk * sbk + i * sbj;
#pragma unroll 8
    for (int k = 0; k < K; k += 2) acc = __builtin_amdgcn_mfma_f32_32x32x2f32(ap[k * sak], bp[k * sbk], acc, 0, 0, 0);
    return acc;
}
#define ACC_ROW(r, lane) (((r) & 3) + 8 * ((r) >> 2) + 4 * ((lane) >> 5))
__device__ __forceinline__ f32x16 zero16() { f32x16 z; UNR for (int r = 0; r < 16; ++r) z[r] = 0.0f; return z; }
constexpr int S65 = 65, MSZ = 64 * 65;

__device__ __forceinline__ void build_rope(float* cosT, float* sinT, int tid) {
    for (int i = tid; i < 1024; i += NTHREADS) { const int pos = i >> 4, f = i & 15; const float inv = powf(10000.0f, -(float)f / 16.0f); const float ang = (float)pos * inv; cosT[i] = cosf(ang); sinT[i] = sinf(ang); }
}
__device__ __forceinline__ float rope_elem(const float* rowp, int dd, int t, const float* cosT, const float* sinT) {
    const int f = dd & 15, second = (dd >> 4) & 1, pos = (dd < 32) ? (t / GRIDW) : (t % GRIDW);
    const float x = rowp[dd], xp = rowp[second ? dd - 16 : dd + 16], cs = cosT[pos * 16 + f], sn = sinT[pos * 16 + f];
    return second ? (xp * sn + x * cs) : (x * cs - xp * sn);
}

constexpr int SL_MF = 0, SL_MB = 1, SL_GF = 2, SL_GB = 3, SL_RF = 4, SL_RB = 5, SL_RBONUS = 6, NSLOT = 7;

struct ChunkRegs { float q1[4], q2[4], k1[4], k2[4], v1[4], v2[4]; };
__device__ __forceinline__ void chunk_load(ChunkRegs& R, const float* cols, size_t tok0, int T, int dir, int ci, int h, int cbq, int tid) {
    UNR for (int u = 0; u < 4; ++u) { const int ps = tid + NTHREADS * u, j = ps >> 5, pp = ps & 31, dd1 = (pp >> 4) * 32 + (pp & 15), t = dir ? T - 1 - (ci * 64 + j) : ci * 64 + j;
        const float* rp = cols + (tok0 + t) * NCF + h * 64 + dd1;
        R.q1[u] = rp[cbq * 256]; R.q2[u] = rp[cbq * 256 + 16]; R.k1[u] = rp[(cbq + 1) * 256]; R.k2[u] = rp[(cbq + 1) * 256 + 16]; R.v1[u] = rp[(cbq + 2) * 256]; R.v2[u] = rp[(cbq + 2) * 256 + 16]; }
}
__device__ __forceinline__ void chunk_store(const ChunkRegs& R, float* Q, float* K, float* V, int T, int dir, int ci, int pass, float qs, float ks, const float* cosT, const float* sinT, int tid) {
    UNR for (int u = 0; u < 4; ++u) { const int ps = tid + NTHREADS * u, j = ps >> 5, pp = ps & 31, dd1 = (pp >> 4) * 32 + (pp & 15), o = j * S65 + dd1;
        float q1 = R.q1[u], q2 = R.q2[u], k1 = R.k1[u], k2 = R.k2[u];
        if (pass) { const int t = dir ? T - 1 - (ci * 64 + j) : ci * 64 + j, pos = (pp >> 4) ? (t % GRIDW) : (t / GRIDW); const float cs = cosT[pos * 16 + (pp & 15)], sn = sinT[pos * 16 + (pp & 15)];
            const float a = q1 * cs - q2 * sn, b = q1 * sn + q2 * cs, cc = k1 * cs - k2 * sn, dd = k1 * sn + k2 * cs; q1 = a; q2 = b; k1 = cc; k2 = dd; }
        Q[o] = q1 * qs; Q[o + 16] = q2 * qs; K[o] = k1 * ks; K[o + 16] = k2 * ks; V[o] = R.v1[u]; V[o + 16] = R.v2[u]; }
}

__device__ __forceinline__ void mix_mlstm(const Ctx& c0, int l, int pass, int b, int h, int dir) {
    const Ctx c = fresh(c0);
    const Dims& d = c.d; const int T = pass ? d.Tl : d.Tc, nc = T / 64, tid = c.tid, lane = c.lane, wave = c.wave; const size_t tok0 = pass ? d.NTc + (size_t)b * d.Tl : (size_t)b * d.Tc;
    float* L = (float*)c.lds;
    float *Q = L, *K = L + MSZ, *V = L + 2 * MSZ, *C = L + 3 * MSZ, *Sm = L + 4 * MSZ, *QC = L + 5 * MSZ, *vec = L + 6 * MSZ;
    float *nv = vec, *ig = vec + 64, *lf = vec + 128, *bc = vec + 192, *lw = vec + 256, *wint = vec + 320, *rden = vec + 384, *scal = vec + 448, *npart = vec + 512, *cosT = vec + 1024, *sinT = vec + 2048;
    const float* cols = c.ws<float>(d.w_cols); float* scr = c.ws<float>(d.w_scr);
    __syncthreads();
    if (pass) build_rope(cosT, sinT, tid);
    if (pass) { const float* C0 = c.in(I_SC) + ((((size_t)b * DEPTH + l) * 2 + dir) * NH + h) * HD * HD;
        _Pragma("unroll 2") for (int i = tid; i < 4096; i += NTHREADS) C[(i >> 6) * S65 + (i & 63)] = C0[i];
        if (tid < 64) nv[tid] = c.in(I_SN)[((((size_t)b * DEPTH + l) * 2 + dir) * NH + h) * HD + tid];
        if (tid == 0) scal[0] = c.in(I_SM)[(((size_t)b * DEPTH + l) * 2 + dir) * NH + h];
    } else { _Pragma("unroll 2") for (int i = tid; i < 4096; i += NTHREADS) C[(i >> 6) * S65 + (i & 63)] = 0.0f; if (tid < 64) nv[tid] = 0.0f; if (tid == 0) scal[0] = 0.0f; }
    const float big = c.in(I_BIG)[((size_t)l * 2 + dir) * NH + h], bfg = c.in(I_BFG)[((size_t)l * 2 + dir) * NH + h];
    ChunkRegs R; float rig = 0.0f, rlf = 0.0f;
    chunk_load(R, cols, tok0, T, dir, 0, h, CB_MQ, tid);
    if (tid < 64) { const int t = dir ? T - 1 - tid : tid; const float* rp = cols + (tok0 + t) * NCF; rig = rp[SM_MI + dir * 4 + h]; rlf = rp[SM_MF + dir * 4 + h]; }
    __syncthreads();
    chunk_store(R, Q, K, V, T, dir, 0, pass, 1.0f, 0.125f, cosT, sinT, tid);
    if (tid < 64) { ig[tid] = rig + big; lf[tid] = logsigmoidf_(rlf + bfg); }
    for (int ci = 0; ci < nc; ++ci) {
        if (ci + 1 < nc) {
            chunk_load(R, cols, tok0, T, dir, ci + 1, h, CB_MQ, tid);
            if (tid < 64) { const int t = dir ? T - 1 - ((ci + 1) * 64 + tid) : (ci + 1) * 64 + tid; const float* rp = cols + (tok0 + t) * NCF; rig = rp[SM_MI + dir * 4 + h]; rlf = rp[SM_MF + dir * 4 + h]; }
        }
        __syncthreads();
        if (wave == 0) { float run = lf[lane];
            UNR for (int o = 1; o < 64; o <<= 1) { const float up = __shfl(run, lane >= o ? lane - o : lane); run += lane >= o ? up : 0.0f; }
            const float bend = __shfl(run, 63), m = scal[0], w = bend - run + ig[lane]; float mx = w;
            UNR for (int o = 1; o < 64; o <<= 1) mx = fmaxf(mx, __shfl_xor(mx, o));
            const float mnew = fmaxf(bend + m, mx); bc[lane] = run; lw[lane] = w; if (lane == 0) { scal[1] = mnew; scal[2] = expf(bend + m - mnew); } }
        { const int ti = (wave >> 1) & 1, tj = wave & 1; f32x16 acc = zero16();
          if (wave < 4) { acc = mm32(lane, acc, Q + ti * 32 * S65, S65, 1, K + tj * 32 * S65, 1, S65, 64); UNR for (int r = 0; r < 16; ++r) Sm[(ti * 32 + ACC_ROW(r, lane)) * S65 + tj * 32 + (lane & 31)] = acc[r]; }
          else { acc = mm32(lane, acc, Q + ti * 32 * S65, S65, 1, C + tj * 32, S65, 1, 64); UNR for (int r = 0; r < 16; ++r) QC[(ti * 32 + ACC_ROW(r, lane)) * S65 + tj * 32 + (lane & 31)] = acc[r]; } }
        __syncthreads();
        { const int t = tid >> 3, g = tid & 7; const float m = scal[0], mnew = scal[1], bt = bc[t]; float mx = -3.0e38f;
          UNR for (int e = 0; e < 8; ++e) { const int s = g * 8 + e; if (s <= t) mx = fmaxf(mx, bt - bc[s] + ig[s]); }
          mx = fmaxf(mx, __shfl_xor(mx, 1)); mx = fmaxf(mx, __shfl_xor(mx, 2)); mx = fmaxf(mx, __shfl_xor(mx, 4));
          const float minter = bt + m, mt = fmaxf(minter, mx); float den = 0.0f, qn = 0.0f;
          UNR for (int e = 0; e < 8; ++e) { const int s = g * 8 + e; float sv = 0.0f; if (s <= t) sv = Sm[t * S65 + s] * expf(bt - bc[s] + ig[s] - mt); Sm[t * S65 + s] = sv; den += sv; qn += Q[t * S65 + s] * nv[s]; }
          den += __shfl_xor(den, 1); den += __shfl_xor(den, 2); den += __shfl_xor(den, 4); qn += __shfl_xor(qn, 1); qn += __shfl_xor(qn, 2); qn += __shfl_xor(qn, 4);
          const float wi = expf(minter - mt); den += wi * qn;
          if (g == 0) { wint[t] = wi; rden[t] = 1.0f / fmaxf(fabsf(den), expf(-mt)); }
          const float ks = expf(lw[t] - mnew); UNR for (int e = 0; e < 8; ++e) K[t * S65 + g * 8 + e] *= ks; }
        __syncthreads();
        { const int ti = (wave >> 1) & 1, tj = wave & 1;
          if (wave < 4) { f32x16 acc = zero16(); acc = mm32(lane, acc, Sm + ti * 32 * S65, S65, 1, V + tj * 32, S65, 1, 64);
              UNR for (int r = 0; r < 16; ++r) { const int row = ti * 32 + ACC_ROW(r, lane), o = row * S65 + tj * 32 + (lane & 31); QC[o] = (acc[r] + wint[row] * QC[o]) * rden[row]; } }
          else { const float carry = scal[2]; f32x16 acc; UNR for (int r = 0; r < 16; ++r) acc[r] = carry * C[(ti * 32 + ACC_ROW(r, lane)) * S65 + tj * 32 + (lane & 31)];
              acc = mm32(lane, acc, K + ti * 32, 1, S65, V + tj * 32, S65, 1, 64);
              UNR for (int r = 0; r < 16; ++r) C[(ti * 32 + ACC_ROW(r, lane)) * S65 + tj * 32 + (lane & 31)] = acc[r]; }
          float s = 0.0f; UNR for (int e = 0; e < 8; ++e) s += K[(wave * 8 + e) * S65 + lane]; npart[wave * 64 + lane] = s; }
        __syncthreads();
        if (tid < 64) { float s = 0.0f; UNR for (int e = 0; e < 8; ++e) s += npart[e * 64 + tid]; nv[tid] = scal[2] * nv[tid] + s; }
        { const int j = tid >> 3, g = tid & 7, t = dir ? T - 1 - (ci * 64 + j) : ci * 64 + j; float* sp = scr + ((tok0 + t) * NSLOT + (dir ? SL_MB : SL_MF)) * MIXW + h * 64 + g * 8; const float* hp = QC + j * S65 + g * 8;
          *(f32x4*)sp = (f32x4){hp[0], hp[1], hp[2], hp[3]}; *(f32x4*)(sp + 4) = (f32x4){hp[4], hp[5], hp[6], hp[7]}; }
        if (ci + 1 < nc) { chunk_store(R, Q, K, V, T, dir, ci + 1, pass, 1.0f, 0.125f, cosT, sinT, tid); if (tid < 64) { ig[tid] = rig + big; lf[tid] = logsigmoidf_(rlf + bfg); } }
        if (tid == 0) scal[0] = scal[1];
    }
    __syncthreads();
    if (!pass) {
        float* Co = c.p->out + d.o_C + ((((size_t)b * DEPTH + l) * 2 + dir) * NH + h) * HD * HD;
        _Pragma("unroll 2") for (int i = tid; i < 4096; i += NTHREADS) Co[i] = C[(i >> 6) * S65 + (i & 63)];
        if (tid < 64) c.p->out[d.o_n + ((((size_t)b * DEPTH + l) * 2 + dir) * NH + h) * HD + tid] = nv[tid];
        if (tid == 0) c.p->out[d.o_m + (((size_t)b * DEPTH + l) * 2 + dir) * NH + h] = scal[0];
    }
    __syncthreads();
}

__device__ __forceinline__ void mix_gla(const Ctx& c0, int l, int pass, int b, int h, int dir) {
    const Ctx c = fresh(c0);
    const Dims& d = c.d; const int T = pass ? d.Tl : d.Tc, nc = T / 64, tid = c.tid, lane = c.lane, wave = c.wave; const size_t tok0 = pass ? d.NTc + (size_t)b * d.Tl : (size_t)b * d.Tc;
    float* L = (float*)c.lds;
    float *Q = L, *K = L + MSZ, *V = L + 2 * MSZ, *S = L + 3 * MSZ, *Gm = L + 4 * MSZ, *O2 = L + 5 * MSZ, *vec = L + 6 * MSZ;
    float *gend = vec, *bA = vec + 64, *gpart = vec + 128, *GA = vec + 640, *wA = vec + 640 + 1024, *cosT = vec + 640 + 2048, *sinT = vec + 640 + 3072;
    const float* cols = c.ws<float>(d.w_cols); float* scr = c.ws<float>(d.w_scr);
    __syncthreads();
    if (pass) build_rope(cosT, sinT, tid);
    if (pass) { const float* S0 = c.in(I_SG) + ((((size_t)b * DEPTH + l) * 2 + dir) * NH + h) * HD * HD; _Pragma("unroll 2") for (int i = tid; i < 4096; i += NTHREADS) S[(i >> 6) * S65 + (i & 63)] = S0[i]; }
    else { _Pragma("unroll 2") for (int i = tid; i < 4096; i += NTHREADS) S[(i >> 6) * S65 + (i & 63)] = 0.0f; }
    for (int i = tid; i < 1024; i += NTHREADS) wA[i] = c.in(I_WGLA)[(((size_t)l * 2 + dir) * 16 + (i >> 6)) * MIXW + h * 64 + (i & 63)];
    if (tid < 64) bA[tid] = c.in(I_BGLA)[((size_t)l * 2 + dir) * MIXW + h * 64 + tid];
    ChunkRegs R; f32x4 rga = (f32x4){0.f, 0.f, 0.f, 0.f};
    chunk_load(R, cols, tok0, T, dir, 0, h, CB_GQ, tid);
    if (tid < 256) { const int j = tid >> 2, t = dir ? T - 1 - j : j; rga = *(const f32x4*)(cols + (tok0 + t) * NCF + SM_GA + dir * 16 + (tid & 3) * 4); }
    __syncthreads();
    chunk_store(R, Q, K, V, T, dir, 0, pass, 0.125f, 1.0f, cosT, sinT, tid);
    if (tid < 256) *(f32x4*)(GA + (tid >> 2) * 16 + (tid & 3) * 4) = rga;
    for (int ci = 0; ci < nc; ++ci) {
        if (ci + 1 < nc) {
            chunk_load(R, cols, tok0, T, dir, ci + 1, h, CB_GQ, tid);
            if (tid < 256) { const int j = tid >> 2, t = dir ? T - 1 - ((ci + 1) * 64 + j) : (ci + 1) * 64 + j; rga = *(const f32x4*)(cols + (tok0 + t) * NCF + SM_GA + dir * 16 + (tid & 3) * 4); }
        }
        __syncthreads();
        float gl[8];
        { float run = 0.0f;
          UNR for (int e = 0; e < 8; ++e) { const float* ga = GA + (wave * 8 + e) * 16; float a = bA[lane];
              UNR for (int r = 0; r < 16; ++r) a += ga[r] * wA[r * 64 + lane];
              run += logsigmoidf_(a) * (1.0f / 16.0f); gl[e] = run; }
          gpart[wave * 64 + lane] = run; }
        __syncthreads();
        { float pre = 0.0f; UNR for (int e = 0; e < 8; ++e) pre += (e < wave) ? gpart[e * 64 + lane] : 0.0f;
          UNR for (int e = 0; e < 8; ++e) { const float g = gl[e] + pre; const int o = (wave * 8 + e) * S65 + lane; Q[o] *= expf(g); K[o] *= expf(-g); if (wave == 7 && e == 7) gend[lane] = g; } }
        __syncthreads();
        { const int ti = (wave >> 1) & 1, tj = wave & 1; f32x16 acc = zero16();
          if (wave < 4) { acc = mm32(lane, acc, Q + ti * 32 * S65, S65, 1, K + tj * 32 * S65, 1, S65, 64);
              UNR for (int r = 0; r < 16; ++r) { const int row = ti * 32 + ACC_ROW(r, lane), col = tj * 32 + (lane & 31); Gm[row * S65 + col] = col <= row ? acc[r] : 0.0f; } }
          else { acc = mm32(lane, acc, Q + ti * 32 * S65, S65, 1, S + tj * 32, S65, 1, 64); UNR for (int r = 0; r < 16; ++r) O2[(ti * 32 + ACC_ROW(r, lane)) * S65 + tj * 32 + (lane & 31)] = acc[r]; } }
        __syncthreads();
        { const int ti = (wave >> 1) & 1, tj = wave & 1;
          if (wave < 4) { f32x16 acc; UNR for (int r = 0; r < 16; ++r) acc[r] = O2[(ti * 32 + ACC_ROW(r, lane)) * S65 + tj * 32 + (lane & 31)];
              acc = mm32(lane, acc, Gm + ti * 32 * S65, S65, 1, V + tj * 32, S65, 1, 64);
              UNR for (int r = 0; r < 16; ++r) O2[(ti * 32 + ACC_ROW(r, lane)) * S65 + tj * 32 + (lane & 31)] = acc[r]; }
          else { f32x16 acc; UNR for (int r = 0; r < 16; ++r) acc[r] = S[(ti * 32 + ACC_ROW(r, lane)) * S65 + tj * 32 + (lane & 31)];
              acc = mm32(lane, acc, K + ti * 32, 1, S65, V + tj * 32, S65, 1, 64);
              UNR for (int r = 0; r < 16; ++r) { const int row = ti * 32 + ACC_ROW(r, lane); S[row * S65 + tj * 32 + (lane & 31)] = expf(gend[row]) * acc[r]; } } }
        __syncthreads();
        { const int j = tid >> 3, g = tid & 7, t = dir ? T - 1 - (ci * 64 + j) : ci * 64 + j; float* sp = scr + ((tok0 + t) * NSLOT + (dir ? SL_GB : SL_GF)) * MIXW + h * 64 + g * 8; const float* hp = O2 + j * S65 + g * 8;
          *(f32x4*)sp = (f32x4){hp[0], hp[1], hp[2], hp[3]}; *(f32x4*)(sp + 4) = (f32x4){hp[4], hp[5], hp[6], hp[7]}; }
        if (ci + 1 < nc) { chunk_store(R, Q, K, V, T, dir, ci + 1, pass, 0.125f, 1.0f, cosT, sinT, tid); if (tid < 256) *(f32x4*)(GA + (tid >> 2) * 16 + (tid & 3) * 4) = rga; }
    }
    __syncthreads();
    if (!pass) { float* So = c.p->out + d.o_g + ((((size_t)b * DEPTH + l) * 2 + dir) * NH + h) * HD * HD; _Pragma("unroll 2") for (int i = tid; i < 4096; i += NTHREADS) So[i] = S[(i >> 6) * S65 + (i & 63)]; }
    __syncthreads();
}

__device__ __forceinline__ void mix_rwkv(const Ctx& c0, int l, int pass, int b, int h, int dir) {
    const Ctx c = fresh(c0);
    const Dims& d = c.d; const int T = pass ? d.Tl : d.Tc, tid = c.tid, lane = c.lane, wave = c.wave; const size_t tok0 = pass ? d.NTc + (size_t)b * d.Tl : (size_t)b * d.Tc;
    float* L = (float*)c.lds;
    const float* cols = c.ws<float>(d.w_cols); float* scr = c.ws<float>(d.w_scr);
    constexpr int TB = 32, VST = 6 * 64;
    float *VEC = L, *W2s = L + 2 * TB * VST, *A2s = W2s + 2048, *TWA = A2s + 2048;
    const int nb = T / TB, ch = h * 64 + lane;
    __syncthreads();
    for (int i = tid; i < 2048; i += NTHREADS) { W2s[i] = c.in(I_WW2)[(((size_t)l * 2 + dir) * 32 + (i >> 6)) * MIXW + h * 64 + (i & 63)]; A2s[i] = c.in(I_WA2)[(((size_t)l * 2 + dir) * 32 + (i >> 6)) * MIXW + h * 64 + (i & 63)]; }
    const int st = tid & 255, vrow = st >> 2, q = st & 3;
    float Sr[16];
    if (pass) { const float* S0 = c.in(I_SR) + ((((size_t)b * DEPTH + l) * 2 + dir) * NH + h) * HD * HD + vrow * 64 + q * 16; UNR for (int j = 0; j < 16; ++j) Sr[j] = S0[j]; }
    else { UNR for (int j = 0; j < 16; ++j) Sr[j] = 0.0f; }
    const float* tp = c.in(I_SHIFT) + (size_t)l * 3 * 768 + ch;
    const float t0r = tp[0], t1r = tp[768], t2r = tp[1536], t0k = tp[256], t1k = tp[768 + 256], t2k = tp[1536 + 256], t0v = tp[512], t1v = tp[768 + 512], t2v = tp[1536 + 512];
    const float w0c = c.in(I_W0)[((size_t)l * 2 + dir) * MIXW + ch], a0c = c.in(I_A0)[((size_t)l * 2 + dir) * MIXW + ch], kkc = c.in(I_KK)[(size_t)l * MIXW + ch], kac = c.in(I_KA)[(size_t)l * MIXW + ch], rkc = c.in(I_RKK)[(size_t)l * MIXW + ch];
    __syncthreads();
    for (int jb = -1; jb < nb; ++jb) {
        if (wave >= 4) {
            if (jb + 1 < nb) {
                const int pw = wave - 4, nbk = jb + 1; float* buf = VEC + (nbk & 1) * TB * VST; float* TW = TWA + pw * 512; float* RA = TW + 256;
                const int pi0 = nbk * TB + pw * 8;
                { const int s = lane >> 3, r4 = (lane & 7) * 4, pi = pi0 + s, t = dir ? T - 1 - pi : pi; const float* rp = cols + (tok0 + t) * NCF;
                  const f32x4 rw = *(const f32x4*)(rp + SM_RW + dir * 32 + r4), ra = *(const f32x4*)(rp + SM_RA + dir * 32 + r4);
                  *(f32x4*)(TW + s * 32 + r4) = (f32x4){tanhf(rw[0]), tanhf(rw[1]), tanhf(rw[2]), tanhf(rw[3])}; *(f32x4*)(RA + s * 32 + r4) = ra; }
                const int tlo = dir ? T - 1 - (pi0 + 7) : pi0;
                float xr[10], xk[10], xv[10];
                UNR for (int e = 0; e < 10; ++e) { const int tt = tlo - 1 + e; const bool ok = tt >= 0 && tt < T; const float* rp = cols + (tok0 + (ok ? tt : 0)) * NCF + ch;
                    xr[e] = ok ? rp[CB_RR * 256] : 0.0f; xk[e] = ok ? rp[CB_RK * 256] : 0.0f; xv[e] = ok ? rp[CB_RV * 256] : 0.0f; }
                WAVE_SYNC();
                UNR for (int s = 0; s < 8; ++s) {
                    const int e1 = dir ? 8 - s : s + 1;
                    const float r = t0r * (dir ? xr[7 - s] : xr[s]) + t1r * (dir ? xr[8 - s] : xr[s + 1]) + t2r * (dir ? xr[9 - s] : xr[s + 2]);
                    const float k = t0k * (dir ? xk[7 - s] : xk[s]) + t1k * (dir ? xk[8 - s] : xk[s + 1]) + t2k * (dir ? xk[9 - s] : xk[s + 2]);
                    const float v = t0v * (dir ? xv[7 - s] : xv[s]) + t1v * (dir ? xv[8 - s] : xv[s + 1]) + t2v * (dir ? xv[9 - s] : xv[s + 2]);
                    (void)e1;
                    float lw = 0.0f, la = 0.0f;
                    UNR for (int r4 = 0; r4 < 32; r4 += 4) { const f32x4 tw = *(const f32x4*)(TW + s * 32 + r4), ra = *(const f32x4*)(RA + s * 32 + r4);
                        UNR for (int e = 0; e < 4; ++e) { lw += tw[e] * W2s[(r4 + e) * 64 + lane]; la += ra[e] * A2s[(r4 + e) * 64 + lane]; } }
                    const float decay = expf(-expf(-softplusf_(-(w0c + lw)) - 0.5f)), a = sigmoidf_(a0c + la);
                    float kap = k * kkc; const float ss = wave_sum(kap * kap); kap *= 1.0f / sqrtf(ss + LN_EPS);
                    const float khat = k * (1.0f + (a - 1.0f) * kac);
                    float* P = buf + (pw * 8 + s) * VST + lane;
                    P[0] = r; P[64] = kap; P[128] = v; P[192] = decay; P[256] = a * kap; P[320] = khat;
                    if (dir == 0) { const float bonus = wave_sum(r * k * rkc) * v; const int t = pi0 + s; scr[((tok0 + t) * NSLOT + SL_RBONUS) * MIXW + ch] = bonus; }
                }
            }
        } else if (jb >= 0) {
            const float* buf = VEC + (jb & 1) * TB * VST;
            for (int i = 0; i < TB; ++i) { const float* Pi = buf + i * VST + q * 16; const int pi = jb * TB + i, t = dir ? T - 1 - pi : pi;
                float sk0 = 0.0f, sk1 = 0.0f;
                UNR for (int j = 0; j < 16; j += 2) { sk0 += Sr[j] * Pi[64 + j]; sk1 += Sr[j + 1] * Pi[64 + j + 1]; }
                float sk = sk0 + sk1; sk += __shfl_xor(sk, 1); sk += __shfl_xor(sk, 2);
                const float vv = buf[i * VST + 128 + vrow]; float y0 = 0.0f, y1 = 0.0f;
                UNR for (int j = 0; j < 16; j += 2) { const float s0 = Sr[j] * Pi[192 + j] - sk * Pi[256 + j] + vv * Pi[320 + j], s1 = Sr[j + 1] * Pi[192 + j + 1] - sk * Pi[256 + j + 1] + vv * Pi[320 + j + 1];
                    Sr[j] = s0; Sr[j + 1] = s1; y0 += s0 * Pi[j]; y1 += s1 * Pi[j + 1]; }
                float y = y0 + y1; y += __shfl_xor(y, 1); y += __shfl_xor(y, 2);
                if (q == 0) scr[((tok0 + t) * NSLOT + (dir ? SL_RB : SL_RF)) * MIXW + h * 64 + vrow] = y; }
        }
        __syncthreads();
    }
    if (!pass && wave < 4) { float* So = c.p->out + d.o_r + ((((size_t)b * DEPTH + l) * 2 + dir) * NH + h) * HD * HD + vrow * 64 + q * 16; UNR for (int j = 0; j < 16; ++j) So[j] = Sr[j]; }
    __syncthreads();
}

__device__ __forceinline__ void phase_combine(const Ctx& c0, int l) {
    const Ctx c = fresh(c0);
    const Dims& d = c.d; const int tid = c.tid, lane = c.lane, wave = c.wave;
    float* L = (float*)c.lds; float *SG = L, *G2 = L + MSZ, *GT = L + MSZ + 64 * 256;
    const float* cols = c.ws<float>(d.w_cols); const float* scr = c.ws<float>(d.w_scr); bf16_t* br = c.ws<bf16_t>(d.w_br);
    __syncthreads();
    for (int i = tid; i < 64 * 256; i += NTHREADS) G2[i] = c.in(I_WG2)[(size_t)l * 64 * MIXW + i];
    for (int blk = c.vcu; blk < d.NT / 64; blk += c.G) {
        const size_t tb = (size_t)blk * 64;
        __syncthreads();
        { const int j = tid >> 3, g = tid & 7; const float* rp = cols + (tb + j) * NCF + SM_RG + g * 8; const f32x4 a = *(const f32x4*)rp, b2 = *(const f32x4*)(rp + 4); float* sp = SG + j * S65 + g * 8;
          sp[0] = sigmoidf_(a[0]); sp[1] = sigmoidf_(a[1]); sp[2] = sigmoidf_(a[2]); sp[3] = sigmoidf_(a[3]); sp[4] = sigmoidf_(b2[0]); sp[5] = sigmoidf_(b2[1]); sp[6] = sigmoidf_(b2[2]); sp[7] = sigmoidf_(b2[3]); }
        __syncthreads();
        UNR for (int u = 0; u < 2; ++u) { const int tl = wave * 2 + u, ti = tl >> 3, tj = tl & 7; f32x16 acc = zero16();
            acc = mm32(lane, acc, SG + ti * 32 * S65, S65, 1, G2 + tj * 32, 256, 1, 64);
            UNR for (int r = 0; r < 16; ++r) GT[(ti * 32 + ACC_ROW(r, lane)) * 257 + tj * 32 + (lane & 31)] = acc[r]; }
        __syncthreads();
        for (int hh = 0; hh < NH; ++hh) {
            const int j = tid >> 3, g = tid & 7; const size_t tok = tb + j; const int cb = hh * 64 + g * 8; const float* sp = scr + tok * NSLOT * MIXW + cb;
            {
              const f32x4 a0 = *(const f32x4*)(sp + SL_MF * MIXW), a1 = *(const f32x4*)(sp + SL_MF * MIXW + 4), b0 = *(const f32x4*)(sp + SL_MB * MIXW), b1 = *(const f32x4*)(sp + SL_MB * MIXW + 4);
              float x[8]; float s = 0.0f; UNR for (int e = 0; e < 4; ++e) { x[e] = a0[e] + b0[e]; x[4 + e] = a1[e] + b1[e]; } UNR for (int e = 0; e < 8; ++e) s += x[e];
              s += __shfl_xor(s, 1); s += __shfl_xor(s, 2); s += __shfl_xor(s, 4); const float mean = s * (1.0f / 64.0f); float qv = 0.0f;
              UNR for (int e = 0; e < 8; ++e) { x[e] -= mean; qv += x[e] * x[e]; }
              qv += __shfl_xor(qv, 1); qv += __shfl_xor(qv, 2); qv += __shfl_xor(qv, 4); const float rs = 1.0f / sqrtf(qv * (1.0f / 64.0f) + LN_EPS);
              const float* og = cols + tok * NCF + CB_MO * 256 + cb; const f32x4 o0 = *(const f32x4*)og, o1 = *(const f32x4*)(og + 4);
              u32x4 w; w.x = pk2(x[0] * rs * sigmoidf_(o0[0]), x[1] * rs * sigmoidf_(o0[1])); w.y = pk2(x[2] * rs * sigmoidf_(o0[2]), x[3] * rs * sigmoidf_(o0[3]));
              w.z = pk2(x[4] * rs * sigmoidf_(o1[0]), x[5] * rs * sigmoidf_(o1[1])); w.w = pk2(x[6] * rs * sigmoidf_(o1[2]), x[7] * rs * sigmoidf_(o1[3])); *(u32x4*)(br + tok * D + 0 * MIXW + cb) = w; }
            {
              const f32x4 a0 = *(const f32x4*)(sp + SL_GF * MIXW), a1 = *(const f32x4*)(sp + SL_GF * MIXW + 4), b0 = *(const f32x4*)(sp + SL_GB * MIXW), b1 = *(const f32x4*)(sp + SL_GB * MIXW + 4);
              float x[8]; float qv = 0.0f; UNR for (int e = 0; e < 4; ++e) { x[e] = a0[e] + b0[e]; x[4 + e] = a1[e] + b1[e]; } UNR for (int e = 0; e < 8; ++e) qv += x[e] * x[e];
              qv += __shfl_xor(qv, 1); qv += __shfl_xor(qv, 2); qv += __shfl_xor(qv, 4); const float rs = 1.0f / sqrtf(qv * (1.0f / 64.0f) + LN_EPS);
              const float* og = cols + tok * NCF + CB_GG * 256 + cb; const f32x4 o0 = *(const f32x4*)og, o1 = *(const f32x4*)(og + 4);
              u32x4 w; w.x = pk2(x[0] * rs * siluf_(o0[0]), x[1] * rs * siluf_(o0[1])); w.y = pk2(x[2] * rs * siluf_(o0[2]), x[3] * rs * siluf_(o0[3]));
              w.z = pk2(x[4] * rs * siluf_(o1[0]), x[5] * rs * siluf_(o1[1])); w.w = pk2(x[6] * rs * siluf_(o1[2]), x[7] * rs * siluf_(o1[3])); *(u32x4*)(br + tok * D + 1 * MIXW + cb) = w; }
            {
              const f32x4 a0 = *(const f32x4*)(sp + SL_RF * MIXW), a1 = *(const f32x4*)(sp + SL_RF * MIXW + 4), b0 = *(const f32x4*)(sp + SL_RB * MIXW), b1 = *(const f32x4*)(sp + SL_RB * MIXW + 4);
              const f32x4 n0 = *(const f32x4*)(sp + SL_RBONUS * MIXW), n1 = *(const f32x4*)(sp + SL_RBONUS * MIXW + 4);
              float x[8]; float s = 0.0f; UNR for (int e = 0; e < 4; ++e) { x[e] = a0[e] + b0[e]; x[4 + e] = a1[e] + b1[e]; } UNR for (int e = 0; e < 8; ++e) s += x[e];
              s += __shfl_xor(s, 1); s += __shfl_xor(s, 2); s += __shfl_xor(s, 4); const float mean = s * (1.0f / 64.0f); float qv = 0.0f;
              UNR for (int e = 0; e < 8; ++e) { x[e] -= mean; qv += x[e] * x[e]; }
              qv += __shfl_xor(qv, 1); qv += __shfl_xor(qv, 2); qv += __shfl_xor(qv, 4); const float rs = 1.0f / sqrtf(qv * (1.0f / 64.0f) + LN_EPS);
              const float* gp = GT + j * 257 + cb;
              u32x4 w; w.x = pk2((x[0] * rs + n0[0]) * gp[0], (x[1] * rs + n0[1]) * gp[1]); w.y = pk2((x[2] * rs + n0[2]) * gp[2], (x[3] * rs + n0[3]) * gp[3]);
              w.z = pk2((x[4] * rs + n1[0]) * gp[4], (x[5] * rs + n1[1]) * gp[5]); w.w = pk2((x[6] * rs + n1[2]) * gp[6], (x[7] * rs + n1[3]) * gp[7]); *(u32x4*)(br + tok * D + 2 * MIXW + cb) = w; }
        }
    }
    __syncthreads();
}

__device__ __forceinline__ void mix_na(const Ctx& c0, int l, int pass, int b, int h, int qb) {
    const Ctx c = fresh(c0);
    const Dims& d = c.d; const int tid = c.tid, lane = c.lane, wave = c.wave; const size_t tok0 = pass ? d.NTc + (size_t)b * d.Tl : (size_t)b * d.Tc;
    float* L = (float*)c.lds;
    float *Q = L, *Kt = L + MSZ, *Vt = L + 2 * MSZ, *Sm = L + 3 * MSZ, *vec = L + 4 * MSZ;
    float *mrow = vec, *lrow = vec + 64, *arow = vec + 128, *rpbs = vec + 192;
    const float* cols = c.ws<float>(d.w_cols); bf16_t* br = c.ws<bf16_t>(d.w_br);
    const int rows = d.Tl / GRIDW, kr = rows < 8 ? rows : 8; int rs = qb - kr / 2; rs = rs < 0 ? 0 : (rs > rows - kr ? rows - kr : rs);
    const int ntile = pass ? kr + PAST / 64 : d.Tc / 64;
    __syncthreads();
    _Pragma("unroll 2") for (int i = tid; i < 4096; i += NTHREADS) { const int j = i >> 6, dd = i & 63; const size_t tok = tok0 + qb * 64 + j; const float* rp = cols + tok * NCF + h * 64;
        Q[j * S65 + dd] = rp[CB_NQ * 256 + dd] * 0.125f;
        if (!pass) { const size_t o = ((((size_t)b * DEPTH + l) * NH + h) * d.Tc + qb * 64 + j) * HD + dd; c.p->out[d.o_nk + o] = rp[CB_NK * 256 + dd]; c.p->out[d.o_nv + o] = rp[CB_NV * 256 + dd]; } }
    if (tid < 64) { mrow[tid] = -1.0e30f; lrow[tid] = 0.0f; }
    if (pass) for (int i = tid; i < 15 * 31; i += NTHREADS) rpbs[i] = c.in(I_RPB)[((size_t)l * NH + h) * 15 * 31 + i];
    f32x16 oacc = zero16();
    const int ti = (wave >> 1) & 1, tj = wave & 1;
    for (int kt = 0; kt < ntile; ++kt) {
        const bool local = pass && kt < kr; const int krow = rs + kt;
        __syncthreads();
        _Pragma("unroll 2") for (int i = tid; i < 4096; i += NTHREADS) { const int j = i >> 6, dd = i & 63; float kv, vv;
            if (!pass) { const float* rp = cols + (tok0 + kt * 64 + j) * NCF + h * 64; kv = rp[CB_NK * 256 + dd]; vv = rp[CB_NV * 256 + dd]; }
            else if (local) { const float* rp = cols + (tok0 + krow * 64 + j) * NCF + h * 64; kv = rp[CB_NK * 256 + dd]; vv = rp[CB_NV * 256 + dd]; }
            else { const size_t o = ((((size_t)b * DEPTH + l) * NH + h) * PAST + (kt - kr) * 64 + j) * HD + dd; kv = c.in(I_CK)[o]; vv = c.in(I_CV)[o]; }
            Kt[j * S65 + dd] = kv; Vt[j * S65 + dd] = vv; }
        __syncthreads();
        if (wave < 4) { f32x16 acc = zero16(); acc = mm32(lane, acc, Q + ti * 32 * S65, S65, 1, Kt + tj * 32 * S65, 1, S65, 64);
            UNR for (int r = 0; r < 16; ++r) { const int qi = ti * 32 + ACC_ROW(r, lane), kj = tj * 32 + (lane & 31); float s = acc[r];
                if (local) { int cs = qi - 8; cs = cs < 0 ? 0 : (cs > 48 ? 48 : cs); s = (kj >= cs && kj < cs + 16) ? s + rpbs[(krow - qb + 7) * 31 + (kj - qi + 15)] : -1.0e30f; }
                Sm[qi * S65 + kj] = s; } }
        __syncthreads();
        { const int t = tid >> 3, g = tid & 7; float mx = -1.0e30f; for (int s = g * 8; s < g * 8 + 8; ++s) mx = fmaxf(mx, Sm[t * S65 + s]);
          mx = fmaxf(mx, __shfl_xor(mx, 1)); mx = fmaxf(mx, __shfl_xor(mx, 2)); mx = fmaxf(mx, __shfl_xor(mx, 4));
          const float mo = mrow[t], mn = fmaxf(mo, mx); float sum = 0.0f;
          for (int s = g * 8; s < g * 8 + 8; ++s) { const float sv = Sm[t * S65 + s]; const float p = sv <= -1.0e29f ? 0.0f : expf(sv - mn); Sm[t * S65 + s] = p; sum += p; }
          sum += __shfl_xor(sum, 1); sum += __shfl_xor(sum, 2); sum += __shfl_xor(sum, 4);
          const float al = expf(mo - mn);
          __syncthreads();
          if (g == 0) { mrow[t] = mn; lrow[t] = lrow[t] * al + sum; arow[t] = al; } }
        __syncthreads();
        if (wave < 4) { UNR for (int r = 0; r < 16; ++r) oacc[r] *= arow[ti * 32 + ACC_ROW(r, lane)];
            oacc = mm32(lane, oacc, Sm + ti * 32 * S65, S65, 1, Vt + tj * 32, S65, 1, 64); }
    }
    __syncthreads();
    if (wave < 4) UNR for (int r = 0; r < 16; ++r) { const int qi = ti * 32 + ACC_ROW(r, lane); Sm[qi * S65 + tj * 32 + (lane & 31)] = oacc[r] / lrow[qi]; }
    __syncthreads();
    { const int j = tid >> 3, g = tid & 7; const size_t tok = tok0 + qb * 64 + j; const float* sp = Sm + j * S65 + g * 8; bf16_t* bp = br + tok * D + 3 * MIXW + h * 64 + g * 8;
      u32x4 w; w.x = pk2(sp[0], sp[1]); w.y = pk2(sp[2], sp[3]); w.z = pk2(sp[4], sp[5]); w.w = pk2(sp[6], sp[7]); *(u32x4*)bp = w; }
    __syncthreads();
}

__device__ __forceinline__ void phase_mixers(const Ctx& c0, int l, int rep) {
    const Ctx c = fresh(c0);
    const Dims& d = c.d; const int rows = d.Tl / GRIDW;
    const int nL = d.Bl * NH, nC = d.Bc * NH, nNAl = nL * rows, nq = d.Tc / 64, nNAc = nC * nq, nR = 2 * (nL + nC);
    const int e0 = nR, e1 = e0 + nR, e2 = e1 + nR, e3 = e2 + nNAl + nNAc;
    unsigned* qctr = c.ws<unsigned>(c.d.w_ctl) + CW_QUEUE + 64 * (l + DEPTH * rep);
    int* slot = (int*)(c.lds + 163840 - 128);
#ifndef MIX_MASK
#define MIX_MASK 15
#endif
#ifndef MIX_DUP
#define MIX_DUP 15
#endif
#define MIX_FETCH() do { __syncthreads(); if (c.tid == 0) *slot = (int)atomicAdd(qctr, 1u); __syncthreads(); it = __builtin_amdgcn_readfirstlane(*slot); } while (0)
    int it; MIX_FETCH();
    while (it < e0) { const int r = it, ps = r < 2 * nL ? 1 : 0, q = ps ? r : r - 2 * nL; if ((MIX_MASK & 1) && (rep == 0 || (MIX_DUP & 1))) mix_rwkv(c, l, opqs(__builtin_amdgcn_readfirstlane(ps)), (q >> 1) / NH, (q >> 1) % NH, q & 1); MIX_FETCH(); }
    while (it < e1) { const int r = it - e0, ps = r < 2 * nL ? 1 : 0, q = ps ? r : r - 2 * nL; if ((MIX_MASK & 2) && (rep == 0 || (MIX_DUP & 2))) mix_mlstm(c, l, opqs(__builtin_amdgcn_readfirstlane(ps)), (q >> 1) / NH, (q >> 1) % NH, q & 1); MIX_FETCH(); }
    while (it < e2) { const int r = it - e1, ps = r < 2 * nL ? 1 : 0, q = ps ? r : r - 2 * nL; if ((MIX_MASK & 4) && (rep == 0 || (MIX_DUP & 4))) mix_gla(c, l, opqs(__builtin_amdgcn_readfirstlane(ps)), (q >> 1) / NH, (q >> 1) % NH, q & 1); MIX_FETCH(); }
    while (it < e3) { const int r = it - e2, ps = r < nNAl ? 1 : 0, q = ps ? r : r - nNAl, nr = ps ? rows : nq; if ((MIX_MASK & 8) && (rep == 0 || (MIX_DUP & 8))) mix_na(c, l, opqs(__builtin_amdgcn_readfirstlane(ps)), q / (NH * nr), (q / nr) % NH, q % nr); MIX_FETCH(); }
#undef MIX_FETCH
}

__device__ __forceinline__ void phase_ln1(const Ctx& c0, int l) {
    const Ctx c = fresh(c0);
    const Dims& d = c.d; const float* mods = c.mods(l); const float* v = c.ws<float>(d.w_v); bf16_t* hb = c.ws<bf16_t>(d.w_hb); float* aff = c.ws<float>(d.w_aff);
    const float* lg = c.in(I_LNG) + ((size_t)l * 2 + 0) * D; const float* lb = c.in(I_LNB) + ((size_t)l * 2 + 0) * D;
    float* WR = (float*)c.lds;
    for (int i = c.tid; i < D * NEXP; i += NTHREADS) WR[(i & 15) * D + (i >> 4)] = c.in(I_WROUTER)[(size_t)l * D * NEXP + i];
    __syncthreads();
    const int gw = c.vcu * NWAVES + c.wave, NGW = c.G * NWAVES;
    for (int tok = gw; tok < d.NT; tok += NGW) {
        const float* mr = mods + (size_t)c.modrow(tok) * NMOD; f32x4 x[4]; float s = 0.0f;
#pragma unroll
        for (int j = 0; j < 4; ++j) { x[j] = *(const f32x4*)(v + (size_t)tok * D + 4 * c.lane + 256 * j); s += (x[j][0] + x[j][1]) + (x[j][2] + x[j][3]); }
        const float mean = wave_sum(s) * (1.0f / D); float q = 0.0f;
#pragma unroll
        for (int j = 0; j < 4; ++j) { x[j] = x[j] - mean; q += (x[j][0] * x[j][0] + x[j][1] * x[j][1]) + (x[j][2] * x[j][2] + x[j][3] * x[j][3]); }
        const float rstd = 1.0f / sqrtf(wave_sum(q) * (1.0f / D) + LN_EPS);
        f32x4 hh[4];
#pragma unroll
        for (int j = 0; j < 4; ++j) { const int col = 4 * c.lane + 256 * j; const f32x4 g = *(const f32x4*)(lg + col), bb = *(const f32x4*)(lb + col);
            const f32x4 x1 = x[j] * rstd * g + bb; *(f32x4*)(c.X() + (size_t)tok * D + col) = x1;
            const f32x4 sh = *(const f32x4*)(mr + 3 * D + col), sc = *(const f32x4*)(mr + 4 * D + col); hh[j] = x1 * (1.0f + sc) + sh;
            u32x2 w; w.x = pk2(hh[j][0], hh[j][1]); w.y = pk2(hh[j][2], hh[j][3]); *(u32x2*)(hb + (size_t)tok * D + col) = w; }
        float lg16[16];
#pragma unroll
        for (int e = 0; e < 16; ++e) { float a = 0.0f;
#pragma unroll
            for (int j = 0; j < 4; ++j) { const f32x4 wv = *(const f32x4*)(WR + e * D + 4 * c.lane + 256 * j); a += (hh[j][0] * wv[0] + hh[j][1] * wv[1]) + (hh[j][2] * wv[2] + hh[j][3] * wv[3]); }
            lg16[e] = a;
#ifndef CPU_EMU
            asm volatile("" ::: "memory");
#endif
        }
        float mx = -3.0e38f;
#pragma unroll
        for (int e = 0; e < 16; ++e) { lg16[e] = wave_sum(lg16[e]); mx = fmaxf(mx, lg16[e]); }
        float se = 0.0f;
#pragma unroll
        for (int e = 0; e < 16; ++e) { lg16[e] = expf(lg16[e] - mx); se += lg16[e]; }
        const float inv = 1.0f / se; float mine = 0.0f;
#pragma unroll
        for (int e = 0; e < 16; ++e) mine = (c.lane == e) ? lg16[e] * inv : mine;
        if (c.lane < 16) aff[(size_t)tok * NEXP + c.lane] = mine;
    }
}

__device__ __forceinline__ void phase_select(const Ctx& c0) {
    const Ctx c = fresh(c0);
    const Dims& d = c.d; const float* aff = c.ws<float>(d.w_aff); int* inv = c.ws<int>(d.w_inv); float* pgate = c.ws<float>(d.w_pgate);
    const bf16_t* hb = c.ws<bf16_t>(d.w_hb); bf16_t* xe = c.ws<bf16_t>(d.w_xe);
    float* A = (float*)c.lds; int* sel = (int*)(A + 1024);
    const int nitems = (d.Bc + d.Bl) * NEXP;
    for (int it = c.vcu; it < nitems; it += c.G) {
        const int e = it % NEXP, bb = it / NEXP, pass = bb >= d.Bc, b = pass ? bb - d.Bc : bb, T = pass ? d.Tl : d.Tc, cap = pass ? d.capl : d.capc;
        const int tok0 = pass ? d.NTc + b * d.Tl : b * d.Tc, row0 = e * d.RPE + (pass ? d.Bc * d.capc + b * d.capl : b * d.capc);
        __syncthreads();
        for (int t = c.tid; t < T; t += NTHREADS) A[t] = aff[(size_t)(tok0 + t) * NEXP + e];
        __syncthreads();
        for (int t = c.tid; t < T; t += NTHREADS) { const float a = A[t]; int rank = 0;
            for (int s = 0; s < T; ++s) { const float o = A[s]; rank += (o > a || (o == a && s < t)) ? 1 : 0; }
            if (rank < cap) { sel[rank] = t; pgate[row0 + rank] = a; inv[(size_t)(tok0 + t) * NEXP + e] = row0 + rank; } else inv[(size_t)(tok0 + t) * NEXP + e] = -1; }
        __syncthreads();
        for (int r = c.wave; r < cap; r += NWAVES) { const u32x4* src = (const u32x4*)(hb + (size_t)(tok0 + sel[r]) * D); u32x4* dst = (u32x4*)(xe + (size_t)(row0 + r) * D);
            dst[c.lane] = src[c.lane]; dst[c.lane + 64] = src[c.lane + 64]; }
    }
}

__device__ __forceinline__ void phase_ln2(const Ctx& c0, int l) {
    const Ctx c = fresh(c0);
    const Dims& d = c.d; const float* mods = c.mods(l); const float* y = c.ws<float>(d.w_y); const int* inv = c.ws<int>(d.w_inv); bf16_t* hb = c.ws<bf16_t>(d.w_hb);
    const float* lg = c.in(I_LNG) + ((size_t)l * 2 + 1) * D; const float* lb = c.in(I_LNB) + ((size_t)l * 2 + 1) * D;
    const float* modn = (l + 1 < DEPTH) ? c.mods(l + 1) : nullptr;
    const int gw = c.vcu * NWAVES + c.wave, NGW = c.G * NWAVES;
    for (int tok = gw; tok < d.NT; tok += NGW) {
        const int mrow = c.modrow(tok); const float* mr = mods + (size_t)mrow * NMOD; f32x4 ff[4];
#pragma unroll
        for (int j = 0; j < 4; ++j) ff[j] = (f32x4){0.f, 0.f, 0.f, 0.f};
        for (int e = 0; e < NEXP; ++e) { const int row = inv[(size_t)tok * NEXP + e]; if (row >= 0) {
#pragma unroll
            for (int j = 0; j < 4; ++j) ff[j] += *(const f32x4*)(y + (size_t)row * D + 4 * c.lane + 256 * j); } }
        f32x4 x[4]; float s = 0.0f;
#pragma unroll
        for (int j = 0; j < 4; ++j) { const int col = 4 * c.lane + 256 * j; const f32x4 x1 = *(const f32x4*)(c.X() + (size_t)tok * D + col), g2 = *(const f32x4*)(mr + 5 * D + col);
            x[j] = ALPHA * x1 + g2 * ff[j]; s += (x[j][0] + x[j][1]) + (x[j][2] + x[j][3]); }
        const float mean = wave_sum(s) * (1.0f / D); float q = 0.0f;
#pragma unroll
        for (int j = 0; j < 4; ++j) { x[j] = x[j] - mean; q += (x[j][0] * x[j][0] + x[j][1] * x[j][1]) + (x[j][2] * x[j][2] + x[j][3] * x[j][3]); }
        const float rstd = 1.0f / sqrtf(wave_sum(q) * (1.0f / D) + LN_EPS);
#pragma unroll
        for (int j = 0; j < 4; ++j) { const int col = 4 * c.lane + 256 * j; const f32x4 g = *(const f32x4*)(lg + col), bb = *(const f32x4*)(lb + col);
            const f32x4 x2 = x[j] * rstd * g + bb; *(f32x4*)(c.X() + (size_t)tok * D + col) = x2;
            if (modn) { const float* mn = modn + (size_t)mrow * NMOD; const f32x4 sh = *(const f32x4*)(mn + col), sc = *(const f32x4*)(mn + D + col); const f32x4 hh = x2 * (1.0f + sc) + sh;
                u32x2 w; w.x = pk2(hh[0], hh[1]); w.y = pk2(hh[2], hh[3]); *(u32x2*)(hb + (size_t)tok * D + col) = w; } }
    }
}

constexpr int N_PHASES = 2 + 10 * DEPTH;
__device__ __forceinline__ void run_phase(const Ctx& c0, int ph, int rep) {
    const Ctx c = fresh(c0); const Dims& d = c.d;
#ifndef PHASE_MASK
#define PHASE_MASK 0xFFFF
#endif
    if (ph == 0) { if (PHASE_MASK & 0x400) phase_prep(c); return; }
    if (ph == 1) { if (PHASE_MASK & 0x800) phase_init(c); return; }
    const int l = (ph - 2) / 10, s = (ph - 2) % 10;
    LAS unsigned char* ldsp = (LAS unsigned char*)c.lds;
    if (!((PHASE_MASK >> s) & 1)) return;
    switch (s) {
    case 0: { pg8::Gemm g{c.ws<bf16_t>(d.w_hb), c.ws<bf16_t>(d.w_win) + (size_t)l * NINP * D, D}; pg8::StaticOrder S; S.init(d.NT, NINP, c.G, (int)blockIdx.x);
              EpiCols E{c.ws<float>(d.w_cols), c.ws<unsigned short>(d.w_gates)}; pg8::gemm_phase<EpiCols, pg8::StaticOrder>(ldsp, g, S, E); } break;
    case 1: phase_mixers(c, l, rep); break;
    case 2: phase_combine(c, l); break;
    case 3: { pg8::Gemm g{c.ws<bf16_t>(d.w_br), c.ws<bf16_t>(d.w_wbr) + (size_t)l * D * D, D}; pg8::StaticOrder S; S.init(d.NT, D, c.G, (int)blockIdx.x);
              EpiWiden E{c.ws<unsigned short>(d.w_gates), c.ws<bf16_t>(d.w_merged)}; pg8::gemm_phase<EpiWiden, pg8::StaticOrder>(ldsp, g, S, E); } break;
    case 4: { pg8::Gemm g{c.ws<bf16_t>(d.w_merged), c.ws<bf16_t>(d.w_wout) + (size_t)l * D * D, D}; pg8::StaticOrder S; S.init(d.NT, D, c.G, (int)blockIdx.x);
              EpiPreLN E{c.X(), c.mods(l), c.ws<float>(d.w_v), d.NTc, d.Tl}; pg8::gemm_phase<EpiPreLN, pg8::StaticOrder>(ldsp, g, S, E); } break;
    case 5: phase_ln1(c, l); break;
    case 6: phase_select(c); break;
    case 7: { pg8::Gemm g{c.ws<bf16_t>(d.w_xe), c.ws<bf16_t>(d.w_wup) + (size_t)l * NEXP * 2 * FF * D, D}; pg8::GroupOrder S; S.init(d.TPE, 2 * FF / 256, NEXP, c.G, c.vcu);
              EpiSwiGLU E{c.ws<bf16_t>(d.w_act)}; pg8::gemm_phase<EpiSwiGLU, pg8::GroupOrder>(ldsp, g, S, E); } break;
    case 8: { pg8::Gemm g{c.ws<bf16_t>(d.w_act), c.ws<bf16_t>(d.w_wdn) + (size_t)l * NEXP * D * FF, FF}; pg8::GroupOrder S; S.init(d.TPE, D / 256, NEXP, c.G, c.vcu);
              EpiDown E{c.ws<float>(d.w_pgate), c.ws<float>(d.w_y)}; pg8::gemm_phase<EpiDown, pg8::GroupOrder>(ldsp, g, S, E); } break;
    default: phase_ln2(c, l); break;
    }
}

#ifndef CPU_EMU
#define XB_TMO      128
#define XB_XCNT(j)  (256  + 64 * (j))
#define XB_XSUB(j)  (1280 + 64 * (j))
#define XB_XGEN(j)  (2304 + 64 * (j))
#define XB_TOP      3328
#define XB_TOPGEN   3392
#define XB_SPIN_CAP (1u << 20)
__device__ __forceinline__ unsigned xb_ld(unsigned* p)              { return __hip_atomic_load(p, __ATOMIC_RELAXED, __HIP_MEMORY_SCOPE_AGENT); }
__device__ __forceinline__ unsigned xb_add(unsigned* p, unsigned v) { return __hip_atomic_fetch_add(p, v, __ATOMIC_RELAXED, __HIP_MEMORY_SCOPE_AGENT); }
__device__ __forceinline__ unsigned xb_xcc_id() { return (unsigned)__builtin_amdgcn_s_getreg((3 << 11) | 20) & 0xFu; }
#define XB_SPIN(cond, bar) do { unsigned _sp = 0; while (cond) { __builtin_amdgcn_s_sleep(1); \
    if ((++_sp & 255u) == 0u) { if (xb_ld(&(bar)[XB_TMO])) break; if (_sp > XB_SPIN_CAP) { atomicAdd(&(bar)[XB_TMO], 1u); break; } } } } while (0)
struct XcdBarrier { unsigned* bar; unsigned x; volatile LAS unsigned* st; };
__device__ __forceinline__ XcdBarrier xcd_barrier_post(unsigned* bar, volatile LAS unsigned* st) {
    XcdBarrier b; b.bar = bar; b.x = xb_xcc_id(); b.st = st;
    if (threadIdx.x == 0) (void)xb_add(&bar[XB_XCNT(b.x)], 1u);
    return b;
}
__device__ __forceinline__ void xcd_barrier_complete(unsigned* bar, unsigned x, unsigned& nloc, unsigned& nx) {
    const unsigned G = gridDim.x * gridDim.y * gridDim.z;
    unsigned sum, cnt, mine, sp = 0u;
    for (;;) {
        sum = 0u; cnt = 0u; mine = 0u;
#pragma unroll
        for (unsigned j = 0; j < 16; ++j) { const unsigned cc = xb_ld(&bar[XB_XCNT(j)]); sum += cc; cnt += (cc > 0u) ? 1u : 0u; mine = (j == x) ? cc : mine; }
        if (sum == G) break;
        __builtin_amdgcn_s_sleep(1);
        if ((++sp & 255u) == 0u) { if (xb_ld(&bar[XB_TMO])) break; if (sp > XB_SPIN_CAP) { atomicAdd(&bar[XB_TMO], 1u); break; } }
    }
    nloc = mine > 0u ? mine : 1u; nx = cnt > 0u ? cnt : 1u;
}
__device__ __forceinline__ void xcd_barrier(const XcdBarrier& b) {
    asm volatile("s_waitcnt vmcnt(0)" ::: "memory");
    __syncthreads();
    if (threadIdx.x == 0) {
        unsigned* bar = b.bar;
        __builtin_amdgcn_s_waitcnt(0);
        unsigned nloc = b.st[0], nx = b.st[1];
        if (nloc == 0u) { xcd_barrier_complete(bar, b.x, nloc, nx); b.st[0] = nloc; b.st[1] = nx; }
        const unsigned old = xb_add(&bar[XB_XSUB(b.x)], 1u);
        const unsigned gen = old / nloc;
        if (old + 1u == (gen + 1u) * nloc) {
            __builtin_amdgcn_fence(__ATOMIC_RELEASE, "agent");
            asm volatile("s_waitcnt vmcnt(0)" ::: "memory");
            const unsigned og = xb_add(&bar[XB_TOP], 1u);
            const unsigned tg = og / nx;
            if (og + 1u == (tg + 1u) * nx) xb_add(&bar[XB_TOPGEN], 1u);
            else XB_SPIN(xb_ld(&bar[XB_TOPGEN]) == tg, bar);
            __builtin_amdgcn_fence(__ATOMIC_ACQUIRE, "agent");
            xb_add(&bar[XB_XGEN(b.x)], 1u);
            asm volatile("s_waitcnt vmcnt(0)" ::: "memory");
        } else {
            XB_SPIN(xb_ld(&bar[XB_XGEN(b.x)]) == gen, bar);
            __builtin_amdgcn_fence(__ATOMIC_ACQUIRE, "agent");
            asm volatile("s_waitcnt vmcnt(0)" ::: "memory");
        }
    }
    __syncthreads();
}

#ifndef PROBE_DUP
#define PROBE_DUP 0
#endif
constexpr int LDS_BYTES = 163840;
__global__ void __launch_bounds__(NTHREADS, 2) trunk_fwd(Params p) {
    extern __shared__ __attribute__((aligned(16))) unsigned char lds[];
    Ctx c; c.p = &p; c.d = make_dims(p.Bc, p.Tc, p.Bl, p.Tl); c.lds = lds;
    c.tid = threadIdx.x; c.lane = c.tid & 63; c.wave = __builtin_amdgcn_readfirstlane(c.tid >> 6);
    c.G = gridDim.x; { const int bx = blockIdx.x; c.vcu = (c.G % 8 == 0) ? (bx % 8) * (c.G / 8) + bx / 8 : bx; }
    volatile LAS unsigned* st = (volatile LAS unsigned*)((LAS unsigned char*)lds + LDS_BYTES - 64);
    XcdBarrier bar; bar.bar = nullptr; bar.x = 0; bar.st = st;
    if (p.use_bar) { if (c.tid < 2) st[c.tid] = 0u; __syncthreads(); bar = xcd_barrier_post((unsigned*)(p.ws) + CW_BAR, st); }
    for (int ph = p.ph_lo; ph < p.ph_hi; ++ph) {
        run_phase(c, ph, 0);
#if PROBE_DUP
        { const int kind = ph == 0 ? 10 : (ph == 1 ? 11 : (ph - 2) % 10); if ((PROBE_DUP >> kind) & 1) { xcd_barrier(bar); run_phase(c, ph, 1); } }
#endif
        if (ph + 1 < p.ph_hi) xcd_barrier(bar);
    }
}

#ifndef N_LAUNCH_MODE
#define N_LAUNCH_MODE 1
#endif
extern "C" void kernel_launch(void* const* d_in, const int* in_sizes, int n_in, void* d_out, int out_size, void* d_ws, size_t ws_size, hipStream_t stream) {
    static int grid = 0;
    const Dims d = make_dims(32, 256, 8, 1024);
    if (grid == 0) {
        int dev = 0, cus = 0;
        if (n_in != N_INPUTS || (size_t)out_size != d.o_end || ws_size < ((size_t)d.w_end << 8)) { fprintf(stderr, "kernel_launch: unexpected sizes: n_in %d out %d ws %zu (need %zu / %zu)\n", n_in, out_size, ws_size, (size_t)d.o_end, (size_t)d.w_end << 8); grid = -1; return; }
        if (hipGetDevice(&dev) != hipSuccess || hipDeviceGetAttribute(&cus, hipDeviceAttributeMultiprocessorCount, dev) != hipSuccess) { grid = -1; return; }
        if (hipFuncSetAttribute((const void*)trunk_fwd, hipFuncAttributeMaxDynamicSharedMemorySize, LDS_BYTES) != hipSuccess) { fprintf(stderr, "kernel_launch: hipFuncSetAttribute failed\n"); grid = -1; return; }
        int per_cu = 0;
        if (hipOccupancyMaxActiveBlocksPerMultiprocessor(&per_cu, (const void*)trunk_fwd, NTHREADS, LDS_BYTES) != hipSuccess || per_cu < 1) fprintf(stderr, "kernel_launch: occupancy query says %d\n", per_cu);
        (void)hipGetLastError();
        grid = cus;
    }
    if (grid < 0) return;
    (void)hipMemsetAsync((char*)d_ws, 0, CTL_BYTES, stream);
    Params p{};
    for (int i = 0; i < N_INPUTS; ++i) p.in[i] = (const float*)d_in[i];
    p.out = (float*)d_out; p.ws = (unsigned char*)d_ws; p.Bc = 32; p.Tc = 256; p.Bl = 8; p.Tl = 1024;
#if N_LAUNCH_MODE == 1
    p.ph_lo = 0; p.ph_hi = N_PHASES; p.use_bar = 1;
    hipLaunchKernelGGL(trunk_fwd, dim3(grid), dim3(NTHREADS), LDS_BYTES, stream, p);
#else
    for (int ph = 0; ph < N_PHASES; ++ph) { p.ph_lo = ph; p.ph_hi = ph + 1; p.use_bar = 0; hipLaunchKernelGGL(trunk_fwd, dim3(grid), dim3(NTHREADS), LDS_BYTES, stream, p); }
#endif
}
#endif
```

```cpp
#ifndef CPU_EMU
#include <hip/hip_runtime.h>
#include <cstdio>
typedef float f32x16 __attribute__((ext_vector_type(16)));
typedef float f32x4 __attribute__((ext_vector_type(4)));
typedef float f32x2 __attribute__((ext_vector_type(2)));
typedef unsigned u32x4 __attribute__((ext_vector_type(4)));
typedef unsigned u32x2 __attribute__((ext_vector_type(2)));
#define LAS __attribute__((address_space(3)))
#define WAVE_SYNC() asm volatile("s_waitcnt lgkmcnt(0)" ::: "memory")
#else
#define LAS
#define WAVE_SYNC() emu::wave_sync()
#endif
#define UNR _Pragma("unroll")
typedef short bf16x8 __attribute__((ext_vector_type(8)));
typedef unsigned short bf16_t;

constexpr int D = 1024, NH = 4, HD = 64, MIXW = 256, NEXP = 16, FF = 2048, DEPTH = 2, PAST = 256, GRIDW = 64;
constexpr int NIN = 7920, NINP = 7936, NCF = 3840, NGATE = 4096, NMOD = 6 * D;
constexpr float ALPHA = 1.4142135623730951f, LN_EPS = 1e-5f;
constexpr int NTHREADS = 512, NWAVES = 8;
constexpr int CB_MQ = 0, CB_MK = 1, CB_MV = 2, CB_MO = 3, CB_GQ = 4, CB_GK = 5, CB_GV = 6, CB_GG = 7, CB_RR = 8, CB_RK = 9, CB_RV = 10, CB_NQ = 11, CB_NK = 12, CB_NV = 13;
constexpr int SM_MI = 3584, SM_MF = 3592, SM_GA = 3600, SM_RW = 3632, SM_RA = 3696, SM_RG = 3760;
enum { I_XP = 0, I_XS, I_SC, I_SN, I_SM, I_SG, I_SR, I_CK, I_CV, I_C, I_CCTX, I_WADA, I_BADA, I_WIN, I_BIG, I_BFG, I_WGLA, I_BGLA, I_SHIFT, I_W0, I_WW2, I_A0, I_WA2, I_WG2, I_KK, I_KA, I_RKK,
       I_RPB, I_WBR, I_WOUT, I_LNG, I_LNB, I_WROUTER, I_WUP, I_WDOWN, N_INPUTS };

__host__ __device__ __forceinline__ int win_col(int p) {
    if (p < 3584) { const int b = p >> 8, w = p & 255; const int base = b < 4 ? b * 256 : (b < 8 ? 1040 + (b - 4) * 256 : (b < 11 ? 2096 + (b - 8) * 256 : 3056 + (b - 11) * 256)); return base + w; }
    if (p < 3840) { const int s = p - 3584; return s < 16 ? 1024 + s : (s < 48 ? 2064 + (s - 16) : (s < 240 ? 2864 + (s - 48) : -1)); }
    return p - 16;
}

struct Params {
    const float* in[N_INPUTS];
    float* out; unsigned char* ws;
    int Bc, Tc, Bl, Tl;
    int ph_lo, ph_hi;
    int use_bar, pad;
};
struct Dims {
    int Bc, Tc, Bl, Tl, NTc, NTl, NT, capc, capl, RPE, TPE, NPR;
    unsigned o_yp, o_ys, o_C, o_n, o_m, o_g, o_r, o_nk, o_nv, o_end;
    unsigned w_ctl, w_win, w_wbr, w_wout, w_wup, w_wdn, w_mods, w_hb, w_cols, w_gates, w_br, w_scr, w_merged, w_v, w_aff, w_inv, w_pgate, w_xe, w_act, w_y, w_end;
};
constexpr size_t CTL_BYTES = 1u << 20;
constexpr int CW_BAR = 4096, CW_QUEUE = 1024;
__host__ __device__ __forceinline__ unsigned al256(size_t x) { return (unsigned)((x + 255) >> 8); }
__host__ __device__ __forceinline__ Dims make_dims(int Bc, int Tc, int Bl, int Tl) {
    Dims d; d.Bc = Bc; d.Tc = Tc; d.Bl = Bl; d.Tl = Tl; d.NTc = Bc * Tc; d.NTl = Bl * Tl; d.NT = d.NTc + d.NTl;
    d.capc = Tc / 8; d.capl = Tl / 8; d.RPE = ((Bc * d.capc + Bl * d.capl + 255) / 256) * 256; d.TPE = d.RPE / 256; d.NPR = NEXP * d.RPE;
    unsigned o = 0; d.o_yp = o; o += (unsigned)d.NTc * D; d.o_ys = o; o += (unsigned)d.NTl * D;
    d.o_C = o; o += (unsigned)Bc * DEPTH * 2 * NH * HD * HD; d.o_n = o; o += (unsigned)Bc * DEPTH * 2 * NH * HD; d.o_m = o; o += (unsigned)Bc * DEPTH * 2 * NH;
    d.o_g = o; o += (unsigned)Bc * DEPTH * 2 * NH * HD * HD; d.o_r = o; o += (unsigned)Bc * DEPTH * 2 * NH * HD * HD;
    d.o_nk = o; o += (unsigned)Bc * DEPTH * NH * Tc * HD; d.o_nv = o; o += (unsigned)Bc * DEPTH * NH * Tc * HD; d.o_end = o;
    unsigned w = 0; d.w_ctl = w; w += (unsigned)(CTL_BYTES >> 8);
    d.w_win = w; w += al256((size_t)DEPTH * NINP * D * 2); d.w_wbr = w; w += al256((size_t)DEPTH * D * D * 2); d.w_wout = w; w += al256((size_t)DEPTH * D * D * 2);
    d.w_wup = w; w += al256((size_t)DEPTH * NEXP * 2 * FF * D * 2); d.w_wdn = w; w += al256((size_t)DEPTH * NEXP * D * FF * 2);
    d.w_mods = w; w += al256((size_t)DEPTH * (1 + Bl) * NMOD * 4);
    d.w_hb = w; w += al256((size_t)d.NT * D * 2); d.w_cols = w; w += al256((size_t)d.NT * NCF * 4); d.w_gates = w; w += al256((size_t)d.NT * NGATE * 2);
    d.w_br = w; w += al256((size_t)d.NT * D * 2); d.w_scr = w; w += al256((size_t)d.NT * 7 * MIXW * 4); d.w_merged = w; w += al256((size_t)d.NT * D * 2);
    d.w_v = w; w += al256((size_t)d.NT * D * 4); d.w_aff = w; w += al256((size_t)d.NT * NEXP * 4); d.w_inv = w; w += al256((size_t)d.NT * NEXP * 4);
    d.w_pgate = w; w += al256((size_t)d.NPR * 4); d.w_xe = w; w += al256((size_t)d.NPR * D * 2); d.w_act = w; w += al256((size_t)d.NPR * FF * 2); d.w_y = w; w += al256((size_t)d.NPR * D * 4);
    d.w_end = w; return d;
}

__device__ __forceinline__ unsigned f2bf(float f) { unsigned u = __builtin_bit_cast(unsigned, f); return (u + 0x7fffu + ((u >> 16) & 1u)) >> 16; }
__device__ __forceinline__ unsigned pk2(float lo, float hi) { return f2bf(lo) | (f2bf(hi) << 16); }

#ifndef CPU_EMU
template <int CTRL> __device__ __forceinline__ float dppf(float v) { return __builtin_bit_cast(float, __builtin_amdgcn_update_dpp(0, __builtin_bit_cast(int, v), CTRL, 0xF, 0xF, true)); }
__device__ __forceinline__ float x1(float v) { return dppf<0xB1>(v); }
__device__ __forceinline__ float x2(float v) { return dppf<0x4E>(v); }
__device__ __forceinline__ float x4m(float v) { return dppf<0x141>(v); }
__device__ __forceinline__ float x8m(float v) { return dppf<0x140>(v); }
__device__ __forceinline__ float fexp(float x) { return __expf(x); }
__device__ __forceinline__ float flog(float x) { return __logf(x); }
__device__ __forceinline__ float frsq(float x) { return __builtin_amdgcn_rsqf(x); }
#else
inline float x1(float v) { return __shfl_xor(v, 1); }
inline float x2(float v) { return __shfl_xor(v, 2); }
inline float x4m(float v) { return __shfl_xor(v, 4); }
inline float x8m(float v) { return __shfl_xor(v, 8); }
inline float fexp(float x) { return expf(x); }
inline float flog(float x) { return logf(x); }
inline float frsq(float x) { return 1.0f / sqrtf(x); }
#endif
__device__ __forceinline__ float quad_sum(float v) { v += x1(v); v += x2(v); return v; }
__device__ __forceinline__ float oct_sum(float v) { v += x1(v); v += x2(v); v += x4m(v); return v; }
__device__ __forceinline__ float oct_max(float v) { v = fmaxf(v, x1(v)); v = fmaxf(v, x2(v)); v = fmaxf(v, x4m(v)); return v; }
__device__ __forceinline__ float sigmoidf_(float x) { return __builtin_amdgcn_rcpf(1.0f + fexp(-x)); }
__device__ __forceinline__ float logsigmoidf_(float x) { return fminf(x, 0.0f) - flog(1.0f + fexp(-fabsf(x))); }
__device__ __forceinline__ float softplusf_(float x) { return fmaxf(x, 0.0f) + flog(1.0f + fexp(-fabsf(x))); }
__device__ __forceinline__ float tanhf_(float x) { const float e = fexp(-2.0f * fabsf(x)); const float t = (1.0f - e) * __builtin_amdgcn_rcpf(1.0f + e); return x < 0.0f ? -t : t; }
__device__ __forceinline__ float siluf_(float x) { return x * __builtin_amdgcn_rcpf(1.0f + fexp(-x)); }
__device__ __forceinline__ float wave_sum(float v) {
    v += x1(v); v += x2(v); v += x4m(v); v += x8m(v); v += __shfl_xor(v, 16); v += __shfl_xor(v, 32);
    return v;
}
__device__ __forceinline__ unsigned pkh2(float a, float b) { const _Float16 x = (_Float16)a, y = (_Float16)b; return (unsigned)__builtin_bit_cast(unsigned short, x) | ((unsigned)__builtin_bit_cast(unsigned short, y) << 16); }
#ifndef CPU_EMU
__device__ __forceinline__ float frcp(float x) { return __builtin_amdgcn_rcpf(x); }
#else
inline float frcp(float x) { return 1.0f / x; }
#endif
__device__ __forceinline__ float h2f(unsigned short h) { return (float)__builtin_bit_cast(_Float16, h); }

#ifndef CPU_EMU
__device__ __forceinline__ int opqv(int x) { asm volatile("" : "+v"(x)); return x; }
__device__ __forceinline__ int opqs(int x) { asm volatile("" : "+s"(x)); return x; }
#else
inline int opqv(int x) { return x; }
inline int opqs(int x) { return x; }
#endif
namespace pg8 {
constexpr int BM = 256, BK = 64, HALF = 128, HTB = HALF * BK * 2, STAGE_BYTES = 8 * HTB, NXCD = 8, WGM = 8;
__host__ __device__ __forceinline__ int lds_byte(int r, int c) { const int st = (r >> 4) * 2 + (c >> 5), rr = r & 15, cc = c & 31, ob = rr * 64 + cc * 2; return st * 1024 + (ob ^ (((ob >> 9) & 1) << 5)); }
__host__ __device__ __forceinline__ void stage_rc(int b, int& R, int& C) { const int st = b / 1024, sb = b % 1024, swz = sb ^ (((sb >> 9) & 1) << 5); R = (st >> 1) * 16 + swz / 64; C = (st & 1) * 32 + (swz % 64) / 2; }
struct Unit { int pm, pn, ta, tb; };
struct Gemm { const bf16_t* A; const bf16_t* Bt; int K; };
struct StaticOrder {
    int nM, nN, nwg, G, c;
    __device__ __forceinline__ void init(int M, int N, int G_, int c_) { nM = M / BM; nN = N / BM; nwg = nM * nN; G = G_; c = c_; }
    __device__ __forceinline__ bool next(int i, Unit& u) const {
        const long L = (long)i * G + c; if (L >= nwg) return false;
        int wgid = (int)L; { const int q = nwg / NXCD, r = nwg % NXCD, xcd = wgid % NXCD, off = wgid / NXCD; wgid = (xcd < r ? xcd * (q + 1) : r * (q + 1) + (xcd - r) * q) + off; }
        const int nig = WGM * nN, gid = wgid / nig, fm = gid * WGM, gsz = (nM - fm) < WGM ? (nM - fm) : WGM;
        u.pm = fm + ((wgid % nig) % gsz); u.pn = (wgid % nig) / gsz; u.ta = u.pm; u.tb = u.pn; return true;
    }
};
struct GroupOrder {
    int tpe, nN, nE, G, c;
    __device__ __forceinline__ void init(int tpe_, int nN_, int nE_, int G_, int c_) { tpe = tpe_; nN = nN_; nE = nE_; G = G_; c = c_; }
    __device__ __forceinline__ bool next(int i, Unit& u) const {
        const long L = (long)i * G + c; if (L >= (long)nE * tpe * nN) return false;
        const int per = tpe * nN, e = (int)(L / per), r = (int)(L % per), pn = r / tpe, pm = r % tpe;
        u.ta = e * tpe + pm; u.tb = e * nN + pn; u.pm = u.ta; u.pn = pn; return true;
    }
};
#ifndef CPU_EMU
template <class Epi, class Sched>
__device__ __forceinline__ void gemm_phase(LAS unsigned char* lds, const Gemm g, const Sched& S, const Epi& E) {
    const int tid = opqv((int)threadIdx.x), wid = __builtin_amdgcn_readfirstlane(tid >> 6), lane = tid & 63, wr = wid >> 2, wc = wid & 3, fr = lane & 15, fq = lane >> 4;
    const int K = g.K, nt = K / BK;
    unsigned voffA[2];
#pragma unroll
    for (int i = 0; i < 2; ++i) { int R, C; stage_rc(tid * 16 + i * 8192, R, C); voffA[i] = (unsigned)(R * K + C) * 2u; }
    const size_t kstep = (size_t)(BK * 2), hstep = (size_t)HALF * K * 2, tstep = 2 * hstep;
    const unsigned ldsw = (unsigned)wid * 1024u;
    const int aoff = lds_byte(wr * 64 + fr, fq * 8), boff = lds_byte(wc * 32 + fr, fq * 8);
#define PG8_SA(b, h) (((b) * 2 + (h)) * HTB)
#define PG8_SB(b, h) ((4 + (b) * 2 + (h)) * HTB)
#define PG8_STAGE(bufoff, gbase) do { _Pragma("unroll") for (int _i = 0; _i < 2; ++_i) \
        __builtin_amdgcn_global_load_lds((const unsigned*)((const char*)(gbase) + voffA[_i]), (LAS unsigned*)(lds + (bufoff) + ldsw + _i * 8192), 16, 0, 0); } while (0)
#define PG8_LDA(dst, b, h) do { _Pragma("unroll") for (int m = 0; m < 4; ++m) _Pragma("unroll") for (int k = 0; k < 2; ++k) dst[m][k] = *(const LAS bf16x8*)(lds + PG8_SA(b, h) + aoff + m * 2048 + k * 1024); } while (0)
#define PG8_LDB(dst, b, h) do { _Pragma("unroll") for (int n = 0; n < 2; ++n) _Pragma("unroll") for (int k = 0; k < 2; ++k) dst[n][k] = *(const LAS bf16x8*)(lds + PG8_SB(b, h) + boff + n * 2048 + k * 1024); } while (0)
#define PG8_MMA(ai, bj, At, Bt) do { __builtin_amdgcn_s_setprio(1); _Pragma("unroll") for (int m = 0; m < 4; ++m) _Pragma("unroll") for (int n = 0; n < 2; ++n) _Pragma("unroll") for (int k = 0; k < 2; ++k) \
        acc[ai][bj][m][n] = __builtin_amdgcn_mfma_f32_16x16x32_bf16(Bt[n][k], At[m][k], acc[ai][bj][m][n], 0, 0, 0); __builtin_amdgcn_s_setprio(0); } while (0)
#define PG8_WAIT_V(n) asm volatile("s_waitcnt vmcnt(" #n ")" ::: "memory")
#define PG8_WAIT_L(n) asm volatile("s_waitcnt lgkmcnt(" #n ")" ::: "memory")
#define PG8_BAR __builtin_amdgcn_s_barrier()
#define PG8_SCHED __builtin_amdgcn_sched_barrier(0)
    Unit cur, nxt; int ui = 0;
    if (!S.next(0, cur)) return;
    f32x4 acc[2][2][4][2];
#pragma unroll
    for (int a = 0; a < 2; ++a)
#pragma unroll
        for (int b = 0; b < 2; ++b)
#pragma unroll
            for (int m = 0; m < 4; ++m)
#pragma unroll
                for (int n = 0; n < 2; ++n) acc[a][b][m][n] = (f32x4){0.f, 0.f, 0.f, 0.f};
    bf16x8 At[4][2], B0[2][2], B1[2][2];
    const char* cA = (const char*)g.A + (size_t)cur.ta * tstep; const char* cB = (const char*)g.Bt + (size_t)cur.tb * tstep;
    PG8_STAGE(PG8_SB(0, 0), cB); PG8_STAGE(PG8_SB(0, 1), cB + hstep); PG8_STAGE(PG8_SA(0, 0), cA); PG8_STAGE(PG8_SA(0, 1), cA + hstep);
    if (wr == 1) PG8_BAR;
    PG8_WAIT_V(2); PG8_BAR;
    PG8_STAGE(PG8_SB(1, 0), cB + kstep); PG8_STAGE(PG8_SA(1, 0), cA + kstep); PG8_STAGE(PG8_SB(1, 1), cB + hstep + kstep);
    PG8_WAIT_V(6); PG8_BAR;
    for (;;) {
        const bool has_next = S.next(ui + 1, nxt);
        const char* nA = has_next ? (const char*)g.A + (size_t)nxt.ta * tstep : cA; const char* nB = has_next ? (const char*)g.Bt + (size_t)nxt.tb * tstep : cB;
        for (int t = 0; t < nt; t += 2) {
            const bool last = (t == nt - 2);
            const char* a1 = cA + (size_t)(t + 1) * kstep;
            const char* a2 = last ? nA : cA + (size_t)(t + 2) * kstep; const char* b2 = last ? nB : cB + (size_t)(t + 2) * kstep;
            const char* a3 = a2 + kstep; const char* b3 = b2 + kstep;
            if constexpr (Epi::MID) { if (t != 0 && (t & 3) == 0) E.mid(acc, cur, t >> 2, wr, wc, fr, fq); }
            PG8_LDB(B0, 0, 0); PG8_LDB(B1, 0, 1); PG8_SCHED; PG8_LDA(At, 0, 0); PG8_STAGE(PG8_SA(1, 1), a1 + hstep);
            PG8_WAIT_V(8); PG8_WAIT_L(0); PG8_BAR; PG8_MMA(0, 0, At, B0); PG8_MMA(0, 1, At, B1); PG8_BAR; PG8_SCHED;
            PG8_LDA(At, 0, 1); PG8_STAGE(PG8_SB(0, 0), b2); PG8_STAGE(PG8_SB(0, 1), b2 + hstep); PG8_STAGE(PG8_SA(0, 0), a2);
            PG8_WAIT_V(8); PG8_WAIT_L(0); PG8_BAR; PG8_MMA(1, 0, At, B0); PG8_MMA(1, 1, At, B1); PG8_BAR; PG8_SCHED;
            PG8_LDB(B0, 1, 0); PG8_LDB(B1, 1, 1); PG8_SCHED; PG8_LDA(At, 1, 0); PG8_STAGE(PG8_SA(0, 1), a2 + hstep);
            PG8_WAIT_V(8); PG8_WAIT_L(0); PG8_BAR; PG8_MMA(0, 0, At, B0); PG8_MMA(0, 1, At, B1); PG8_BAR; PG8_SCHED;
            PG8_LDA(At, 1, 1); PG8_STAGE(PG8_SB(1, 0), b3); PG8_STAGE(PG8_SB(1, 1), b3 + hstep); PG8_STAGE(PG8_SA(1, 0), a3);
            PG8_WAIT_V(8); PG8_WAIT_L(0); PG8_BAR; PG8_MMA(1, 0, At, B0); PG8_MMA(1, 1, At, B1); PG8_BAR; PG8_SCHED;
        }
        if (wr == 0) PG8_BAR;
        E(acc, cur, wr, wc, fr, fq);
        if (!has_next) break;
#pragma unroll
        for (int a = 0; a < 2; ++a)
#pragma unroll
            for (int b = 0; b < 2; ++b)
#pragma unroll
                for (int m = 0; m < 4; ++m)
#pragma unroll
                    for (int n = 0; n < 2; ++n) acc[a][b][m][n] = (f32x4){0.f, 0.f, 0.f, 0.f};
        cur = nxt; cA = nA; cB = nB; ++ui;
        if (wr == 1) PG8_BAR;
    }
    PG8_WAIT_V(0);
    PG8_BAR;
#undef PG8_SA
#undef PG8_SB
#undef PG8_STAGE
#undef PG8_LDA
#undef PG8_LDB
#undef PG8_MMA
#undef PG8_WAIT_V
#undef PG8_WAIT_L
#undef PG8_BAR
#undef PG8_SCHED
}
#else
template <class Epi, class Sched> void gemm_phase(unsigned char* lds, const Gemm g, const Sched& S, const Epi& E);
#endif
}
typedef f32x4 AccT[2][2][4][2];

struct Ctx {
    const Params* p; Dims d; unsigned char* lds; int tid, lane, wave, G, vcu;
    template <class T> __device__ __forceinline__ T* ws(unsigned off) const { return (T*)(p->ws + ((size_t)off << 8)); }
    __device__ __forceinline__ const float* in(int i) const { return p->in[i]; }
    __device__ __forceinline__ int modrow(int tok) const { return tok < d.NTc ? 0 : 1 + (tok - d.NTc) / d.Tl; }
    __device__ __forceinline__ const float* mods(int l) const { return ws<float>(d.w_mods) + (size_t)l * (1 + d.Bl) * NMOD; }
    __device__ __forceinline__ float* X() const { return p->out; }
};

__device__ __forceinline__ Ctx fresh(const Ctx& c0) {
    Ctx c; c.p = c0.p; c.lds = c0.lds; c.tid = opqv(c0.tid); c.lane = c.tid & 63; c.wave = opqs(c0.wave); c.G = opqs(c0.G); c.vcu = opqs(c0.vcu);
    c.d = make_dims(opqs(c0.p->Bc), opqs(c0.p->Tc), opqs(c0.p->Bl), opqs(c0.p->Tl)); return c;
}

struct EpiCols {
    static constexpr bool MID = false;
    float* cols; unsigned short* gates;
    __device__ __forceinline__ void operator()(const AccT& acc, const pg8::Unit& u, int wr, int wc, int fr, int fq) const {
        const int row0 = u.pm * 256 + wr * 64 + fr;
        if (u.pn < 15) {
            const int col0 = u.pn * 256 + wc * 32 + 4 * fq;
#pragma unroll
            for (int ai = 0; ai < 2; ++ai)
#pragma unroll
                for (int m = 0; m < 4; ++m) { float* rp = cols + (size_t)(row0 + ai * 128 + m * 16) * NCF + col0;
#pragma unroll
                    for (int bj = 0; bj < 2; ++bj)
#pragma unroll
                        for (int n = 0; n < 2; ++n) *(f32x4*)(rp + bj * 128 + n * 16) = acc[ai][bj][m][n]; }
        } else {
            const int col0 = (u.pn - 15) * 256 + wc * 32 + 4 * fq;
#pragma unroll
            for (int ai = 0; ai < 2; ++ai)
#pragma unroll
                for (int m = 0; m < 4; ++m) { unsigned short* rp = gates + (size_t)(row0 + ai * 128 + m * 16) * NGATE + col0;
#pragma unroll
                    for (int bj = 0; bj < 2; ++bj)
#pragma unroll
                        for (int n = 0; n < 2; ++n) { const f32x4 a = acc[ai][bj][m][n]; u32x2 w;
                            w.x = pkh2(fmaxf(sigmoidf_(a[0]), 6.2e-5f), fmaxf(sigmoidf_(a[1]), 6.2e-5f)); w.y = pkh2(fmaxf(sigmoidf_(a[2]), 6.2e-5f), fmaxf(sigmoidf_(a[3]), 6.2e-5f));
                            *(u32x2*)(rp + bj * 128 + n * 16) = w; } }
        }
    }
};
struct EpiWiden {
    static constexpr bool MID = true;
    const unsigned short* gates; bf16_t* merged;
    __device__ __forceinline__ void mid(AccT& acc, const pg8::Unit& u, int z1, int wr, int wc, int fr, int fq) const {
        const int row0 = opqv(u.pm * 256 + wr * 64 + fr), col0 = opqv(u.pn * 256 + wc * 32 + 4 * fq);
#pragma unroll
        for (int ai = 0; ai < 2; ++ai)
#pragma unroll
            for (int m = 0; m < 4; ++m) { const unsigned short* rp = gates + (size_t)(row0 + ai * 128 + m * 16) * NGATE + col0;
#pragma unroll
                for (int bj = 0; bj < 2; ++bj)
#pragma unroll
                    for (int n = 0; n < 2; ++n) { const u32x2 a = *(const u32x2*)(rp + (z1 - 1) * 1024 + bj * 128 + n * 16), b = *(const u32x2*)(rp + z1 * 1024 + bj * 128 + n * 16);
                        f32x4 r; r[0] = h2f(a.x & 0xffff) * frcp(h2f(b.x & 0xffff)); r[1] = h2f(a.x >> 16) * frcp(h2f(b.x >> 16)); r[2] = h2f(a.y & 0xffff) * frcp(h2f(b.y & 0xffff)); r[3] = h2f(a.y >> 16) * frcp(h2f(b.y >> 16));
                        acc[ai][bj][m][n] *= r;
#ifndef CPU_EMU
                        asm volatile("" ::: "memory");
#endif
                    } }
    }
    __device__ __forceinline__ void operator()(const AccT& acc, const pg8::Unit& u, int wr, int wc, int fr, int fq) const {
        const int row0 = u.pm * 256 + wr * 64 + fr, col0 = u.pn * 256 + wc * 32 + 4 * fq;
#pragma unroll
        for (int ai = 0; ai < 2; ++ai)
#pragma unroll
            for (int m = 0; m < 4; ++m) { const size_t ro = (size_t)(row0 + ai * 128 + m * 16);
#pragma unroll
                for (int bj = 0; bj < 2; ++bj)
#pragma unroll
                    for (int n = 0; n < 2; ++n) { const u32x2 b = *(const u32x2*)(gates + ro * NGATE + 3 * 1024 + col0 + bj * 128 + n * 16); const f32x4 a = acc[ai][bj][m][n]; u32x2 w;
                        w.x = pk2(a[0] * h2f(b.x & 0xffff), a[1] * h2f(b.x >> 16)); w.y = pk2(a[2] * h2f(b.y & 0xffff), a[3] * h2f(b.y >> 16));
                        *(u32x2*)(merged + ro * D + col0 + bj * 128 + n * 16) = w; } }
    }
};
struct EpiPreLN {
    static constexpr bool MID = false;
    const float* x; const float* mods; float* v; int NTc, Tl;
    __device__ __forceinline__ void operator()(const AccT& acc, const pg8::Unit& u, int wr, int wc, int fr, int fq) const {
        const int row0 = u.pm * 256 + wr * 64 + fr, col0 = u.pn * 256 + wc * 32 + 4 * fq;
#pragma unroll
        for (int ai = 0; ai < 2; ++ai)
#pragma unroll
            for (int m = 0; m < 4; ++m) { const int row = row0 + ai * 128 + m * 16; const int mr = row < NTc ? 0 : 1 + (row - NTc) / Tl; const float* g1 = mods + (size_t)mr * NMOD + 2 * D + col0;
                const size_t ro = (size_t)row * D + col0;
#pragma unroll
                for (int bj = 0; bj < 2; ++bj)
#pragma unroll
                    for (int n = 0; n < 2; ++n) { const int o = bj * 128 + n * 16; const f32x4 xv = *(const f32x4*)(x + ro + o), gv = *(const f32x4*)(g1 + o);
                        *(f32x4*)(v + ro + o) = ALPHA * xv + gv * acc[ai][bj][m][n]; } }
    }
};
struct EpiSwiGLU {
    static constexpr bool MID = false;
    bf16_t* act;
    __device__ __forceinline__ void operator()(const AccT& acc, const pg8::Unit& u, int wr, int wc, int fr, int fq) const {
        const int row0 = u.pm * 256 + wr * 64 + fr, col0 = u.pn * 128 + wc * 32 + 4 * fq;
#pragma unroll
        for (int ai = 0; ai < 2; ++ai)
#pragma unroll
            for (int m = 0; m < 4; ++m) { bf16_t* rp = act + (size_t)(row0 + ai * 128 + m * 16) * FF + col0;
#pragma unroll
                for (int n = 0; n < 2; ++n) { const f32x4 a = acc[ai][0][m][n], b = acc[ai][1][m][n]; u32x2 w;
                    w.x = pk2(siluf_(a[0]) * b[0], siluf_(a[1]) * b[1]); w.y = pk2(siluf_(a[2]) * b[2], siluf_(a[3]) * b[3]); *(u32x2*)(rp + n * 16) = w; } }
    }
};
struct EpiDown {
    static constexpr bool MID = false;
    const float* pgate; float* y;
    __device__ __forceinline__ void operator()(const AccT& acc, const pg8::Unit& u, int wr, int wc, int fr, int fq) const {
        const int row0 = u.pm * 256 + wr * 64 + fr, col0 = u.pn * 256 + wc * 32 + 4 * fq;
#pragma unroll
        for (int ai = 0; ai < 2; ++ai)
#pragma unroll
            for (int m = 0; m < 4; ++m) { const int row = row0 + ai * 128 + m * 16; const float gt = pgate[row]; float* rp = y + (size_t)row * D + col0;
#pragma unroll
                for (int bj = 0; bj < 2; ++bj)
#pragma unroll
                    for (int n = 0; n < 2; ++n) *(f32x4*)(rp + bj * 128 + n * 16) = gt * acc[ai][bj][m][n]; }
    }
};

template <class ColMap>
__device__ __forceinline__ void tr_item(const float* src, int src_ld, const ColMap& cm, bf16_t* dst, int dst_ld, int dst_koff, int n0, int k0, float* scr, int lane) {
    const int r = lane >> 4, c4 = (lane & 15) * 4; const int sc = cm(n0 + c4);
    f32x4 v[16];
    UNR for (int i = 0; i < 16; ++i) v[i] = sc >= 0 ? *(const f32x4*)(src + (size_t)(k0 + i * 4 + r) * src_ld + sc) : (f32x4){0.f, 0.f, 0.f, 0.f};
    UNR for (int i = 0; i < 16; ++i) { float* p = scr + (i * 4 + r) * 65 + c4; p[0] = v[i][0]; p[1] = v[i][1]; p[2] = v[i][2]; p[3] = v[i][3]; }
    WAVE_SYNC();
    const int kc = lane & 7;
    UNR for (int j = 0; j < 8; ++j) { const int n = (lane >> 3) + 8 * j; const float* p = scr + (8 * kc) * 65 + n;
        u32x4 o; o.x = pk2(p[0 * 65], p[1 * 65]); o.y = pk2(p[2 * 65], p[3 * 65]); o.z = pk2(p[4 * 65], p[5 * 65]); o.w = pk2(p[6 * 65], p[7 * 65]);
        *(u32x4*)(dst + (size_t)(n0 + n) * dst_ld + dst_koff + k0 + 8 * kc) = o; }
    WAVE_SYNC();
}
struct CmId { __device__ __forceinline__ int operator()(int n) const { return n; } };
struct CmWin { __device__ __forceinline__ int operator()(int n) const { return win_col(n); } };
struct CmUp { __device__ __forceinline__ int operator()(int n) const { const int u = n >> 8, w = n & 255; return (w < 128 ? 0 : FF) + u * 128 + (w & 127); } };

__device__ __forceinline__ void phase_prep(const Ctx& c0) {
    const Ctx c = fresh(c0);
    const Dims& d = c.d;
    float* L = (float*)c.lds;
    const int nrow = 1 + d.Bl;
    const int gw = c.vcu * NWAVES + c.wave, NGW = c.G * NWAVES;
    const int nmod_items = DEPTH * (NMOD / 64);
    if (c.vcu < nmod_items) {
        const int l = c.vcu / (NMOD / 64), j = (c.vcu % (NMOD / 64)) * 64 + c.lane, kw = c.wave * 128;
        const float* w = c.in(I_WADA) + ((size_t)l * D + kw) * NMOD + j;
        float* cond = L + c.wave * 4160;
        for (int i = c.lane; i < 9 * 128; i += 64) { const int r = i >> 7, k = kw + (i & 127); const float v = r == 0 ? c.in(I_CCTX)[k] : (r < nrow ? c.in(I_C)[(size_t)(r - 1) * D + k] : 0.0f); cond[i] = siluf_(v); }
        WAVE_SYNC();
        float a[9];
        UNR for (int r = 0; r < 9; ++r) a[r] = 0.0f;
#pragma unroll 8
        for (int k = 0; k < 128; ++k) { const float wv = w[(size_t)k * NMOD]; UNR for (int r = 0; r < 9; ++r) a[r] += cond[r * 128 + k] * wv; }
        UNR for (int r = 0; r < 9; ++r) cond[1152 + r * 64 + c.lane] = a[r];
        __syncthreads();
        if (c.wave == 0) { const float bias = c.in(I_BADA)[(size_t)l * NMOD + j]; float* mo = c.ws<float>(d.w_mods) + (size_t)l * nrow * NMOD + j;
            UNR for (int r = 0; r < 9; ++r) { float t = bias; UNR for (int ww = 0; ww < 8; ++ww) t += L[ww * 4160 + 1152 + r * 64 + c.lane]; if (r < nrow) mo[(size_t)r * NMOD] = t; } }
        __syncthreads();
    }
    float* scr = L + c.wave * 4160;
    const int I_IN = (D / 64) * (NINP / 64), I_BR = 4 * (MIXW / 64) * (D / 64), I_OUT = (D / 64) * (D / 64), I_UP = NEXP * (D / 64) * (2 * FF / 64), I_DN = NEXP * (FF / 64) * (D / 64);
    const int PER_L = I_IN + I_BR + I_OUT + I_UP + I_DN;
    for (int it = gw; it < DEPTH * PER_L; it += NGW) {
        const int l = it / PER_L; int r = it % PER_L;
        if (r < I_IN) { const int nb = NINP / 64, kb = r / nb, n0 = (r % nb) * 64;
            tr_item(c.in(I_WIN) + (size_t)l * D * NIN, NIN, CmWin(), c.ws<bf16_t>(d.w_win) + (size_t)l * NINP * D, D, 0, n0, kb * 64, scr, c.lane); continue; } r -= I_IN;
        if (r < I_BR) { const int per = (MIXW / 64) * (D / 64), z = r / per, q = r % per, kb = q / (D / 64), n0 = (q % (D / 64)) * 64;
            tr_item(c.in(I_WBR) + ((size_t)l * 4 + z) * MIXW * D, D, CmId(), c.ws<bf16_t>(d.w_wbr) + (size_t)l * D * D, D, z * MIXW, n0, kb * 64, scr, c.lane); continue; } r -= I_BR;
        if (r < I_OUT) { const int kb = r / (D / 64), n0 = (r % (D / 64)) * 64;
            tr_item(c.in(I_WOUT) + (size_t)l * D * D, D, CmId(), c.ws<bf16_t>(d.w_wout) + (size_t)l * D * D, D, 0, n0, kb * 64, scr, c.lane); continue; } r -= I_OUT;
        if (r < I_UP) { const int per = (D / 64) * (2 * FF / 64), e = r / per, q = r % per, kb = q / (2 * FF / 64), n0 = (q % (2 * FF / 64)) * 64;
            tr_item(c.in(I_WUP) + ((size_t)l * NEXP + e) * D * 2 * FF, 2 * FF, CmUp(), c.ws<bf16_t>(d.w_wup) + ((size_t)l * NEXP + e) * 2 * FF * D, D, 0, n0, kb * 64, scr, c.lane); continue; } r -= I_UP;
        { const int per = (FF / 64) * (D / 64), e = r / per, q = r % per, kb = q / (D / 64), n0 = (q % (D / 64)) * 64;
            tr_item(c.in(I_WDOWN) + ((size_t)l * NEXP + e) * FF * D, D, CmId(), c.ws<bf16_t>(d.w_wdn) + ((size_t)l * NEXP + e) * D * FF, FF, 0, n0, kb * 64, scr, c.lane); }
    }
}

__device__ __forceinline__ void phase_init(const Ctx& c0) {
    const Ctx c = fresh(c0);
    const Dims& d = c.d; const float* mods = c.mods(0); bf16_t* hb = c.ws<bf16_t>(d.w_hb);
    const int gw = c.vcu * NWAVES + c.wave, NGW = c.G * NWAVES;
    for (int tok = gw; tok < d.NT; tok += NGW) {
        const float* xr = tok < d.NTc ? c.in(I_XP) + (size_t)tok * D : c.in(I_XS) + (size_t)(tok - d.NTc) * D;
        const float* mr = mods + (size_t)c.modrow(tok) * NMOD;
#pragma unroll
        for (int j = 0; j < 4; ++j) { const int col = 4 * c.lane + 256 * j; const f32x4 x = *(const f32x4*)(xr + col), sh = *(const f32x4*)(mr + col), sc = *(const f32x4*)(mr + D + col);
            *(f32x4*)(c.X() + (size_t)tok * D + col) = x; const f32x4 h = x * (1.0f + sc) + sh;
            u32x2 w; w.x = pk2(h[0], h[1]); w.y = pk2(h[2], h[3]); *(u32x2*)(hb + (size_t)tok * D + col) = w; }
    }
}

__device__ __forceinline__ f32x16 mm32(int lane, f32x16 acc, const float* A, int sai, int sak, const float* Bm, int sbk, int sbj, int K) {
    const int i = lane & 31, kk = lane >> 5;
    const float* ap = A + i * sai + kk * sak; const float* bp = Bm + kk * sbk + i * sbj;
#pragma unroll 8
    for (int k = 0; k < K; k += 2) acc = __builtin_amdgcn_mfma_f32_32x32x2f32(ap[k * sak], bp[k * sbk], acc, 0, 0, 0);
    return acc;
}
#define ACC_ROW(r, lane) (((r) & 3) + 8 * ((r) >> 2) + 4 * ((lane) >> 5))
__device__ __forceinline__ f32x16 zero16() { f32x16 z; UNR for (int r = 0; r < 16; ++r) z[r] = 0.0f; return z; }
constexpr int S65 = 65, MSZ = 64 * 65;

__device__ __forceinline__ void build_rope(float* cosT, float* sinT, int tid) {
    for (int i = tid; i < 1024; i += NTHREADS) { const int pos = i >> 4, f = i & 15; const float inv = powf(10000.0f, -(float)f / 16.0f); const float ang = (float)pos * inv; cosT[i] = cosf(ang); sinT[i] = sinf(ang); }
}
__device__ __forceinline__ float rope_elem(const float* rowp, int dd, int t, const float* cosT, const float* sinT) {
    const int f = dd & 15, second = (dd >> 4) & 1, pos = (dd < 32) ? (t / GRIDW) : (t % GRIDW);
    const float x = rowp[dd], xp = rowp[second ? dd - 16 : dd + 16], cs = cosT[pos * 16 + f], sn = sinT[pos * 16 + f];
    return second ? (xp * sn + x * cs) : (x * cs - xp * sn);
}

constexpr int SL_MF = 0, SL_MB = 1, SL_GF = 2, SL_GB = 3, SL_RF = 4, SL_RB = 5, SL_RBONUS = 6, NSLOT = 7;

struct ChunkRegs { float q1[4], q2[4], k1[4], k2[4], v1[4], v2[4]; };
__device__ __forceinline__ void chunk_load(ChunkRegs& R, const float* cols, size_t tok0, int T, int dir, int ci, int h, int cbq, int tid) {
    UNR for (int u = 0; u < 4; ++u) { const int ps = tid + NTHREADS * u, j = ps >> 5, pp = ps & 31, dd1 = (pp >> 4) * 32 + (pp & 15), t = dir ? T - 1 - (ci * 64 + j) : ci * 64 + j;
        const float* rp = cols + (tok0 + t) * NCF + h * 64 + dd1;
        R.q1[u] = rp[cbq * 256]; R.q2[u] = rp[cbq * 256 + 16]; R.k1[u] = rp[(cbq + 1) * 256]; R.k2[u] = rp[(cbq + 1) * 256 + 16]; R.v1[u] = rp[(cbq + 2) * 256]; R.v2[u] = rp[(cbq + 2) * 256 + 16]; }
}
__device__ __forceinline__ void chunk_store(const ChunkRegs& R, float* Q, float* K, float* V, int T, int dir, int ci, int pass, float qs, float ks, const float* cosT, const float* sinT, int tid) {
    UNR for (int u = 0; u < 4; ++u) { const int ps = tid + NTHREADS * u, j = ps >> 5, pp = ps & 31, dd1 = (pp >> 4) * 32 + (pp & 15), o = j * S65 + dd1;
        float q1 = R.q1[u], q2 = R.q2[u], k1 = R.k1[u], k2 = R.k2[u];
        if (pass) { const int t = dir ? T - 1 - (ci * 64 + j) : ci * 64 + j, pos = (pp >> 4) ? (t % GRIDW) : (t / GRIDW); const float cs = cosT[pos * 16 + (pp & 15)], sn = sinT[pos * 16 + (pp & 15)];
            const float a = q1 * cs - q2 * sn, b = q1 * sn + q2 * cs, cc = k1 * cs - k2 * sn, dd = k1 * sn + k2 * cs; q1 = a; q2 = b; k1 = cc; k2 = dd; }
        Q[o] = q1 * qs; Q[o + 16] = q2 * qs; K[o] = k1 * ks; K[o + 16] = k2 * ks; V[o] = R.v1[u]; V[o + 16] = R.v2[u]; }
}

__device__ __forceinline__ void mix_mlstm(const Ctx& c0, int l, int pass, int b, int h, int dir) {
    const Ctx c = fresh(c0);
    const Dims& d = c.d; const int T = pass ? d.Tl : d.Tc, nc = T / 64, tid = c.tid, lane = c.lane, wave = c.wave; const size_t tok0 = pass ? d.NTc + (size_t)b * d.Tl : (size_t)b * d.Tc;
    float* L = (float*)c.lds;
    float *Q = L, *K = L + MSZ, *V = L + 2 * MSZ, *C = L + 3 * MSZ, *Sm = L + 4 * MSZ, *QC = L + 5 * MSZ, *vec = L + 6 * MSZ;
    float *nv = vec, *ig = vec + 64, *lf = vec + 128, *bc = vec + 192, *lw = vec + 256, *wint = vec + 320, *rden = vec + 384, *scal = vec + 448, *npart = vec + 512, *cosT = vec + 1024, *sinT = vec + 2048;
    const float* cols = c.ws<float>(d.w_cols); float* scr = c.ws<float>(d.w_scr);
    __syncthreads();
    if (pass) build_rope(cosT, sinT, tid);
    if (pass) { const float* C0 = c.in(I_SC) + ((((size_t)b * DEPTH + l) * 2 + dir) * NH + h) * HD * HD;
        _Pragma("unroll 2") for (int i = tid; i < 4096; i += NTHREADS) C[(i >> 6) * S65 + (i & 63)] = C0[i];
        if (tid < 64) nv[tid] = c.in(I_SN)[((((size_t)b * DEPTH + l) * 2 + dir) * NH + h) * HD + tid];
        if (tid == 0) scal[0] = c.in(I_SM)[(((size_t)b * DEPTH + l) * 2 + dir) * NH + h];
    } else { _Pragma("unroll 2") for (int i = tid; i < 4096; i += NTHREADS) C[(i >> 6) * S65 + (i & 63)] = 0.0f; if (tid < 64) nv[tid] = 0.0f; if (tid == 0) scal[0] = 0.0f; }
    const float big = c.in(I_BIG)[((size_t)l * 2 + dir) * NH + h], bfg = c.in(I_BFG)[((size_t)l * 2 + dir) * NH + h];
    ChunkRegs R; float rig = 0.0f, rlf = 0.0f;
    chunk_load(R, cols, tok0, T, dir, 0, h, CB_MQ, tid);
    if (tid < 64) { const int t = dir ? T - 1 - tid : tid; const float* rp = cols + (tok0 + t) * NCF; rig = rp[SM_MI + dir * 4 + h]; rlf = rp[SM_MF + dir * 4 + h]; }
    __syncthreads();
    chunk_store(R, Q, K, V, T, dir, 0, pass, 1.0f, 0.125f, cosT, sinT, tid);
    if (tid < 64) { ig[tid] = rig + big; lf[tid] = logsigmoidf_(rlf + bfg); }
    for (int ci = 0; ci < nc; ++ci) {
        if (ci + 1 < nc) {
            chunk_load(R, cols, tok0, T, dir, ci + 1, h, CB_MQ, tid);
            if (tid < 64) { const int t = dir ? T - 1 - ((ci + 1) * 64 + tid) : (ci + 1) * 64 + tid; const float* rp = cols + (tok0 + t) * NCF; rig = rp[SM_MI + dir * 4 + h]; rlf = rp[SM_MF + dir * 4 + h]; }
        }
        __syncthreads();
        if (wave == 0) { float run = lf[lane];
            UNR for (int o = 1; o < 64; o <<= 1) { const float up = __shfl(run, lane >= o ? lane - o : lane); run += lane >= o ? up : 0.0f; }
            const float bend = __shfl(run, 63), m = scal[0], w = bend - run + ig[lane]; float mx = w;
            mx = fmaxf(mx, x1(mx)); mx = fmaxf(mx, x2(mx)); mx = fmaxf(mx, x4m(mx)); mx = fmaxf(mx, x8m(mx)); mx = fmaxf(mx, __shfl_xor(mx, 16)); mx = fmaxf(mx, __shfl_xor(mx, 32));
            const float mnew = fmaxf(bend + m, mx); bc[lane] = run; lw[lane] = w; if (lane == 0) { scal[1] = mnew; scal[2] = fexp(bend + m - mnew); } }
        { const int ti = (wave >> 1) & 1, tj = wave & 1; f32x16 acc = zero16();
          if (wave < 4) { acc = mm32(lane, acc, Q + ti * 32 * S65, S65, 1, K + tj * 32 * S65, 1, S65, 64); UNR for (int r = 0; r < 16; ++r) Sm[(ti * 32 + ACC_ROW(r, lane)) * S65 + tj * 32 + (lane & 31)] = acc[r]; }
          else { acc = mm32(lane, acc, Q + ti * 32 * S65, S65, 1, C + tj * 32, S65, 1, 64); UNR for (int r = 0; r < 16; ++r) QC[(ti * 32 + ACC_ROW(r, lane)) * S65 + tj * 32 + (lane & 31)] = acc[r]; } }
        __syncthreads();
        { const int t = tid >> 3, g = tid & 7; const float m = scal[0], mnew = scal[1], bt = bc[t]; float mx = -3.0e38f;
          UNR for (int e = 0; e < 8; ++e) { const int s = g * 8 + e; if (s <= t) mx = fmaxf(mx, bt - bc[s] + ig[s]); }
          mx = fmaxf(mx, x1(mx)); mx = fmaxf(mx, x2(mx)); mx = fmaxf(mx, x4m(mx));
          const float minter = bt + m, mt = fmaxf(minter, mx); float den = 0.0f, qn = 0.0f;
          UNR for (int e = 0; e < 8; ++e) { const int s = g * 8 + e; float sv = 0.0f; if (s <= t) sv = Sm[t * S65 + s] * fexp(bt - bc[s] + ig[s] - mt); Sm[t * S65 + s] = sv; den += sv; qn += Q[t * S65 + s] * nv[s]; }
          den += x1(den); den += x2(den); den += x4m(den); qn += x1(qn); qn += x2(qn); qn += x4m(qn);
          const float wi = fexp(minter - mt); den += wi * qn;
          if (g == 0) { wint[t] = wi; rden[t] = 1.0f / fmaxf(fabsf(den), fexp(-mt)); }
          const float ks = fexp(lw[t] - mnew); UNR for (int e = 0; e < 8; ++e) K[t * S65 + g * 8 + e] *= ks; }
        __syncthreads();
        { const int ti = (wave >> 1) & 1, tj = wave & 1;
          if (wave < 4) { f32x16 acc = zero16(); acc = mm32(lane, acc, Sm + ti * 32 * S65, S65, 1, V + tj * 32, S65, 1, 64);
              UNR for (int r = 0; r < 16; ++r) { const int row = ti * 32 + ACC_ROW(r, lane), o = row * S65 + tj * 32 + (lane & 31); QC[o] = (acc[r] + wint[row] * QC[o]) * rden[row]; } }
          else { const float carry = scal[2]; f32x16 acc; UNR for (int r = 0; r < 16; ++r) acc[r] = carry * C[(ti * 32 + ACC_ROW(r, lane)) * S65 + tj * 32 + (lane & 31)];
              acc = mm32(lane, acc, K + ti * 32, 1, S65, V + tj * 32, S65, 1, 64);
              UNR for (int r = 0; r < 16; ++r) C[(ti * 32 + ACC_ROW(r, lane)) * S65 + tj * 32 + (lane & 31)] = acc[r]; }
          float s = 0.0f; UNR for (int e = 0; e < 8; ++e) s += K[(wave * 8 + e) * S65 + lane]; npart[wave * 64 + lane] = s; }
        __syncthreads();
        if (tid < 64) { float s = 0.0f; UNR for (int e = 0; e < 8; ++e) s += npart[e * 64 + tid]; nv[tid] = scal[2] * nv[tid] + s; }
        { const int j = tid >> 3, g = tid & 7, t = dir ? T - 1 - (ci * 64 + j) : ci * 64 + j; float* sp = scr + ((tok0 + t) * NSLOT + (dir ? SL_MB : SL_MF)) * MIXW + h * 64 + g * 8; const float* hp = QC + j * S65 + g * 8;
          *(f32x4*)sp = (f32x4){hp[0], hp[1], hp[2], hp[3]}; *(f32x4*)(sp + 4) = (f32x4){hp[4], hp[5], hp[6], hp[7]}; }
        if (ci + 1 < nc) { chunk_store(R, Q, K, V, T, dir, ci + 1, pass, 1.0f, 0.125f, cosT, sinT, tid); if (tid < 64) { ig[tid] = rig + big; lf[tid] = logsigmoidf_(rlf + bfg); } }
        if (tid == 0) scal[0] = scal[1];
    }
    __syncthreads();
    if (!pass) {
        float* Co = c.p->out + d.o_C + ((((size_t)b * DEPTH + l) * 2 + dir) * NH + h) * HD * HD;
        _Pragma("unroll 2") for (int i = tid; i < 4096; i += NTHREADS) Co[i] = C[(i >> 6) * S65 + (i & 63)];
        if (tid < 64) c.p->out[d.o_n + ((((size_t)b * DEPTH + l) * 2 + dir) * NH + h) * HD + tid] = nv[tid];
        if (tid == 0) c.p->out[d.o_m + (((size_t)b * DEPTH + l) * 2 + dir) * NH + h] = scal[0];
    }
    __syncthreads();
}

__device__ __forceinline__ void mix_gla(const Ctx& c0, int l, int pass, int b, int h, int dir) {
    const Ctx c = fresh(c0);
    const Dims& d = c.d; const int T = pass ? d.Tl : d.Tc, nc = T / 64, tid = c.tid, lane = c.lane, wave = c.wave; const size_t tok0 = pass ? d.NTc + (size_t)b * d.Tl : (size_t)b * d.Tc;
    float* L = (float*)c.lds;
    float *Q = L, *K = L + MSZ, *V = L + 2 * MSZ, *S = L + 3 * MSZ, *Gm = L + 4 * MSZ, *O2 = L + 5 * MSZ, *vec = L + 6 * MSZ;
    float *gend = vec, *bA = vec + 64, *gpart = vec + 128, *GA = vec + 640, *wA = vec + 640 + 1024, *cosT = vec + 640 + 2048, *sinT = vec + 640 + 3072;
    const float* cols = c.ws<float>(d.w_cols); float* scr = c.ws<float>(d.w_scr);
    __syncthreads();
    if (pass) build_rope(cosT, sinT, tid);
    if (pass) { const float* S0 = c.in(I_SG) + ((((size_t)b * DEPTH + l) * 2 + dir) * NH + h) * HD * HD; _Pragma("unroll 2") for (int i = tid; i < 4096; i += NTHREADS) S[(i >> 6) * S65 + (i & 63)] = S0[i]; }
    else { _Pragma("unroll 2") for (int i = tid; i < 4096; i += NTHREADS) S[(i >> 6) * S65 + (i & 63)] = 0.0f; }
    for (int i = tid; i < 1024; i += NTHREADS) wA[i] = c.in(I_WGLA)[(((size_t)l * 2 + dir) * 16 + (i >> 6)) * MIXW + h * 64 + (i & 63)];
    if (tid < 64) bA[tid] = c.in(I_BGLA)[((size_t)l * 2 + dir) * MIXW + h * 64 + tid];
    ChunkRegs R; f32x4 rga = (f32x4){0.f, 0.f, 0.f, 0.f};
    chunk_load(R, cols, tok0, T, dir, 0, h, CB_GQ, tid);
    if (tid < 256) { const int j = tid >> 2, t = dir ? T - 1 - j : j; rga = *(const f32x4*)(cols + (tok0 + t) * NCF + SM_GA + dir * 16 + (tid & 3) * 4); }
    __syncthreads();
    chunk_store(R, Q, K, V, T, dir, 0, pass, 0.125f, 1.0f, cosT, sinT, tid);
    if (tid < 256) *(f32x4*)(GA + (tid >> 2) * 16 + (tid & 3) * 4) = rga;
    for (int ci = 0; ci < nc; ++ci) {
        if (ci + 1 < nc) {
            chunk_load(R, cols, tok0, T, dir, ci + 1, h, CB_GQ, tid);
            if (tid < 256) { const int j = tid >> 2, t = dir ? T - 1 - ((ci + 1) * 64 + j) : (ci + 1) * 64 + j; rga = *(const f32x4*)(cols + (tok0 + t) * NCF + SM_GA + dir * 16 + (tid & 3) * 4); }
        }
        __syncthreads();
        float gl[8];
        { float run = 0.0f;
          UNR for (int e = 0; e < 8; ++e) { const float* ga = GA + (wave * 8 + e) * 16; float a = bA[lane];
              UNR for (int r = 0; r < 16; ++r) a += ga[r] * wA[r * 64 + lane];
              run += logsigmoidf_(a) * (1.0f / 16.0f); gl[e] = run; }
          gpart[wave * 64 + lane] = run; }
        __syncthreads();
        { float pre = 0.0f; UNR for (int e = 0; e < 8; ++e) pre += (e < wave) ? gpart[e * 64 + lane] : 0.0f;
          UNR for (int e = 0; e < 8; ++e) { const float g = gl[e] + pre; const int o = (wave * 8 + e) * S65 + lane; Q[o] *= fexp(g); K[o] *= fexp(-g); if (wave == 7 && e == 7) gend[lane] = g; } }
        __syncthreads();
        { const int ti = (wave >> 1) & 1, tj = wave & 1; f32x16 acc = zero16();
          if (wave < 4) { acc = mm32(lane, acc, Q + ti * 32 * S65, S65, 1, K + tj * 32 * S65, 1, S65, 64);
              UNR for (int r = 0; r < 16; ++r) { const int row = ti * 32 + ACC_ROW(r, lane), col = tj * 32 + (lane & 31); Gm[row * S65 + col] = col <= row ? acc[r] : 0.0f; } }
          else { acc = mm32(lane, acc, Q + ti * 32 * S65, S65, 1, S + tj * 32, S65, 1, 64); UNR for (int r = 0; r < 16; ++r) O2[(ti * 32 + ACC_ROW(r, lane)) * S65 + tj * 32 + (lane & 31)] = acc[r]; } }
        __syncthreads();
        { const int ti = (wave >> 1) & 1, tj = wave & 1;
          if (wave < 4) { f32x16 acc; UNR for (int r = 0; r < 16; ++r) acc[r] = O2[(ti * 32 + ACC_ROW(r, lane)) * S65 + tj * 32 + (lane & 31)];
              acc = mm32(lane, acc, Gm + ti * 32 * S65, S65, 1, V + tj * 32, S65, 1, 64);
              UNR for (int r = 0; r < 16; ++r) O2[(ti * 32 + ACC_ROW(r, lane)) * S65 + tj * 32 + (lane & 31)] = acc[r]; }
          else { f32x16 acc; UNR for (int r = 0; r < 16; ++r) acc[r] = S[(ti * 32 + ACC_ROW(r, lane)) * S65 + tj * 32 + (lane & 31)];
              acc = mm32(lane, acc, K + ti * 32, 1, S65, V + tj * 32, S65, 1, 64);
              UNR for (int r = 0; r < 16; ++r) { const int row = ti * 32 + ACC_ROW(r, lane); S[row * S65 + tj * 32 + (lane & 31)] = fexp(gend[row]) * acc[r]; } } }
        __syncthreads();
        { const int j = tid >> 3, g = tid & 7, t = dir ? T - 1 - (ci * 64 + j) : ci * 64 + j; float* sp = scr + ((tok0 + t) * NSLOT + (dir ? SL_GB : SL_GF)) * MIXW + h * 64 + g * 8; const float* hp = O2 + j * S65 + g * 8;
          *(f32x4*)sp = (f32x4){hp[0], hp[1], hp[2], hp[3]}; *(f32x4*)(sp + 4) = (f32x4){hp[4], hp[5], hp[6], hp[7]}; }
        if (ci + 1 < nc) { chunk_store(R, Q, K, V, T, dir, ci + 1, pass, 0.125f, 1.0f, cosT, sinT, tid); if (tid < 256) *(f32x4*)(GA + (tid >> 2) * 16 + (tid & 3) * 4) = rga; }
    }
    __syncthreads();
    if (!pass) { float* So = c.p->out + d.o_g + ((((size_t)b * DEPTH + l) * 2 + dir) * NH + h) * HD * HD; _Pragma("unroll 2") for (int i = tid; i < 4096; i += NTHREADS) So[i] = S[(i >> 6) * S65 + (i & 63)]; }
    __syncthreads();
}

#define RW_LOAD(i_, R_, K_, W_, A_, H_, v_) do { const float* Pi_ = buf + (i_) * VST + q * 16; \
    UNR for (int u_ = 0; u_ < 4; ++u_) { R_[u_] = *(const f32x4*)(Pi_ + 4 * u_); K_[u_] = *(const f32x4*)(Pi_ + 64 + 4 * u_); W_[u_] = *(const f32x4*)(Pi_ + 192 + 4 * u_); \
        A_[u_] = *(const f32x4*)(Pi_ + 256 + 4 * u_); H_[u_] = *(const f32x4*)(Pi_ + 320 + 4 * u_); } v_ = buf[(i_) * VST + 128 + vrow]; } while (0)
#define RW_STEP(R_, K_, W_, A_, H_, v_) do { f32x4 d_ = Sv[0] * K_[0]; d_ += Sv[1] * K_[1]; d_ += Sv[2] * K_[2]; d_ += Sv[3] * K_[3]; \
    const float sk_ = quad_sum((d_[0] + d_[1]) + (d_[2] + d_[3])); f32x4 y_ = (f32x4){0.f, 0.f, 0.f, 0.f}; \
    UNR for (int u_ = 0; u_ < 4; ++u_) { Sv[u_] = Sv[u_] * W_[u_] - sk_ * A_[u_] + v_ * H_[u_]; y_ += Sv[u_] * R_[u_]; } \
    const float yy_ = quad_sum((y_[0] + y_[1]) + (y_[2] + y_[3])); if (q == 0) *yp = yy_; yp += ystep; } while (0)
__device__ __forceinline__ void mix_rwkv(const Ctx& c0, int l, int pass, int b, int h, int dir) {
    const Ctx c = fresh(c0);
    const Dims& d = c.d; const int T = pass ? d.Tl : d.Tc, tid = c.tid, lane = c.lane, wave = c.wave; const size_t tok0 = pass ? d.NTc + (size_t)b * d.Tl : (size_t)b * d.Tc;
    float* L = (float*)c.lds;
    const float* cols = c.ws<float>(d.w_cols); float* scr = c.ws<float>(d.w_scr);
    constexpr int TB = 32, VST = 6 * 64;
    float *VEC = L, *LWA = L + 2 * TB * VST, *STG = LWA + 2 * 2 * TB * 64;
    const int nb = T / TB;
    __syncthreads();
    if (wave < 4) {
        const int vrow = tid >> 2, q = tid & 3;
        f32x4 Sv[4];
        if (pass) { const float* S0 = c.in(I_SR) + ((((size_t)b * DEPTH + l) * 2 + dir) * NH + h) * HD * HD + vrow * 64 + q * 16; UNR for (int u = 0; u < 4; ++u) Sv[u] = *(const f32x4*)(S0 + 4 * u); }
        else { UNR for (int u = 0; u < 4; ++u) Sv[u] = (f32x4){0.f, 0.f, 0.f, 0.f}; }
        float* yp = scr + ((tok0 + (dir ? T - 1 : 0)) * NSLOT + (dir ? SL_RB : SL_RF)) * MIXW + h * 64 + vrow; const long ystep = dir ? -(long)(NSLOT * MIXW) : (long)(NSLOT * MIXW);
        __syncthreads(); __syncthreads();
        for (int jb = 0; jb < nb; ++jb) {
            const float* buf = VEC + (jb & 1) * TB * VST;
            f32x4 aR[4], aK[4], aW[4], aA[4], aH[4], bR[4], bK[4], bW[4], bA[4], bH[4]; float av, bv;
            RW_LOAD(0, aR, aK, aW, aA, aH, av);
#pragma unroll 1
            for (int i = 0; i < TB; i += 2) {
                RW_LOAD(i + 1, bR, bK, bW, bA, bH, bv);
                RW_STEP(aR, aK, aW, aA, aH, av);
                if (i + 2 < TB) RW_LOAD(i + 2, aR, aK, aW, aA, aH, av);
                RW_STEP(bR, bK, bW, bA, bH, bv);
            }
            __syncthreads();
        }
        if (!pass) { float* So = c.p->out + d.o_r + ((((size_t)b * DEPTH + l) * 2 + dir) * NH + h) * HD * HD + vrow * 64 + q * 16; UNR for (int u = 0; u < 4; ++u) *(f32x4*)(So + 4 * u) = Sv[u]; }
    } else {
        const int pw = wave - 4, kind = pw >> 1, tj = pw & 1, ch = h * 64 + lane;
        float* stg = STG + pw * (32 * 33);
        float bw[16];
        { const float* Wg = c.in(kind ? I_WA2 : I_WW2) + ((size_t)l * 2 + dir) * 32 * MIXW + h * 64 + tj * 32 + (lane & 31);
          UNR for (int ks = 0; ks < 16; ++ks) bw[ks] = Wg[(size_t)(2 * ks + (lane >> 5)) * MIXW]; }
        const float* tp = c.in(I_SHIFT) + (size_t)l * 3 * 768 + ch;
        const float t0r = tp[0], t1r = tp[768], t2r = tp[1536], t0k = tp[256], t1k = tp[768 + 256], t2k = tp[1536 + 256], t0v = tp[512], t1v = tp[768 + 512], t2v = tp[1536 + 512];
        const float w0c = c.in(I_W0)[((size_t)l * 2 + dir) * MIXW + ch], a0c = c.in(I_A0)[((size_t)l * 2 + dir) * MIXW + ch], kkc = c.in(I_KK)[(size_t)l * MIXW + ch], kac = c.in(I_KA)[(size_t)l * MIXW + ch], rkc = c.in(I_RKK)[(size_t)l * MIXW + ch];
        for (int jb = -2; jb < nb; ++jb) {
            const int mB = jb + 1, mA = jb + 2;
            float xr[10], xk[10], xv[10];
            const int pi0 = mB * TB + pw * 8, tlo = dir ? T - 1 - (pi0 + 7) : pi0;
            if (mB >= 0 && mB < nb) {
                UNR for (int e = 0; e < 10; ++e) { const int tt = tlo - 1 + e; const bool ok = tt >= 0 && tt < T; const float* rp = cols + (tok0 + (ok ? tt : 0)) * NCF + ch;
                    xr[e] = ok ? rp[CB_RR * 256] : 0.0f; xk[e] = ok ? rp[CB_RK * 256] : 0.0f; xv[e] = ok ? rp[CB_RV * 256] : 0.0f; }
            }
            if (mA < nb) {
                float xs[16];
                UNR for (int e = 0; e < 16; ++e) { const int idx = e * 64 + lane, stp = idx >> 5, r = idx & 31, pi = mA * TB + stp, t = dir ? T - 1 - pi : pi; xs[e] = cols[(tok0 + t) * NCF + (kind ? SM_RA : SM_RW) + dir * 32 + r]; }
                UNR for (int e = 0; e < 16; ++e) { const int idx = e * 64 + lane; stg[(idx >> 5) * 33 + (idx & 31)] = kind ? xs[e] : tanhf_(xs[e]); }
                WAVE_SYNC();
                f32x16 acc = zero16(); const float* ap = stg + (lane & 31) * 33 + (lane >> 5);
                UNR for (int ks = 0; ks < 16; ++ks) acc = __builtin_amdgcn_mfma_f32_32x32x2f32(ap[2 * ks], bw[ks], acc, 0, 0, 0);
                float* lo = LWA + (((mA & 1) * 2 + kind) * TB) * 64 + tj * 32 + (lane & 31);
                UNR for (int r = 0; r < 16; ++r) lo[ACC_ROW(r, lane) * 64] = acc[r];
                WAVE_SYNC();
            }
            if (mB >= 0 && mB < nb) {
                float* buf = VEC + (mB & 1) * TB * VST; const float* lwp = LWA + (((mB & 1) * 2 + 0) * TB) * 64 + lane; const float* lap = LWA + (((mB & 1) * 2 + 1) * TB) * 64 + lane;
                UNR for (int s = 0; s < 8; ++s) {
                    const float r = t0r * (dir ? xr[7 - s] : xr[s]) + t1r * (dir ? xr[8 - s] : xr[s + 1]) + t2r * (dir ? xr[9 - s] : xr[s + 2]);
                    const float k = t0k * (dir ? xk[7 - s] : xk[s]) + t1k * (dir ? xk[8 - s] : xk[s + 1]) + t2k * (dir ? xk[9 - s] : xk[s + 2]);
                    const float v = t0v * (dir ? xv[7 - s] : xv[s]) + t1v * (dir ? xv[8 - s] : xv[s + 1]) + t2v * (dir ? xv[9 - s] : xv[s + 2]);
                    const float lw = lwp[(pw * 8 + s) * 64], la = lap[(pw * 8 + s) * 64];
                    const float decay = fexp(-fexp(-softplusf_(-(w0c + lw)) - 0.5f)), a = sigmoidf_(a0c + la);
                    float kap = k * kkc; const float ss = wave_sum(kap * kap); kap *= frsq(ss + LN_EPS);
                    const float khat = k * (1.0f + (a - 1.0f) * kac);
                    float* P = buf + (pw * 8 + s) * VST + lane;
                    P[0] = r; P[64] = kap; P[128] = v; P[192] = decay; P[256] = a * kap; P[320] = khat;
                    if (dir == 0) { const float bonus = wave_sum(r * k * rkc) * v; scr[((tok0 + pi0 + s) * NSLOT + SL_RBONUS) * MIXW + ch] = bonus; }
                }
            }
            __syncthreads();
        }
    }
    __syncthreads();
}
#undef RW_LOAD
#undef RW_STEP

__device__ __forceinline__ void phase_combine(const Ctx& c0, int l) {
    const Ctx c = fresh(c0);
    const Dims& d = c.d; const int tid = c.tid, lane = c.lane, wave = c.wave;
    float* L = (float*)c.lds; float *SG = L, *G2 = L + MSZ, *GT = L + MSZ + 64 * 256;
    const float* cols = c.ws<float>(d.w_cols); const float* scr = c.ws<float>(d.w_scr); bf16_t* br = c.ws<bf16_t>(d.w_br);
    __syncthreads();
    for (int i = tid; i < 64 * 256; i += NTHREADS) G2[i] = c.in(I_WG2)[(size_t)l * 64 * MIXW + i];
    for (int blk = c.vcu; blk < d.NT / 64; blk += c.G) {
        const size_t tb = (size_t)blk * 64;
        __syncthreads();
        { const int j = tid >> 3, g = tid & 7; const float* rp = cols + (tb + j) * NCF + SM_RG + g * 8; const f32x4 a = *(const f32x4*)rp, b2 = *(const f32x4*)(rp + 4); float* sp = SG + j * S65 + g * 8;
          sp[0] = sigmoidf_(a[0]); sp[1] = sigmoidf_(a[1]); sp[2] = sigmoidf_(a[2]); sp[3] = sigmoidf_(a[3]); sp[4] = sigmoidf_(b2[0]); sp[5] = sigmoidf_(b2[1]); sp[6] = sigmoidf_(b2[2]); sp[7] = sigmoidf_(b2[3]); }
        __syncthreads();
        UNR for (int u = 0; u < 2; ++u) { const int tl = wave * 2 + u, ti = tl >> 3, tj = tl & 7; f32x16 acc = zero16();
            acc = mm32(lane, acc, SG + ti * 32 * S65, S65, 1, G2 + tj * 32, 256, 1, 64);
            UNR for (int r = 0; r < 16; ++r) GT[(ti * 32 + ACC_ROW(r, lane)) * 257 + tj * 32 + (lane & 31)] = acc[r]; }
        __syncthreads();
        for (int hh = 0; hh < NH; ++hh) {
            const int j = tid >> 3, g = tid & 7; const size_t tok = tb + j; const int cb = hh * 64 + g * 8; const float* sp = scr + tok * NSLOT * MIXW + cb;
            {
              const f32x4 a0 = *(const f32x4*)(sp + SL_MF * MIXW), a1 = *(const f32x4*)(sp + SL_MF * MIXW + 4), b0 = *(const f32x4*)(sp + SL_MB * MIXW), b1 = *(const f32x4*)(sp + SL_MB * MIXW + 4);
              float x[8]; float s = 0.0f; UNR for (int e = 0; e < 4; ++e) { x[e] = a0[e] + b0[e]; x[4 + e] = a1[e] + b1[e]; } UNR for (int e = 0; e < 8; ++e) s += x[e];
              s += x1(s); s += x2(s); s += x4m(s); const float mean = s * (1.0f / 64.0f); float qv = 0.0f;
              UNR for (int e = 0; e < 8; ++e) { x[e] -= mean; qv += x[e] * x[e]; }
              qv += x1(qv); qv += x2(qv); qv += x4m(qv); const float rs = frsq(qv * (1.0f / 64.0f) + LN_EPS);
              const float* og = cols + tok * NCF + CB_MO * 256 + cb; const f32x4 o0 = *(const f32x4*)og, o1 = *(const f32x4*)(og + 4);
              u32x4 w; w.x = pk2(x[0] * rs * sigmoidf_(o0[0]), x[1] * rs * sigmoidf_(o0[1])); w.y = pk2(x[2] * rs * sigmoidf_(o0[2]), x[3] * rs * sigmoidf_(o0[3]));
              w.z = pk2(x[4] * rs * sigmoidf_(o1[0]), x[5] * rs * sigmoidf_(o1[1])); w.w = pk2(x[6] * rs * sigmoidf_(o1[2]), x[7] * rs * sigmoidf_(o1[3])); *(u32x4*)(br + tok * D + 0 * MIXW + cb) = w; }
            {
              const f32x4 a0 = *(const f32x4*)(sp + SL_GF * MIXW), a1 = *(const f32x4*)(sp + SL_GF * MIXW + 4), b0 = *(const f32x4*)(sp + SL_GB * MIXW), b1 = *(const f32x4*)(sp + SL_GB * MIXW + 4);
              float x[8]; float qv = 0.0f; UNR for (int e = 0; e < 4; ++e) { x[e] = a0[e] + b0[e]; x[4 + e] = a1[e] + b1[e]; } UNR for (int e = 0; e < 8; ++e) qv += x[e] * x[e];
              qv += x1(qv); qv += x2(qv); qv += x4m(qv); const float rs = frsq(qv * (1.0f / 64.0f) + LN_EPS);
              const float* og = cols + tok * NCF + CB_GG * 256 + cb; const f32x4 o0 = *(const f32x4*)og, o1 = *(const f32x4*)(og + 4);
              u32x4 w; w.x = pk2(x[0] * rs * siluf_(o0[0]), x[1] * rs * siluf_(o0[1])); w.y = pk2(x[2] * rs * siluf_(o0[2]), x[3] * rs * siluf_(o0[3]));
              w.z = pk2(x[4] * rs * siluf_(o1[0]), x[5] * rs * siluf_(o1[1])); w.w = pk2(x[6] * rs * siluf_(o1[2]), x[7] * rs * siluf_(o1[3])); *(u32x4*)(br + tok * D + 1 * MIXW + cb) = w; }
            {
              const f32x4 a0 = *(const f32x4*)(sp + SL_RF * MIXW), a1 = *(const f32x4*)(sp + SL_RF * MIXW + 4), b0 = *(const f32x4*)(sp + SL_RB * MIXW), b1 = *(const f32x4*)(sp + SL_RB * MIXW + 4);
              const f32x4 n0 = *(const f32x4*)(sp + SL_RBONUS * MIXW), n1 = *(const f32x4*)(sp + SL_RBONUS * MIXW + 4);
              float x[8]; float s = 0.0f; UNR for (int e = 0; e < 4; ++e) { x[e] = a0[e] + b0[e]; x[4 + e] = a1[e] + b1[e]; } UNR for (int e = 0; e < 8; ++e) s += x[e];
              s += x1(s); s += x2(s); s += x4m(s); const float mean = s * (1.0f / 64.0f); float qv = 0.0f;
              UNR for (int e = 0; e < 8; ++e) { x[e] -= mean; qv += x[e] * x[e]; }
              qv += x1(qv); qv += x2(qv); qv += x4m(qv); const float rs = frsq(qv * (1.0f / 64.0f) + LN_EPS);
              const float* gp = GT + j * 257 + cb;
              u32x4 w; w.x = pk2((x[0] * rs + n0[0]) * gp[0], (x[1] * rs + n0[1]) * gp[1]); w.y = pk2((x[2] * rs + n0[2]) * gp[2], (x[3] * rs + n0[3]) * gp[3]);
              w.z = pk2((x[4] * rs + n1[0]) * gp[4], (x[5] * rs + n1[1]) * gp[5]); w.w = pk2((x[6] * rs + n1[2]) * gp[6], (x[7] * rs + n1[3]) * gp[7]); *(u32x4*)(br + tok * D + 2 * MIXW + cb) = w; }
        }
    }
    __syncthreads();
}

__device__ __forceinline__ void mix_na(const Ctx& c0, int l, int pass, int b, int h, int qb) {
    const Ctx c = fresh(c0);
    const Dims& d = c.d; const int tid = c.tid, lane = c.lane, wave = c.wave; const size_t tok0 = pass ? d.NTc + (size_t)b * d.Tl : (size_t)b * d.Tc;
    float* L = (float*)c.lds;
    float *Q = L, *Kt = L + MSZ, *Vt = L + 2 * MSZ, *Sm = L + 3 * MSZ, *vec = L + 4 * MSZ;
    float *mrow = vec, *lrow = vec + 64, *arow = vec + 128, *rpbs = vec + 192;
    const float* cols = c.ws<float>(d.w_cols); bf16_t* br = c.ws<bf16_t>(d.w_br);
    const int rows = d.Tl / GRIDW, kr = rows < 8 ? rows : 8; int rs = qb - kr / 2; rs = rs < 0 ? 0 : (rs > rows - kr ? rows - kr : rs);
    const int ntile = pass ? kr + PAST / 64 : d.Tc / 64;
    __syncthreads();
    _Pragma("unroll 2") for (int i = tid; i < 4096; i += NTHREADS) { const int j = i >> 6, dd = i & 63; const size_t tok = tok0 + qb * 64 + j; const float* rp = cols + tok * NCF + h * 64;
        Q[j * S65 + dd] = rp[CB_NQ * 256 + dd] * 0.125f;
        if (!pass) { const size_t o = ((((size_t)b * DEPTH + l) * NH + h) * d.Tc + qb * 64 + j) * HD + dd; c.p->out[d.o_nk + o] = rp[CB_NK * 256 + dd]; c.p->out[d.o_nv + o] = rp[CB_NV * 256 + dd]; } }
    if (tid < 64) { mrow[tid] = -1.0e30f; lrow[tid] = 0.0f; }
    if (pass) for (int i = tid; i < 15 * 31; i += NTHREADS) rpbs[i] = c.in(I_RPB)[((size_t)l * NH + h) * 15 * 31 + i];
    f32x16 oacc = zero16();
    const int ti = (wave >> 1) & 1, tj = wave & 1;
    for (int kt = 0; kt < ntile; ++kt) {
        const bool local = pass && kt < kr; const int krow = rs + kt;
        __syncthreads();
        _Pragma("unroll 2") for (int i = tid; i < 4096; i += NTHREADS) { const int j = i >> 6, dd = i & 63; float kv, vv;
            if (!pass) { const float* rp = cols + (tok0 + kt * 64 + j) * NCF + h * 64; kv = rp[CB_NK * 256 + dd]; vv = rp[CB_NV * 256 + dd]; }
            else if (local) { const float* rp = cols + (tok0 + krow * 64 + j) * NCF + h * 64; kv = rp[CB_NK * 256 + dd]; vv = rp[CB_NV * 256 + dd]; }
            else { const size_t o = ((((size_t)b * DEPTH + l) * NH + h) * PAST + (kt - kr) * 64 + j) * HD + dd; kv = c.in(I_CK)[o]; vv = c.in(I_CV)[o]; }
            Kt[j * S65 + dd] = kv; Vt[j * S65 + dd] = vv; }
        __syncthreads();
        if (wave < 4) { f32x16 acc = zero16(); acc = mm32(lane, acc, Q + ti * 32 * S65, S65, 1, Kt + tj * 32 * S65, 1, S65, 64);
            UNR for (int r = 0; r < 16; ++r) { const int qi = ti * 32 + ACC_ROW(r, lane), kj = tj * 32 + (lane & 31); float s = acc[r];
                if (local) { int cs = qi - 8; cs = cs < 0 ? 0 : (cs > 48 ? 48 : cs); s = (kj >= cs && kj < cs + 16) ? s + rpbs[(krow - qb + 7) * 31 + (kj - qi + 15)] : -1.0e30f; }
                Sm[qi * S65 + kj] = s; } }
        __syncthreads();
        { const int t = tid >> 3, g = tid & 7; float mx = -1.0e30f; for (int s = g * 8; s < g * 8 + 8; ++s) mx = fmaxf(mx, Sm[t * S65 + s]);
          mx = fmaxf(mx, x1(mx)); mx = fmaxf(mx, x2(mx)); mx = fmaxf(mx, x4m(mx));
          const float mo = mrow[t], mn = fmaxf(mo, mx); float sum = 0.0f;
          for (int s = g * 8; s < g * 8 + 8; ++s) { const float sv = Sm[t * S65 + s]; const float p = sv <= -1.0e29f ? 0.0f : fexp(sv - mn); Sm[t * S65 + s] = p; sum += p; }
          sum += x1(sum); sum += x2(sum); sum += x4m(sum);
          const float al = fexp(mo - mn);
          __syncthreads();
          if (g == 0) { mrow[t] = mn; lrow[t] = lrow[t] * al + sum; arow[t] = al; } }
        __syncthreads();
        if (wave < 4) { UNR for (int r = 0; r < 16; ++r) oacc[r] *= arow[ti * 32 + ACC_ROW(r, lane)];
            oacc = mm32(lane, oacc, Sm + ti * 32 * S65, S65, 1, Vt + tj * 32, S65, 1, 64); }
    }
    __syncthreads();
    if (wave < 4) UNR for (int r = 0; r < 16; ++r) { const int qi = ti * 32 + ACC_ROW(r, lane); Sm[qi * S65 + tj * 32 + (lane & 31)] = oacc[r] / lrow[qi]; }
    __syncthreads();
    { const int j = tid >> 3, g = tid & 7; const size_t tok = tok0 + qb * 64 + j; const float* sp = Sm + j * S65 + g * 8; bf16_t* bp = br + tok * D + 3 * MIXW + h * 64 + g * 8;
      u32x4 w; w.x = pk2(sp[0], sp[1]); w.y = pk2(sp[2], sp[3]); w.z = pk2(sp[4], sp[5]); w.w = pk2(sp[6], sp[7]); *(u32x4*)bp = w; }
    __syncthreads();
}

__device__ __forceinline__ void phase_mixers(const Ctx& c0, int l, int rep) {
    const Ctx c = fresh(c0);
    const Dims& d = c.d; const int rows = d.Tl / GRIDW;
    const int nL = d.Bl * NH, nC = d.Bc * NH, nNAl = nL * rows, nq = d.Tc / 64, nNAc = nC * nq, nR = 2 * (nL + nC);
    const int e0 = nR, e1 = e0 + nR, e2 = e1 + nR, e3 = e2 + nNAl + nNAc;
    unsigned* qctr = c.ws<unsigned>(c.d.w_ctl) + CW_QUEUE + 64 * (l + DEPTH * rep);
    int* slot = (int*)(c.lds + 163840 - 128);
#ifndef MIX_MASK
#define MIX_MASK 15
#endif
#ifndef MIX_DUP
#define MIX_DUP 15
#endif
#define MIX_FETCH() do { __syncthreads(); if (c.tid == 0) *slot = (int)atomicAdd(qctr, 1u); __syncthreads(); it = __builtin_amdgcn_readfirstlane(*slot); } while (0)
    int it; MIX_FETCH();
    while (it < e0) { const int r = it, ps = r < 2 * nL ? 1 : 0, q = ps ? r : r - 2 * nL; if ((MIX_MASK & 1) && (rep == 0 || (MIX_DUP & 1))) mix_rwkv(c, l, opqs(__builtin_amdgcn_readfirstlane(ps)), (q >> 1) / NH, (q >> 1) % NH, q & 1); MIX_FETCH(); }
    while (it < e1) { const int r = it - e0, ps = r < 2 * nL ? 1 : 0, q = ps ? r : r - 2 * nL; if ((MIX_MASK & 2) && (rep == 0 || (MIX_DUP & 2))) mix_mlstm(c, l, opqs(__builtin_amdgcn_readfirstlane(ps)), (q >> 1) / NH, (q >> 1) % NH, q & 1); MIX_FETCH(); }
    while (it < e2) { const int r = it - e1, ps = r < 2 * nL ? 1 : 0, q = ps ? r : r - 2 * nL; if ((MIX_MASK & 4) && (rep == 0 || (MIX_DUP & 4))) mix_gla(c, l, opqs(__builtin_amdgcn_readfirstlane(ps)), (q >> 1) / NH, (q >> 1) % NH, q & 1); MIX_FETCH(); }
    while (it < e3) { const int r = it - e2, ps = r < nNAl ? 1 : 0, q = ps ? r : r - nNAl, nr = ps ? rows : nq; if ((MIX_MASK & 8) && (rep == 0 || (MIX_DUP & 8))) mix_na(c, l, opqs(__builtin_amdgcn_readfirstlane(ps)), q / (NH * nr), (q / nr) % NH, q % nr); MIX_FETCH(); }
#undef MIX_FETCH
}

__device__ __forceinline__ void phase_ln1(const Ctx& c0, int l) {
    const Ctx c = fresh(c0);
    const Dims& d = c.d; const float* mods = c.mods(l); const float* v = c.ws<float>(d.w_v); bf16_t* hb = c.ws<bf16_t>(d.w_hb); float* aff = c.ws<float>(d.w_aff);
    const float* lg = c.in(I_LNG) + ((size_t)l * 2 + 0) * D; const float* lb = c.in(I_LNB) + ((size_t)l * 2 + 0) * D;
    float* WR = (float*)c.lds;
    for (int i = c.tid; i < D * NEXP; i += NTHREADS) WR[i] = c.in(I_WROUTER)[(size_t)l * D * NEXP + (i & (D - 1)) * NEXP + (i >> 10)];
    __syncthreads();
    const int gw = c.vcu * NWAVES + c.wave, NGW = c.G * NWAVES;
    for (int tok = gw; tok < d.NT; tok += NGW) {
        const float* mr = mods + (size_t)c.modrow(tok) * NMOD; f32x4 x[4]; float s = 0.0f;
#pragma unroll
        for (int j = 0; j < 4; ++j) { x[j] = *(const f32x4*)(v + (size_t)tok * D + 4 * c.lane + 256 * j); s += (x[j][0] + x[j][1]) + (x[j][2] + x[j][3]); }
        const float mean = wave_sum(s) * (1.0f / D); float q = 0.0f;
#pragma unroll
        for (int j = 0; j < 4; ++j) { x[j] = x[j] - mean; q += (x[j][0] * x[j][0] + x[j][1] * x[j][1]) + (x[j][2] * x[j][2] + x[j][3] * x[j][3]); }
        const float rstd = frsq(wave_sum(q) * (1.0f / D) + LN_EPS);
        f32x4 hh[4];
#pragma unroll
        for (int j = 0; j < 4; ++j) { const int col = 4 * c.lane + 256 * j; const f32x4 g = *(const f32x4*)(lg + col), bb = *(const f32x4*)(lb + col);
            const f32x4 x1 = x[j] * rstd * g + bb; *(f32x4*)(c.X() + (size_t)tok * D + col) = x1;
            const f32x4 sh = *(const f32x4*)(mr + 3 * D + col), sc = *(const f32x4*)(mr + 4 * D + col); hh[j] = x1 * (1.0f + sc) + sh;
            u32x2 w; w.x = pk2(hh[j][0], hh[j][1]); w.y = pk2(hh[j][2], hh[j][3]); *(u32x2*)(hb + (size_t)tok * D + col) = w; }
        float lg16[16];
#pragma unroll
        for (int e = 0; e < 16; ++e) { float a = 0.0f;
#pragma unroll
            for (int j = 0; j < 4; ++j) { const f32x4 wv = *(const f32x4*)(WR + e * D + 4 * c.lane + 256 * j); a += (hh[j][0] * wv[0] + hh[j][1] * wv[1]) + (hh[j][2] * wv[2] + hh[j][3] * wv[3]); }
            lg16[e] = a;
#ifndef CPU_EMU
            asm volatile("" ::: "memory");
#endif
        }
        float mx = -3.0e38f;
#pragma unroll
        for (int e = 0; e < 16; ++e) { lg16[e] = wave_sum(lg16[e]); mx = fmaxf(mx, lg16[e]); }
        float se = 0.0f;
#pragma unroll
        for (int e = 0; e < 16; ++e) { lg16[e] = expf(lg16[e] - mx); se += lg16[e]; }
        const float inv = 1.0f / se; float mine = 0.0f;
#pragma unroll
        for (int e = 0; e < 16; ++e) mine = (c.lane == e) ? lg16[e] * inv : mine;
        if (c.lane < 16) aff[(size_t)tok * NEXP + c.lane] = mine;
    }
}

__device__ __forceinline__ void phase_select(const Ctx& c0) {
    const Ctx c = fresh(c0);
    const Dims& d = c.d; const float* aff = c.ws<float>(d.w_aff); int* inv = c.ws<int>(d.w_inv); float* pgate = c.ws<float>(d.w_pgate);
    const bf16_t* hb = c.ws<bf16_t>(d.w_hb); bf16_t* xe = c.ws<bf16_t>(d.w_xe);
    float* A = (float*)c.lds; int* sel = (int*)(A + 1024);
    const int nitems = (d.Bc + d.Bl) * NEXP;
    for (int it = c.vcu; it < nitems; it += c.G) {
        const int e = it % NEXP, bb = it / NEXP, pass = bb >= d.Bc, b = pass ? bb - d.Bc : bb, T = pass ? d.Tl : d.Tc, cap = pass ? d.capl : d.capc;
        const int tok0 = pass ? d.NTc + b * d.Tl : b * d.Tc, row0 = e * d.RPE + (pass ? d.Bc * d.capc + b * d.capl : b * d.capc);
        __syncthreads();
        for (int t = c.tid; t < T; t += NTHREADS) A[t] = aff[(size_t)(tok0 + t) * NEXP + e];
        __syncthreads();
        for (int t = c.tid; t < T; t += NTHREADS) { const float a = A[t]; int rank = 0;
            for (int s = 0; s < T; ++s) { const float o = A[s]; rank += (o > a || (o == a && s < t)) ? 1 : 0; }
            if (rank < cap) { sel[rank] = t; pgate[row0 + rank] = a; inv[(size_t)(tok0 + t) * NEXP + e] = row0 + rank; } else inv[(size_t)(tok0 + t) * NEXP + e] = -1; }
        __syncthreads();
        for (int r0 = c.wave * 4; r0 < cap; r0 += NWAVES * 4) {
            u32x4 v[4][2];
            UNR for (int u = 0; u < 4; ++u) { const int r = r0 + u < cap ? r0 + u : cap - 1; const u32x4* src = (const u32x4*)(hb + (size_t)(tok0 + sel[r]) * D); v[u][0] = src[c.lane]; v[u][1] = src[c.lane + 64]; }
            UNR for (int u = 0; u < 4; ++u) { if (r0 + u < cap) { u32x4* dst = (u32x4*)(xe + (size_t)(row0 + r0 + u) * D); dst[c.lane] = v[u][0]; dst[c.lane + 64] = v[u][1]; } }
        }
    }
}

__device__ __forceinline__ void phase_ln2(const Ctx& c0, int l) {
    const Ctx c = fresh(c0);
    const Dims& d = c.d; const float* mods = c.mods(l); const float* y = c.ws<float>(d.w_y); const int* inv = c.ws<int>(d.w_inv); bf16_t* hb = c.ws<bf16_t>(d.w_hb);
    const float* lg = c.in(I_LNG) + ((size_t)l * 2 + 1) * D; const float* lb = c.in(I_LNB) + ((size_t)l * 2 + 1) * D;
    const float* modn = (l + 1 < DEPTH) ? c.mods(l + 1) : nullptr;
    const int gw = c.vcu * NWAVES + c.wave, NGW = c.G * NWAVES;
    for (int tok = gw; tok < d.NT; tok += NGW) {
        const int mrow = c.modrow(tok); const float* mr = mods + (size_t)mrow * NMOD; f32x4 ff[4];
#pragma unroll
        for (int j = 0; j < 4; ++j) ff[j] = (f32x4){0.f, 0.f, 0.f, 0.f};
        for (int e = 0; e < NEXP; ++e) { const int row = inv[(size_t)tok * NEXP + e]; if (row >= 0) {
#pragma unroll
            for (int j = 0; j < 4; ++j) ff[j] += *(const f32x4*)(y + (size_t)row * D + 4 * c.lane + 256 * j); } }
        f32x4 x[4]; float s = 0.0f;
#pragma unroll
        for (int j = 0; j < 4; ++j) { const int col = 4 * c.lane + 256 * j; const f32x4 x1 = *(const f32x4*)(c.X() + (size_t)tok * D + col), g2 = *(const f32x4*)(mr + 5 * D + col);
            x[j] = ALPHA * x1 + g2 * ff[j]; s += (x[j][0] + x[j][1]) + (x[j][2] + x[j][3]); }
        const float mean = wave_sum(s) * (1.0f / D); float q = 0.0f;
#pragma unroll
        for (int j = 0; j < 4; ++j) { x[j] = x[j] - mean; q += (x[j][0] * x[j][0] + x[j][1] * x[j][1]) + (x[j][2] * x[j][2] + x[j][3] * x[j][3]); }
        const float rstd = frsq(wave_sum(q) * (1.0f / D) + LN_EPS);
#pragma unroll
        for (int j = 0; j < 4; ++j) { const int col = 4 * c.lane + 256 * j; const f32x4 g = *(const f32x4*)(lg + col), bb = *(const f32x4*)(lb + col);
            const f32x4 x2 = x[j] * rstd * g + bb; *(f32x4*)(c.X() + (size_t)tok * D + col) = x2;
            if (modn) { const float* mn = modn + (size_t)mrow * NMOD; const f32x4 sh = *(const f32x4*)(mn + col), sc = *(const f32x4*)(mn + D + col); const f32x4 hh = x2 * (1.0f + sc) + sh;
                u32x2 w; w.x = pk2(hh[0], hh[1]); w.y = pk2(hh[2], hh[3]); *(u32x2*)(hb + (size_t)tok * D + col) = w; } }
    }
}

constexpr int N_PHASES = 2 + 10 * DEPTH;
__device__ __forceinline__ void run_phase(const Ctx& c0, int ph, int rep) {
    const Ctx c = fresh(c0); const Dims& d = c.d;
#ifndef PHASE_MASK
#define PHASE_MASK 0xFFFF
#endif
    if (ph == 0) { if (PHASE_MASK & 0x400) phase_prep(c); return; }
    if (ph == 1) { if (PHASE_MASK & 0x800) phase_init(c); return; }
    const int l = (ph - 2) / 10, s = (ph - 2) % 10;
    LAS unsigned char* ldsp = (LAS unsigned char*)c.lds;
    if (!((PHASE_MASK >> s) & 1)) return;
    switch (s) {
    case 0: { pg8::Gemm g{c.ws<bf16_t>(d.w_hb), c.ws<bf16_t>(d.w_win) + (size_t)l * NINP * D, D}; pg8::StaticOrder S; S.init(d.NT, NINP, c.G, (int)blockIdx.x);
              EpiCols E{c.ws<float>(d.w_cols), c.ws<unsigned short>(d.w_gates)}; pg8::gemm_phase<EpiCols, pg8::StaticOrder>(ldsp, g, S, E); } break;
    case 1: phase_mixers(c, l, rep); break;
    case 2: phase_combine(c, l); break;
    case 3: { pg8::Gemm g{c.ws<bf16_t>(d.w_br), c.ws<bf16_t>(d.w_wbr) + (size_t)l * D * D, D}; pg8::StaticOrder S; S.init(d.NT, D, c.G, (int)blockIdx.x);
              EpiWiden E{c.ws<unsigned short>(d.w_gates), c.ws<bf16_t>(d.w_merged)}; pg8::gemm_phase<EpiWiden, pg8::StaticOrder>(ldsp, g, S, E); } break;
    case 4: { pg8::Gemm g{c.ws<bf16_t>(d.w_merged), c.ws<bf16_t>(d.w_wout) + (size_t)l * D * D, D}; pg8::StaticOrder S; S.init(d.NT, D, c.G, (int)blockIdx.x);
              EpiPreLN E{c.X(), c.mods(l), c.ws<float>(d.w_v), d.NTc, d.Tl}; pg8::gemm_phase<EpiPreLN, pg8::StaticOrder>(ldsp, g, S, E); } break;
    case 5: phase_ln1(c, l); break;
    case 6: phase_select(c); break;
    case 7: { pg8::Gemm g{c.ws<bf16_t>(d.w_xe), c.ws<bf16_t>(d.w_wup) + (size_t)l * NEXP * 2 * FF * D, D}; pg8::GroupOrder S; S.init(d.TPE, 2 * FF / 256, NEXP, c.G, c.vcu);
              EpiSwiGLU E{c.ws<bf16_t>(d.w_act)}; pg8::gemm_phase<EpiSwiGLU, pg8::GroupOrder>(ldsp, g, S, E); } break;
    case 8: { pg8::Gemm g{c.ws<bf16_t>(d.w_act), c.ws<bf16_t>(d.w_wdn) + (size_t)l * NEXP * D * FF, FF}; pg8::GroupOrder S; S.init(d.TPE, D / 256, NEXP, c.G, c.vcu);
              EpiDown E{c.ws<float>(d.w_pgate), c.ws<float>(d.w_y)}; pg8::gemm_phase<EpiDown, pg8::GroupOrder>(ldsp, g, S, E); } break;
    default: phase_ln2(c, l); break;
    }
}

#ifndef CPU_EMU
#define XB_TMO      128
#define XB_XCNT(j)  (256  + 64 * (j))
#define XB_XSUB(j)  (1280 + 64 * (j))
#define XB_XGEN(j)  (2304 + 64 * (j))
#define XB_TOP      3328
#define XB_TOPGEN   3392
#define XB_SPIN_CAP (1u << 20)
__device__ __forceinline__ unsigned xb_ld(unsigned* p)              { return __hip_atomic_load(p, __ATOMIC_RELAXED, __HIP_MEMORY_SCOPE_AGENT); }
__device__ __forceinline__ unsigned xb_add(unsigned* p, unsigned v) { return __hip_atomic_fetch_add(p, v, __ATOMIC_RELAXED, __HIP_MEMORY_SCOPE_AGENT); }
__device__ __forceinline__ unsigned xb_xcc_id() { return (unsigned)__builtin_amdgcn_s_getreg((3 << 11) | 20) & 0xFu; }
#define XB_SPIN(cond, bar) do { unsigned _sp = 0; while (cond) { __builtin_amdgcn_s_sleep(1); \
    if ((++_sp & 255u) == 0u) { if (xb_ld(&(bar)[XB_TMO])) break; if (_sp > XB_SPIN_CAP) { atomicAdd(&(bar)[XB_TMO], 1u); break; } } } } while (0)
struct XcdBarrier { unsigned* bar; unsigned x; volatile LAS unsigned* st; };
__device__ __forceinline__ XcdBarrier xcd_barrier_post(unsigned* bar, volatile LAS unsigned* st) {
    XcdBarrier b; b.bar = bar; b.x = xb_xcc_id(); b.st = st;
    if (threadIdx.x == 0) (void)xb_add(&bar[XB_XCNT(b.x)], 1u);
    return b;
}
__device__ __forceinline__ void xcd_barrier_complete(unsigned* bar, unsigned x, unsigned& nloc, unsigned& nx) {
    const unsigned G = gridDim.x * gridDim.y * gridDim.z;
    unsigned sum, cnt, mine, sp = 0u;
    for (;;) {
        sum = 0u; cnt = 0u; mine = 0u;
#pragma unroll
        for (unsigned j = 0; j < 16; ++j) { const unsigned cc = xb_ld(&bar[XB_XCNT(j)]); sum += cc; cnt += (cc > 0u) ? 1u : 0u; mine = (j == x) ? cc : mine; }
        if (sum == G) break;
        __builtin_amdgcn_s_sleep(1);
        if ((++sp & 255u) == 0u) { if (xb_ld(&bar[XB_TMO])) break; if (sp > XB_SPIN_CAP) { atomicAdd(&bar[XB_TMO], 1u); break; } }
    }
    nloc = mine > 0u ? mine : 1u; nx = cnt > 0u ? cnt : 1u;
}
__device__ __forceinline__ void xcd_barrier(const XcdBarrier& b) {
    asm volatile("s_waitcnt vmcnt(0)" ::: "memory");
    __syncthreads();
    if (threadIdx.x == 0) {
        unsigned* bar = b.bar;
        __builtin_amdgcn_s_waitcnt(0);
        unsigned nloc = b.st[0], nx = b.st[1];
        if (nloc == 0u) { xcd_barrier_complete(bar, b.x, nloc, nx); b.st[0] = nloc; b.st[1] = nx; }
        const unsigned old = xb_add(&bar[XB_XSUB(b.x)], 1u);
        const unsigned gen = old / nloc;
        if (old + 1u == (gen + 1u) * nloc) {
            __builtin_amdgcn_fence(__ATOMIC_RELEASE, "agent");
            asm volatile("s_waitcnt vmcnt(0)" ::: "memory");
            const unsigned og = xb_add(&bar[XB_TOP], 1u);
            const unsigned tg = og / nx;
            if (og + 1u == (tg + 1u) * nx) xb_add(&bar[XB_TOPGEN], 1u);
            else XB_SPIN(xb_ld(&bar[XB_TOPGEN]) == tg, bar);
            __builtin_amdgcn_fence(__ATOMIC_ACQUIRE, "agent");
            xb_add(&bar[XB_XGEN(b.x)], 1u);
            asm volatile("s_waitcnt vmcnt(0)" ::: "memory");
        } else {
            XB_SPIN(xb_ld(&bar[XB_XGEN(b.x)]) == gen, bar);
            __builtin_amdgcn_fence(__ATOMIC_ACQUIRE, "agent");
            asm volatile("s_waitcnt vmcnt(0)" ::: "memory");
        }
    }
    __syncthreads();
}

#ifndef PROBE_DUP
#define PROBE_DUP 0
#endif
constexpr int LDS_BYTES = 163840;
__global__ void __launch_bounds__(NTHREADS, 2) trunk_fwd(Params p) {
    extern __shared__ __attribute__((aligned(16))) unsigned char lds[];
    Ctx c; c.p = &p; c.d = make_dims(p.Bc, p.Tc, p.Bl, p.Tl); c.lds = lds;
    c.tid = threadIdx.x; c.lane = c.tid & 63; c.wave = __builtin_amdgcn_readfirstlane(c.tid >> 6);
    c.G = gridDim.x; { const int bx = blockIdx.x; c.vcu = (c.G % 8 == 0) ? (bx % 8) * (c.G / 8) + bx / 8 : bx; }
    volatile LAS unsigned* st = (volatile LAS unsigned*)((LAS unsigned char*)lds + LDS_BYTES - 64);
    XcdBarrier bar; bar.bar = nullptr; bar.x = 0; bar.st = st;
    if (p.use_bar) { if (c.tid < 2) st[c.tid] = 0u; __syncthreads(); bar = xcd_barrier_post((unsigned*)(p.ws) + CW_BAR, st); }
    for (int ph = p.ph_lo; ph < p.ph_hi; ++ph) {
        run_phase(c, ph, 0);
#if PROBE_DUP
        { const int kind = ph == 0 ? 10 : (ph == 1 ? 11 : (ph - 2) % 10); if ((PROBE_DUP >> kind) & 1) { xcd_barrier(bar); run_phase(c, ph, 1); } }
#endif
        if (ph + 1 < p.ph_hi) xcd_barrier(bar);
    }
}

#ifndef N_LAUNCH_MODE
#define N_LAUNCH_MODE 1
#endif
extern "C" void kernel_launch(void* const* d_in, const int* in_sizes, int n_in, void* d_out, int out_size, void* d_ws, size_t ws_size, hipStream_t stream) {
    static int grid = 0;
    const Dims d = make_dims(32, 256, 8, 1024);
    if (grid == 0) {
        int dev = 0, cus = 0;
        if (n_in != N_INPUTS || (size_t)out_size != d.o_end || ws_size < ((size_t)d.w_end << 8)) { fprintf(stderr, "kernel_launch: unexpected sizes: n_in %d out %d ws %zu (need %zu / %zu)\n", n_in, out_size, ws_size, (size_t)d.o_end, (size_t)d.w_end << 8); grid = -1; return; }
        if (hipGetDevice(&dev) != hipSuccess || hipDeviceGetAttribute(&cus, hipDeviceAttributeMultiprocessorCount, dev) != hipSuccess) { grid = -1; return; }
        if (hipFuncSetAttribute((const void*)trunk_fwd, hipFuncAttributeMaxDynamicSharedMemorySize, LDS_BYTES) != hipSuccess) { fprintf(stderr, "kernel_launch: hipFuncSetAttribute failed\n"); grid = -1; return; }
        int per_cu = 0;
        if (hipOccupancyMaxActiveBlocksPerMultiprocessor(&per_cu, (const void*)trunk_fwd, NTHREADS, LDS_BYTES) != hipSuccess || per_cu < 1) fprintf(stderr, "kernel_launch: occupancy query says %d\n", per_cu);
        (void)hipGetLastError();
        grid = cus;
    }
    if (grid < 0) return;
    (void)hipMemsetAsync((char*)d_ws, 0, CTL_BYTES, stream);
    Params p{};
    for (int i = 0; i < N_INPUTS; ++i) p.in[i] = (const float*)d_in[i];
    p.out = (float*)d_out; p.ws = (unsigned char*)d_ws; p.Bc = 32; p.Tc = 256; p.Bl = 8; p.Tl = 1024;
#if N_LAUNCH_MODE == 1
    p.ph_lo = 0; p.ph_hi = N_PHASES; p.use_bar = 1;
    hipLaunchKernelGGL(trunk_fwd, dim3(grid), dim3(NTHREADS), LDS_BYTES, stream, p);
#else
    for (int ph = 0; ph < N_PHASES; ++ph) { p.ph_lo = ph; p.ph_hi = ph + 1; p.use_bar = 0; hipLaunchKernelGGL(trunk_fwd, dim3(grid), dim3(NTHREADS), LDS_BYTES, stream, p); }
#endif
}
#endif
```

```cpp
#ifndef CPU_EMU
#include <hip/hip_runtime.h>
#include <cstdio>
typedef float f32x16 __attribute__((ext_vector_type(16)));
typedef float f32x4 __attribute__((ext_vector_type(4)));
typedef float f32x2 __attribute__((ext_vector_type(2)));
typedef unsigned u32x4 __attribute__((ext_vector_type(4)));
typedef unsigned u32x2 __attribute__((ext_vector_type(2)));
#define LAS __attribute__((address_space(3)))
#define WAVE_SYNC() asm volatile("s_waitcnt lgkmcnt(0)" ::: "memory")
#else
#define LAS
#define WAVE_SYNC() emu::wave_sync()
#endif
#define UNR _Pragma("unroll")
typedef short bf16x8 __attribute__((ext_vector_type(8)));
typedef unsigned short bf16_t;

constexpr int D = 1024, NH = 4, HD = 64, MIXW = 256, NEXP = 16, FF = 2048, DEPTH = 2, PAST = 256, GRIDW = 64;
constexpr int NIN = 7920, NINP = 7936, NCF = 3840, NGATE = 4096, NMOD = 6 * D;
constexpr float ALPHA = 1.4142135623730951f, LN_EPS = 1e-5f;
constexpr int NTHREADS = 512, NWAVES = 8;
constexpr int CB_MQ = 0, CB_MK = 1, CB_MV = 2, CB_MO = 3, CB_GQ = 4, CB_GK = 5, CB_GV = 6, CB_GG = 7, CB_RR = 8, CB_RK = 9, CB_RV = 10, CB_NQ = 11, CB_NK = 12, CB_NV = 13;
constexpr int SM_MI = 3584, SM_MF = 3592, SM_GA = 3600, SM_RW = 3632, SM_RA = 3696, SM_RG = 3760;
enum { I_XP = 0, I_XS, I_SC, I_SN, I_SM, I_SG, I_SR, I_CK, I_CV, I_C, I_CCTX, I_WADA, I_BADA, I_WIN, I_BIG, I_BFG, I_WGLA, I_BGLA, I_SHIFT, I_W0, I_WW2, I_A0, I_WA2, I_WG2, I_KK, I_KA, I_RKK,
       I_RPB, I_WBR, I_WOUT, I_LNG, I_LNB, I_WROUTER, I_WUP, I_WDOWN, N_INPUTS };

__host__ __device__ __forceinline__ int win_col(int p) {
    if (p < 3584) { const int b = p >> 8, w = p & 255; const int base = b < 4 ? b * 256 : (b < 8 ? 1040 + (b - 4) * 256 : (b < 11 ? 2096 + (b - 8) * 256 : 3056 + (b - 11) * 256)); return base + w; }
    if (p < 3840) { const int s = p - 3584; return s < 16 ? 1024 + s : (s < 48 ? 2064 + (s - 16) : (s < 240 ? 2864 + (s - 48) : -1)); }
    return p - 16;
}

struct Params {
    const float* in[N_INPUTS];
    float* out; unsigned char* ws;
    int Bc, Tc, Bl, Tl;
    int ph_lo, ph_hi;
    int use_bar, pad;
};
struct Dims {
    int Bc, Tc, Bl, Tl, NTc, NTl, NT, capc, capl, RPE, TPE, NPR;
    unsigned o_yp, o_ys, o_C, o_n, o_m, o_g, o_r, o_nk, o_nv, o_end;
    unsigned w_ctl, w_win, w_wbr, w_wout, w_wup, w_wdn, w_mods, w_hb, w_cols, w_gates, w_br, w_scr, w_merged, w_v, w_aff, w_inv, w_pgate, w_xe, w_act, w_y, w_end;
};
constexpr size_t CTL_BYTES = 1u << 20;
constexpr int CW_BAR = 4096, CW_QUEUE = 1024;
__host__ __device__ __forceinline__ unsigned al256(size_t x) { return (unsigned)((x + 255) >> 8); }
__host__ __device__ __forceinline__ Dims make_dims(int Bc, int Tc, int Bl, int Tl) {
    Dims d; d.Bc = Bc; d.Tc = Tc; d.Bl = Bl; d.Tl = Tl; d.NTc = Bc * Tc; d.NTl = Bl * Tl; d.NT = d.NTc + d.NTl;
    d.capc = Tc / 8; d.capl = Tl / 8; d.RPE = ((Bc * d.capc + Bl * d.capl + 255) / 256) * 256; d.TPE = d.RPE / 256; d.NPR = NEXP * d.RPE;
    unsigned o = 0; d.o_yp = o; o += (unsigned)d.NTc * D; d.o_ys = o; o += (unsigned)d.NTl * D;
    d.o_C = o; o += (unsigned)Bc * DEPTH * 2 * NH * HD * HD; d.o_n = o; o += (unsigned)Bc * DEPTH * 2 * NH * HD; d.o_m = o; o += (unsigned)Bc * DEPTH * 2 * NH;
    d.o_g = o; o += (unsigned)Bc * DEPTH * 2 * NH * HD * HD; d.o_r = o; o += (unsigned)Bc * DEPTH * 2 * NH * HD * HD;
    d.o_nk = o; o += (unsigned)Bc * DEPTH * NH * Tc * HD; d.o_nv = o; o += (unsigned)Bc * DEPTH * NH * Tc * HD; d.o_end = o;
    unsigned w = 0; d.w_ctl = w; w += (unsigned)(CTL_BYTES >> 8);
    d.w_win = w; w += al256((size_t)DEPTH * NINP * D * 2); d.w_wbr = w; w += al256((size_t)DEPTH * D * D * 2); d.w_wout = w; w += al256((size_t)DEPTH * D * D * 2);
    d.w_wup = w; w += al256((size_t)DEPTH * NEXP * 2 * FF * D * 2); d.w_wdn = w; w += al256((size_t)DEPTH * NEXP * D * FF * 2);
    d.w_mods = w; w += al256((size_t)DEPTH * (1 + Bl) * NMOD * 4);
    d.w_hb = w; w += al256((size_t)d.NT * D * 2); d.w_cols = w; w += al256((size_t)d.NT * NCF * 4); d.w_gates = w; w += al256((size_t)d.NT * NGATE * 2);
    d.w_br = w; w += al256((size_t)d.NT * D * 2); d.w_scr = w; w += al256((size_t)d.NT * 7 * MIXW * 4); d.w_merged = w; w += al256((size_t)d.NT * D * 2);
    d.w_v = w; w += al256((size_t)d.NT * D * 4); d.w_aff = w; w += al256((size_t)d.NT * NEXP * 4); d.w_inv = w; w += al256((size_t)d.NT * NEXP * 4);
    d.w_pgate = w; w += al256((size_t)d.NPR * 4); d.w_xe = w; w += al256((size_t)d.NPR * D * 2); d.w_act = w; w += al256((size_t)d.NPR * FF * 2); d.w_y = w; w += al256((size_t)d.NPR * D * 4);
    d.w_end = w; return d;
}

__device__ __forceinline__ unsigned f2bf(float f) { unsigned u = __builtin_bit_cast(unsigned, f); return (u + 0x7fffu + ((u >> 16) & 1u)) >> 16; }
__device__ __forceinline__ unsigned pk2(float lo, float hi) { return f2bf(lo) | (f2bf(hi) << 16); }

#ifndef CPU_EMU
template <int CTRL> __device__ __forceinline__ float dppf(float v) { return __builtin_bit_cast(float, __builtin_amdgcn_update_dpp(0, __builtin_bit_cast(int, v), CTRL, 0xF, 0xF, true)); }
__device__ __forceinline__ float x1(float v) { return dppf<0xB1>(v); }
__device__ __forceinline__ float x2(float v) { return dppf<0x4E>(v); }
__device__ __forceinline__ float x4m(float v) { return dppf<0x141>(v); }
__device__ __forceinline__ float x8m(float v) { return dppf<0x140>(v); }
__device__ __forceinline__ float fexp(float x) { return __expf(x); }
__device__ __forceinline__ float flog(float x) { return __logf(x); }
__device__ __forceinline__ float frsq(float x) { return __builtin_amdgcn_rsqf(x); }
#else
inline float x1(float v) { return __shfl_xor(v, 1); }
inline float x2(float v) { return __shfl_xor(v, 2); }
inline float x4m(float v) { return __shfl_xor(v, 4); }
inline float x8m(float v) { return __shfl_xor(v, 8); }
inline float fexp(float x) { return expf(x); }
inline float flog(float x) { return logf(x); }
inline float frsq(float x) { return 1.0f / sqrtf(x); }
#endif
__device__ __forceinline__ float quad_sum(float v) { v += x1(v); v += x2(v); return v; }
__device__ __forceinline__ float oct_sum(float v) { v += x1(v); v += x2(v); v += x4m(v); return v; }
__device__ __forceinline__ float oct_max(float v) { v = fmaxf(v, x1(v)); v = fmaxf(v, x2(v)); v = fmaxf(v, x4m(v)); return v; }
__device__ __forceinline__ float sigmoidf_(float x) { return __builtin_amdgcn_rcpf(1.0f + fexp(-x)); }
__device__ __forceinline__ float logsigmoidf_(float x) { return fminf(x, 0.0f) - flog(1.0f + fexp(-fabsf(x))); }
__device__ __forceinline__ float softplusf_(float x) { return fmaxf(x, 0.0f) + flog(1.0f + fexp(-fabsf(x))); }
__device__ __forceinline__ float tanhf_(float x) { const float e = fexp(-2.0f * fabsf(x)); const float t = (1.0f - e) * __builtin_amdgcn_rcpf(1.0f + e); return x < 0.0f ? -t : t; }
__device__ __forceinline__ float siluf_(float x) { return x * __builtin_amdgcn_rcpf(1.0f + fexp(-x)); }
__device__ __forceinline__ float wave_sum(float v) {
    v += x1(v); v += x2(v); v += x4m(v); v += x8m(v); v += __shfl_xor(v, 16); v += __shfl_xor(v, 32);
    return v;
}
__device__ __forceinline__ unsigned pkh2(float a, float b) { const _Float16 x = (_Float16)a, y = (_Float16)b; return (unsigned)__builtin_bit_cast(unsigned short, x) | ((unsigned)__builtin_bit_cast(unsigned short, y) << 16); }
#ifndef CPU_EMU
__device__ __forceinline__ float frcp(float x) { return __builtin_amdgcn_rcpf(x); }
#else
inline float frcp(float x) { return 1.0f / x; }
#endif
__device__ __forceinline__ float h2f(unsigned short h) { return (float)__builtin_bit_cast(_Float16, h); }

#ifndef CPU_EMU
__device__ __forceinline__ int opqv(int x) { asm volatile("" : "+v"(x)); return x; }
__device__ __forceinline__ int opqs(int x) { asm volatile("" : "+s"(x)); return x; }
#else
inline int opqv(int x) { return x; }
inline int opqs(int x) { return x; }
#endif
namespace pg8 {
constexpr int BM = 256, BK = 64, HALF = 128, HTB = HALF * BK * 2, STAGE_BYTES = 8 * HTB, NXCD = 8, WGM = 8;
__host__ __device__ __forceinline__ int lds_byte(int r, int c) { const int st = (r >> 4) * 2 + (c >> 5), rr = r & 15, cc = c & 31, ob = rr * 64 + cc * 2; return st * 1024 + (ob ^ (((ob >> 9) & 1) << 5)); }
__host__ __device__ __forceinline__ void stage_rc(int b, int& R, int& C) { const int st = b / 1024, sb = b % 1024, swz = sb ^ (((sb >> 9) & 1) << 5); R = (st >> 1) * 16 + swz / 64; C = (st & 1) * 32 + (swz % 64) / 2; }
struct Unit { int pm, pn, ta, tb; };
struct Gemm { const bf16_t* A; const bf16_t* Bt; int K; };
struct StaticOrder {
    int nM, nN, nwg, G, c;
    __device__ __forceinline__ void init(int M, int N, int G_, int c_) { nM = M / BM; nN = N / BM; nwg = nM * nN; G = G_; c = c_; }
    __device__ __forceinline__ bool next(int i, Unit& u) const {
        const long L = (long)i * G + c; if (L >= nwg) return false;
        int wgid = (int)L; { const int q = nwg / NXCD, r = nwg % NXCD, xcd = wgid % NXCD, off = wgid / NXCD; wgid = (xcd < r ? xcd * (q + 1) : r * (q + 1) + (xcd - r) * q) + off; }
        const int nig = WGM * nN, gid = wgid / nig, fm = gid * WGM, gsz = (nM - fm) < WGM ? (nM - fm) : WGM;
        u.pm = fm + ((wgid % nig) % gsz); u.pn = (wgid % nig) / gsz; u.ta = u.pm; u.tb = u.pn; return true;
    }
};
struct GroupOrder {
    int tpe, nN, nE, G, c;
    __device__ __forceinline__ void init(int tpe_, int nN_, int nE_, int G_, int c_) { tpe = tpe_; nN = nN_; nE = nE_; G = G_; c = c_; }
    __device__ __forceinline__ bool next(int i, Unit& u) const {
        const long L = (long)i * G + c; if (L >= (long)nE * tpe * nN) return false;
        const int per = tpe * nN, e = (int)(L / per), r = (int)(L % per), pn = r / tpe, pm = r % tpe;
        u.ta = e * tpe + pm; u.tb = e * nN + pn; u.pm = u.ta; u.pn = pn; return true;
    }
};
#ifndef CPU_EMU
template <class Epi, class Sched>
__device__ __forceinline__ void gemm_phase(LAS unsigned char* lds, const Gemm g, const Sched& S, const Epi& E) {
    const int tid = opqv((int)threadIdx.x), wid = __builtin_amdgcn_readfirstlane(tid >> 6), lane = tid & 63, wr = wid >> 2, wc = wid & 3, fr = lane & 15, fq = lane >> 4;
    const int K = g.K, nt = K / BK;
    unsigned voffA[2];
#pragma unroll
    for (int i = 0; i < 2; ++i) { int R, C; stage_rc(tid * 16 + i * 8192, R, C); voffA[i] = (unsigned)(R * K + C) * 2u; }
    const size_t kstep = (size_t)(BK * 2), hstep = (size_t)HALF * K * 2, tstep = 2 * hstep;
    const unsigned ldsw = (unsigned)wid * 1024u;
    const int aoff = lds_byte(wr * 64 + fr, fq * 8), boff = lds_byte(wc * 32 + fr, fq * 8);
#define PG8_SA(b, h) (((b) * 2 + (h)) * HTB)
#define PG8_SB(b, h) ((4 + (b) * 2 + (h)) * HTB)
#define PG8_STAGE(bufoff, gbase) do { _Pragma("unroll") for (int _i = 0; _i < 2; ++_i) \
        __builtin_amdgcn_global_load_lds((const unsigned*)((const char*)(gbase) + voffA[_i]), (LAS unsigned*)(lds + (bufoff) + ldsw + _i * 8192), 16, 0, 0); } while (0)
#define PG8_LDA(dst, b, h) do { _Pragma("unroll") for (int m = 0; m < 4; ++m) _Pragma("unroll") for (int k = 0; k < 2; ++k) dst[m][k] = *(const LAS bf16x8*)(lds + PG8_SA(b, h) + aoff + m * 2048 + k * 1024); } while (0)
#define PG8_LDB(dst, b, h) do { _Pragma("unroll") for (int n = 0; n < 2; ++n) _Pragma("unroll") for (int k = 0; k < 2; ++k) dst[n][k] = *(const LAS bf16x8*)(lds + PG8_SB(b, h) + boff + n * 2048 + k * 1024); } while (0)
#define PG8_MMA(ai, bj, At, Bt) do { __builtin_amdgcn_s_setprio(1); _Pragma("unroll") for (int m = 0; m < 4; ++m) _Pragma("unroll") for (int n = 0; n < 2; ++n) _Pragma("unroll") for (int k = 0; k < 2; ++k) \
        acc[ai][bj][m][n] = __builtin_amdgcn_mfma_f32_16x16x32_bf16(Bt[n][k], At[m][k], acc[ai][bj][m][n], 0, 0, 0); __builtin_amdgcn_s_setprio(0); } while (0)
#define PG8_WAIT_V(n) asm volatile("s_waitcnt vmcnt(" #n ")" ::: "memory")
#define PG8_WAIT_L(n) asm volatile("s_waitcnt lgkmcnt(" #n ")" ::: "memory")
#define PG8_BAR __builtin_amdgcn_s_barrier()
#define PG8_SCHED __builtin_amdgcn_sched_barrier(0)
    Unit cur, nxt; int ui = 0;
    if (!S.next(0, cur)) return;
    f32x4 acc[2][2][4][2];
#pragma unroll
    for (int a = 0; a < 2; ++a)
#pragma unroll
        for (int b = 0; b < 2; ++b)
#pragma unroll
            for (int m = 0; m < 4; ++m)
#pragma unroll
                for (int n = 0; n < 2; ++n) acc[a][b][m][n] = (f32x4){0.f, 0.f, 0.f, 0.f};
    bf16x8 At[4][2], B0[2][2], B1[2][2];
    const char* cA = (const char*)g.A + (size_t)cur.ta * tstep; const char* cB = (const char*)g.Bt + (size_t)cur.tb * tstep;
    PG8_STAGE(PG8_SB(0, 0), cB); PG8_STAGE(PG8_SB(0, 1), cB + hstep); PG8_STAGE(PG8_SA(0, 0), cA); PG8_STAGE(PG8_SA(0, 1), cA + hstep);
    if (wr == 1) PG8_BAR;
    PG8_WAIT_V(2); PG8_BAR;
    PG8_STAGE(PG8_SB(1, 0), cB + kstep); PG8_STAGE(PG8_SA(1, 0), cA + kstep); PG8_STAGE(PG8_SB(1, 1), cB + hstep + kstep);
    PG8_WAIT_V(6); PG8_BAR;
    for (;;) {
        const bool has_next = S.next(ui + 1, nxt);
        const char* nA = has_next ? (const char*)g.A + (size_t)nxt.ta * tstep : cA; const char* nB = has_next ? (const char*)g.Bt + (size_t)nxt.tb * tstep : cB;
        for (int t = 0; t < nt; t += 2) {
            const bool last = (t == nt - 2);
            const char* a1 = cA + (size_t)(t + 1) * kstep;
            const char* a2 = last ? nA : cA + (size_t)(t + 2) * kstep; const char* b2 = last ? nB : cB + (size_t)(t + 2) * kstep;
            const char* a3 = a2 + kstep; const char* b3 = b2 + kstep;
            if constexpr (Epi::MID) { if (t != 0 && (t & 3) == 0) E.mid(acc, cur, t >> 2, wr, wc, fr, fq); }
            PG8_LDB(B0, 0, 0); PG8_LDB(B1, 0, 1); PG8_SCHED; PG8_LDA(At, 0, 0); PG8_STAGE(PG8_SA(1, 1), a1 + hstep);
            PG8_WAIT_V(8); PG8_WAIT_L(0); PG8_BAR; PG8_MMA(0, 0, At, B0); PG8_MMA(0, 1, At, B1); PG8_BAR; PG8_SCHED;
            PG8_LDA(At, 0, 1); PG8_STAGE(PG8_SB(0, 0), b2); PG8_STAGE(PG8_SB(0, 1), b2 + hstep); PG8_STAGE(PG8_SA(0, 0), a2);
            PG8_WAIT_V(8); PG8_WAIT_L(0); PG8_BAR; PG8_MMA(1, 0, At, B0); PG8_MMA(1, 1, At, B1); PG8_BAR; PG8_SCHED;
            PG8_LDB(B0, 1, 0); PG8_LDB(B1, 1, 1); PG8_SCHED; PG8_LDA(At, 1, 0); PG8_STAGE(PG8_SA(0, 1), a2 + hstep);
            PG8_WAIT_V(8); PG8_WAIT_L(0); PG8_BAR; PG8_MMA(0, 0, At, B0); PG8_MMA(0, 1, At, B1); PG8_BAR; PG8_SCHED;
            PG8_LDA(At, 1, 1); PG8_STAGE(PG8_SB(1, 0), b3); PG8_STAGE(PG8_SB(1, 1), b3 + hstep); PG8_STAGE(PG8_SA(1, 0), a3);
            PG8_WAIT_V(8); PG8_WAIT_L(0); PG8_BAR; PG8_MMA(1, 0, At, B0); PG8_MMA(1, 1, At, B1); PG8_BAR; PG8_SCHED;
        }
        if (wr == 0) PG8_BAR;
        E(acc, cur, wr, wc, fr, fq);
        if (!has_next) break;
#pragma unroll
        for (int a = 0; a < 2; ++a)
#pragma unroll
            for (int b = 0; b < 2; ++b)
#pragma unroll
                for (int m = 0; m < 4; ++m)
#pragma unroll
                    for (int n = 0; n < 2; ++n) acc[a][b][m][n] = (f32x4){0.f, 0.f, 0.f, 0.f};
        cur = nxt; cA = nA; cB = nB; ++ui;
        if (wr == 1) PG8_BAR;
    }
    PG8_WAIT_V(0);
    PG8_BAR;
#undef PG8_SA
#undef PG8_SB
#undef PG8_STAGE
#undef PG8_LDA
#undef PG8_LDB
#undef PG8_MMA
#undef PG8_WAIT_V
#undef PG8_WAIT_L
#undef PG8_BAR
#undef PG8_SCHED
}
#else
template <class Epi, class Sched> void gemm_phase(unsigned char* lds, const Gemm g, const Sched& S, const Epi& E);
#endif
}
typedef f32x4 AccT[2][2][4][2];

struct Ctx {
    const Params* p; Dims d; unsigned char* lds; int tid, lane, wave, G, vcu;
    template <class T> __device__ __forceinline__ T* ws(unsigned off) const { return (T*)(p->ws + ((size_t)off << 8)); }
    __device__ __forceinline__ const float* in(int i) const { return p->in[i]; }
    __device__ __forceinline__ int modrow(int tok) const { return tok < d.NTc ? 0 : 1 + (tok - d.NTc) / d.Tl; }
    __device__ __forceinline__ const float* mods(int l) const { return ws<float>(d.w_mods) + (size_t)l * (1 + d.Bl) * NMOD; }
    __device__ __forceinline__ float* X() const { return p->out; }
};

__device__ __forceinline__ Ctx fresh(const Ctx& c0) {
    Ctx c; c.p = c0.p; c.lds = c0.lds; c.tid = opqv(c0.tid); c.lane = c.tid & 63; c.wave = opqs(c0.wave); c.G = opqs(c0.G); c.vcu = opqs(c0.vcu);
    c.d = make_dims(opqs(c0.p->Bc), opqs(c0.p->Tc), opqs(c0.p->Bl), opqs(c0.p->Tl)); return c;
}

struct EpiCols {
    static constexpr bool MID = false;
    float* cols; unsigned short* gates;
    __device__ __forceinline__ void operator()(const AccT& acc, const pg8::Unit& u, int wr, int wc, int fr, int fq) const {
        const int row0 = u.pm * 256 + wr * 64 + fr;
        if (u.pn < 15) {
            const int col0 = u.pn * 256 + wc * 32 + 4 * fq;
#pragma unroll
            for (int ai = 0; ai < 2; ++ai)
#pragma unroll
                for (int m = 0; m < 4; ++m) { float* rp = cols + (size_t)(row0 + ai * 128 + m * 16) * NCF + col0;
#pragma unroll
                    for (int bj = 0; bj < 2; ++bj)
#pragma unroll
                        for (int n = 0; n < 2; ++n) *(f32x4*)(rp + bj * 128 + n * 16) = acc[ai][bj][m][n]; }
        } else {
            const int col0 = (u.pn - 15) * 256 + wc * 32 + 4 * fq;
#pragma unroll
            for (int ai = 0; ai < 2; ++ai)
#pragma unroll
                for (int m = 0; m < 4; ++m) { unsigned short* rp = gates + (size_t)(row0 + ai * 128 + m * 16) * NGATE + col0;
#pragma unroll
                    for (int bj = 0; bj < 2; ++bj)
#pragma unroll
                        for (int n = 0; n < 2; ++n) { const f32x4 a = acc[ai][bj][m][n]; u32x2 w;
                            w.x = pkh2(fmaxf(sigmoidf_(a[0]), 6.2e-5f), fmaxf(sigmoidf_(a[1]), 6.2e-5f)); w.y = pkh2(fmaxf(sigmoidf_(a[2]), 6.2e-5f), fmaxf(sigmoidf_(a[3]), 6.2e-5f));
                            *(u32x2*)(rp + bj * 128 + n * 16) = w; } }
        }
    }
};
struct EpiWiden {
    static constexpr bool MID = true;
    const unsigned short* gates; bf16_t* merged;
    __device__ __forceinline__ void mid(AccT& acc, const pg8::Unit& u, int z1, int wr, int wc, int fr, int fq) const {
        const int row0 = opqv(u.pm * 256 + wr * 64 + fr), col0 = opqv(u.pn * 256 + wc * 32 + 4 * fq);
#pragma unroll
        for (int ai = 0; ai < 2; ++ai)
#pragma unroll
            for (int m = 0; m < 4; ++m) { const unsigned short* rp = gates + (size_t)(row0 + ai * 128 + m * 16) * NGATE + col0;
#pragma unroll
                for (int bj = 0; bj < 2; ++bj)
#pragma unroll
                    for (int n = 0; n < 2; ++n) { const u32x2 a = *(const u32x2*)(rp + (z1 - 1) * 1024 + bj * 128 + n * 16), b = *(const u32x2*)(rp + z1 * 1024 + bj * 128 + n * 16);
                        f32x4 r; r[0] = h2f(a.x & 0xffff) * frcp(h2f(b.x & 0xffff)); r[1] = h2f(a.x >> 16) * frcp(h2f(b.x >> 16)); r[2] = h2f(a.y & 0xffff) * frcp(h2f(b.y & 0xffff)); r[3] = h2f(a.y >> 16) * frcp(h2f(b.y >> 16));
                        acc[ai][bj][m][n] *= r;
#ifndef CPU_EMU
                        asm volatile("" ::: "memory");
#endif
                    } }
    }
    __device__ __forceinline__ void operator()(const AccT& acc, const pg8::Unit& u, int wr, int wc, int fr, int fq) const {
        const int row0 = u.pm * 256 + wr * 64 + fr, col0 = u.pn * 256 + wc * 32 + 4 * fq;
#pragma unroll
        for (int ai = 0; ai < 2; ++ai)
#pragma unroll
            for (int m = 0; m < 4; ++m) { const size_t ro = (size_t)(row0 + ai * 128 + m * 16);
#pragma unroll
                for (int bj = 0; bj < 2; ++bj)
#pragma unroll
                    for (int n = 0; n < 2; ++n) { const u32x2 b = *(const u32x2*)(gates + ro * NGATE + 3 * 1024 + col0 + bj * 128 + n * 16); const f32x4 a = acc[ai][bj][m][n]; u32x2 w;
                        w.x = pk2(a[0] * h2f(b.x & 0xffff), a[1] * h2f(b.x >> 16)); w.y = pk2(a[2] * h2f(b.y & 0xffff), a[3] * h2f(b.y >> 16));
                        *(u32x2*)(merged + ro * D + col0 + bj * 128 + n * 16) = w; } }
    }
};
struct EpiPreLN {
    static constexpr bool MID = false;
    const float* x; const float* mods; float* v; int NTc, Tl;
    __device__ __forceinline__ void operator()(const AccT& acc, const pg8::Unit& u, int wr, int wc, int fr, int fq) const {
        const int row0 = u.pm * 256 + wr * 64 + fr, col0 = u.pn * 256 + wc * 32 + 4 * fq;
#pragma unroll
        for (int ai = 0; ai < 2; ++ai)
#pragma unroll
            for (int m = 0; m < 4; ++m) { const int row = row0 + ai * 128 + m * 16; const int mr = row < NTc ? 0 : 1 + (row - NTc) / Tl; const float* g1 = mods + (size_t)mr * NMOD + 2 * D + col0;
                const size_t ro = (size_t)row * D + col0;
#pragma unroll
                for (int bj = 0; bj < 2; ++bj)
#pragma unroll
                    for (int n = 0; n < 2; ++n) { const int o = bj * 128 + n * 16; const f32x4 xv = *(const f32x4*)(x + ro + o), gv = *(const f32x4*)(g1 + o);
                        *(f32x4*)(v + ro + o) = ALPHA * xv + gv * acc[ai][bj][m][n]; } }
    }
};
struct EpiSwiGLU {
    static constexpr bool MID = false;
    bf16_t* act;
    __device__ __forceinline__ void operator()(const AccT& acc, const pg8::Unit& u, int wr, int wc, int fr, int fq) const {
        const int row0 = u.pm * 256 + wr * 64 + fr, col0 = u.pn * 128 + wc * 32 + 4 * fq;
#pragma unroll
        for (int ai = 0; ai < 2; ++ai)
#pragma unroll
            for (int m = 0; m < 4; ++m) { bf16_t* rp = act + (size_t)(row0 + ai * 128 + m * 16) * FF + col0;
#pragma unroll
                for (int n = 0; n < 2; ++n) { const f32x4 a = acc[ai][0][m][n], b = acc[ai][1][m][n]; u32x2 w;
                    w.x = pk2(siluf_(a[0]) * b[0], siluf_(a[1]) * b[1]); w.y = pk2(siluf_(a[2]) * b[2], siluf_(a[3]) * b[3]); *(u32x2*)(rp + n * 16) = w; } }
    }
};
struct EpiDown {
    static constexpr bool MID = false;
    const float* pgate; float* y;
    __device__ __forceinline__ void operator()(const AccT& acc, const pg8::Unit& u, int wr, int wc, int fr, int fq) const {
        const int row0 = u.pm * 256 + wr * 64 + fr, col0 = u.pn * 256 + wc * 32 + 4 * fq;
#pragma unroll
        for (int ai = 0; ai < 2; ++ai)
#pragma unroll
            for (int m = 0; m < 4; ++m) { const int row = row0 + ai * 128 + m * 16; const float gt = pgate[row]; float* rp = y + (size_t)row * D + col0;
#pragma unroll
                for (int bj = 0; bj < 2; ++bj)
#pragma unroll
                    for (int n = 0; n < 2; ++n) *(f32x4*)(rp + bj * 128 + n * 16) = gt * acc[ai][bj][m][n]; }
    }
};

template <class ColMap>
__device__ __forceinline__ void tr_item(const float* src, int src_ld, const ColMap& cm, bf16_t* dst, int dst_ld, int dst_koff, int n0, int k0, float* scr, int lane) {
    const int r = lane >> 4, c4 = (lane & 15) * 4; const int sc = cm(n0 + c4);
    f32x4 v[16];
    UNR for (int i = 0; i < 16; ++i) v[i] = sc >= 0 ? *(const f32x4*)(src + (size_t)(k0 + i * 4 + r) * src_ld + sc) : (f32x4){0.f, 0.f, 0.f, 0.f};
    UNR for (int i = 0; i < 16; ++i) { float* p = scr + (i * 4 + r) * 65 + c4; p[0] = v[i][0]; p[1] = v[i][1]; p[2] = v[i][2]; p[3] = v[i][3]; }
    WAVE_SYNC();
    const int kc = lane & 7;
    UNR for (int j = 0; j < 8; ++j) { const int n = (lane >> 3) + 8 * j; const float* p = scr + (8 * kc) * 65 + n;
        u32x4 o; o.x = pk2(p[0 * 65], p[1 * 65]); o.y = pk2(p[2 * 65], p[3 * 65]); o.z = pk2(p[4 * 65], p[5 * 65]); o.w = pk2(p[6 * 65], p[7 * 65]);
        *(u32x4*)(dst + (size_t)(n0 + n) * dst_ld + dst_koff + k0 + 8 * kc) = o; }
    WAVE_SYNC();
}
struct CmId { __device__ __forceinline__ int operator()(int n) const { return n; } };
struct CmWin { __device__ __forceinline__ int operator()(int n) const { return win_col(n); } };
struct CmUp { __device__ __forceinline__ int operator()(int n) const { const int u = n >> 8, w = n & 255; return (w < 128 ? 0 : FF) + u * 128 + (w & 127); } };

__device__ __forceinline__ void phase_prep(const Ctx& c0) {
    const Ctx c = fresh(c0);
    const Dims& d = c.d;
    float* L = (float*)c.lds;
    const int nrow = 1 + d.Bl;
    const int gw = c.vcu * NWAVES + c.wave, NGW = c.G * NWAVES;
    const int nmod_items = DEPTH * (NMOD / 64);
    if (c.vcu < nmod_items) {
        const int l = c.vcu / (NMOD / 64), j = (c.vcu % (NMOD / 64)) * 64 + c.lane, kw = c.wave * 128;
        const float* w = c.in(I_WADA) + ((size_t)l * D + kw) * NMOD + j;
        float* cond = L + c.wave * 4160;
        for (int i = c.lane; i < 9 * 128; i += 64) { const int r = i >> 7, k = kw + (i & 127); const float v = r == 0 ? c.in(I_CCTX)[k] : (r < nrow ? c.in(I_C)[(size_t)(r - 1) * D + k] : 0.0f); cond[i] = siluf_(v); }
        WAVE_SYNC();
        float a[9];
        UNR for (int r = 0; r < 9; ++r) a[r] = 0.0f;
#pragma unroll 8
        for (int k = 0; k < 128; ++k) { const float wv = w[(size_t)k * NMOD]; UNR for (int r = 0; r < 9; ++r) a[r] += cond[r * 128 + k] * wv; }
        UNR for (int r = 0; r < 9; ++r) cond[1152 + r * 64 + c.lane] = a[r];
        __syncthreads();
        if (c.wave == 0) { const float bias = c.in(I_BADA)[(size_t)l * NMOD + j]; float* mo = c.ws<float>(d.w_mods) + (size_t)l * nrow * NMOD + j;
            UNR for (int r = 0; r < 9; ++r) { float t = bias; UNR for (int ww = 0; ww < 8; ++ww) t += L[ww * 4160 + 1152 + r * 64 + c.lane]; if (r < nrow) mo[(size_t)r * NMOD] = t; } }
        __syncthreads();
    }
    float* scr = L + c.wave * 4160;
    const int I_IN = (D / 64) * (NINP / 64), I_BR = 4 * (MIXW / 64) * (D / 64), I_OUT = (D / 64) * (D / 64), I_UP = NEXP * (D / 64) * (2 * FF / 64), I_DN = NEXP * (FF / 64) * (D / 64);
    const int PER_L = I_IN + I_BR + I_OUT + I_UP + I_DN;
    for (int it = gw; it < DEPTH * PER_L; it += NGW) {
        const int l = it / PER_L; int r = it % PER_L;
        if (r < I_IN) { const int nb = NINP / 64, kb = r / nb, n0 = (r % nb) * 64;
            tr_item(c.in(I_WIN) + (size_t)l * D * NIN, NIN, CmWin(), c.ws<bf16_t>(d.w_win) + (size_t)l * NINP * D, D, 0, n0, kb * 64, scr, c.lane); continue; } r -= I_IN;
        if (r < I_BR) { const int per = (MIXW / 64) * (D / 64), z = r / per, q = r % per, kb = q / (D / 64), n0 = (q % (D / 64)) * 64;
            tr_item(c.in(I_WBR) + ((size_t)l * 4 + z) * MIXW * D, D, CmId(), c.ws<bf16_t>(d.w_wbr) + (size_t)l * D * D, D, z * MIXW, n0, kb * 64, scr, c.lane); continue; } r -= I_BR;
        if (r < I_OUT) { const int kb = r / (D / 64), n0 = (r % (D / 64)) * 64;
            tr_item(c.in(I_WOUT) + (size_t)l * D * D, D, CmId(), c.ws<bf16_t>(d.w_wout) + (size_t)l * D * D, D, 0, n0, kb * 64, scr, c.lane); continue; } r -= I_OUT;
        if (r < I_UP) { const int per = (D / 64) * (2 * FF / 64), e = r / per, q = r % per, kb = q / (2 * FF / 64), n0 = (q % (2 * FF / 64)) * 64;
            tr_item(c.in(I_WUP) + ((size_t)l * NEXP + e) * D * 2 * FF, 2 * FF, CmUp(), c.ws<bf16_t>(d.w_wup) + ((size_t)l * NEXP + e) * 2 * FF * D, D, 0, n0, kb * 64, scr, c.lane); continue; } r -= I_UP;
        { const int per = (FF / 64) * (D / 64), e = r / per, q = r % per, kb = q / (D / 64), n0 = (q % (D / 64)) * 64;
            tr_item(c.in(I_WDOWN) + ((size_t)l * NEXP + e) * FF * D, D, CmId(), c.ws<bf16_t>(d.w_wdn) + ((size_t)l * NEXP + e) * D * FF, FF, 0, n0, kb * 64, scr, c.lane); }
    }
}

__device__ __forceinline__ void phase_init(const Ctx& c0) {
    const Ctx c = fresh(c0);
    const Dims& d = c.d; const float* mods = c.mods(0); bf16_t* hb = c.ws<bf16_t>(d.w_hb);
    const int gw = c.vcu * NWAVES + c.wave, NGW = c.G * NWAVES;
    for (int tok = gw; tok < d.NT; tok += NGW) {
        const float* xr = tok < d.NTc ? c.in(I_XP) + (size_t)tok * D : c.in(I_XS) + (size_t)(tok - d.NTc) * D;
        const float* mr = mods + (size_t)c.modrow(tok) * NMOD;
#pragma unroll
        for (int j = 0; j < 4; ++j) { const int col = 4 * c.lane + 256 * j; const f32x4 x = *(const f32x4*)(xr + col), sh = *(const f32x4*)(mr + col), sc = *(const f32x4*)(mr + D + col);
            *(f32x4*)(c.X() + (size_t)tok * D + col) = x; const f32x4 h = x * (1.0f + sc) + sh;
            u32x2 w; w.x = pk2(h[0], h[1]); w.y = pk2(h[2], h[3]); *(u32x2*)(hb + (size_t)tok * D + col) = w; }
    }
}

__device__ __forceinline__ f32x16 mm32(int lane, f32x16 acc, const float* A, int sai, int sak, const float* Bm, int sbk, int sbj, int K) {
    const int i = lane & 31, kk = lane >> 5;
    const float* ap = A + i * sai + kk * sak; const float* bp = Bm + kk * sbk + i * sbj;
#pragma unroll 8
    for (int k = 0; k < K; k += 2) acc = __builtin_amdgcn_mfma_f32_32x32x2f32(ap[k * sak], bp[k * sbk], acc, 0, 0, 0);
    return acc;
}
#define ACC_ROW(r, lane) (((r) & 3) + 8 * ((r) >> 2) + 4 * ((lane) >> 5))
__device__ __forceinline__ f32x16 zero16() { f32x16 z; UNR for (int r = 0; r < 16; ++r) z[r] = 0.0f; return z; }
constexpr int S65 = 65, MSZ = 64 * 65;

__device__ __forceinline__ void build_rope(float* cosT, float* sinT, int tid) {
    for (int i = tid; i < 1024; i += NTHREADS) { const int pos = i >> 4, f = i & 15; const float inv = powf(10000.0f, -(float)f / 16.0f); const float ang = (float)pos * inv; cosT[i] = cosf(ang); sinT[i] = sinf(ang); }
}
__device__ __forceinline__ float rope_elem(const float* rowp, int dd, int t, const float* cosT, const float* sinT) {
    const int f = dd & 15, second = (dd >> 4) & 1, pos = (dd < 32) ? (t / GRIDW) : (t % GRIDW);
    const float x = rowp[dd], xp = rowp[second ? dd - 16 : dd + 16], cs = cosT[pos * 16 + f], sn = sinT[pos * 16 + f];
    return second ? (xp * sn + x * cs) : (x * cs - xp * sn);
}

constexpr int SL_MF = 0, SL_MB = 1, SL_GF = 2, SL_GB = 3, SL_RF = 4, SL_RB = 5, SL_RBONUS = 6, NSLOT = 7;

struct ChunkRegs { float q1[4], q2[4], k1[4], k2[4], v1[4], v2[4]; };
__device__ __forceinline__ void chunk_load(ChunkRegs& R, const float* cols, size_t tok0, int T, int dir, int ci, int h, int cbq, int tid) {
    UNR for (int u = 0; u < 4; ++u) { const int ps = tid + NTHREADS * u, j = ps >> 5, pp = ps & 31, dd1 = (pp >> 4) * 32 + (pp & 15), t = dir ? T - 1 - (ci * 64 + j) : ci * 64 + j;
        const float* rp = cols + (tok0 + t) * NCF + h * 64 + dd1;
        R.q1[u] = rp[cbq * 256]; R.q2[u] = rp[cbq * 256 + 16]; R.k1[u] = rp[(cbq + 1) * 256]; R.k2[u] = rp[(cbq + 1) * 256 + 16]; R.v1[u] = rp[(cbq + 2) * 256]; R.v2[u] = rp[(cbq + 2) * 256 + 16]; }
}
__device__ __forceinline__ void chunk_store(const ChunkRegs& R, float* Q, float* K, float* V, int T, int dir, int ci, int pass, float qs, float ks, const float* cosT, const float* sinT, int tid) {
    UNR for (int u = 0; u < 4; ++u) { const int ps = tid + NTHREADS * u, j = ps >> 5, pp = ps & 31, dd1 = (pp >> 4) * 32 + (pp & 15), o = j * S65 + dd1;
        float q1 = R.q1[u], q2 = R.q2[u], k1 = R.k1[u], k2 = R.k2[u];
        if (pass) { const int t = dir ? T - 1 - (ci * 64 + j) : ci * 64 + j, pos = (pp >> 4) ? (t % GRIDW) : (t / GRIDW); const float cs = cosT[pos * 16 + (pp & 15)], sn = sinT[pos * 16 + (pp & 15)];
            const float a = q1 * cs - q2 * sn, b = q1 * sn + q2 * cs, cc = k1 * cs - k2 * sn, dd = k1 * sn + k2 * cs; q1 = a; q2 = b; k1 = cc; k2 = dd; }
        Q[o] = q1 * qs; Q[o + 16] = q2 * qs; K[o] = k1 * ks; K[o + 16] = k2 * ks; V[o] = R.v1[u]; V[o + 16] = R.v2[u]; }
}

__device__ __forceinline__ void mix_mlstm(const Ctx& c0, int l, int pass, int b, int h, int dir) {
    const Ctx c = fresh(c0);
    const Dims& d = c.d; const int T = pass ? d.Tl : d.Tc, nc = T / 64, tid = c.tid, lane = c.lane, wave = c.wave; const size_t tok0 = pass ? d.NTc + (size_t)b * d.Tl : (size_t)b * d.Tc;
    float* L = (float*)c.lds;
    float *Q = L, *K = L + MSZ, *V = L + 2 * MSZ, *C = L + 3 * MSZ, *Sm = L + 4 * MSZ, *QC = L + 5 * MSZ, *vec = L + 6 * MSZ;
    float *nv = vec, *ig = vec + 64, *lf = vec + 128, *bc = vec + 192, *lw = vec + 256, *wint = vec + 320, *rden = vec + 384, *scal = vec + 448, *npart = vec + 512, *cosT = vec + 1024, *sinT = vec + 2048;
    const float* cols = c.ws<float>(d.w_cols); float* scr = c.ws<float>(d.w_scr);
    __syncthreads();
    if (pass) build_rope(cosT, sinT, tid);
    if (pass) { const float* C0 = c.in(I_SC) + ((((size_t)b * DEPTH + l) * 2 + dir) * NH + h) * HD * HD;
        _Pragma("unroll 2") for (int i = tid; i < 4096; i += NTHREADS) C[(i >> 6) * S65 + (i & 63)] = C0[i];
        if (tid < 64) nv[tid] = c.in(I_SN)[((((size_t)b * DEPTH + l) * 2 + dir) * NH + h) * HD + tid];
        if (tid == 0) scal[0] = c.in(I_SM)[(((size_t)b * DEPTH + l) * 2 + dir) * NH + h];
    } else { _Pragma("unroll 2") for (int i = tid; i < 4096; i += NTHREADS) C[(i >> 6) * S65 + (i & 63)] = 0.0f; if (tid < 64) nv[tid] = 0.0f; if (tid == 0) scal[0] = 0.0f; }
    const float big = c.in(I_BIG)[((size_t)l * 2 + dir) * NH + h], bfg = c.in(I_BFG)[((size_t)l * 2 + dir) * NH + h];
    ChunkRegs R; float rig = 0.0f, rlf = 0.0f;
    chunk_load(R, cols, tok0, T, dir, 0, h, CB_MQ, tid);
    if (tid < 64) { const int t = dir ? T - 1 - tid : tid; const float* rp = cols + (tok0 + t) * NCF; rig = rp[SM_MI + dir * 4 + h]; rlf = rp[SM_MF + dir * 4 + h]; }
    __syncthreads();
    chunk_store(R, Q, K, V, T, dir, 0, pass, 1.0f, 0.125f, cosT, sinT, tid);
    if (tid < 64) { ig[tid] = rig + big; lf[tid] = logsigmoidf_(rlf + bfg); }
    for (int ci = 0; ci < nc; ++ci) {
        if (ci + 1 < nc) {
            chunk_load(R, cols, tok0, T, dir, ci + 1, h, CB_MQ, tid);
            if (tid < 64) { const int t = dir ? T - 1 - ((ci + 1) * 64 + tid) : (ci + 1) * 64 + tid; const float* rp = cols + (tok0 + t) * NCF; rig = rp[SM_MI + dir * 4 + h]; rlf = rp[SM_MF + dir * 4 + h]; }
        }
        __syncthreads();
        if (wave == 0) { float run = lf[lane];
            UNR for (int o = 1; o < 64; o <<= 1) { const float up = __shfl(run, lane >= o ? lane - o : lane); run += lane >= o ? up : 0.0f; }
            const float bend = __shfl(run, 63), m = scal[0], w = bend - run + ig[lane]; float mx = w;
            mx = fmaxf(mx, x1(mx)); mx = fmaxf(mx, x2(mx)); mx = fmaxf(mx, x4m(mx)); mx = fmaxf(mx, x8m(mx)); mx = fmaxf(mx, __shfl_xor(mx, 16)); mx = fmaxf(mx, __shfl_xor(mx, 32));
            const float mnew = fmaxf(bend + m, mx); bc[lane] = run; lw[lane] = w; if (lane == 0) { scal[1] = mnew; scal[2] = fexp(bend + m - mnew); } }
        { const int ti = (wave >> 1) & 1, tj = wave & 1; f32x16 acc = zero16();
          if (wave < 4) { acc = mm32(lane, acc, Q + ti * 32 * S65, S65, 1, K + tj * 32 * S65, 1, S65, 64); UNR for (int r = 0; r < 16; ++r) Sm[(ti * 32 + ACC_ROW(r, lane)) * S65 + tj * 32 + (lane & 31)] = acc[r]; }
          else { acc = mm32(lane, acc, Q + ti * 32 * S65, S65, 1, C + tj * 32, S65, 1, 64); UNR for (int r = 0; r < 16; ++r) QC[(ti * 32 + ACC_ROW(r, lane)) * S65 + tj * 32 + (lane & 31)] = acc[r]; } }
        __syncthreads();
        { const int t = tid >> 3, g = tid & 7; const float m = scal[0], mnew = scal[1], bt = bc[t]; float mx = -3.0e38f;
          UNR for (int e = 0; e < 8; ++e) { const int s = g * 8 + e; if (s <= t) mx = fmaxf(mx, bt - bc[s] + ig[s]); }
          mx = fmaxf(mx, x1(mx)); mx = fmaxf(mx, x2(mx)); mx = fmaxf(mx, x4m(mx));
          const float minter = bt + m, mt = fmaxf(minter, mx); float den = 0.0f, qn = 0.0f;
          UNR for (int e = 0; e < 8; ++e) { const int s = g * 8 + e; float sv = 0.0f; if (s <= t) sv = Sm[t * S65 + s] * fexp(bt - bc[s] + ig[s] - mt); Sm[t * S65 + s] = sv; den += sv; qn += Q[t * S65 + s] * nv[s]; }
          den += x1(den); den += x2(den); den += x4m(den); qn += x1(qn); qn += x2(qn); qn += x4m(qn);
          const float wi = fexp(minter - mt); den += wi * qn;
          if (g == 0) { wint[t] = wi; rden[t] = 1.0f / fmaxf(fabsf(den), fexp(-mt)); }
          const float ks = fexp(lw[t] - mnew); UNR for (int e = 0; e < 8; ++e) K[t * S65 + g * 8 + e] *= ks; }
        __syncthreads();
        { const int ti = (wave >> 1) & 1, tj = wave & 1;
          if (wave < 4) { f32x16 acc = zero16(); acc = mm32(lane, acc, Sm + ti * 32 * S65, S65, 1, V + tj * 32, S65, 1, 64);
              UNR for (int r = 0; r < 16; ++r) { const int row = ti * 32 + ACC_ROW(r, lane), o = row * S65 + tj * 32 + (lane & 31); QC[o] = (acc[r] + wint[row] * QC[o]) * rden[row]; } }
          else { const float carry = scal[2]; f32x16 acc; UNR for (int r = 0; r < 16; ++r) acc[r] = carry * C[(ti * 32 + ACC_ROW(r, lane)) * S65 + tj * 32 + (lane & 31)];
              acc = mm32(lane, acc, K + ti * 32, 1, S65, V + tj * 32, S65, 1, 64);
              UNR for (int r = 0; r < 16; ++r) C[(ti * 32 + ACC_ROW(r, lane)) * S65 + tj * 32 + (lane & 31)] = acc[r]; }
          float s = 0.0f; UNR for (int e = 0; e < 8; ++e) s += K[(wave * 8 + e) * S65 + lane]; npart[wave * 64 + lane] = s; }
        __syncthreads();
        if (tid < 64) { float s = 0.0f; UNR for (int e = 0; e < 8; ++e) s += npart[e * 64 + tid]; nv[tid] = scal[2] * nv[tid] + s; }
        { const int j = tid >> 3, g = tid & 7, t = dir ? T - 1 - (ci * 64 + j) : ci * 64 + j; float* sp = scr + ((tok0 + t) * NSLOT + (dir ? SL_MB : SL_MF)) * MIXW + h * 64 + g * 8; const float* hp = QC + j * S65 + g * 8;
          *(f32x4*)sp = (f32x4){hp[0], hp[1], hp[2], hp[3]}; *(f32x4*)(sp + 4) = (f32x4){hp[4], hp[5], hp[6], hp[7]}; }
        if (ci + 1 < nc) { chunk_store(R, Q, K, V, T, dir, ci + 1, pass, 1.0f, 0.125f, cosT, sinT, tid); if (tid < 64) { ig[tid] = rig + big; lf[tid] = logsigmoidf_(rlf + bfg); } }
        if (tid == 0) scal[0] = scal[1];
    }
    __syncthreads();
    if (!pass) {
        float* Co = c.p->out + d.o_C + ((((size_t)b * DEPTH + l) * 2 + dir) * NH + h) * HD * HD;
        _Pragma("unroll 2") for (int i = tid; i < 4096; i += NTHREADS) Co[i] = C[(i >> 6) * S65 + (i & 63)];
        if (tid < 64) c.p->out[d.o_n + ((((size_t)b * DEPTH + l) * 2 + dir) * NH + h) * HD + tid] = nv[tid];
        if (tid == 0) c.p->out[d.o_m + (((size_t)b * DEPTH + l) * 2 + dir) * NH + h] = scal[0];
    }
    __syncthreads();
}

__device__ __forceinline__ void mix_gla(const Ctx& c0, int l, int pass, int b, int h, int dir) {
    const Ctx c = fresh(c0);
    const Dims& d = c.d; const int T = pass ? d.Tl : d.Tc, nc = T / 64, tid = c.tid, lane = c.lane, wave = c.wave; const size_t tok0 = pass ? d.NTc + (size_t)b * d.Tl : (size_t)b * d.Tc;
    float* L = (float*)c.lds;
    float *Q = L, *K = L + MSZ, *V = L + 2 * MSZ, *S = L + 3 * MSZ, *Gm = L + 4 * MSZ, *O2 = L + 5 * MSZ, *vec = L + 6 * MSZ;
    float *gend = vec, *bA = vec + 64, *gpart = vec + 128, *GA = vec + 640, *wA = vec + 640 + 1024, *cosT = vec + 640 + 2048, *sinT = vec + 640 + 3072;
    const float* cols = c.ws<float>(d.w_cols); float* scr = c.ws<float>(d.w_scr);
    __syncthreads();
    if (pass) build_rope(cosT, sinT, tid);
    if (pass) { const float* S0 = c.in(I_SG) + ((((size_t)b * DEPTH + l) * 2 + dir) * NH + h) * HD * HD; _Pragma("unroll 2") for (int i = tid; i < 4096; i += NTHREADS) S[(i >> 6) * S65 + (i & 63)] = S0[i]; }
    else { _Pragma("unroll 2") for (int i = tid; i < 4096; i += NTHREADS) S[(i >> 6) * S65 + (i & 63)] = 0.0f; }
    for (int i = tid; i < 1024; i += NTHREADS) wA[i] = c.in(I_WGLA)[(((size_t)l * 2 + dir) * 16 + (i >> 6)) * MIXW + h * 64 + (i & 63)];
    if (tid < 64) bA[tid] = c.in(I_BGLA)[((size_t)l * 2 + dir) * MIXW + h * 64 + tid];
    ChunkRegs R; f32x4 rga = (f32x4){0.f, 0.f, 0.f, 0.f};
    chunk_load(R, cols, tok0, T, dir, 0, h, CB_GQ, tid);
    if (tid < 256) { const int j = tid >> 2, t = dir ? T - 1 - j : j; rga = *(const f32x4*)(cols + (tok0 + t) * NCF + SM_GA + dir * 16 + (tid & 3) * 4); }
    __syncthreads();
    chunk_store(R, Q, K, V, T, dir, 0, pass, 0.125f, 1.0f, cosT, sinT, tid);
    if (tid < 256) *(f32x4*)(GA + (tid >> 2) * 16 + (tid & 3) * 4) = rga;
    for (int ci = 0; ci < nc; ++ci) {
        if (ci + 1 < nc) {
            chunk_load(R, cols, tok0, T, dir, ci + 1, h, CB_GQ, tid);
            if (tid < 256) { const int j = tid >> 2, t = dir ? T - 1 - ((ci + 1) * 64 + j) : (ci + 1) * 64 + j; rga = *(const f32x4*)(cols + (tok0 + t) * NCF + SM_GA + dir * 16 + (tid & 3) * 4); }
        }
        __syncthreads();
        float gl[8];
        { float run = 0.0f;
          UNR for (int e = 0; e < 8; ++e) { const float* ga = GA + (wave * 8 + e) * 16; float a = bA[lane];
              UNR for (int r = 0; r < 16; ++r) a += ga[r] * wA[r * 64 + lane];
              run += logsigmoidf_(a) * (1.0f / 16.0f); gl[e] = run; }
          gpart[wave * 64 + lane] = run; }
        __syncthreads();
        { float pre = 0.0f; UNR for (int e = 0; e < 8; ++e) pre += (e < wave) ? gpart[e * 64 + lane] : 0.0f;
          UNR for (int e = 0; e < 8; ++e) { const float g = gl[e] + pre; const int o = (wave * 8 + e) * S65 + lane; Q[o] *= fexp(g); K[o] *= fexp(-g); if (wave == 7 && e == 7) gend[lane] = g; } }
        __syncthreads();
        { const int ti = (wave >> 1) & 1, tj = wave & 1; f32x16 acc = zero16();
          if (wave < 4) { acc = mm32(lane, acc, Q + ti * 32 * S65, S65, 1, K + tj * 32 * S65, 1, S65, 64);
              UNR for (int r = 0; r < 16; ++r) { const int row = ti * 32 + ACC_ROW(r, lane), col = tj * 32 + (lane & 31); Gm[row * S65 + col] = col <= row ? acc[r] : 0.0f; } }
          else { acc = mm32(lane, acc, Q + ti * 32 * S65, S65, 1, S + tj * 32, S65, 1, 64); UNR for (int r = 0; r < 16; ++r) O2[(ti * 32 + ACC_ROW(r, lane)) * S65 + tj * 32 + (lane & 31)] = acc[r]; } }
        __syncthreads();
        { const int ti = (wave >> 1) & 1, tj = wave & 1;
          if (wave < 4) { f32x16 acc; UNR for (int r = 0; r < 16; ++r) acc[r] = O2[(ti * 32 + ACC_ROW(r, lane)) * S65 + tj * 32 + (lane & 31)];
              acc = mm32(lane, acc, Gm + ti * 32 * S65, S65, 1, V + tj * 32, S65, 1, 64);
              UNR for (int r = 0; r < 16; ++r) O2[(ti * 32 + ACC_ROW(r, lane)) * S65 + tj * 32 + (lane & 31)] = acc[r]; }
          else { f32x16 acc; UNR for (int r = 0; r < 16; ++r) acc[r] = S[(ti * 32 + ACC_ROW(r, lane)) * S65 + tj * 32 + (lane & 31)];
              acc = mm32(lane, acc, K + ti * 32, 1, S65, V + tj * 32, S65, 1, 64);
              UNR for (int r = 0; r < 16; ++r) { const int row = ti * 32 + ACC_ROW(r, lane); S[row * S65 + tj * 32 + (lane & 31)] = fexp(gend[row]) * acc[r]; } } }
        __syncthreads();
        { const int j = tid >> 3, g = tid & 7, t = dir ? T - 1 - (ci * 64 + j) : ci * 64 + j; float* sp = scr + ((tok0 + t) * NSLOT + (dir ? SL_GB : SL_GF)) * MIXW + h * 64 + g * 8; const float* hp = O2 + j * S65 + g * 8;
          *(f32x4*)sp = (f32x4){hp[0], hp[1], hp[2], hp[3]}; *(f32x4*)(sp + 4) = (f32x4){hp[4], hp[5], hp[6], hp[7]}; }
        if (ci + 1 < nc) { chunk_store(R, Q, K, V, T, dir, ci + 1, pass, 0.125f, 1.0f, cosT, sinT, tid); if (tid < 256) *(f32x4*)(GA + (tid >> 2) * 16 + (tid & 3) * 4) = rga; }
    }
    __syncthreads();
    if (!pass) { float* So = c.p->out + d.o_g + ((((size_t)b * DEPTH + l) * 2 + dir) * NH + h) * HD * HD; _Pragma("unroll 2") for (int i = tid; i < 4096; i += NTHREADS) So[i] = S[(i >> 6) * S65 + (i & 63)]; }
    __syncthreads();
}

#define RW_LOAD(i_, R_, K_, W_, A_, H_, v_) do { const float* Pi_ = buf + (i_) * VST + q * 16; \
    UNR for (int u_ = 0; u_ < 4; ++u_) { R_[u_] = *(const f32x4*)(Pi_ + 4 * u_); K_[u_] = *(const f32x4*)(Pi_ + 64 + 4 * u_); W_[u_] = *(const f32x4*)(Pi_ + 192 + 4 * u_); \
        A_[u_] = *(const f32x4*)(Pi_ + 256 + 4 * u_); H_[u_] = *(const f32x4*)(Pi_ + 320 + 4 * u_); } v_ = buf[(i_) * VST + 128 + vrow]; } while (0)
#define RW_STEP(R_, K_, W_, A_, H_, v_) do { f32x4 d_ = Sv[0] * K_[0]; d_ += Sv[1] * K_[1]; d_ += Sv[2] * K_[2]; d_ += Sv[3] * K_[3]; \
    const float sk_ = quad_sum((d_[0] + d_[1]) + (d_[2] + d_[3])); f32x4 y_ = (f32x4){0.f, 0.f, 0.f, 0.f}; \
    UNR for (int u_ = 0; u_ < 4; ++u_) { Sv[u_] = Sv[u_] * W_[u_] - sk_ * A_[u_] + v_ * H_[u_]; y_ += Sv[u_] * R_[u_]; } \
    const float yy_ = quad_sum((y_[0] + y_[1]) + (y_[2] + y_[3])); if (q == 0) *yp = yy_; yp += ystep; } while (0)
__device__ __forceinline__ void mix_rwkv(const Ctx& c0, int l, int pass, int b, int h, int dir) {
    const Ctx c = fresh(c0);
    const Dims& d = c.d; const int T = pass ? d.Tl : d.Tc, tid = c.tid, lane = c.lane, wave = c.wave; const size_t tok0 = pass ? d.NTc + (size_t)b * d.Tl : (size_t)b * d.Tc;
    float* L = (float*)c.lds;
    const float* cols = c.ws<float>(d.w_cols); float* scr = c.ws<float>(d.w_scr);
    constexpr int TB = 32, VST = 6 * 64;
    float *VEC = L, *LWA = L + 2 * TB * VST, *STG = LWA + 2 * 2 * TB * 64;
    const int nb = T / TB;
    __syncthreads();
    if (wave < 4) {
        const int vrow = tid >> 2, q = tid & 3;
        f32x4 Sv[4];
        if (pass) { const float* S0 = c.in(I_SR) + ((((size_t)b * DEPTH + l) * 2 + dir) * NH + h) * HD * HD + vrow * 64 + q * 16; UNR for (int u = 0; u < 4; ++u) Sv[u] = *(const f32x4*)(S0 + 4 * u); }
        else { UNR for (int u = 0; u < 4; ++u) Sv[u] = (f32x4){0.f, 0.f, 0.f, 0.f}; }
        float* yp = scr + ((tok0 + (dir ? T - 1 : 0)) * NSLOT + (dir ? SL_RB : SL_RF)) * MIXW + h * 64 + vrow; const long ystep = dir ? -(long)(NSLOT * MIXW) : (long)(NSLOT * MIXW);
        __syncthreads(); __syncthreads();
        for (int jb = 0; jb < nb; ++jb) {
            const float* buf = VEC + (jb & 1) * TB * VST;
            f32x4 aR[4], aK[4], aW[4], aA[4], aH[4], bR[4], bK[4], bW[4], bA[4], bH[4]; float av, bv;
            RW_LOAD(0, aR, aK, aW, aA, aH, av);
#pragma unroll 1
            for (int i = 0; i < TB; i += 2) {
                RW_LOAD(i + 1, bR, bK, bW, bA, bH, bv);
                RW_STEP(aR, aK, aW, aA, aH, av);
                if (i + 2 < TB) RW_LOAD(i + 2, aR, aK, aW, aA, aH, av);
                RW_STEP(bR, bK, bW, bA, bH, bv);
            }
            __syncthreads();
        }
        if (!pass) { float* So = c.p->out + d.o_r + ((((size_t)b * DEPTH + l) * 2 + dir) * NH + h) * HD * HD + vrow * 64 + q * 16; UNR for (int u = 0; u < 4; ++u) *(f32x4*)(So + 4 * u) = Sv[u]; }
    } else {
        const int pw = wave - 4, kind = pw >> 1, tj = pw & 1, ch = h * 64 + lane;
        float* stg = STG + pw * (32 * 33);
        float bw[16];
        { const float* Wg = c.in(kind ? I_WA2 : I_WW2) + ((size_t)l * 2 + dir) * 32 * MIXW + h * 64 + tj * 32 + (lane & 31);
          UNR for (int ks = 0; ks < 16; ++ks) bw[ks] = Wg[(size_t)(2 * ks + (lane >> 5)) * MIXW]; }
        const float* tp = c.in(I_SHIFT) + (size_t)l * 3 * 768 + ch;
        const float t0r = tp[0], t1r = tp[768], t2r = tp[1536], t0k = tp[256], t1k = tp[768 + 256], t2k = tp[1536 + 256], t0v = tp[512], t1v = tp[768 + 512], t2v = tp[1536 + 512];
        const float w0c = c.in(I_W0)[((size_t)l * 2 + dir) * MIXW + ch], a0c = c.in(I_A0)[((size_t)l * 2 + dir) * MIXW + ch], kkc = c.in(I_KK)[(size_t)l * MIXW + ch], kac = c.in(I_KA)[(size_t)l * MIXW + ch], rkc = c.in(I_RKK)[(size_t)l * MIXW + ch];
        for (int jb = -2; jb < nb; ++jb) {
            const int mB = jb + 1, mA = jb + 2;
            float xr[10], xk[10], xv[10];
            const int pi0 = mB * TB + pw * 8, tlo = dir ? T - 1 - (pi0 + 7) : pi0;
            if (mB >= 0 && mB < nb) {
                UNR for (int e = 0; e < 10; ++e) { const int tt = tlo - 1 + e; const bool ok = tt >= 0 && tt < T; const float* rp = cols + (tok0 + (ok ? tt : 0)) * NCF + ch;
                    xr[e] = ok ? rp[CB_RR * 256] : 0.0f; xk[e] = ok ? rp[CB_RK * 256] : 0.0f; xv[e] = ok ? rp[CB_RV * 256] : 0.0f; }
            }
            if (mA < nb) {
                float xs[16];
                UNR for (int e = 0; e < 16; ++e) { const int idx = e * 64 + lane, stp = idx >> 5, r = idx & 31, pi = mA * TB + stp, t = dir ? T - 1 - pi : pi; xs[e] = cols[(tok0 + t) * NCF + (kind ? SM_RA : SM_RW) + dir * 32 + r]; }
                UNR for (int e = 0; e < 16; ++e) { const int idx = e * 64 + lane; stg[(idx >> 5) * 33 + (idx & 31)] = kind ? xs[e] : tanhf_(xs[e]); }
                WAVE_SYNC();
                f32x16 acc = zero16(); const float* ap = stg + (lane & 31) * 33 + (lane >> 5);
                UNR for (int ks = 0; ks < 16; ++ks) acc = __builtin_amdgcn_mfma_f32_32x32x2f32(ap[2 * ks], bw[ks], acc, 0, 0, 0);
                float* lo = LWA + (((mA & 1) * 2 + kind) * TB) * 64 + tj * 32 + (lane & 31);
                UNR for (int r = 0; r < 16; ++r) lo[ACC_ROW(r, lane) * 64] = acc[r];
                WAVE_SYNC();
            }
            if (mB >= 0 && mB < nb) {
                float* buf = VEC + (mB & 1) * TB * VST; const float* lwp = LWA + (((mB & 1) * 2 + 0) * TB) * 64 + lane; const float* lap = LWA + (((mB & 1) * 2 + 1) * TB) * 64 + lane;
                UNR for (int s = 0; s < 8; ++s) {
                    const float r = t0r * (dir ? xr[7 - s] : xr[s]) + t1r * (dir ? xr[8 - s] : xr[s + 1]) + t2r * (dir ? xr[9 - s] : xr[s + 2]);
                    const float k = t0k * (dir ? xk[7 - s] : xk[s]) + t1k * (dir ? xk[8 - s] : xk[s + 1]) + t2k * (dir ? xk[9 - s] : xk[s + 2]);
                    const float v = t0v * (dir ? xv[7 - s] : xv[s]) + t1v * (dir ? xv[8 - s] : xv[s + 1]) + t2v * (dir ? xv[9 - s] : xv[s + 2]);
                    const float lw = lwp[(pw * 8 + s) * 64], la = lap[(pw * 8 + s) * 64];
                    const float decay = fexp(-fexp(-softplusf_(-(w0c + lw)) - 0.5f)), a = sigmoidf_(a0c + la);
                    float kap = k * kkc; const float ss = wave_sum(kap * kap); kap *= frsq(ss + LN_EPS);
                    const float khat = k * (1.0f + (a - 1.0f) * kac);
                    float* P = buf + (pw * 8 + s) * VST + lane;
                    P[0] = r; P[64] = kap; P[128] = v; P[192] = decay; P[256] = a * kap; P[320] = khat;
                    if (dir == 0) { const float bonus = wave_sum(r * k * rkc) * v; scr[((tok0 + pi0 + s) * NSLOT + SL_RBONUS) * MIXW + ch] = bonus; }
                }
            }
            __syncthreads();
        }
    }
    __syncthreads();
}
#undef RW_LOAD
#undef RW_STEP

__device__ __forceinline__ void phase_combine(const Ctx& c0, int l) {
    const Ctx c = fresh(c0);
    const Dims& d = c.d; const int tid = c.tid, lane = c.lane, wave = c.wave;
    float* L = (float*)c.lds; float *SG = L, *G2 = L + MSZ, *GT = L + MSZ + 64 * 256;
    const float* cols = c.ws<float>(d.w_cols); const float* scr = c.ws<float>(d.w_scr); bf16_t* br = c.ws<bf16_t>(d.w_br);
    __syncthreads();
    for (int i = tid; i < 64 * 256; i += NTHREADS) G2[i] = c.in(I_WG2)[(size_t)l * 64 * MIXW + i];
    for (int blk = c.vcu; blk < d.NT / 64; blk += c.G) {
        const size_t tb = (size_t)blk * 64;
        __syncthreads();
        { const int j = tid >> 3, g = tid & 7; const float* rp = cols + (tb + j) * NCF + SM_RG + g * 8; const f32x4 a = *(const f32x4*)rp, b2 = *(const f32x4*)(rp + 4); float* sp = SG + j * S65 + g * 8;
          sp[0] = sigmoidf_(a[0]); sp[1] = sigmoidf_(a[1]); sp[2] = sigmoidf_(a[2]); sp[3] = sigmoidf_(a[3]); sp[4] = sigmoidf_(b2[0]); sp[5] = sigmoidf_(b2[1]); sp[6] = sigmoidf_(b2[2]); sp[7] = sigmoidf_(b2[3]); }
        __syncthreads();
        UNR for (int u = 0; u < 2; ++u) { const int tl = wave * 2 + u, ti = tl >> 3, tj = tl & 7; f32x16 acc = zero16();
            acc = mm32(lane, acc, SG + ti * 32 * S65, S65, 1, G2 + tj * 32, 256, 1, 64);
            UNR for (int r = 0; r < 16; ++r) GT[(ti * 32 + ACC_ROW(r, lane)) * 257 + tj * 32 + (lane & 31)] = acc[r]; }
        __syncthreads();
        for (int hh = 0; hh < NH; ++hh) {
            const int j = tid >> 3, g = tid & 7; const size_t tok = tb + j; const int cb = hh * 64 + g * 8; const float* sp = scr + tok * NSLOT * MIXW + cb;
            {
              const f32x4 a0 = *(const f32x4*)(sp + SL_MF * MIXW), a1 = *(const f32x4*)(sp + SL_MF * MIXW + 4), b0 = *(const f32x4*)(sp + SL_MB * MIXW), b1 = *(const f32x4*)(sp + SL_MB * MIXW + 4);
              float x[8]; float s = 0.0f; UNR for (int e = 0; e < 4; ++e) { x[e] = a0[e] + b0[e]; x[4 + e] = a1[e] + b1[e]; } UNR for (int e = 0; e < 8; ++e) s += x[e];
              s += x1(s); s += x2(s); s += x4m(s); const float mean = s * (1.0f / 64.0f); float qv = 0.0f;
              UNR for (int e = 0; e < 8; ++e) { x[e] -= mean; qv += x[e] * x[e]; }
              qv += x1(qv); qv += x2(qv); qv += x4m(qv); const float rs = frsq(qv * (1.0f / 64.0f) + LN_EPS);
              const float* og = cols + tok * NCF + CB_MO * 256 + cb; const f32x4 o0 = *(const f32x4*)og, o1 = *(const f32x4*)(og + 4);
              u32x4 w; w.x = pk2(x[0] * rs * sigmoidf_(o0[0]), x[1] * rs * sigmoidf_(o0[1])); w.y = pk2(x[2] * rs * sigmoidf_(o0[2]), x[3] * rs * sigmoidf_(o0[3]));
              w.z = pk2(x[4] * rs * sigmoidf_(o1[0]), x[5] * rs * sigmoidf_(o1[1])); w.w = pk2(x[6] * rs * sigmoidf_(o1[2]), x[7] * rs * sigmoidf_(o1[3])); *(u32x4*)(br + tok * D + 0 * MIXW + cb) = w; }
            {
              const f32x4 a0 = *(const f32x4*)(sp + SL_GF * MIXW), a1 = *(const f32x4*)(sp + SL_GF * MIXW + 4), b0 = *(const f32x4*)(sp + SL_GB * MIXW), b1 = *(const f32x4*)(sp + SL_GB * MIXW + 4);
              float x[8]; float qv = 0.0f; UNR for (int e = 0; e < 4; ++e) { x[e] = a0[e] + b0[e]; x[4 + e] = a1[e] + b1[e]; } UNR for (int e = 0; e < 8; ++e) qv += x[e] * x[e];
              qv += x1(qv); qv += x2(qv); qv += x4m(qv); const float rs = frsq(qv * (1.0f / 64.0f) + LN_EPS);
              const float* og = cols + tok * NCF + CB_GG * 256 + cb; const f32x4 o0 = *(const f32x4*)og, o1 = *(const f32x4*)(og + 4);
              u32x4 w; w.x = pk2(x[0] * rs * siluf_(o0[0]), x[1] * rs * siluf_(o0[1])); w.y = pk2(x[2] * rs * siluf_(o0[2]), x[3] * rs * siluf_(o0[3]));
              w.z = pk2(x[4] * rs * siluf_(o1[0]), x[5] * rs * siluf_(o1[1])); w.w = pk2(x[6] * rs * siluf_(o1[2]), x[7] * rs * siluf_(o1[3])); *(u32x4*)(br + tok * D + 1 * MIXW + cb) = w; }
            {
              const f32x4 a0 = *(const f32x4*)(sp + SL_RF * MIXW), a1 = *(const f32x4*)(sp + SL_RF * MIXW + 4), b0 = *(const f32x4*)(sp + SL_RB * MIXW), b1 = *(const f32x4*)(sp + SL_RB * MIXW + 4);
              const f32x4 n0 = *(const f32x4*)(sp + SL_RBONUS * MIXW), n1 = *(const f32x4*)(sp + SL_RBONUS * MIXW + 4);
              float x[8]; float s = 0.0f; UNR for (int e = 0; e < 4; ++e) { x[e] = a0[e] + b0[e]; x[4 + e] = a1[e] + b1[e]; } UNR for (int e = 0; e < 8; ++e) s += x[e];
              s += x1(s); s += x2(s); s += x4m(s); const float mean = s * (1.0f / 64.0f); float qv = 0.0f;
              UNR for (int e = 0; e < 8; ++e) { x[e] -= mean; qv += x[e] * x[e]; }
              qv += x1(qv); qv += x2(qv); qv += x4m(qv); const float rs = frsq(qv * (1.0f / 64.0f) + LN_EPS);
              const float* gp = GT + j * 257 + cb;
              u32x4 w; w.x = pk2((x[0] * rs + n0[0]) * gp[0], (x[1] * rs + n0[1]) * gp[1]); w.y = pk2((x[2] * rs + n0[2]) * gp[2], (x[3] * rs + n0[3]) * gp[3]);
              w.z = pk2((x[4] * rs + n1[0]) * gp[4], (x[5] * rs + n1[1]) * gp[5]); w.w = pk2((x[6] * rs + n1[2]) * gp[6], (x[7] * rs + n1[3]) * gp[7]); *(u32x4*)(br + tok * D + 2 * MIXW + cb) = w; }
        }
    }
    __syncthreads();
}

#ifndef CPU_EMU
__device__ __forceinline__ unsigned cvtpk(float lo, float hi) { unsigned r; asm("v_cvt_pk_bf16_f32 %0, %1, %2" : "=v"(r) : "v"(lo), "v"(hi)); return r; }
#else
inline unsigned cvtpk(float lo, float hi) { return pk2(lo, hi); }
#endif
__device__ __forceinline__ void mix_na(const Ctx& c0, int l, int pass, int b, int h, int qb) {
    const Ctx c = fresh(c0);
    const Dims& d = c.d; const int tid = c.tid, lane = c.lane, wave = c.wave; const size_t tok0 = pass ? d.NTc + (size_t)b * d.Tl : (size_t)b * d.Tc;
    constexpr int KST = 72, VST_ = 136;
    unsigned char* LB = c.lds;
    bf16_t* Kt = (bf16_t*)LB;
    bf16_t* Vt = (bf16_t*)(LB + 2 * 128 * KST * 2);
    float* rpbs = (float*)(LB + 2 * 128 * KST * 2 + 2 * 64 * VST_ * 2);
    float* Om = (float*)LB;
    float* Lm = Om + 8 * 32 * 64;
    const float* cols = c.ws<float>(d.w_cols); bf16_t* br = c.ws<bf16_t>(d.w_br);
    const int rows = d.Tl / GRIDW, kr = rows < 8 ? rows : 8; int rs = qb - kr / 2; rs = rs < 0 ? 0 : (rs > rows - kr ? rows - kr : rs);
    const int nloc = pass ? kr / 2 : 0, ntile = pass ? nloc + PAST / 128 : d.Tc / 128;
    const int qt = wave & 1, kq = wave >> 1, hh = lane >> 5, ql = lane & 31;
    __syncthreads();
    if (pass) for (int i = tid; i < 15 * 31; i += NTHREADS) rpbs[i] = c.in(I_RPB)[((size_t)l * NH + h) * 15 * 31 + i];
    if (!pass) {
        UNR for (int u = 0; u < 2; ++u) { const int i = tid + NTHREADS * u, j = i >> 4, dd = (i & 15) * 4; const float* rp = cols + (tok0 + qb * 64 + j) * NCF + h * 64 + dd;
            const size_t o = ((((size_t)b * DEPTH + l) * NH + h) * d.Tc + qb * 64 + j) * HD + dd; *(f32x4*)(c.p->out + d.o_nk + o) = *(const f32x4*)(rp + CB_NK * 256); *(f32x4*)(c.p->out + d.o_nv + o) = *(const f32x4*)(rp + CB_NV * 256); }
    }
    bf16x8 qf[4];
    { const float* qp = cols + (tok0 + qb * 64 + qt * 32 + ql) * NCF + CB_NQ * 256 + h * 64 + 8 * hh;
      UNR for (int s4 = 0; s4 < 4; ++s4) { const f32x4 a = *(const f32x4*)(qp + 16 * s4), bq = *(const f32x4*)(qp + 16 * s4 + 4); u32x4 w;
          w.x = cvtpk(a[0] * 0.125f, a[1] * 0.125f); w.y = cvtpk(a[2] * 0.125f, a[3] * 0.125f); w.z = cvtpk(bq[0] * 0.125f, bq[1] * 0.125f); w.w = cvtpk(bq[2] * 0.125f, bq[3] * 0.125f); qf[s4] = __builtin_bit_cast(bf16x8, w); } }
    const int jp = tid >> 3, d8 = (tid & 7) * 8;
    f32x4 pk[2][2], pv[2][2];
#define NA_LOAD(kt_) do { UNR for (int u_ = 0; u_ < 2; ++u_) { const int j_ = 2 * jp + u_; const float *kp_, *vp_; \
        if (!pass) { const float* rp_ = cols + (tok0 + (kt_) * 128 + j_) * NCF + h * 64 + d8; kp_ = rp_ + CB_NK * 256; vp_ = rp_ + CB_NV * 256; } \
        else if ((kt_) < nloc) { const float* rp_ = cols + (tok0 + (size_t)(rs + 2 * (kt_) + (j_ >> 6)) * 64 + (j_ & 63)) * NCF + h * 64 + d8; kp_ = rp_ + CB_NK * 256; vp_ = rp_ + CB_NV * 256; } \
        else { const size_t o_ = ((((size_t)b * DEPTH + l) * NH + h) * PAST + ((kt_) - nloc) * 128 + j_) * HD + d8; kp_ = c.in(I_CK) + o_; vp_ = c.in(I_CV) + o_; } \
        pk[u_][0] = *(const f32x4*)kp_; pk[u_][1] = *(const f32x4*)(kp_ + 4); pv[u_][0] = *(const f32x4*)vp_; pv[u_][1] = *(const f32x4*)(vp_ + 4); } } while (0)
#define NA_STORE(buf_) do { bf16_t* kb_ = Kt + (buf_) * 128 * KST; bf16_t* vb_ = Vt + (buf_) * 64 * VST_; \
        UNR for (int u_ = 0; u_ < 2; ++u_) { u32x4 w_; w_.x = cvtpk(pk[u_][0][0], pk[u_][0][1]); w_.y = cvtpk(pk[u_][0][2], pk[u_][0][3]); w_.z = cvtpk(pk[u_][1][0], pk[u_][1][1]); w_.w = cvtpk(pk[u_][1][2], pk[u_][1][3]); \
            *(u32x4*)(kb_ + (2 * jp + u_) * KST + d8) = w_; } \
        UNR for (int e_ = 0; e_ < 8; ++e_) *(unsigned*)(vb_ + (d8 + e_) * VST_ + 2 * jp) = cvtpk(pv[0][e_ >> 2][e_ & 3], pv[1][e_ >> 2][e_ & 3]); } while (0)
    NA_LOAD(0);
    NA_STORE(0);
    f32x16 o0 = zero16(), o1 = zero16(); float lsum = 0.0f;
    __syncthreads();
    for (int kt = 0; kt < ntile; ++kt) {
        if (kt + 1 < ntile) NA_LOAD(kt + 1);
        const bf16_t* kb = Kt + (kt & 1) * 128 * KST + (32 * kq + ql) * KST + 8 * hh; const bf16_t* vb = Vt + (kt & 1) * 64 * VST_ + 32 * kq + 4 * hh;
        f32x16 sc = zero16();
        UNR for (int s4 = 0; s4 < 4; ++s4) sc = __builtin_amdgcn_mfma_f32_32x32x16_bf16(*(const bf16x8*)(kb + 16 * s4), qf[s4], sc, 0, 0, 0);
        if (pass && kt < nloc) {
            const int qc = 32 * qt + ql; int cs = qc - 8; cs = cs < 0 ? 0 : (cs > 48 ? 48 : cs);
            UNR for (int r = 0; r < 16; ++r) { const int jj = 32 * kq + ACC_ROW(r, lane), krow = rs + 2 * kt + (jj >> 6), kc = jj & 63; const bool ok = kc >= cs && kc < cs + 16;
                const float bias = rpbs[ok ? (krow - qb + 7) * 31 + (kc - qc + 15) : 0]; sc[r] = ok ? fexp(fminf(sc[r] + bias, 80.0f)) : 0.0f; }
        } else { UNR for (int r = 0; r < 16; ++r) sc[r] = fexp(fminf(sc[r], 80.0f)); }
        UNR for (int r = 0; r < 16; ++r) lsum += sc[r];
        UNR for (int s2 = 0; s2 < 2; ++s2) { u32x4 w; w.x = cvtpk(sc[8 * s2], sc[8 * s2 + 1]); w.y = cvtpk(sc[8 * s2 + 2], sc[8 * s2 + 3]); w.z = cvtpk(sc[8 * s2 + 4], sc[8 * s2 + 5]); w.w = cvtpk(sc[8 * s2 + 6], sc[8 * s2 + 7]);
            const bf16x8 pf = __builtin_bit_cast(bf16x8, w);
            { const u32x2 v0 = *(const u32x2*)(vb + ql * VST_ + 16 * s2), v1 = *(const u32x2*)(vb + ql * VST_ + 16 * s2 + 8); u32x4 vw; vw.x = v0.x; vw.y = v0.y; vw.z = v1.x; vw.w = v1.y;
              o0 = __builtin_amdgcn_mfma_f32_32x32x16_bf16(pf, __builtin_bit_cast(bf16x8, vw), o0, 0, 0, 0); }
            { const u32x2 v0 = *(const u32x2*)(vb + (32 + ql) * VST_ + 16 * s2), v1 = *(const u32x2*)(vb + (32 + ql) * VST_ + 16 * s2 + 8); u32x4 vw; vw.x = v0.x; vw.y = v0.y; vw.z = v1.x; vw.w = v1.y;
              o1 = __builtin_amdgcn_mfma_f32_32x32x16_bf16(pf, __builtin_bit_cast(bf16x8, vw), o1, 0, 0, 0); } }
        if (kt + 1 < ntile) NA_STORE((kt + 1) & 1);
        __syncthreads();
    }
#undef NA_LOAD
#undef NA_STORE
    { float* om = Om + wave * 32 * 64; UNR for (int r = 0; r < 16; ++r) { om[ACC_ROW(r, lane) * 64 + ql] = o0[r]; om[ACC_ROW(r, lane) * 64 + 32 + ql] = o1[r]; }
      const float lt = lsum + __shfl_xor(lsum, 32); if (lane < 32) Lm[wave * 32 + lane] = lt; }
    __syncthreads();
    { const int q = tid >> 3, g = tid & 7, qt2 = q >> 5, q2 = q & 31; float ls = 0.0f; f32x4 a0 = (f32x4){0.f, 0.f, 0.f, 0.f}, a1 = a0;
      UNR for (int kq2 = 0; kq2 < 4; ++kq2) { const int w = kq2 * 2 + qt2; ls += Lm[w * 32 + q2]; const float* op = Om + w * 32 * 64 + q2 * 64 + g * 8; a0 += *(const f32x4*)op; a1 += *(const f32x4*)(op + 4); }
      const float il = 1.0f / ls; const size_t tok = tok0 + qb * 64 + q; bf16_t* bp = br + tok * D + 3 * MIXW + h * 64 + g * 8;
      u32x4 w; w.x = pk2(a0[0] * il, a0[1] * il); w.y = pk2(a0[2] * il, a0[3] * il); w.z = pk2(a1[0] * il, a1[1] * il); w.w = pk2(a1[2] * il, a1[3] * il); *(u32x4*)bp = w; }
    __syncthreads();
}

__device__ __forceinline__ void phase_mixers(const Ctx& c0, int l, int rep) {
    const Ctx c = fresh(c0);
    const Dims& d = c.d; const int rows = d.Tl / GRIDW;
    const int nL = d.Bl * NH, nC = d.Bc * NH, nNAl = nL * rows, nq = d.Tc / 64, nNAc = nC * nq, nR = 2 * (nL + nC);
    const int e0 = nR, e1 = e0 + nR, e2 = e1 + nR, e3 = e2 + nNAl + nNAc;
    unsigned* qctr = c.ws<unsigned>(c.d.w_ctl) + CW_QUEUE + 64 * (l + DEPTH * rep);
    int* slot = (int*)(c.lds + 163840 - 128);
#ifndef MIX_MASK
#define MIX_MASK 15
#endif
#ifndef MIX_DUP
#define MIX_DUP 15
#endif
#define MIX_FETCH() do { __syncthreads(); if (c.tid == 0) *slot = (int)atomicAdd(qctr, 1u); __syncthreads(); it = __builtin_amdgcn_readfirstlane(*slot); } while (0)
    int it; MIX_FETCH();
    while (it < e0) { const int r = it, ps = r < 2 * nL ? 1 : 0, q = ps ? r : r - 2 * nL; if ((MIX_MASK & 1) && (rep == 0 || (MIX_DUP & 1))) mix_rwkv(c, l, opqs(__builtin_amdgcn_readfirstlane(ps)), (q >> 1) / NH, (q >> 1) % NH, q & 1); MIX_FETCH(); }
    while (it < e1) { const int r = it - e0, ps = r < 2 * nL ? 1 : 0, q = ps ? r : r - 2 * nL; if ((MIX_MASK & 2) && (rep == 0 || (MIX_DUP & 2))) mix_mlstm(c, l, opqs(__builtin_amdgcn_readfirstlane(ps)), (q >> 1) / NH, (q >> 1) % NH, q & 1); MIX_FETCH(); }
    while (it < e2) { const int r = it - e1, ps = r < 2 * nL ? 1 : 0, q = ps ? r : r - 2 * nL; if ((MIX_MASK & 4) && (rep == 0 || (MIX_DUP & 4))) mix_gla(c, l, opqs(__builtin_amdgcn_readfirstlane(ps)), (q >> 1) / NH, (q >> 1) % NH, q & 1); MIX_FETCH(); }
    while (it < e3) { const int r = it - e2, ps = r < nNAl ? 1 : 0, q = ps ? r : r - nNAl, nr = ps ? rows : nq; if ((MIX_MASK & 8) && (rep == 0 || (MIX_DUP & 8))) mix_na(c, l, opqs(__builtin_amdgcn_readfirstlane(ps)), q / (NH * nr), (q / nr) % NH, q % nr); MIX_FETCH(); }
#undef MIX_FETCH
}

__device__ __forceinline__ void phase_ln1(const Ctx& c0, int l) {
    const Ctx c = fresh(c0);
    const Dims& d = c.d; const float* mods = c.mods(l); const float* v = c.ws<float>(d.w_v); bf16_t* hb = c.ws<bf16_t>(d.w_hb); float* aff = c.ws<float>(d.w_aff);
    const float* lg = c.in(I_LNG) + ((size_t)l * 2 + 0) * D; const float* lb = c.in(I_LNB) + ((size_t)l * 2 + 0) * D;
    constexpr int WRS = D + 4;
    float* WR = (float*)c.lds;
    __syncthreads();
    for (int i = c.tid; i < D * NEXP; i += NTHREADS) WR[(i & 15) * WRS + (i >> 4)] = c.in(I_WROUTER)[(size_t)l * D * NEXP + i];
    __syncthreads();
    f32x4 g4[4], b4[4];
#pragma unroll
    for (int j = 0; j < 4; ++j) { g4[j] = *(const f32x4*)(lg + 4 * c.lane + 256 * j); b4[j] = *(const f32x4*)(lb + 4 * c.lane + 256 * j); }
    for (int blk = c.vcu * NWAVES + c.wave; blk < d.NT / 8; blk += c.G * NWAVES) {
        const int tokb = blk * 8; const float* mr = mods + (size_t)c.modrow(tokb) * NMOD;
        f32x4 sh4[4], sc4[4], xn[4];
#pragma unroll
        for (int j = 0; j < 4; ++j) { sh4[j] = *(const f32x4*)(mr + 3 * D + 4 * c.lane + 256 * j); sc4[j] = *(const f32x4*)(mr + 4 * D + 4 * c.lane + 256 * j); xn[j] = *(const f32x4*)(v + (size_t)tokb * D + 4 * c.lane + 256 * j); }
        for (int ti = 0; ti < 8; ++ti) {
            const int tok = tokb + ti; f32x4 x[4]; float s = 0.0f;
#pragma unroll
            for (int j = 0; j < 4; ++j) { x[j] = xn[j]; s += (x[j][0] + x[j][1]) + (x[j][2] + x[j][3]); }
            if (ti + 1 < 8) {
#pragma unroll
                for (int j = 0; j < 4; ++j) xn[j] = *(const f32x4*)(v + (size_t)(tok + 1) * D + 4 * c.lane + 256 * j); }
            const float mean = wave_sum(s) * (1.0f / D); float q = 0.0f;
#pragma unroll
            for (int j = 0; j < 4; ++j) { x[j] = x[j] - mean; q += (x[j][0] * x[j][0] + x[j][1] * x[j][1]) + (x[j][2] * x[j][2] + x[j][3] * x[j][3]); }
            const float rstd = frsq(wave_sum(q) * (1.0f / D) + LN_EPS);
            f32x4 hh[4];
#pragma unroll
            for (int j = 0; j < 4; ++j) { const int col = 4 * c.lane + 256 * j; const f32x4 x1 = x[j] * rstd * g4[j] + b4[j]; *(f32x4*)(c.X() + (size_t)tok * D + col) = x1;
                hh[j] = x1 * (1.0f + sc4[j]) + sh4[j]; u32x2 w; w.x = pk2(hh[j][0], hh[j][1]); w.y = pk2(hh[j][2], hh[j][3]); *(u32x2*)(hb + (size_t)tok * D + col) = w; }
            float lg16[16];
#pragma unroll
            for (int e = 0; e < 16; ++e) { float a = 0.0f;
#pragma unroll
                for (int j = 0; j < 4; ++j) { const f32x4 wv = *(const f32x4*)(WR + e * WRS + 4 * c.lane + 256 * j); a += (hh[j][0] * wv[0] + hh[j][1] * wv[1]) + (hh[j][2] * wv[2] + hh[j][3] * wv[3]); }
                lg16[e] = a;
#ifndef CPU_EMU
                asm volatile("" ::: "memory");
#endif
            }
            float mx = -3.0e38f;
#pragma unroll
            for (int e = 0; e < 16; ++e) { lg16[e] = wave_sum(lg16[e]); mx = fmaxf(mx, lg16[e]); }
            float se = 0.0f;
#pragma unroll
            for (int e = 0; e < 16; ++e) { lg16[e] = expf(lg16[e] - mx); se += lg16[e]; }
            const float inv = 1.0f / se; float mine = 0.0f;
#pragma unroll
            for (int e = 0; e < 16; ++e) mine = (c.lane == e) ? lg16[e] * inv : mine;
            if (c.lane < 16) aff[(size_t)tok * NEXP + c.lane] = mine;
        }
    }
}

__device__ __forceinline__ void phase_select(const Ctx& c0) {
    const Ctx c = fresh(c0);
    const Dims& d = c.d; const float* aff = c.ws<float>(d.w_aff); int* inv = c.ws<int>(d.w_inv); float* pgate = c.ws<float>(d.w_pgate);
    const bf16_t* hb = c.ws<bf16_t>(d.w_hb); bf16_t* xe = c.ws<bf16_t>(d.w_xe);
    unsigned long long* KEY = (unsigned long long*)c.lds; int* sel = (int*)(KEY + 1024);
    const int nitems = (d.Bc + d.Bl) * NEXP;
    for (int it = c.vcu; it < nitems; it += c.G) {
        const int e = it % NEXP, bb = it / NEXP, pass = bb >= d.Bc, b = pass ? bb - d.Bc : bb, T = pass ? d.Tl : d.Tc, cap = pass ? d.capl : d.capc;
        const int tok0 = pass ? d.NTc + b * d.Tl : b * d.Tc, row0 = e * d.RPE + (pass ? d.Bc * d.capc + b * d.capl : b * d.capc);
        __syncthreads();
        for (int t = c.tid; t < T; t += NTHREADS) KEY[t] = ((unsigned long long)__builtin_bit_cast(unsigned, aff[(size_t)(tok0 + t) * NEXP + e]) << 32) | (unsigned)(~t);
        __syncthreads();
        { const int t0 = c.tid, t1 = c.tid + NTHREADS; const bool h0 = t0 < T, h1 = t1 < T; const unsigned long long k0 = h0 ? KEY[t0] : ~0ull, k1 = h1 ? KEY[t1] : ~0ull; int rank0 = 0, rank1 = 0;
#pragma unroll 4
          for (int s2 = 0; s2 < T; s2 += 2) { const unsigned long long o0 = KEY[s2], o1 = KEY[s2 + 1];
              rank0 += (o0 > k0 ? 1 : 0) + (o1 > k0 ? 1 : 0); rank1 += (o0 > k1 ? 1 : 0) + (o1 > k1 ? 1 : 0); }
          if (h0) { if (rank0 < cap) { sel[rank0] = t0; pgate[row0 + rank0] = __builtin_bit_cast(float, (unsigned)(k0 >> 32)); inv[(size_t)e * d.NT + tok0 + t0] = row0 + rank0; } else inv[(size_t)e * d.NT + tok0 + t0] = -1; }
          if (h1) { if (rank1 < cap) { sel[rank1] = t1; pgate[row0 + rank1] = __builtin_bit_cast(float, (unsigned)(k1 >> 32)); inv[(size_t)e * d.NT + tok0 + t1] = row0 + rank1; } else inv[(size_t)e * d.NT + tok0 + t1] = -1; } }
        __syncthreads();
        for (int r0 = c.wave * 4; r0 < cap; r0 += NWAVES * 4) {
            u32x4 v[4][2];
            UNR for (int u = 0; u < 4; ++u) { const int r = r0 + u < cap ? r0 + u : cap - 1; const u32x4* src = (const u32x4*)(hb + (size_t)(tok0 + sel[r]) * D); v[u][0] = src[c.lane]; v[u][1] = src[c.lane + 64]; }
            UNR for (int u = 0; u < 4; ++u) { if (r0 + u < cap) { u32x4* dst = (u32x4*)(xe + (size_t)(row0 + r0 + u) * D); dst[c.lane] = v[u][0]; dst[c.lane + 64] = v[u][1]; } }
        }
    }
}

__device__ __forceinline__ void phase_ln2(const Ctx& c0, int l) {
    const Ctx c = fresh(c0);
    const Dims& d = c.d; const float* mods = c.mods(l); const float* y = c.ws<float>(d.w_y); const int* inv = c.ws<int>(d.w_inv); bf16_t* hb = c.ws<bf16_t>(d.w_hb);
    const float* lg = c.in(I_LNG) + ((size_t)l * 2 + 1) * D; const float* lb = c.in(I_LNB) + ((size_t)l * 2 + 1) * D;
    const float* modn = (l + 1 < DEPTH) ? c.mods(l + 1) : nullptr;
    const int gw = c.vcu * NWAVES + c.wave, NGW = c.G * NWAVES;
    for (int tok = gw; tok < d.NT; tok += NGW) {
        const int mrow = c.modrow(tok); const float* mr = mods + (size_t)mrow * NMOD; f32x4 ff[4];
#pragma unroll
        for (int j = 0; j < 4; ++j) ff[j] = (f32x4){0.f, 0.f, 0.f, 0.f};
        for (int e = 0; e < NEXP; ++e) { const int row = inv[(size_t)e * d.NT + tok]; if (row >= 0) {
#pragma unroll
            for (int j = 0; j < 4; ++j) ff[j] += *(const f32x4*)(y + (size_t)row * D + 4 * c.lane + 256 * j); } }
        f32x4 x[4]; float s = 0.0f;
#pragma unroll
        for (int j = 0; j < 4; ++j) { const int col = 4 * c.lane + 256 * j; const f32x4 x1 = *(const f32x4*)(c.X() + (size_t)tok * D + col), g2 = *(const f32x4*)(mr + 5 * D + col);
            x[j] = ALPHA * x1 + g2 * ff[j]; s += (x[j][0] + x[j][1]) + (x[j][2] + x[j][3]); }
        const float mean = wave_sum(s) * (1.0f / D); float q = 0.0f;
#pragma unroll
        for (int j = 0; j < 4; ++j) { x[j] = x[j] - mean; q += (x[j][0] * x[j][0] + x[j][1] * x[j][1]) + (x[j][2] * x[j][2] + x[j][3] * x[j][3]); }
        const float rstd = frsq(wave_sum(q) * (1.0f / D) + LN_EPS);
#pragma unroll
        for (int j = 0; j < 4; ++j) { const int col = 4 * c.lane + 256 * j; const f32x4 g = *(const f32x4*)(lg + col), bb = *(const f32x4*)(lb + col);
            const f32x4 x2 = x[j] * rstd * g + bb; *(f32x4*)(c.X() + (size_t)tok * D + col) = x2;
            if (modn) { const float* mn = modn + (size_t)mrow * NMOD; const f32x4 sh = *(const f32x4*)(mn + col), sc = *(const f32x4*)(mn + D + col); const f32x4 hh = x2 * (1.0f + sc) + sh;
                u32x2 w; w.x = pk2(hh[0], hh[1]); w.y = pk2(hh[2], hh[3]); *(u32x2*)(hb + (size_t)tok * D + col) = w; } }
    }
}

constexpr int N_PHASES = 2 + 10 * DEPTH;
__device__ __forceinline__ void run_phase(const Ctx& c0, int ph, int rep) {
    const Ctx c = fresh(c0); const Dims& d = c.d;
#ifndef PHASE_MASK
#define PHASE_MASK 0xFFFF
#endif
    if (ph == 0) { if (PHASE_MASK & 0x400) phase_prep(c); return; }
    if (ph == 1) { if (PHASE_MASK & 0x800) phase_init(c); return; }
    const int l = (ph - 2) / 10, s = (ph - 2) % 10;
    LAS unsigned char* ldsp = (LAS unsigned char*)c.lds;
    if (!((PHASE_MASK >> s) & 1)) return;
    switch (s) {
    case 0: { pg8::Gemm g{c.ws<bf16_t>(d.w_hb), c.ws<bf16_t>(d.w_win) + (size_t)l * NINP * D, D}; pg8::StaticOrder S; S.init(d.NT, NINP, c.G, (int)blockIdx.x);
              EpiCols E{c.ws<float>(d.w_cols), c.ws<unsigned short>(d.w_gates)}; pg8::gemm_phase<EpiCols, pg8::StaticOrder>(ldsp, g, S, E); } break;
    case 1: phase_mixers(c, l, rep); break;
    case 2: phase_combine(c, l); break;
    case 3: { pg8::Gemm g{c.ws<bf16_t>(d.w_br), c.ws<bf16_t>(d.w_wbr) + (size_t)l * D * D, D}; pg8::StaticOrder S; S.init(d.NT, D, c.G, (int)blockIdx.x);
              EpiWiden E{c.ws<unsigned short>(d.w_gates), c.ws<bf16_t>(d.w_merged)}; pg8::gemm_phase<EpiWiden, pg8::StaticOrder>(ldsp, g, S, E); } break;
    case 4: { pg8::Gemm g{c.ws<bf16_t>(d.w_merged), c.ws<bf16_t>(d.w_wout) + (size_t)l * D * D, D}; pg8::StaticOrder S; S.init(d.NT, D, c.G, (int)blockIdx.x);
              EpiPreLN E{c.X(), c.mods(l), c.ws<float>(d.w_v), d.NTc, d.Tl}; pg8::gemm_phase<EpiPreLN, pg8::StaticOrder>(ldsp, g, S, E); } break;
    case 5: phase_ln1(c, l); break;
    case 6: phase_select(c); break;
    case 7: { pg8::Gemm g{c.ws<bf16_t>(d.w_xe), c.ws<bf16_t>(d.w_wup) + (size_t)l * NEXP * 2 * FF * D, D}; pg8::GroupOrder S; S.init(d.TPE, 2 * FF / 256, NEXP, c.G, c.vcu);
              EpiSwiGLU E{c.ws<bf16_t>(d.w_act)}; pg8::gemm_phase<EpiSwiGLU, pg8::GroupOrder>(ldsp, g, S, E); } break;
    case 8: { pg8::Gemm g{c.ws<bf16_t>(d.w_act), c.ws<bf16_t>(d.w_wdn) + (size_t)l * NEXP * D * FF, FF}; pg8::GroupOrder S; S.init(d.TPE, D / 256, NEXP, c.G, c.vcu);
              EpiDown E{c.ws<float>(d.w_pgate), c.ws<float>(d.w_y)}; pg8::gemm_phase<EpiDown, pg8::GroupOrder>(ldsp, g, S, E); } break;
    default: phase_ln2(c, l); break;
    }
}

#ifndef CPU_EMU
#define XB_TMO      128
#define XB_XCNT(j)  (256  + 64 * (j))
#define XB_XSUB(j)  (1280 + 64 * (j))
#define XB_XGEN(j)  (2304 + 64 * (j))
#define XB_TOP      3328
#define XB_TOPGEN   3392
#define XB_SPIN_CAP (1u << 20)
__device__ __forceinline__ unsigned xb_ld(unsigned* p)              { return __hip_atomic_load(p, __ATOMIC_RELAXED, __HIP_MEMORY_SCOPE_AGENT); }
__device__ __forceinline__ unsigned xb_add(unsigned* p, unsigned v) { return __hip_atomic_fetch_add(p, v, __ATOMIC_RELAXED, __HIP_MEMORY_SCOPE_AGENT); }
__device__ __forceinline__ unsigned xb_xcc_id() { return (unsigned)__builtin_amdgcn_s_getreg((3 << 11) | 20) & 0xFu; }
#define XB_SPIN(cond, bar) do { unsigned _sp = 0; while (cond) { __builtin_amdgcn_s_sleep(1); \
    if ((++_sp & 255u) == 0u) { if (xb_ld(&(bar)[XB_TMO])) break; if (_sp > XB_SPIN_CAP) { atomicAdd(&(bar)[XB_TMO], 1u); break; } } } } while (0)
struct XcdBarrier { unsigned* bar; unsigned x; volatile LAS unsigned* st; };
__device__ __forceinline__ XcdBarrier xcd_barrier_post(unsigned* bar, volatile LAS unsigned* st) {
    XcdBarrier b; b.bar = bar; b.x = xb_xcc_id(); b.st = st;
    if (threadIdx.x == 0) (void)xb_add(&bar[XB_XCNT(b.x)], 1u);
    return b;
}
__device__ __forceinline__ void xcd_barrier_complete(unsigned* bar, unsigned x, unsigned& nloc, unsigned& nx) {
    const unsigned G = gridDim.x * gridDim.y * gridDim.z;
    unsigned sum, cnt, mine, sp = 0u;
    for (;;) {
        sum = 0u; cnt = 0u; mine = 0u;
#pragma unroll
        for (unsigned j = 0; j < 16; ++j) { const unsigned cc = xb_ld(&bar[XB_XCNT(j)]); sum += cc; cnt += (cc > 0u) ? 1u : 0u; mine = (j == x) ? cc : mine; }
        if (sum == G) break;
        __builtin_amdgcn_s_sleep(1);
        if ((++sp & 255u) == 0u) { if (xb_ld(&bar[XB_TMO])) break; if (sp > XB_SPIN_CAP) { atomicAdd(&bar[XB_TMO], 1u); break; } }
    }
    nloc = mine > 0u ? mine : 1u; nx = cnt > 0u ? cnt : 1u;
}
__device__ __forceinline__ void xcd_barrier(const XcdBarrier& b) {
    asm volatile("s_waitcnt vmcnt(0)" ::: "memory");
    __syncthreads();
    if (threadIdx.x == 0) {
        unsigned* bar = b.bar;
        __builtin_amdgcn_s_waitcnt(0);
        unsigned nloc = b.st[0], nx = b.st[1];
        if (nloc == 0u) { xcd_barrier_complete(bar, b.x, nloc, nx); b.st[0] = nloc; b.st[1] = nx; }
        const unsigned old = xb_add(&bar[XB_XSUB(b.x)], 1u);
        const unsigned gen = old / nloc;
        if (old + 1u == (gen + 1u) * nloc) {
            __builtin_amdgcn_fence(__ATOMIC_RELEASE, "agent");
            asm volatile("s_waitcnt vmcnt(0)" ::: "memory");
            const unsigned og = xb_add(&bar[XB_TOP], 1u);
            const unsigned tg = og / nx;
            if (og + 1u == (tg + 1u) * nx) xb_add(&bar[XB_TOPGEN], 1u);
            else XB_SPIN(xb_ld(&bar[XB_TOPGEN]) == tg, bar);
            __builtin_amdgcn_fence(__ATOMIC_ACQUIRE, "agent");
            xb_add(&bar[XB_XGEN(b.x)], 1u);
            asm volatile("s_waitcnt vmcnt(0)" ::: "memory");
        } else {
            XB_SPIN(xb_ld(&bar[XB_XGEN(b.x)]) == gen, bar);
            __builtin_amdgcn_fence(__ATOMIC_ACQUIRE, "agent");
            asm volatile("s_waitcnt vmcnt(0)" ::: "memory");
        }
    }
    __syncthreads();
}

#ifndef PROBE_DUP
#define PROBE_DUP 0
#endif
constexpr int LDS_BYTES = 163840;
__global__ void __launch_bounds__(NTHREADS, 2) trunk_fwd(Params p) {
    extern __shared__ __attribute__((aligned(16))) unsigned char lds[];
    Ctx c; c.p = &p; c.d = make_dims(p.Bc, p.Tc, p.Bl, p.Tl); c.lds = lds;
    c.tid = threadIdx.x; c.lane = c.tid & 63; c.wave = __builtin_amdgcn_readfirstlane(c.tid >> 6);
    c.G = gridDim.x; { const int bx = blockIdx.x; c.vcu = (c.G % 8 == 0) ? (bx % 8) * (c.G / 8) + bx / 8 : bx; }
    volatile LAS unsigned* st = (volatile LAS unsigned*)((LAS unsigned char*)lds + LDS_BYTES - 64);
    XcdBarrier bar; bar.bar = nullptr; bar.x = 0; bar.st = st;
    if (p.use_bar) { if (c.tid < 2) st[c.tid] = 0u; __syncthreads(); bar = xcd_barrier_post((unsigned*)(p.ws) + CW_BAR, st); }
    for (int ph = p.ph_lo; ph < p.ph_hi; ++ph) {
        run_phase(c, ph, 0);
#if PROBE_DUP
        { const int kind = ph == 0 ? 10 : (ph == 1 ? 11 : (ph - 2) % 10); if ((PROBE_DUP >> kind) & 1) { xcd_barrier(bar); run_phase(c, ph, 1); } }
#endif
        if (ph + 1 < p.ph_hi) xcd_barrier(bar);
    }
}

#ifndef N_LAUNCH_MODE
#define N_LAUNCH_MODE 1
#endif
extern "C" void kernel_launch(void* const* d_in, const int* in_sizes, int n_in, void* d_out, int out_size, void* d_ws, size_t ws_size, hipStream_t stream) {
    static int grid = 0;
    const Dims d = make_dims(32, 256, 8, 1024);
    if (grid == 0) {
        int dev = 0, cus = 0;
        if (n_in != N_INPUTS || (size_t)out_size != d.o_end || ws_size < ((size_t)d.w_end << 8)) { fprintf(stderr, "kernel_launch: unexpected sizes: n_in %d out %d ws %zu (need %zu / %zu)\n", n_in, out_size, ws_size, (size_t)d.o_end, (size_t)d.w_end << 8); grid = -1; return; }
        if (hipGetDevice(&dev) != hipSuccess || hipDeviceGetAttribute(&cus, hipDeviceAttributeMultiprocessorCount, dev) != hipSuccess) { grid = -1; return; }
        if (hipFuncSetAttribute((const void*)trunk_fwd, hipFuncAttributeMaxDynamicSharedMemorySize, LDS_BYTES) != hipSuccess) { fprintf(stderr, "kernel_launch: hipFuncSetAttribute failed\n"); grid = -1; return; }
        int per_cu = 0;
        if (hipOccupancyMaxActiveBlocksPerMultiprocessor(&per_cu, (const void*)trunk_fwd, NTHREADS, LDS_BYTES) != hipSuccess || per_cu < 1) fprintf(stderr, "kernel_launch: occupancy query says %d\n", per_cu);
        (void)hipGetLastError();
        grid = cus;
    }
    if (grid < 0) return;
    (void)hipMemsetAsync((char*)d_ws, 0, CTL_BYTES, stream);
    Params p{};
    for (int i = 0; i < N_INPUTS; ++i) p.in[i] = (const float*)d_in[i];
    p.out = (float*)d_out; p.ws = (unsigned char*)d_ws; p.Bc = 32; p.Tc = 256; p.Bl = 8; p.Tl = 1024;
#if N_LAUNCH_MODE == 1
    p.ph_lo = 0; p.ph_hi = N_PHASES; p.use_bar = 1;
    hipLaunchKernelGGL(trunk_fwd, dim3(grid), dim3(NTHREADS), LDS_BYTES, stream, p);
#else
    for (int ph = 0; ph < N_PHASES; ++ph) { p.ph_lo = ph; p.ph_hi = ph + 1; p.use_bar = 0; hipLaunchKernelGGL(trunk_fwd, dim3(grid), dim3(NTHREADS), LDS_BYTES, stream, p); }
#endif
}
#endif
```

```cpp
#ifndef CPU_EMU
#include <hip/hip_runtime.h>
#include <cstdio>
typedef float f32x16 __attribute__((ext_vector_type(16)));
typedef float f32x4 __attribute__((ext_vector_type(4)));
typedef float f32x2 __attribute__((ext_vector_type(2)));
typedef unsigned u32x4 __attribute__((ext_vector_type(4)));
typedef unsigned u32x2 __attribute__((ext_vector_type(2)));
#define LAS __attribute__((address_space(3)))
#define WAVE_SYNC() asm volatile("s_waitcnt lgkmcnt(0)" ::: "memory")
#else
#define LAS
#define WAVE_SYNC() emu::wave_sync()
#endif
#define UNR _Pragma("unroll")
typedef short bf16x8 __attribute__((ext_vector_type(8)));
typedef unsigned short bf16_t;

constexpr int D = 1024, NH = 4, HD = 64, MIXW = 256, NEXP = 16, FF = 2048, DEPTH = 2, PAST = 256, GRIDW = 64;
constexpr int NIN = 7920, NINP = 7936, NCB = 3584, NSM = 256, NGATE = 4096, NMOD = 6 * D;
constexpr float ALPHA = 1.4142135623730951f, LN_EPS = 1e-5f;
constexpr int NTHREADS = 512, NWAVES = 8;
constexpr int CB_MQ = 0, CB_MK = 1, CB_MV = 2, CB_MO = 3, CB_GQ = 4, CB_GK = 5, CB_GV = 6, CB_GG = 7, CB_RR = 8, CB_RK = 9, CB_RV = 10, CB_NQ = 11, CB_NK = 12, CB_NV = 13;
constexpr int SM_MI = 0, SM_MF = 8, SM_GA = 16, SM_RW = 48, SM_RA = 112, SM_RG = 176;
enum { I_XP = 0, I_XS, I_SC, I_SN, I_SM, I_SG, I_SR, I_CK, I_CV, I_C, I_CCTX, I_WADA, I_BADA, I_WIN, I_BIG, I_BFG, I_WGLA, I_BGLA, I_SHIFT, I_W0, I_WW2, I_A0, I_WA2, I_WG2, I_KK, I_KA, I_RKK,
       I_RPB, I_WBR, I_WOUT, I_LNG, I_LNB, I_WROUTER, I_WUP, I_WDOWN, N_INPUTS };

__host__ __device__ __forceinline__ int prow(int n) { const int rho = n & 31; return (n & ~31) + 8 * ((rho & 15) >> 2) + 4 * (rho >> 4) + (rho & 3); }
__host__ __device__ __forceinline__ int win_col(int p) {
    if (p < 3584) { const int b = p >> 8, w = p & 255; const int base = b < 4 ? b * 256 : (b < 8 ? 1040 + (b - 4) * 256 : (b < 11 ? 2096 + (b - 8) * 256 : 3056 + (b - 11) * 256)); return base + w; }
    if (p < 3840) { const int s = p - 3584; return s < 16 ? 1024 + s : (s < 48 ? 2064 + (s - 16) : (s < 240 ? 2864 + (s - 48) : -1)); }
    return p - 16;
}

struct Params {
    const float* in[N_INPUTS];
    float* out; unsigned char* ws;
    int Bc, Tc, Bl, Tl;
    int ph_lo, ph_hi;
    int use_bar, pad;
};
struct Dims {
    int Bc, Tc, Bl, Tl, NTc, NTl, NT, capc, capl, RPE, TPE, NPR;
    unsigned o_yp, o_ys, o_C, o_n, o_m, o_g, o_r, o_nk, o_nv, o_end;
    unsigned w_ctl, w_win, w_wbr, w_wout, w_wup, w_wdn, w_mods, w_hb, w_cols, w_small, w_gates, w_br, w_scr, w_merged, w_v, w_aff, w_inv, w_pgate, w_xe, w_act, w_y, w_end;
};
constexpr size_t CTL_BYTES = 1u << 20;
constexpr int CW_BAR = 4096, CW_QUEUE = 1024;
__host__ __device__ __forceinline__ unsigned al256(size_t x) { return (unsigned)((x + 255) >> 8); }
__host__ __device__ __forceinline__ Dims make_dims(int Bc, int Tc, int Bl, int Tl) {
    Dims d; d.Bc = Bc; d.Tc = Tc; d.Bl = Bl; d.Tl = Tl; d.NTc = Bc * Tc; d.NTl = Bl * Tl; d.NT = d.NTc + d.NTl;
    d.capc = Tc / 8; d.capl = Tl / 8; d.RPE = ((Bc * d.capc + Bl * d.capl + 255) / 256) * 256; d.TPE = d.RPE / 256; d.NPR = NEXP * d.RPE;
    unsigned o = 0; d.o_yp = o; o += (unsigned)d.NTc * D; d.o_ys = o; o += (unsigned)d.NTl * D;
    d.o_C = o; o += (unsigned)Bc * DEPTH * 2 * NH * HD * HD; d.o_n = o; o += (unsigned)Bc * DEPTH * 2 * NH * HD; d.o_m = o; o += (unsigned)Bc * DEPTH * 2 * NH;
    d.o_g = o; o += (unsigned)Bc * DEPTH * 2 * NH * HD * HD; d.o_r = o; o += (unsigned)Bc * DEPTH * 2 * NH * HD * HD;
    d.o_nk = o; o += (unsigned)Bc * DEPTH * NH * Tc * HD; d.o_nv = o; o += (unsigned)Bc * DEPTH * NH * Tc * HD; d.o_end = o;
    unsigned w = 0; d.w_ctl = w; w += (unsigned)(CTL_BYTES >> 8);
    d.w_win = w; w += al256((size_t)DEPTH * NINP * D * 2); d.w_wbr = w; w += al256((size_t)DEPTH * D * D * 2); d.w_wout = w; w += al256((size_t)DEPTH * D * D * 2);
    d.w_wup = w; w += al256((size_t)DEPTH * NEXP * 2 * FF * D * 2); d.w_wdn = w; w += al256((size_t)DEPTH * NEXP * D * FF * 2);
    d.w_mods = w; w += al256((size_t)DEPTH * (1 + Bl) * NMOD * 4);
    d.w_hb = w; w += al256((size_t)d.NT * D * 2); d.w_cols = w; w += al256((size_t)d.NT * NCB * 2); d.w_small = w; w += al256((size_t)d.NT * NSM * 4); d.w_gates = w; w += al256((size_t)d.NT * NGATE * 2);
    d.w_br = w; w += al256((size_t)d.NT * D * 2); d.w_scr = w; w += al256((size_t)d.NT * 7 * MIXW * 4); d.w_merged = w; w += al256((size_t)d.NT * D * 2);
    d.w_v = w; w += al256((size_t)d.NT * D * 4); d.w_aff = w; w += al256((size_t)d.NT * NEXP * 4); d.w_inv = w; w += al256((size_t)d.NT * NEXP * 4);
    d.w_pgate = w; w += al256((size_t)d.NPR * 4); d.w_xe = w; w += al256((size_t)d.NPR * D * 2); d.w_act = w; w += al256((size_t)d.NPR * FF * 2); d.w_y = w; w += al256((size_t)d.NPR * D * 2);
    d.w_end = w; return d;
}

__device__ __forceinline__ unsigned f2bf(float f) { unsigned u = __builtin_bit_cast(unsigned, f); return (u + 0x7fffu + ((u >> 16) & 1u)) >> 16; }
__device__ __forceinline__ unsigned pk2(float lo, float hi) { return f2bf(lo) | (f2bf(hi) << 16); }

#ifndef CPU_EMU
template <int CTRL> __device__ __forceinline__ float dppf(float v) { return __builtin_bit_cast(float, __builtin_amdgcn_update_dpp(0, __builtin_bit_cast(int, v), CTRL, 0xF, 0xF, true)); }
__device__ __forceinline__ float x1(float v) { return dppf<0xB1>(v); }
__device__ __forceinline__ float x2(float v) { return dppf<0x4E>(v); }
__device__ __forceinline__ float x4m(float v) { return dppf<0x141>(v); }
__device__ __forceinline__ float x8m(float v) { return dppf<0x140>(v); }
__device__ __forceinline__ float fexp(float x) { return __expf(x); }
__device__ __forceinline__ float flog(float x) { return __logf(x); }
__device__ __forceinline__ float frsq(float x) { return __builtin_amdgcn_rsqf(x); }
#else
inline float x1(float v) { return __shfl_xor(v, 1); }
inline float x2(float v) { return __shfl_xor(v, 2); }
inline float x4m(float v) { return __shfl_xor(v, 4); }
inline float x8m(float v) { return __shfl_xor(v, 8); }
inline float fexp(float x) { return expf(x); }
inline float flog(float x) { return logf(x); }
inline float frsq(float x) { return 1.0f / sqrtf(x); }
#endif
__device__ __forceinline__ float quad_sum(float v) { v += x1(v); v += x2(v); return v; }
__device__ __forceinline__ float oct_sum(float v) { v += x1(v); v += x2(v); v += x4m(v); return v; }
__device__ __forceinline__ float oct_max(float v) { v = fmaxf(v, x1(v)); v = fmaxf(v, x2(v)); v = fmaxf(v, x4m(v)); return v; }
__device__ __forceinline__ float sigmoidf_(float x) { return __builtin_amdgcn_rcpf(1.0f + fexp(-x)); }
__device__ __forceinline__ float logsigmoidf_(float x) { return fminf(x, 0.0f) - flog(1.0f + fexp(-fabsf(x))); }
__device__ __forceinline__ float softplusf_(float x) { return fmaxf(x, 0.0f) + flog(1.0f + fexp(-fabsf(x))); }
__device__ __forceinline__ float tanhf_(float x) { const float e = fexp(-2.0f * fabsf(x)); const float t = (1.0f - e) * __builtin_amdgcn_rcpf(1.0f + e); return x < 0.0f ? -t : t; }
__device__ __forceinline__ float siluf_(float x) { return x * __builtin_amdgcn_rcpf(1.0f + fexp(-x)); }
__device__ __forceinline__ float wave_sum(float v) {
    v += x1(v); v += x2(v); v += x4m(v); v += x8m(v); v += __shfl_xor(v, 16); v += __shfl_xor(v, 32);
    return v;
}
__device__ __forceinline__ unsigned pkh2(float a, float b) { const _Float16 x = (_Float16)a, y = (_Float16)b; return (unsigned)__builtin_bit_cast(unsigned short, x) | ((unsigned)__builtin_bit_cast(unsigned short, y) << 16); }
#ifndef CPU_EMU
__device__ __forceinline__ float frcp(float x) { return __builtin_amdgcn_rcpf(x); }
#else
inline float frcp(float x) { return 1.0f / x; }
#endif
__device__ __forceinline__ float bf2f(unsigned v) { return __builtin_bit_cast(float, v << 16); }
__device__ __forceinline__ float bflo(unsigned w) { return __builtin_bit_cast(float, w << 16); }
__device__ __forceinline__ float bfhi(unsigned w) { return __builtin_bit_cast(float, w & 0xffff0000u); }
__device__ __forceinline__ float h2f(unsigned short h) { return (float)__builtin_bit_cast(_Float16, h); }

#ifndef CPU_EMU
__device__ __forceinline__ int opqv(int x) { asm volatile("" : "+v"(x)); return x; }
__device__ __forceinline__ int opqs(int x) { asm volatile("" : "+s"(x)); return x; }
#else
inline int opqv(int x) { return x; }
inline int opqs(int x) { return x; }
#endif
namespace pg8 {
constexpr int BM = 256, BK = 64, HALF = 128, HTB = HALF * BK * 2, STAGE_BYTES = 8 * HTB, NXCD = 8, WGM = 8;
__host__ __device__ __forceinline__ int lds_byte(int r, int c) { const int st = (r >> 4) * 2 + (c >> 5), rr = r & 15, cc = c & 31, ob = rr * 64 + cc * 2; return st * 1024 + (ob ^ (((ob >> 9) & 1) << 5)); }
__host__ __device__ __forceinline__ void stage_rc(int b, int& R, int& C) { const int st = b / 1024, sb = b % 1024, swz = sb ^ (((sb >> 9) & 1) << 5); R = (st >> 1) * 16 + swz / 64; C = (st & 1) * 32 + (swz % 64) / 2; }
struct Unit { int pm, pn, ta, tb; };
struct Gemm { const bf16_t* A; const bf16_t* Bt; int K; };
struct StaticOrder {
    int nM, nN, nwg, G, c;
    __device__ __forceinline__ void init(int M, int N, int G_, int c_) { nM = M / BM; nN = N / BM; nwg = nM * nN; G = G_; c = c_; }
    __device__ __forceinline__ bool next(int i, Unit& u) const {
        const long L = (long)i * G + c; if (L >= nwg) return false;
        int wgid = (int)L; { const int q = nwg / NXCD, r = nwg % NXCD, xcd = wgid % NXCD, off = wgid / NXCD; wgid = (xcd < r ? xcd * (q + 1) : r * (q + 1) + (xcd - r) * q) + off; }
        const int nig = WGM * nN, gid = wgid / nig, fm = gid * WGM, gsz = (nM - fm) < WGM ? (nM - fm) : WGM;
        u.pm = fm + ((wgid % nig) % gsz); u.pn = (wgid % nig) / gsz; u.ta = u.pm; u.tb = u.pn; return true;
    }
};
struct GroupOrder {
    int tpe, nN, nE, G, c;
    __device__ __forceinline__ void init(int tpe_, int nN_, int nE_, int G_, int c_) { tpe = tpe_; nN = nN_; nE = nE_; G = G_; c = c_; }
    __device__ __forceinline__ bool next(int i, Unit& u) const {
        const long L = (long)i * G + c; if (L >= (long)nE * tpe * nN) return false;
        const int per = tpe * nN, e = (int)(L / per), r = (int)(L % per), pn = r / tpe, pm = r % tpe;
        u.ta = e * tpe + pm; u.tb = e * nN + pn; u.pm = u.ta; u.pn = pn; return true;
    }
};
#ifndef CPU_EMU
template <class Epi, class Sched>
__device__ __forceinline__ void gemm_phase(LAS unsigned char* lds, const Gemm g, const Sched& S, const Epi& E) {
    const int tid = opqv((int)threadIdx.x), wid = __builtin_amdgcn_readfirstlane(tid >> 6), lane = tid & 63, wr = wid >> 2, wc = wid & 3, fr = lane & 15, fq = lane >> 4;
    const int K = g.K, nt = K / BK;
    unsigned voffA[2];
#pragma unroll
    for (int i = 0; i < 2; ++i) { int R, C; stage_rc(tid * 16 + i * 8192, R, C); voffA[i] = (unsigned)(R * K + C) * 2u; }
    const size_t kstep = (size_t)(BK * 2), hstep = (size_t)HALF * K * 2, tstep = 2 * hstep;
    const unsigned ldsw = (unsigned)wid * 1024u;
    const int aoff = lds_byte(wr * 64 + fr, fq * 8), boff = lds_byte(wc * 32 + fr, fq * 8);
#define PG8_SA(b, h) (((b) * 2 + (h)) * HTB)
#define PG8_SB(b, h) ((4 + (b) * 2 + (h)) * HTB)
#define PG8_STAGE(bufoff, gbase) do { _Pragma("unroll") for (int _i = 0; _i < 2; ++_i) \
        __builtin_amdgcn_global_load_lds((const unsigned*)((const char*)(gbase) + voffA[_i]), (LAS unsigned*)(lds + (bufoff) + ldsw + _i * 8192), 16, 0, 0); } while (0)
#define PG8_LDA(dst, b, h) do { _Pragma("unroll") for (int m = 0; m < 4; ++m) _Pragma("unroll") for (int k = 0; k < 2; ++k) dst[m][k] = *(const LAS bf16x8*)(lds + PG8_SA(b, h) + aoff + m * 2048 + k * 1024); } while (0)
#define PG8_LDB(dst, b, h) do { _Pragma("unroll") for (int n = 0; n < 2; ++n) _Pragma("unroll") for (int k = 0; k < 2; ++k) dst[n][k] = *(const LAS bf16x8*)(lds + PG8_SB(b, h) + boff + n * 2048 + k * 1024); } while (0)
#define PG8_MMA(ai, bj, At, Bt) do { __builtin_amdgcn_s_setprio(1); _Pragma("unroll") for (int m = 0; m < 4; ++m) _Pragma("unroll") for (int n = 0; n < 2; ++n) _Pragma("unroll") for (int k = 0; k < 2; ++k) \
        acc[ai][bj][m][n] = __builtin_amdgcn_mfma_f32_16x16x32_bf16(Bt[n][k], At[m][k], acc[ai][bj][m][n], 0, 0, 0); __builtin_amdgcn_s_setprio(0); } while (0)
#define PG8_WAIT_V(n) asm volatile("s_waitcnt vmcnt(" #n ")" ::: "memory")
#define PG8_WAIT_L(n) asm volatile("s_waitcnt lgkmcnt(" #n ")" ::: "memory")
#define PG8_BAR __builtin_amdgcn_s_barrier()
#define PG8_SCHED __builtin_amdgcn_sched_barrier(0)
    Unit cur, nxt; int ui = 0;
    if (!S.next(0, cur)) return;
    f32x4 acc[2][2][4][2];
#pragma unroll
    for (int a = 0; a < 2; ++a)
#pragma unroll
        for (int b = 0; b < 2; ++b)
#pragma unroll
            for (int m = 0; m < 4; ++m)
#pragma unroll
                for (int n = 0; n < 2; ++n) acc[a][b][m][n] = (f32x4){0.f, 0.f, 0.f, 0.f};
    bf16x8 At[4][2], B0[2][2], B1[2][2];
    const char* cA = (const char*)g.A + (size_t)cur.ta * tstep; const char* cB = (const char*)g.Bt + (size_t)cur.tb * tstep;
    PG8_STAGE(PG8_SB(0, 0), cB); PG8_STAGE(PG8_SB(0, 1), cB + hstep); PG8_STAGE(PG8_SA(0, 0), cA); PG8_STAGE(PG8_SA(0, 1), cA + hstep);
    if (wr == 1) PG8_BAR;
    PG8_WAIT_V(2); PG8_BAR;
    PG8_STAGE(PG8_SB(1, 0), cB + kstep); PG8_STAGE(PG8_SA(1, 0), cA + kstep); PG8_STAGE(PG8_SB(1, 1), cB + hstep + kstep);
    PG8_WAIT_V(6); PG8_BAR;
    for (;;) {
        const bool has_next = S.next(ui + 1, nxt);
        const char* nA = has_next ? (const char*)g.A + (size_t)nxt.ta * tstep : cA; const char* nB = has_next ? (const char*)g.Bt + (size_t)nxt.tb * tstep : cB;
        for (int t = 0; t < nt; t += 2) {
            const bool last = (t == nt - 2);
            const char* a1 = cA + (size_t)(t + 1) * kstep;
            const char* a2 = last ? nA : cA + (size_t)(t + 2) * kstep; const char* b2 = last ? nB : cB + (size_t)(t + 2) * kstep;
            const char* a3 = a2 + kstep; const char* b3 = b2 + kstep;
            if constexpr (Epi::MID) { if (t != 0 && (t & 3) == 0) E.mid(acc, cur, t >> 2, wr, wc, fr, fq); }
            PG8_LDB(B0, 0, 0); PG8_LDB(B1, 0, 1); PG8_SCHED; PG8_LDA(At, 0, 0); PG8_STAGE(PG8_SA(1, 1), a1 + hstep);
            PG8_WAIT_V(8); PG8_WAIT_L(0); PG8_BAR; PG8_MMA(0, 0, At, B0); PG8_MMA(0, 1, At, B1); PG8_BAR; PG8_SCHED;
            PG8_LDA(At, 0, 1); PG8_STAGE(PG8_SB(0, 0), b2); PG8_STAGE(PG8_SB(0, 1), b2 + hstep); PG8_STAGE(PG8_SA(0, 0), a2);
            PG8_WAIT_V(8); PG8_WAIT_L(0); PG8_BAR; PG8_MMA(1, 0, At, B0); PG8_MMA(1, 1, At, B1); PG8_BAR; PG8_SCHED;
            PG8_LDB(B0, 1, 0); PG8_LDB(B1, 1, 1); PG8_SCHED; PG8_LDA(At, 1, 0); PG8_STAGE(PG8_SA(0, 1), a2 + hstep);
            PG8_WAIT_V(8); PG8_WAIT_L(0); PG8_BAR; PG8_MMA(0, 0, At, B0); PG8_MMA(0, 1, At, B1); PG8_BAR; PG8_SCHED;
            PG8_LDA(At, 1, 1); PG8_STAGE(PG8_SB(1, 0), b3); PG8_STAGE(PG8_SB(1, 1), b3 + hstep); PG8_STAGE(PG8_SA(1, 0), a3);
            PG8_WAIT_V(8); PG8_WAIT_L(0); PG8_BAR; PG8_MMA(1, 0, At, B0); PG8_MMA(1, 1, At, B1); PG8_BAR; PG8_SCHED;
        }
        if (wr == 0) PG8_BAR;
        E(acc, cur, wr, wc, fr, fq);
        if (!has_next) break;
#pragma unroll
        for (int a = 0; a < 2; ++a)
#pragma unroll
            for (int b = 0; b < 2; ++b)
#pragma unroll
                for (int m = 0; m < 4; ++m)
#pragma unroll
                    for (int n = 0; n < 2; ++n) acc[a][b][m][n] = (f32x4){0.f, 0.f, 0.f, 0.f};
        cur = nxt; cA = nA; cB = nB; ++ui;
        if (wr == 1) PG8_BAR;
    }
    PG8_WAIT_V(0);
    PG8_BAR;
#undef PG8_SA
#undef PG8_SB
#undef PG8_STAGE
#undef PG8_LDA
#undef PG8_LDB
#undef PG8_MMA
#undef PG8_WAIT_V
#undef PG8_WAIT_L
#undef PG8_BAR
#undef PG8_SCHED
}
#else
template <class Epi, class Sched> void gemm_phase(unsigned char* lds, const Gemm g, const Sched& S, const Epi& E);
#endif
}
typedef f32x4 AccT[2][2][4][2];

struct Ctx {
    const Params* p; Dims d; unsigned char* lds; int tid, lane, wave, G, vcu;
    template <class T> __device__ __forceinline__ T* ws(unsigned off) const { return (T*)(p->ws + ((size_t)off << 8)); }
    __device__ __forceinline__ const float* in(int i) const { return p->in[i]; }
    __device__ __forceinline__ int modrow(int tok) const { return tok < d.NTc ? 0 : 1 + (tok - d.NTc) / d.Tl; }
    __device__ __forceinline__ const float* mods(int l) const { return ws<float>(d.w_mods) + (size_t)l * (1 + d.Bl) * NMOD; }
    __device__ __forceinline__ float* X() const { return p->out; }
};

__device__ __forceinline__ Ctx fresh(const Ctx& c0) {
    Ctx c; c.p = c0.p; c.lds = c0.lds; c.tid = opqv(c0.tid); c.lane = c.tid & 63; c.wave = opqs(c0.wave); c.G = opqs(c0.G); c.vcu = opqs(c0.vcu);
    c.d = make_dims(opqs(c0.p->Bc), opqs(c0.p->Tc), opqs(c0.p->Bl), opqs(c0.p->Tl)); return c;
}

__device__ __forceinline__ u32x4 pk8(const f32x4 a, const f32x4 b) { u32x4 w; w.x = pk2(a[0], a[1]); w.y = pk2(a[2], a[3]); w.z = pk2(b[0], b[1]); w.w = pk2(b[2], b[3]); return w; }
struct EpiCols {
    static constexpr bool MID = false;
    bf16_t* cols; float* small; unsigned short* gates; float* onk; float* onv; int l, NTc, Tc;
    __device__ __forceinline__ void operator()(const AccT& acc, const pg8::Unit& u, int wr, int wc, int fr, int fq) const {
        const int row0 = u.pm * 256 + wr * 64 + fr, cw = wc * 32 + 8 * fq;
        if (u.pn < 14) {
            float* okv = u.pn == 12 ? onk : (u.pn == 13 ? onv : nullptr);
#pragma unroll
            for (int ai = 0; ai < 2; ++ai)
#pragma unroll
                for (int m = 0; m < 4; ++m) { const int row = row0 + ai * 128 + m * 16; bf16_t* rp = cols + (size_t)row * NCB + u.pn * 256 + cw;
#pragma unroll
                    for (int bj = 0; bj < 2; ++bj) { *(u32x4*)(rp + bj * 128) = pk8(acc[ai][bj][m][0], acc[ai][bj][m][1]);
                        if (okv && row < NTc) { const int cc = bj * 128 + cw, b = row / Tc, t = row - b * Tc; float* op = okv + ((((size_t)b * DEPTH + l) * NH + (cc >> 6)) * Tc + t) * HD + (cc & 63);
                            *(f32x4*)op = acc[ai][bj][m][0]; *(f32x4*)(op + 4) = acc[ai][bj][m][1]; } } }
        } else if (u.pn == 14) {
#pragma unroll
            for (int ai = 0; ai < 2; ++ai)
#pragma unroll
                for (int m = 0; m < 4; ++m) { float* rp = small + (size_t)(row0 + ai * 128 + m * 16) * NSM + cw;
#pragma unroll
                    for (int bj = 0; bj < 2; ++bj) { *(f32x4*)(rp + bj * 128) = acc[ai][bj][m][0]; *(f32x4*)(rp + bj * 128 + 4) = acc[ai][bj][m][1]; } }
        } else {
#pragma unroll
            for (int ai = 0; ai < 2; ++ai)
#pragma unroll
                for (int m = 0; m < 4; ++m) { unsigned short* rp = gates + (size_t)(row0 + ai * 128 + m * 16) * NGATE + (u.pn - 15) * 256 + cw;
#pragma unroll
                    for (int bj = 0; bj < 2; ++bj) { const f32x4 a = acc[ai][bj][m][0], b = acc[ai][bj][m][1]; u32x4 w;
                        w.x = pkh2(fmaxf(sigmoidf_(a[0]), 6.2e-5f), fmaxf(sigmoidf_(a[1]), 6.2e-5f)); w.y = pkh2(fmaxf(sigmoidf_(a[2]), 6.2e-5f), fmaxf(sigmoidf_(a[3]), 6.2e-5f));
                        w.z = pkh2(fmaxf(sigmoidf_(b[0]), 6.2e-5f), fmaxf(sigmoidf_(b[1]), 6.2e-5f)); w.w = pkh2(fmaxf(sigmoidf_(b[2]), 6.2e-5f), fmaxf(sigmoidf_(b[3]), 6.2e-5f));
                        *(u32x4*)(rp + bj * 128) = w; } }
        }
    }
};
struct EpiWiden {
    static constexpr bool MID = true;
    const unsigned short* gates; bf16_t* merged;
    __device__ __forceinline__ void mid(AccT& acc, const pg8::Unit& u, int z1, int wr, int wc, int fr, int fq) const {
        const int row0 = opqv(u.pm * 256 + wr * 64 + fr), col0 = opqv(u.pn * 256 + wc * 32 + 8 * fq);
#pragma unroll
        for (int ai = 0; ai < 2; ++ai)
#pragma unroll
            for (int m = 0; m < 4; ++m) { const unsigned short* rp = gates + (size_t)(row0 + ai * 128 + m * 16) * NGATE + col0;
#pragma unroll
                for (int bj = 0; bj < 2; ++bj) { const u32x4 a = *(const u32x4*)(rp + (z1 - 1) * 1024 + bj * 128), b = *(const u32x4*)(rp + z1 * 1024 + bj * 128);
                    f32x4 r0, r1; r0[0] = h2f(a.x & 0xffff) * frcp(h2f(b.x & 0xffff)); r0[1] = h2f(a.x >> 16) * frcp(h2f(b.x >> 16)); r0[2] = h2f(a.y & 0xffff) * frcp(h2f(b.y & 0xffff)); r0[3] = h2f(a.y >> 16) * frcp(h2f(b.y >> 16));
                    r1[0] = h2f(a.z & 0xffff) * frcp(h2f(b.z & 0xffff)); r1[1] = h2f(a.z >> 16) * frcp(h2f(b.z >> 16)); r1[2] = h2f(a.w & 0xffff) * frcp(h2f(b.w & 0xffff)); r1[3] = h2f(a.w >> 16) * frcp(h2f(b.w >> 16));
                    acc[ai][bj][m][0] *= r0; acc[ai][bj][m][1] *= r1;
#ifndef CPU_EMU
                    asm volatile("" ::: "memory");
#endif
                } }
    }
    __device__ __forceinline__ void operator()(const AccT& acc, const pg8::Unit& u, int wr, int wc, int fr, int fq) const {
        const int row0 = u.pm * 256 + wr * 64 + fr, col0 = u.pn * 256 + wc * 32 + 8 * fq;
#pragma unroll
        for (int ai = 0; ai < 2; ++ai)
#pragma unroll
            for (int m = 0; m < 4; ++m) { const size_t ro = (size_t)(row0 + ai * 128 + m * 16);
#pragma unroll
                for (int bj = 0; bj < 2; ++bj) { const u32x4 b = *(const u32x4*)(gates + ro * NGATE + 3 * 1024 + col0 + bj * 128); f32x4 a0 = acc[ai][bj][m][0], a1 = acc[ai][bj][m][1];
                    a0[0] *= h2f(b.x & 0xffff); a0[1] *= h2f(b.x >> 16); a0[2] *= h2f(b.y & 0xffff); a0[3] *= h2f(b.y >> 16); a1[0] *= h2f(b.z & 0xffff); a1[1] *= h2f(b.z >> 16); a1[2] *= h2f(b.w & 0xffff); a1[3] *= h2f(b.w >> 16);
                    *(u32x4*)(merged + ro * D + col0 + bj * 128) = pk8(a0, a1); } }
    }
};
struct EpiPreLN {
    static constexpr bool MID = false;
    const float* x; const float* mods; float* v; int NTc, Tl;
    __device__ __forceinline__ void operator()(const AccT& acc, const pg8::Unit& u, int wr, int wc, int fr, int fq) const {
        const int row0 = u.pm * 256 + wr * 64 + fr, col0 = u.pn * 256 + wc * 32 + 8 * fq;
#pragma unroll
        for (int ai = 0; ai < 2; ++ai)
#pragma unroll
            for (int m = 0; m < 4; ++m) { const int row = row0 + ai * 128 + m * 16; const int mr = row < NTc ? 0 : 1 + (row - NTc) / Tl; const float* g1 = mods + (size_t)mr * NMOD + 2 * D + col0;
                const size_t ro = (size_t)row * D + col0;
#pragma unroll
                for (int bj = 0; bj < 2; ++bj)
#pragma unroll
                    for (int n = 0; n < 2; ++n) { const int o = bj * 128 + n * 4; const f32x4 xv = *(const f32x4*)(x + ro + o), gv = *(const f32x4*)(g1 + o);
                        *(f32x4*)(v + ro + o) = ALPHA * xv + gv * acc[ai][bj][m][n]; } }
    }
};
struct EpiSwiGLU {
    static constexpr bool MID = false;
    bf16_t* act;
    __device__ __forceinline__ void operator()(const AccT& acc, const pg8::Unit& u, int wr, int wc, int fr, int fq) const {
        const int row0 = u.pm * 256 + wr * 64 + fr, col0 = u.pn * 128 + wc * 32 + 8 * fq;
#pragma unroll
        for (int ai = 0; ai < 2; ++ai)
#pragma unroll
            for (int m = 0; m < 4; ++m) { bf16_t* rp = act + (size_t)(row0 + ai * 128 + m * 16) * FF + col0; f32x4 o[2];
#pragma unroll
                for (int n = 0; n < 2; ++n) { const f32x4 a = acc[ai][0][m][n], b = acc[ai][1][m][n]; o[n][0] = siluf_(a[0]) * b[0]; o[n][1] = siluf_(a[1]) * b[1]; o[n][2] = siluf_(a[2]) * b[2]; o[n][3] = siluf_(a[3]) * b[3]; }
                *(u32x4*)rp = pk8(o[0], o[1]); }
    }
};
struct EpiDown {
    static constexpr bool MID = false;
    const float* pgate; bf16_t* y;
    __device__ __forceinline__ void operator()(const AccT& acc, const pg8::Unit& u, int wr, int wc, int fr, int fq) const {
        const int row0 = u.pm * 256 + wr * 64 + fr, col0 = u.pn * 256 + wc * 32 + 8 * fq;
#pragma unroll
        for (int ai = 0; ai < 2; ++ai)
#pragma unroll
            for (int m = 0; m < 4; ++m) { const int row = row0 + ai * 128 + m * 16; const float gt = pgate[row]; bf16_t* rp = y + (size_t)row * D + col0;
#pragma unroll
                for (int bj = 0; bj < 2; ++bj) *(u32x4*)(rp + bj * 128) = pk8(gt * acc[ai][bj][m][0], gt * acc[ai][bj][m][1]); }
    }
};

template <class ColMap>
__device__ __forceinline__ void tr_item(const float* src, int src_ld, const ColMap& cm, bf16_t* dst, int dst_ld, int dst_koff, int n0, int k0, float* scr, int lane) {
    const int r = lane >> 4, c4 = (lane & 15) * 4; const int sc = cm(prow(n0 + c4));
    f32x4 v[16];
    UNR for (int i = 0; i < 16; ++i) v[i] = sc >= 0 ? *(const f32x4*)(src + (size_t)(k0 + i * 4 + r) * src_ld + sc) : (f32x4){0.f, 0.f, 0.f, 0.f};
    UNR for (int i = 0; i < 16; ++i) { float* p = scr + (i * 4 + r) * 65 + c4; p[0] = v[i][0]; p[1] = v[i][1]; p[2] = v[i][2]; p[3] = v[i][3]; }
    WAVE_SYNC();
    const int kc = lane & 7;
    UNR for (int j = 0; j < 8; ++j) { const int n = (lane >> 3) + 8 * j; const float* p = scr + (8 * kc) * 65 + n;
        u32x4 o; o.x = pk2(p[0 * 65], p[1 * 65]); o.y = pk2(p[2 * 65], p[3 * 65]); o.z = pk2(p[4 * 65], p[5 * 65]); o.w = pk2(p[6 * 65], p[7 * 65]);
        *(u32x4*)(dst + (size_t)(n0 + n) * dst_ld + dst_koff + k0 + 8 * kc) = o; }
    WAVE_SYNC();
}
struct CmId { __device__ __forceinline__ int operator()(int n) const { return n; } };
struct CmWin { __device__ __forceinline__ int operator()(int n) const { return win_col(n); } };
struct CmUp { __device__ __forceinline__ int operator()(int n) const { const int u = n >> 8, w = n & 255; return (w < 128 ? 0 : FF) + u * 128 + (w & 127); } };

__device__ __forceinline__ void phase_prep(const Ctx& c0) {
    const Ctx c = fresh(c0);
    const Dims& d = c.d;
    float* L = (float*)c.lds;
    const int nrow = 1 + d.Bl;
    const int gw = c.vcu * NWAVES + c.wave, NGW = c.G * NWAVES;
    const int nmod_items = DEPTH * (NMOD / 64);
    if (c.vcu < nmod_items) {
        const int l = c.vcu / (NMOD / 64), j = (c.vcu % (NMOD / 64)) * 64 + c.lane, kw = c.wave * 128;
        const float* w = c.in(I_WADA) + ((size_t)l * D + kw) * NMOD + j;
        float* cond = L + c.wave * 4160;
        for (int i = c.lane; i < 9 * 128; i += 64) { const int r = i >> 7, k = kw + (i & 127); const float v = r == 0 ? c.in(I_CCTX)[k] : (r < nrow ? c.in(I_C)[(size_t)(r - 1) * D + k] : 0.0f); cond[i] = siluf_(v); }
        WAVE_SYNC();
        float a[9];
        UNR for (int r = 0; r < 9; ++r) a[r] = 0.0f;
#pragma unroll 8
        for (int k = 0; k < 128; ++k) { const float wv = w[(size_t)k * NMOD]; UNR for (int r = 0; r < 9; ++r) a[r] += cond[r * 128 + k] * wv; }
        UNR for (int r = 0; r < 9; ++r) cond[1152 + r * 64 + c.lane] = a[r];
        __syncthreads();
        if (c.wave == 0) { const float bias = c.in(I_BADA)[(size_t)l * NMOD + j]; float* mo = c.ws<float>(d.w_mods) + (size_t)l * nrow * NMOD + j;
            UNR for (int r = 0; r < 9; ++r) { float t = bias; UNR for (int ww = 0; ww < 8; ++ww) t += L[ww * 4160 + 1152 + r * 64 + c.lane]; if (r < nrow) mo[(size_t)r * NMOD] = t; } }
        __syncthreads();
    }
    float* scr = L + c.wave * 4160;
    const int I_IN = (D / 64) * (NINP / 64), I_BR = 4 * (MIXW / 64) * (D / 64), I_OUT = (D / 64) * (D / 64), I_UP = NEXP * (D / 64) * (2 * FF / 64), I_DN = NEXP * (FF / 64) * (D / 64);
    const int PER_L = I_IN + I_BR + I_OUT + I_UP + I_DN;
    for (int it = gw; it < DEPTH * PER_L; it += NGW) {
        const int l = it / PER_L; int r = it % PER_L;
        if (r < I_IN) { const int nb = NINP / 64, kb = r / nb, n0 = (r % nb) * 64;
            tr_item(c.in(I_WIN) + (size_t)l * D * NIN, NIN, CmWin(), c.ws<bf16_t>(d.w_win) + (size_t)l * NINP * D, D, 0, n0, kb * 64, scr, c.lane); continue; } r -= I_IN;
        if (r < I_BR) { const int per = (MIXW / 64) * (D / 64), z = r / per, q = r % per, kb = q / (D / 64), n0 = (q % (D / 64)) * 64;
            tr_item(c.in(I_WBR) + ((size_t)l * 4 + z) * MIXW * D, D, CmId(), c.ws<bf16_t>(d.w_wbr) + (size_t)l * D * D, D, z * MIXW, n0, kb * 64, scr, c.lane); continue; } r -= I_BR;
        if (r < I_OUT) { const int kb = r / (D / 64), n0 = (r % (D / 64)) * 64;
            tr_item(c.in(I_WOUT) + (size_t)l * D * D, D, CmId(), c.ws<bf16_t>(d.w_wout) + (size_t)l * D * D, D, 0, n0, kb * 64, scr, c.lane); continue; } r -= I_OUT;
        if (r < I_UP) { const int per = (D / 64) * (2 * FF / 64), e = r / per, q = r % per, kb = q / (2 * FF / 64), n0 = (q % (2 * FF / 64)) * 64;
            tr_item(c.in(I_WUP) + ((size_t)l * NEXP + e) * D * 2 * FF, 2 * FF, CmUp(), c.ws<bf16_t>(d.w_wup) + ((size_t)l * NEXP + e) * 2 * FF * D, D, 0, n0, kb * 64, scr, c.lane); continue; } r -= I_UP;
        { const int per = (FF / 64) * (D / 64), e = r / per, q = r % per, kb = q / (D / 64), n0 = (q % (D / 64)) * 64;
            tr_item(c.in(I_WDOWN) + ((size_t)l * NEXP + e) * FF * D, D, CmId(), c.ws<bf16_t>(d.w_wdn) + ((size_t)l * NEXP + e) * D * FF, FF, 0, n0, kb * 64, scr, c.lane); }
    }
}

__device__ __forceinline__ void phase_init(const Ctx& c0) {
    const Ctx c = fresh(c0);
    const Dims& d = c.d; const float* mods = c.mods(0); bf16_t* hb = c.ws<bf16_t>(d.w_hb);
    const int gw = c.vcu * NWAVES + c.wave, NGW = c.G * NWAVES;
    for (int tok = gw; tok < d.NT; tok += NGW) {
        const float* xr = tok < d.NTc ? c.in(I_XP) + (size_t)tok * D : c.in(I_XS) + (size_t)(tok - d.NTc) * D;
        const float* mr = mods + (size_t)c.modrow(tok) * NMOD;
#pragma unroll
        for (int j = 0; j < 4; ++j) { const int col = 4 * c.lane + 256 * j; const f32x4 x = *(const f32x4*)(xr + col), sh = *(const f32x4*)(mr + col), sc = *(const f32x4*)(mr + D + col);
            *(f32x4*)(c.X() + (size_t)tok * D + col) = x; const f32x4 h = x * (1.0f + sc) + sh;
            u32x2 w; w.x = pk2(h[0], h[1]); w.y = pk2(h[2], h[3]); *(u32x2*)(hb + (size_t)tok * D + col) = w; }
    }
}

__device__ __forceinline__ f32x16 mm32(int lane, f32x16 acc, const float* A, int sai, int sak, const float* Bm, int sbk, int sbj, int K) {
    const int i = lane & 31, kk = lane >> 5;
    const float* ap = A + i * sai + kk * sak; const float* bp = Bm + kk * sbk + i * sbj;
#pragma unroll 8
    for (int k = 0; k < K; k += 2) acc = __builtin_amdgcn_mfma_f32_32x32x2f32(ap[k * sak], bp[k * sbk], acc, 0, 0, 0);
    return acc;
}
#define ACC_ROW(r, lane) (((r) & 3) + 8 * ((r) >> 2) + 4 * ((lane) >> 5))
__device__ __forceinline__ f32x16 zero16() { f32x16 z; UNR for (int r = 0; r < 16; ++r) z[r] = 0.0f; return z; }
constexpr int S65 = 65, MSZ = 64 * 65;

__device__ __forceinline__ void build_rope(float* cosT, float* sinT, int tid) {
    for (int i = tid; i < 1024; i += NTHREADS) { const int pos = i >> 4, f = i & 15; const float inv = powf(10000.0f, -(float)f / 16.0f); const float ang = (float)pos * inv; cosT[i] = cosf(ang); sinT[i] = sinf(ang); }
}
__device__ __forceinline__ float rope_elem(const float* rowp, int dd, int t, const float* cosT, const float* sinT) {
    const int f = dd & 15, second = (dd >> 4) & 1, pos = (dd < 32) ? (t / GRIDW) : (t % GRIDW);
    const float x = rowp[dd], xp = rowp[second ? dd - 16 : dd + 16], cs = cosT[pos * 16 + f], sn = sinT[pos * 16 + f];
    return second ? (xp * sn + x * cs) : (x * cs - xp * sn);
}

constexpr int SL_MF = 0, SL_MB = 1, SL_GF = 2, SL_GB = 3, SL_RF = 4, SL_RB = 5, SL_RBONUS = 6, NSLOT = 7;

struct ChunkRegs { u32x4 q, qp, k, kp, v; };
__device__ __forceinline__ float bfel(const u32x4 w, int e) { const unsigned x = w[e >> 1]; return (e & 1) ? bfhi(x) : bflo(x); }
__device__ __forceinline__ void chunk_load(ChunkRegs& R, const bf16_t* cols, size_t tok0, int T, int dir, int ci, int h, int cbq, int tid) {
    const int j = tid >> 3, g = tid & 7, t = dir ? T - 1 - (ci * 64 + j) : ci * 64 + j; const bf16_t* rp = cols + (tok0 + t) * NCB + cbq * 256 + h * 64;
    R.q = *(const u32x4*)(rp + 8 * g); R.qp = *(const u32x4*)(rp + 8 * (g ^ 2)); R.k = *(const u32x4*)(rp + 256 + 8 * g); R.kp = *(const u32x4*)(rp + 256 + 8 * (g ^ 2)); R.v = *(const u32x4*)(rp + 512 + 8 * g);
}
__device__ __forceinline__ void chunk_store(const ChunkRegs& R, float* Q, float* K, float* V, int T, int dir, int ci, int pass, float qs, float ks, const float* cosT, const float* sinT, int tid) {
    const int j = tid >> 3, g = tid & 7, t = dir ? T - 1 - (ci * 64 + j) : ci * 64 + j, second = (g >> 1) & 1, pos = g < 4 ? (t / GRIDW) : (t % GRIDW), o = j * S65 + 8 * g;
    UNR for (int e = 0; e < 8; ++e) { float q = bfel(R.q, e), k = bfel(R.k, e);
        if (pass) { const float qp = bfel(R.qp, e), kp = bfel(R.kp, e), cs = cosT[pos * 16 + 8 * (g & 1) + e], sn = sinT[pos * 16 + 8 * (g & 1) + e];
            q = second ? qp * sn + q * cs : q * cs - qp * sn; k = second ? kp * sn + k * cs : k * cs - kp * sn; }
        Q[o + e] = q * qs; K[o + e] = k * ks; V[o + e] = bfel(R.v, e); }
}

__device__ __forceinline__ void mix_mlstm(const Ctx& c0, int l, int pass, int b, int h, int dir) {
    const Ctx c = fresh(c0);
    const Dims& d = c.d; const int T = pass ? d.Tl : d.Tc, nc = T / 64, tid = c.tid, lane = c.lane, wave = c.wave; const size_t tok0 = pass ? d.NTc + (size_t)b * d.Tl : (size_t)b * d.Tc;
    float* L = (float*)c.lds;
    float *Q = L, *K = L + MSZ, *V = L + 2 * MSZ, *C = L + 3 * MSZ, *Sm = L + 4 * MSZ, *QC = L + 5 * MSZ, *vec = L + 6 * MSZ;
    float *nv = vec, *ig = vec + 64, *lf = vec + 128, *bc = vec + 192, *lw = vec + 256, *wint = vec + 320, *rden = vec + 384, *scal = vec + 448, *npart = vec + 512, *cosT = vec + 1024, *sinT = vec + 2048;
    const bf16_t* cols = c.ws<bf16_t>(d.w_cols); const float* small = c.ws<float>(d.w_small); float* scr = c.ws<float>(d.w_scr);
    __syncthreads();
    if (pass) build_rope(cosT, sinT, tid);
    if (pass) { const float* C0 = c.in(I_SC) + ((((size_t)b * DEPTH + l) * 2 + dir) * NH + h) * HD * HD;
        _Pragma("unroll 2") for (int i = tid; i < 4096; i += NTHREADS) C[(i >> 6) * S65 + (i & 63)] = C0[i];
        if (tid < 64) nv[tid] = c.in(I_SN)[((((size_t)b * DEPTH + l) * 2 + dir) * NH + h) * HD + tid];
        if (tid == 0) scal[0] = c.in(I_SM)[(((size_t)b * DEPTH + l) * 2 + dir) * NH + h];
    } else { _Pragma("unroll 2") for (int i = tid; i < 4096; i += NTHREADS) C[(i >> 6) * S65 + (i & 63)] = 0.0f; if (tid < 64) nv[tid] = 0.0f; if (tid == 0) scal[0] = 0.0f; }
    const float big = c.in(I_BIG)[((size_t)l * 2 + dir) * NH + h], bfg = c.in(I_BFG)[((size_t)l * 2 + dir) * NH + h];
    ChunkRegs R; float rig = 0.0f, rlf = 0.0f;
    chunk_load(R, cols, tok0, T, dir, 0, h, CB_MQ, tid);
    if (tid < 64) { const int t = dir ? T - 1 - tid : tid; const float* rp = small + (tok0 + t) * NSM; rig = rp[SM_MI + dir * 4 + h]; rlf = rp[SM_MF + dir * 4 + h]; }
    __syncthreads();
    chunk_store(R, Q, K, V, T, dir, 0, pass, 1.0f, 0.125f, cosT, sinT, tid);
    if (tid < 64) { ig[tid] = rig + big; lf[tid] = logsigmoidf_(rlf + bfg); }
    for (int ci = 0; ci < nc; ++ci) {
        if (ci + 1 < nc) {
            chunk_load(R, cols, tok0, T, dir, ci + 1, h, CB_MQ, tid);
            if (tid < 64) { const int t = dir ? T - 1 - ((ci + 1) * 64 + tid) : (ci + 1) * 64 + tid; const float* rp = small + (tok0 + t) * NSM; rig = rp[SM_MI + dir * 4 + h]; rlf = rp[SM_MF + dir * 4 + h]; }
        }
        __syncthreads();
        if (wave == 0) { float run = lf[lane];
            UNR for (int o = 1; o < 64; o <<= 1) { const float up = __shfl(run, lane >= o ? lane - o : lane); run += lane >= o ? up : 0.0f; }
            const float bend = __shfl(run, 63), m = scal[0], w = bend - run + ig[lane]; float mx = w;
            mx = fmaxf(mx, x1(mx)); mx = fmaxf(mx, x2(mx)); mx = fmaxf(mx, x4m(mx)); mx = fmaxf(mx, x8m(mx)); mx = fmaxf(mx, __shfl_xor(mx, 16)); mx = fmaxf(mx, __shfl_xor(mx, 32));
            const float mnew = fmaxf(bend + m, mx); bc[lane] = run; lw[lane] = w; if (lane == 0) { scal[1] = mnew; scal[2] = fexp(bend + m - mnew); } }
        { const int ti = (wave >> 1) & 1, tj = wave & 1; f32x16 acc = zero16();
          if (wave < 4) { acc = mm32(lane, acc, Q + ti * 32 * S65, S65, 1, K + tj * 32 * S65, 1, S65, 64); UNR for (int r = 0; r < 16; ++r) Sm[(ti * 32 + ACC_ROW(r, lane)) * S65 + tj * 32 + (lane & 31)] = acc[r]; }
          else { acc = mm32(lane, acc, Q + ti * 32 * S65, S65, 1, C + tj * 32, S65, 1, 64); UNR for (int r = 0; r < 16; ++r) QC[(ti * 32 + ACC_ROW(r, lane)) * S65 + tj * 32 + (lane & 31)] = acc[r]; } }
        __syncthreads();
        { const int t = tid >> 3, g = tid & 7; const float m = scal[0], mnew = scal[1], bt = bc[t]; float mx = -3.0e38f;
          UNR for (int e = 0; e < 8; ++e) { const int s = g * 8 + e; if (s <= t) mx = fmaxf(mx, bt - bc[s] + ig[s]); }
          mx = fmaxf(mx, x1(mx)); mx = fmaxf(mx, x2(mx)); mx = fmaxf(mx, x4m(mx));
          const float minter = bt + m, mt = fmaxf(minter, mx); float den = 0.0f, qn = 0.0f;
          UNR for (int e = 0; e < 8; ++e) { const int s = g * 8 + e; float sv = 0.0f; if (s <= t) sv = Sm[t * S65 + s] * fexp(bt - bc[s] + ig[s] - mt); Sm[t * S65 + s] = sv; den += sv; qn += Q[t * S65 + s] * nv[s]; }
          den += x1(den); den += x2(den); den += x4m(den); qn += x1(qn); qn += x2(qn); qn += x4m(qn);
          const float wi = fexp(minter - mt); den += wi * qn;
          if (g == 0) { wint[t] = wi; rden[t] = 1.0f / fmaxf(fabsf(den), fexp(-mt)); }
          const float ks = fexp(lw[t] - mnew); UNR for (int e = 0; e < 8; ++e) K[t * S65 + g * 8 + e] *= ks; }
        __syncthreads();
        { const int ti = (wave >> 1) & 1, tj = wave & 1;
          if (wave < 4) { f32x16 acc = zero16(); acc = mm32(lane, acc, Sm + ti * 32 * S65, S65, 1, V + tj * 32, S65, 1, 64);
              UNR for (int r = 0; r < 16; ++r) { const int row = ti * 32 + ACC_ROW(r, lane), o = row * S65 + tj * 32 + (lane & 31); QC[o] = (acc[r] + wint[row] * QC[o]) * rden[row]; } }
          else { const float carry = scal[2]; f32x16 acc; UNR for (int r = 0; r < 16; ++r) acc[r] = carry * C[(ti * 32 + ACC_ROW(r, lane)) * S65 + tj * 32 + (lane & 31)];
              acc = mm32(lane, acc, K + ti * 32, 1, S65, V + tj * 32, S65, 1, 64);
              UNR for (int r = 0; r < 16; ++r) C[(ti * 32 + ACC_ROW(r, lane)) * S65 + tj * 32 + (lane & 31)] = acc[r]; }
          float s = 0.0f; UNR for (int e = 0; e < 8; ++e) s += K[(wave * 8 + e) * S65 + lane]; npart[wave * 64 + lane] = s; }
        __syncthreads();
        if (tid < 64) { float s = 0.0f; UNR for (int e = 0; e < 8; ++e) s += npart[e * 64 + tid]; nv[tid] = scal[2] * nv[tid] + s; }
        { const int j = tid >> 3, g = tid & 7, t = dir ? T - 1 - (ci * 64 + j) : ci * 64 + j; float* sp = scr + ((tok0 + t) * NSLOT + (dir ? SL_MB : SL_MF)) * MIXW + h * 64 + g * 8; const float* hp = QC + j * S65 + g * 8;
          *(f32x4*)sp = (f32x4){hp[0], hp[1], hp[2], hp[3]}; *(f32x4*)(sp + 4) = (f32x4){hp[4], hp[5], hp[6], hp[7]}; }
        if (ci + 1 < nc) { chunk_store(R, Q, K, V, T, dir, ci + 1, pass, 1.0f, 0.125f, cosT, sinT, tid); if (tid < 64) { ig[tid] = rig + big; lf[tid] = logsigmoidf_(rlf + bfg); } }
        if (tid == 0) scal[0] = scal[1];
    }
    __syncthreads();
    if (!pass) {
        float* Co = c.p->out + d.o_C + ((((size_t)b * DEPTH + l) * 2 + dir) * NH + h) * HD * HD;
        _Pragma("unroll 2") for (int i = tid; i < 4096; i += NTHREADS) Co[i] = C[(i >> 6) * S65 + (i & 63)];
        if (tid < 64) c.p->out[d.o_n + ((((size_t)b * DEPTH + l) * 2 + dir) * NH + h) * HD + tid] = nv[tid];
        if (tid == 0) c.p->out[d.o_m + (((size_t)b * DEPTH + l) * 2 + dir) * NH + h] = scal[0];
    }
    __syncthreads();
}

__device__ __forceinline__ void mix_gla(const Ctx& c0, int l, int pass, int b, int h, int dir) {
    const Ctx c = fresh(c0);
    const Dims& d = c.d; const int T = pass ? d.Tl : d.Tc, nc = T / 64, tid = c.tid, lane = c.lane, wave = c.wave; const size_t tok0 = pass ? d.NTc + (size_t)b * d.Tl : (size_t)b * d.Tc;
    float* L = (float*)c.lds;
    float *Q = L, *K = L + MSZ, *V = L + 2 * MSZ, *S = L + 3 * MSZ, *Gm = L + 4 * MSZ, *O2 = L + 5 * MSZ, *vec = L + 6 * MSZ;
    float *gend = vec, *bA = vec + 64, *gpart = vec + 128, *GA = vec + 640, *wA = vec + 640 + 1024, *cosT = vec + 640 + 2048, *sinT = vec + 640 + 3072;
    const bf16_t* cols = c.ws<bf16_t>(d.w_cols); const float* small = c.ws<float>(d.w_small); float* scr = c.ws<float>(d.w_scr);
    __syncthreads();
    if (pass) build_rope(cosT, sinT, tid);
    if (pass) { const float* S0 = c.in(I_SG) + ((((size_t)b * DEPTH + l) * 2 + dir) * NH + h) * HD * HD; _Pragma("unroll 2") for (int i = tid; i < 4096; i += NTHREADS) S[(i >> 6) * S65 + (i & 63)] = S0[i]; }
    else { _Pragma("unroll 2") for (int i = tid; i < 4096; i += NTHREADS) S[(i >> 6) * S65 + (i & 63)] = 0.0f; }
    for (int i = tid; i < 1024; i += NTHREADS) wA[i] = c.in(I_WGLA)[(((size_t)l * 2 + dir) * 16 + (i >> 6)) * MIXW + h * 64 + (i & 63)];
    if (tid < 64) bA[tid] = c.in(I_BGLA)[((size_t)l * 2 + dir) * MIXW + h * 64 + tid];
    ChunkRegs R; f32x4 rga = (f32x4){0.f, 0.f, 0.f, 0.f};
    chunk_load(R, cols, tok0, T, dir, 0, h, CB_GQ, tid);
    if (tid < 256) { const int j = tid >> 2, t = dir ? T - 1 - j : j; rga = *(const f32x4*)(small + (tok0 + t) * NSM + SM_GA + dir * 16 + (tid & 3) * 4); }
    __syncthreads();
    chunk_store(R, Q, K, V, T, dir, 0, pass, 0.125f, 1.0f, cosT, sinT, tid);
    if (tid < 256) *(f32x4*)(GA + (tid >> 2) * 16 + (tid & 3) * 4) = rga;
    for (int ci = 0; ci < nc; ++ci) {
        if (ci + 1 < nc) {
            chunk_load(R, cols, tok0, T, dir, ci + 1, h, CB_GQ, tid);
            if (tid < 256) { const int j = tid >> 2, t = dir ? T - 1 - ((ci + 1) * 64 + j) : (ci + 1) * 64 + j; rga = *(const f32x4*)(small + (tok0 + t) * NSM + SM_GA + dir * 16 + (tid & 3) * 4); }
        }
        __syncthreads();
        float gl[8];
        { float run = 0.0f;
          UNR for (int e = 0; e < 8; ++e) { const float* ga = GA + (wave * 8 + e) * 16; float a = bA[lane];
              UNR for (int r = 0; r < 16; ++r) a += ga[r] * wA[r * 64 + lane];
              run += logsigmoidf_(a) * (1.0f / 16.0f); gl[e] = run; }
          gpart[wave * 64 + lane] = run; }
        __syncthreads();
        { float pre = 0.0f; UNR for (int e = 0; e < 8; ++e) pre += (e < wave) ? gpart[e * 64 + lane] : 0.0f;
          UNR for (int e = 0; e < 8; ++e) { const float g = gl[e] + pre; const int o = (wave * 8 + e) * S65 + lane; Q[o] *= fexp(g); K[o] *= fexp(-g); if (wave == 7 && e == 7) gend[lane] = g; } }
        __syncthreads();
        { const int ti = (wave >> 1) & 1, tj = wave & 1; f32x16 acc = zero16();
          if (wave < 4) { acc = mm32(lane, acc, Q + ti * 32 * S65, S65, 1, K + tj * 32 * S65, 1, S65, 64);
              UNR for (int r = 0; r < 16; ++r) { const int row = ti * 32 + ACC_ROW(r, lane), col = tj * 32 + (lane & 31); Gm[row * S65 + col] = col <= row ? acc[r] : 0.0f; } }
          else { acc = mm32(lane, acc, Q + ti * 32 * S65, S65, 1, S + tj * 32, S65, 1, 64); UNR for (int r = 0; r < 16; ++r) O2[(ti * 32 + ACC_ROW(r, lane)) * S65 + tj * 32 + (lane & 31)] = acc[r]; } }
        __syncthreads();
        { const int ti = (wave >> 1) & 1, tj = wave & 1;
          if (wave < 4) { f32x16 acc; UNR for (int r = 0; r < 16; ++r) acc[r] = O2[(ti * 32 + ACC_ROW(r, lane)) * S65 + tj * 32 + (lane & 31)];
              acc = mm32(lane, acc, Gm + ti * 32 * S65, S65, 1, V + tj * 32, S65, 1, 64);
              UNR for (int r = 0; r < 16; ++r) O2[(ti * 32 + ACC_ROW(r, lane)) * S65 + tj * 32 + (lane & 31)] = acc[r]; }
          else { f32x16 acc; UNR for (int r = 0; r < 16; ++r) acc[r] = S[(ti * 32 + ACC_ROW(r, lane)) * S65 + tj * 32 + (lane & 31)];
              acc = mm32(lane, acc, K + ti * 32, 1, S65, V + tj * 32, S65, 1, 64);
              UNR for (int r = 0; r < 16; ++r) { const int row = ti * 32 + ACC_ROW(r, lane); S[row * S65 + tj * 32 + (lane & 31)] = fexp(gend[row]) * acc[r]; } } }
        __syncthreads();
        { const int j = tid >> 3, g = tid & 7, t = dir ? T - 1 - (ci * 64 + j) : ci * 64 + j; float* sp = scr + ((tok0 + t) * NSLOT + (dir ? SL_GB : SL_GF)) * MIXW + h * 64 + g * 8; const float* hp = O2 + j * S65 + g * 8;
          *(f32x4*)sp = (f32x4){hp[0], hp[1], hp[2], hp[3]}; *(f32x4*)(sp + 4) = (f32x4){hp[4], hp[5], hp[6], hp[7]}; }
        if (ci + 1 < nc) { chunk_store(R, Q, K, V, T, dir, ci + 1, pass, 0.125f, 1.0f, cosT, sinT, tid); if (tid < 256) *(f32x4*)(GA + (tid >> 2) * 16 + (tid & 3) * 4) = rga; }
    }
    __syncthreads();
    if (!pass) { float* So = c.p->out + d.o_g + ((((size_t)b * DEPTH + l) * 2 + dir) * NH + h) * HD * HD; _Pragma("unroll 2") for (int i = tid; i < 4096; i += NTHREADS) So[i] = S[(i >> 6) * S65 + (i & 63)]; }
    __syncthreads();
}

#define RW_LOAD(i_, R_, K_, W_, A_, H_, v_) do { const float* Pi_ = buf + (i_) * VST + q * 16; \
    UNR for (int u_ = 0; u_ < 4; ++u_) { R_[u_] = *(const f32x4*)(Pi_ + 4 * u_); K_[u_] = *(const f32x4*)(Pi_ + 64 + 4 * u_); W_[u_] = *(const f32x4*)(Pi_ + 192 + 4 * u_); \
        A_[u_] = *(const f32x4*)(Pi_ + 256 + 4 * u_); H_[u_] = *(const f32x4*)(Pi_ + 320 + 4 * u_); } v_ = buf[(i_) * VST + 128 + vrow]; } while (0)
#define RW_STEP(R_, K_, W_, A_, H_, v_) do { f32x4 d_ = Sv[0] * K_[0]; d_ += Sv[1] * K_[1]; d_ += Sv[2] * K_[2]; d_ += Sv[3] * K_[3]; \
    const float sk_ = quad_sum((d_[0] + d_[1]) + (d_[2] + d_[3])); f32x4 y_ = (f32x4){0.f, 0.f, 0.f, 0.f}; \
    UNR for (int u_ = 0; u_ < 4; ++u_) { Sv[u_] = Sv[u_] * W_[u_] - sk_ * A_[u_] + v_ * H_[u_]; y_ += Sv[u_] * R_[u_]; } \
    const float yy_ = quad_sum((y_[0] + y_[1]) + (y_[2] + y_[3])); if (q == 0) *yp = yy_; yp += ystep; } while (0)
__device__ __forceinline__ void mix_rwkv(const Ctx& c0, int l, int pass, int b, int h, int dir) {
    const Ctx c = fresh(c0);
    const Dims& d = c.d; const int T = pass ? d.Tl : d.Tc, tid = c.tid, lane = c.lane, wave = c.wave; const size_t tok0 = pass ? d.NTc + (size_t)b * d.Tl : (size_t)b * d.Tc;
    float* L = (float*)c.lds;
    const bf16_t* cols = c.ws<bf16_t>(d.w_cols); const float* small = c.ws<float>(d.w_small); float* scr = c.ws<float>(d.w_scr);
    constexpr int TB = 32, VST = 6 * 64;
    float *VEC = L, *LWA = L + 2 * TB * VST, *STG = LWA + 2 * 2 * TB * 64;
    const int nb = T / TB;
    __syncthreads();
    if (wave < 4) {
        const int vrow = tid >> 2, q = tid & 3;
        f32x4 Sv[4];
        if (pass) { const float* S0 = c.in(I_SR) + ((((size_t)b * DEPTH + l) * 2 + dir) * NH + h) * HD * HD + vrow * 64 + q * 16; UNR for (int u = 0; u < 4; ++u) Sv[u] = *(const f32x4*)(S0 + 4 * u); }
        else { UNR for (int u = 0; u < 4; ++u) Sv[u] = (f32x4){0.f, 0.f, 0.f, 0.f}; }
        float* yp = scr + ((tok0 + (dir ? T - 1 : 0)) * NSLOT + (dir ? SL_RB : SL_RF)) * MIXW + h * 64 + vrow; const long ystep = dir ? -(long)(NSLOT * MIXW) : (long)(NSLOT * MIXW);
        __syncthreads(); __syncthreads();
        for (int jb = 0; jb < nb; ++jb) {
            const float* buf = VEC + (jb & 1) * TB * VST;
            f32x4 aR[4], aK[4], aW[4], aA[4], aH[4], bR[4], bK[4], bW[4], bA[4], bH[4]; float av, bv;
            RW_LOAD(0, aR, aK, aW, aA, aH, av);
#pragma unroll 1
            for (int i = 0; i < TB; i += 2) {
                RW_LOAD(i + 1, bR, bK, bW, bA, bH, bv);
                RW_STEP(aR, aK, aW, aA, aH, av);
                if (i + 2 < TB) RW_LOAD(i + 2, aR, aK, aW, aA, aH, av);
                RW_STEP(bR, bK, bW, bA, bH, bv);
            }
            __syncthreads();
        }
        if (!pass) { float* So = c.p->out + d.o_r + ((((size_t)b * DEPTH + l) * 2 + dir) * NH + h) * HD * HD + vrow * 64 + q * 16; UNR for (int u = 0; u < 4; ++u) *(f32x4*)(So + 4 * u) = Sv[u]; }
    } else {
        const int pw = wave - 4, kind = pw >> 1, tj = pw & 1, ch = h * 64 + lane;
        float* stg = STG + pw * (32 * 33);
        float bw[16];
        { const float* Wg = c.in(kind ? I_WA2 : I_WW2) + ((size_t)l * 2 + dir) * 32 * MIXW + h * 64 + tj * 32 + (lane & 31);
          UNR for (int ks = 0; ks < 16; ++ks) bw[ks] = Wg[(size_t)(2 * ks + (lane >> 5)) * MIXW]; }
        const float* tp = c.in(I_SHIFT) + (size_t)l * 3 * 768 + ch;
        const float t0r = tp[0], t1r = tp[768], t2r = tp[1536], t0k = tp[256], t1k = tp[768 + 256], t2k = tp[1536 + 256], t0v = tp[512], t1v = tp[768 + 512], t2v = tp[1536 + 512];
        const float w0c = c.in(I_W0)[((size_t)l * 2 + dir) * MIXW + ch], a0c = c.in(I_A0)[((size_t)l * 2 + dir) * MIXW + ch], kkc = c.in(I_KK)[(size_t)l * MIXW + ch], kac = c.in(I_KA)[(size_t)l * MIXW + ch], rkc = c.in(I_RKK)[(size_t)l * MIXW + ch];
        for (int jb = -2; jb < nb; ++jb) {
            const int mB = jb + 1, mA = jb + 2;
            float xr[10], xk[10], xv[10];
            const int pi0 = mB * TB + pw * 8, tlo = dir ? T - 1 - (pi0 + 7) : pi0;
            if (mB >= 0 && mB < nb) {
                UNR for (int e = 0; e < 10; ++e) { const int tt = tlo - 1 + e; const bool ok = tt >= 0 && tt < T; const bf16_t* rp = cols + (tok0 + (ok ? tt : 0)) * NCB + ch;
                    xr[e] = ok ? bf2f(rp[CB_RR * 256]) : 0.0f; xk[e] = ok ? bf2f(rp[CB_RK * 256]) : 0.0f; xv[e] = ok ? bf2f(rp[CB_RV * 256]) : 0.0f; }
            }
            if (mA < nb) {
                float xs[16];
                UNR for (int e = 0; e < 16; ++e) { const int idx = e * 64 + lane, stp = idx >> 5, r = idx & 31, pi = mA * TB + stp, t = dir ? T - 1 - pi : pi; xs[e] = small[(tok0 + t) * NSM + (kind ? SM_RA : SM_RW) + dir * 32 + r]; }
                UNR for (int e = 0; e < 16; ++e) { const int idx = e * 64 + lane; stg[(idx >> 5) * 33 + (idx & 31)] = kind ? xs[e] : tanhf_(xs[e]); }
                WAVE_SYNC();
                f32x16 acc = zero16(); const float* ap = stg + (lane & 31) * 33 + (lane >> 5);
                UNR for (int ks = 0; ks < 16; ++ks) acc = __builtin_amdgcn_mfma_f32_32x32x2f32(ap[2 * ks], bw[ks], acc, 0, 0, 0);
                float* lo = LWA + (((mA & 1) * 2 + kind) * TB) * 64 + tj * 32 + (lane & 31);
                UNR for (int r = 0; r < 16; ++r) lo[ACC_ROW(r, lane) * 64] = acc[r];
                WAVE_SYNC();
            }
            if (mB >= 0 && mB < nb) {
                float* buf = VEC + (mB & 1) * TB * VST; const float* lwp = LWA + (((mB & 1) * 2 + 0) * TB) * 64 + lane; const float* lap = LWA + (((mB & 1) * 2 + 1) * TB) * 64 + lane;
                UNR for (int s = 0; s < 8; ++s) {
                    const float r = t0r * (dir ? xr[7 - s] : xr[s]) + t1r * (dir ? xr[8 - s] : xr[s + 1]) + t2r * (dir ? xr[9 - s] : xr[s + 2]);
                    const float k = t0k * (dir ? xk[7 - s] : xk[s]) + t1k * (dir ? xk[8 - s] : xk[s + 1]) + t2k * (dir ? xk[9 - s] : xk[s + 2]);
                    const float v = t0v * (dir ? xv[7 - s] : xv[s]) + t1v * (dir ? xv[8 - s] : xv[s + 1]) + t2v * (dir ? xv[9 - s] : xv[s + 2]);
                    const float lw = lwp[(pw * 8 + s) * 64], la = lap[(pw * 8 + s) * 64];
                    const float decay = fexp(-fexp(-softplusf_(-(w0c + lw)) - 0.5f)), a = sigmoidf_(a0c + la);
                    float kap = k * kkc; const float ss = wave_sum(kap * kap); kap *= frsq(ss + LN_EPS);
                    const float khat = k * (1.0f + (a - 1.0f) * kac);
                    float* P = buf + (pw * 8 + s) * VST + lane;
                    P[0] = r; P[64] = kap; P[128] = v; P[192] = decay; P[256] = a * kap; P[320] = khat;
                    if (dir == 0) { const float bonus = wave_sum(r * k * rkc) * v; scr[((tok0 + pi0 + s) * NSLOT + SL_RBONUS) * MIXW + ch] = bonus; }
                }
            }
            __syncthreads();
        }
    }
    __syncthreads();
}
#undef RW_LOAD
#undef RW_STEP

__device__ __forceinline__ void phase_combine(const Ctx& c0, int l) {
    const Ctx c = fresh(c0);
    const Dims& d = c.d; const int tid = c.tid, lane = c.lane, wave = c.wave;
    float* L = (float*)c.lds; float *SG = L, *G2 = L + MSZ, *GT = L + MSZ + 64 * 256;
    const bf16_t* cols = c.ws<bf16_t>(d.w_cols); const float* small = c.ws<float>(d.w_small); const float* scr = c.ws<float>(d.w_scr); bf16_t* br = c.ws<bf16_t>(d.w_br);
    __syncthreads();
    for (int i = tid; i < 64 * 256; i += NTHREADS) G2[i] = c.in(I_WG2)[(size_t)l * 64 * MIXW + i];
    for (int blk = c.vcu; blk < d.NT / 64; blk += c.G) {
        const size_t tb = (size_t)blk * 64;
        __syncthreads();
        { const int j = tid >> 3, g = tid & 7; const float* rp = small + (tb + j) * NSM + SM_RG + g * 8; const f32x4 a = *(const f32x4*)rp, b2 = *(const f32x4*)(rp + 4); float* sp = SG + j * S65 + g * 8;
          sp[0] = sigmoidf_(a[0]); sp[1] = sigmoidf_(a[1]); sp[2] = sigmoidf_(a[2]); sp[3] = sigmoidf_(a[3]); sp[4] = sigmoidf_(b2[0]); sp[5] = sigmoidf_(b2[1]); sp[6] = sigmoidf_(b2[2]); sp[7] = sigmoidf_(b2[3]); }
        __syncthreads();
        UNR for (int u = 0; u < 2; ++u) { const int tl = wave * 2 + u, ti = tl >> 3, tj = tl & 7; f32x16 acc = zero16();
            acc = mm32(lane, acc, SG + ti * 32 * S65, S65, 1, G2 + tj * 32, 256, 1, 64);
            UNR for (int r = 0; r < 16; ++r) GT[(ti * 32 + ACC_ROW(r, lane)) * 257 + tj * 32 + (lane & 31)] = acc[r]; }
        __syncthreads();
        for (int hh = 0; hh < NH; ++hh) {
            const int j = tid >> 3, g = tid & 7; const size_t tok = tb + j; const int cb = hh * 64 + g * 8; const float* sp = scr + tok * NSLOT * MIXW + cb;
            {
              const f32x4 a0 = *(const f32x4*)(sp + SL_MF * MIXW), a1 = *(const f32x4*)(sp + SL_MF * MIXW + 4), b0 = *(const f32x4*)(sp + SL_MB * MIXW), b1 = *(const f32x4*)(sp + SL_MB * MIXW + 4);
              float x[8]; float s = 0.0f; UNR for (int e = 0; e < 4; ++e) { x[e] = a0[e] + b0[e]; x[4 + e] = a1[e] + b1[e]; } UNR for (int e = 0; e < 8; ++e) s += x[e];
              s += x1(s); s += x2(s); s += x4m(s); const float mean = s * (1.0f / 64.0f); float qv = 0.0f;
              UNR for (int e = 0; e < 8; ++e) { x[e] -= mean; qv += x[e] * x[e]; }
              qv += x1(qv); qv += x2(qv); qv += x4m(qv); const float rs = frsq(qv * (1.0f / 64.0f) + LN_EPS);
              const u32x4 ow = *(const u32x4*)(cols + tok * NCB + CB_MO * 256 + cb); const f32x4 o0 = (f32x4){bflo(ow.x), bfhi(ow.x), bflo(ow.y), bfhi(ow.y)}, o1 = (f32x4){bflo(ow.z), bfhi(ow.z), bflo(ow.w), bfhi(ow.w)};
              u32x4 w; w.x = pk2(x[0] * rs * sigmoidf_(o0[0]), x[1] * rs * sigmoidf_(o0[1])); w.y = pk2(x[2] * rs * sigmoidf_(o0[2]), x[3] * rs * sigmoidf_(o0[3]));
              w.z = pk2(x[4] * rs * sigmoidf_(o1[0]), x[5] * rs * sigmoidf_(o1[1])); w.w = pk2(x[6] * rs * sigmoidf_(o1[2]), x[7] * rs * sigmoidf_(o1[3])); *(u32x4*)(br + tok * D + 0 * MIXW + cb) = w; }
            {
              const f32x4 a0 = *(const f32x4*)(sp + SL_GF * MIXW), a1 = *(const f32x4*)(sp + SL_GF * MIXW + 4), b0 = *(const f32x4*)(sp + SL_GB * MIXW), b1 = *(const f32x4*)(sp + SL_GB * MIXW + 4);
              float x[8]; float qv = 0.0f; UNR for (int e = 0; e < 4; ++e) { x[e] = a0[e] + b0[e]; x[4 + e] = a1[e] + b1[e]; } UNR for (int e = 0; e < 8; ++e) qv += x[e] * x[e];
              qv += x1(qv); qv += x2(qv); qv += x4m(qv); const float rs = frsq(qv * (1.0f / 64.0f) + LN_EPS);
              const u32x4 ow = *(const u32x4*)(cols + tok * NCB + CB_GG * 256 + cb); const f32x4 o0 = (f32x4){bflo(ow.x), bfhi(ow.x), bflo(ow.y), bfhi(ow.y)}, o1 = (f32x4){bflo(ow.z), bfhi(ow.z), bflo(ow.w), bfhi(ow.w)};
              u32x4 w; w.x = pk2(x[0] * rs * siluf_(o0[0]), x[1] * rs * siluf_(o0[1])); w.y = pk2(x[2] * rs * siluf_(o0[2]), x[3] * rs * siluf_(o0[3]));
              w.z = pk2(x[4] * rs * siluf_(o1[0]), x[5] * rs * siluf_(o1[1])); w.w = pk2(x[6] * rs * siluf_(o1[2]), x[7] * rs * siluf_(o1[3])); *(u32x4*)(br + tok * D + 1 * MIXW + cb) = w; }
            {
              const f32x4 a0 = *(const f32x4*)(sp + SL_RF * MIXW), a1 = *(const f32x4*)(sp + SL_RF * MIXW + 4), b0 = *(const f32x4*)(sp + SL_RB * MIXW), b1 = *(const f32x4*)(sp + SL_RB * MIXW + 4);
              const f32x4 n0 = *(const f32x4*)(sp + SL_RBONUS * MIXW), n1 = *(const f32x4*)(sp + SL_RBONUS * MIXW + 4);
              float x[8]; float s = 0.0f; UNR for (int e = 0; e < 4; ++e) { x[e] = a0[e] + b0[e]; x[4 + e] = a1[e] + b1[e]; } UNR for (int e = 0; e < 8; ++e) s += x[e];
              s += x1(s); s += x2(s); s += x4m(s); const float mean = s * (1.0f / 64.0f); float qv = 0.0f;
              UNR for (int e = 0; e < 8; ++e) { x[e] -= mean; qv += x[e] * x[e]; }
              qv += x1(qv); qv += x2(qv); qv += x4m(qv); const float rs = frsq(qv * (1.0f / 64.0f) + LN_EPS);
              const float* gp = GT + j * 257 + cb;
              u32x4 w; w.x = pk2((x[0] * rs + n0[0]) * gp[0], (x[1] * rs + n0[1]) * gp[1]); w.y = pk2((x[2] * rs + n0[2]) * gp[2], (x[3] * rs + n0[3]) * gp[3]);
              w.z = pk2((x[4] * rs + n1[0]) * gp[4], (x[5] * rs + n1[1]) * gp[5]); w.w = pk2((x[6] * rs + n1[2]) * gp[6], (x[7] * rs + n1[3]) * gp[7]); *(u32x4*)(br + tok * D + 2 * MIXW + cb) = w; }
        }
    }
    __syncthreads();
}

#ifndef CPU_EMU
__device__ __forceinline__ unsigned cvtpk(float lo, float hi) { unsigned r; asm("v_cvt_pk_bf16_f32 %0, %1, %2" : "=v"(r) : "v"(lo), "v"(hi)); return r; }
#else
inline unsigned cvtpk(float lo, float hi) { return pk2(lo, hi); }
#endif
__device__ __forceinline__ void mix_na(const Ctx& c0, int l, int pass, int b, int h, int qb) {
    const Ctx c = fresh(c0);
    const Dims& d = c.d; const int tid = c.tid, lane = c.lane, wave = c.wave; const size_t tok0 = pass ? d.NTc + (size_t)b * d.Tl : (size_t)b * d.Tc;
    constexpr int KST = 72, VST_ = 136;
    unsigned char* LB = c.lds;
    bf16_t* Kt = (bf16_t*)LB;
    bf16_t* Vt = (bf16_t*)(LB + 2 * 128 * KST * 2);
    float* rpbs = (float*)(LB + 2 * 128 * KST * 2 + 2 * 64 * VST_ * 2);
    float* Om = (float*)LB;
    float* Lm = Om + 8 * 32 * 64;
    const bf16_t* cols = c.ws<bf16_t>(d.w_cols); bf16_t* br = c.ws<bf16_t>(d.w_br);
    const int rows = d.Tl / GRIDW, kr = rows < 8 ? rows : 8; int rs = qb - kr / 2; rs = rs < 0 ? 0 : (rs > rows - kr ? rows - kr : rs);
    const int nloc = pass ? kr / 2 : 0, ntile = pass ? nloc + PAST / 128 : d.Tc / 128;
    const int qt = wave & 1, kq = wave >> 1, hh = lane >> 5, ql = lane & 31;
    __syncthreads();
    if (pass) for (int i = tid; i < 15 * 31; i += NTHREADS) rpbs[i] = c.in(I_RPB)[((size_t)l * NH + h) * 15 * 31 + i];
    bf16x8 qf[4];
    { const bf16_t* qp = cols + (tok0 + qb * 64 + qt * 32 + ql) * NCB + CB_NQ * 256 + h * 64 + 8 * hh;
      UNR for (int s4 = 0; s4 < 4; ++s4) qf[s4] = *(const bf16x8*)(qp + 16 * s4); }
    const int jp = tid >> 3, d8 = (tid & 7) * 8;
    u32x4 pk[2], pv[2];
#define NA_LOAD(kt_) do { UNR for (int u_ = 0; u_ < 2; ++u_) { const int j_ = 2 * jp + u_; \
        if (pass && (kt_) >= nloc) { const size_t o_ = ((((size_t)b * DEPTH + l) * NH + h) * PAST + ((kt_) - nloc) * 128 + j_) * HD + d8; const float* kp_ = c.in(I_CK) + o_; const float* vp_ = c.in(I_CV) + o_; \
            pk[u_] = pk8(*(const f32x4*)kp_, *(const f32x4*)(kp_ + 4)); pv[u_] = pk8(*(const f32x4*)vp_, *(const f32x4*)(vp_ + 4)); } \
        else { const size_t tk_ = pass ? tok0 + (size_t)(rs + 2 * (kt_) + (j_ >> 6)) * 64 + (j_ & 63) : tok0 + (kt_) * 128 + j_; const bf16_t* rp_ = cols + tk_ * NCB + h * 64 + d8; \
            pk[u_] = *(const u32x4*)(rp_ + CB_NK * 256); pv[u_] = *(const u32x4*)(rp_ + CB_NV * 256); } } } while (0)
#define NA_STORE(buf_) do { bf16_t* kb_ = Kt + (buf_) * 128 * KST; bf16_t* vb_ = Vt + (buf_) * 64 * VST_; \
        UNR for (int u_ = 0; u_ < 2; ++u_) *(u32x4*)(kb_ + (2 * jp + u_) * KST + d8) = pk[u_]; \
        UNR for (int e_ = 0; e_ < 8; ++e_) { const unsigned a_ = pv[0][e_ >> 1], b_ = pv[1][e_ >> 1]; \
            *(unsigned*)(vb_ + (d8 + e_) * VST_ + 2 * jp) = (e_ & 1) ? ((a_ >> 16) | (b_ & 0xffff0000u)) : ((a_ & 0xffffu) | (b_ << 16)); } } while (0)
    NA_LOAD(0);
    NA_STORE(0);
    f32x16 o0 = zero16(), o1 = zero16(); float lsum = 0.0f;
    __syncthreads();
    for (int kt = 0; kt < ntile; ++kt) {
        if (kt + 1 < ntile) NA_LOAD(kt + 1);
        const bf16_t* kb = Kt + (kt & 1) * 128 * KST + (32 * kq + ql) * KST + 8 * hh; const bf16_t* vb = Vt + (kt & 1) * 64 * VST_ + 32 * kq + 4 * hh;
        f32x16 sc = zero16();
        UNR for (int s4 = 0; s4 < 4; ++s4) sc = __builtin_amdgcn_mfma_f32_32x32x16_bf16(*(const bf16x8*)(kb + 16 * s4), qf[s4], sc, 0, 0, 0);
        if (pass && kt < nloc) {
            const int qc = 32 * qt + ql; int cs = qc - 8; cs = cs < 0 ? 0 : (cs > 48 ? 48 : cs);
            UNR for (int r = 0; r < 16; ++r) { const int jj = 32 * kq + ACC_ROW(r, lane), krow = rs + 2 * kt + (jj >> 6), kc = jj & 63; const bool ok = kc >= cs && kc < cs + 16;
                const float bias = rpbs[ok ? (krow - qb + 7) * 31 + (kc - qc + 15) : 0]; sc[r] = ok ? fexp(fminf(sc[r] * 0.125f + bias, 80.0f)) : 0.0f; }
        } else { UNR for (int r = 0; r < 16; ++r) sc[r] = fexp(fminf(sc[r] * 0.125f, 80.0f)); }
        UNR for (int r = 0; r < 16; ++r) lsum += sc[r];
        UNR for (int s2 = 0; s2 < 2; ++s2) { u32x4 w; w.x = cvtpk(sc[8 * s2], sc[8 * s2 + 1]); w.y = cvtpk(sc[8 * s2 + 2], sc[8 * s2 + 3]); w.z = cvtpk(sc[8 * s2 + 4], sc[8 * s2 + 5]); w.w = cvtpk(sc[8 * s2 + 6], sc[8 * s2 + 7]);
            const bf16x8 pf = __builtin_bit_cast(bf16x8, w);
            { const u32x2 v0 = *(const u32x2*)(vb + ql * VST_ + 16 * s2), v1 = *(const u32x2*)(vb + ql * VST_ + 16 * s2 + 8); u32x4 vw; vw.x = v0.x; vw.y = v0.y; vw.z = v1.x; vw.w = v1.y;
              o0 = __builtin_amdgcn_mfma_f32_32x32x16_bf16(pf, __builtin_bit_cast(bf16x8, vw), o0, 0, 0, 0); }
            { const u32x2 v0 = *(const u32x2*)(vb + (32 + ql) * VST_ + 16 * s2), v1 = *(const u32x2*)(vb + (32 + ql) * VST_ + 16 * s2 + 8); u32x4 vw; vw.x = v0.x; vw.y = v0.y; vw.z = v1.x; vw.w = v1.y;
              o1 = __builtin_amdgcn_mfma_f32_32x32x16_bf16(pf, __builtin_bit_cast(bf16x8, vw), o1, 0, 0, 0); } }
        if (kt + 1 < ntile) NA_STORE((kt + 1) & 1);
        __syncthreads();
    }
#undef NA_LOAD
#undef NA_STORE
    { float* om = Om + wave * 32 * 64; UNR for (int r = 0; r < 16; ++r) { om[ACC_ROW(r, lane) * 64 + ql] = o0[r]; om[ACC_ROW(r, lane) * 64 + 32 + ql] = o1[r]; }
      const float lt = lsum + __shfl_xor(lsum, 32); if (lane < 32) Lm[wave * 32 + lane] = lt; }
    __syncthreads();
    { const int q = tid >> 3, g = tid & 7, qt2 = q >> 5, q2 = q & 31; float ls = 0.0f; f32x4 a0 = (f32x4){0.f, 0.f, 0.f, 0.f}, a1 = a0;
      UNR for (int kq2 = 0; kq2 < 4; ++kq2) { const int w = kq2 * 2 + qt2; ls += Lm[w * 32 + q2]; const float* op = Om + w * 32 * 64 + q2 * 64 + g * 8; a0 += *(const f32x4*)op; a1 += *(const f32x4*)(op + 4); }
      const float il = 1.0f / ls; const size_t tok = tok0 + qb * 64 + q; bf16_t* bp = br + tok * D + 3 * MIXW + h * 64 + g * 8;
      u32x4 w; w.x = pk2(a0[0] * il, a0[1] * il); w.y = pk2(a0[2] * il, a0[3] * il); w.z = pk2(a1[0] * il, a1[1] * il); w.w = pk2(a1[2] * il, a1[3] * il); *(u32x4*)bp = w; }
    __syncthreads();
}

__device__ __forceinline__ void phase_mixers(const Ctx& c0, int l, int rep) {
    const Ctx c = fresh(c0);
    const Dims& d = c.d; const int rows = d.Tl / GRIDW;
    const int nL = d.Bl * NH, nC = d.Bc * NH, nNAl = nL * rows, nq = d.Tc / 64, nNAc = nC * nq, nR = 2 * (nL + nC);
    const int e0 = nR, e1 = e0 + nR, e2 = e1 + nR, e3 = e2 + nNAl + nNAc;
    unsigned* qctr = c.ws<unsigned>(c.d.w_ctl) + CW_QUEUE + 64 * (l + DEPTH * rep);
    int* slot = (int*)(c.lds + 163840 - 128);
#ifndef MIX_MASK
#define MIX_MASK 15
#endif
#ifndef MIX_DUP
#define MIX_DUP 15
#endif
#define MIX_FETCH() do { __syncthreads(); if (c.tid == 0) *slot = (int)atomicAdd(qctr, 1u); __syncthreads(); it = __builtin_amdgcn_readfirstlane(*slot); } while (0)
    int it; MIX_FETCH();
    while (it < e0) { const int r = it, ps = r < 2 * nL ? 1 : 0, q = ps ? r : r - 2 * nL; if ((MIX_MASK & 1) && (rep == 0 || (MIX_DUP & 1))) mix_rwkv(c, l, opqs(__builtin_amdgcn_readfirstlane(ps)), (q >> 1) / NH, (q >> 1) % NH, q & 1); MIX_FETCH(); }
    while (it < e1) { const int r = it - e0, ps = r < 2 * nL ? 1 : 0, q = ps ? r : r - 2 * nL; if ((MIX_MASK & 2) && (rep == 0 || (MIX_DUP & 2))) mix_mlstm(c, l, opqs(__builtin_amdgcn_readfirstlane(ps)), (q >> 1) / NH, (q >> 1) % NH, q & 1); MIX_FETCH(); }
    while (it < e2) { const int r = it - e1, ps = r < 2 * nL ? 1 : 0, q = ps ? r : r - 2 * nL; if ((MIX_MASK & 4) && (rep == 0 || (MIX_DUP & 4))) mix_gla(c, l, opqs(__builtin_amdgcn_readfirstlane(ps)), (q >> 1) / NH, (q >> 1) % NH, q & 1); MIX_FETCH(); }
    while (it < e3) { const int r = it - e2, ps = r < nNAl ? 1 : 0, q = ps ? r : r - nNAl, nr = ps ? rows : nq; if ((MIX_MASK & 8) && (rep == 0 || (MIX_DUP & 8))) mix_na(c, l, opqs(__builtin_amdgcn_readfirstlane(ps)), q / (NH * nr), (q / nr) % NH, q % nr); MIX_FETCH(); }
#undef MIX_FETCH
}

__device__ __forceinline__ void phase_ln1(const Ctx& c0, int l) {
    const Ctx c = fresh(c0);
    const Dims& d = c.d; const float* mods = c.mods(l); const float* v = c.ws<float>(d.w_v); bf16_t* hb = c.ws<bf16_t>(d.w_hb); float* aff = c.ws<float>(d.w_aff);
    const float* lg = c.in(I_LNG) + ((size_t)l * 2 + 0) * D; const float* lb = c.in(I_LNB) + ((size_t)l * 2 + 0) * D;
    constexpr int WRS = D + 4;
    float* WR = (float*)c.lds;
    __syncthreads();
    for (int i = c.tid; i < D * NEXP; i += NTHREADS) WR[(i & 15) * WRS + (i >> 4)] = c.in(I_WROUTER)[(size_t)l * D * NEXP + i];
    __syncthreads();
    f32x4 g4[4], b4[4];
#pragma unroll
    for (int j = 0; j < 4; ++j) { g4[j] = *(const f32x4*)(lg + 4 * c.lane + 256 * j); b4[j] = *(const f32x4*)(lb + 4 * c.lane + 256 * j); }
    for (int blk = c.vcu * NWAVES + c.wave; blk < d.NT / 8; blk += c.G * NWAVES) {
        const int tokb = blk * 8; const float* mr = mods + (size_t)c.modrow(tokb) * NMOD;
        f32x4 sh4[4], sc4[4], xn[4];
#pragma unroll
        for (int j = 0; j < 4; ++j) { sh4[j] = *(const f32x4*)(mr + 3 * D + 4 * c.lane + 256 * j); sc4[j] = *(const f32x4*)(mr + 4 * D + 4 * c.lane + 256 * j); xn[j] = *(const f32x4*)(v + (size_t)tokb * D + 4 * c.lane + 256 * j); }
        for (int ti = 0; ti < 8; ++ti) {
            const int tok = tokb + ti; f32x4 x[4]; float s = 0.0f;
#pragma unroll
            for (int j = 0; j < 4; ++j) { x[j] = xn[j]; s += (x[j][0] + x[j][1]) + (x[j][2] + x[j][3]); }
            if (ti + 1 < 8) {
#pragma unroll
                for (int j = 0; j < 4; ++j) xn[j] = *(const f32x4*)(v + (size_t)(tok + 1) * D + 4 * c.lane + 256 * j); }
            const float mean = wave_sum(s) * (1.0f / D); float q = 0.0f;
#pragma unroll
            for (int j = 0; j < 4; ++j) { x[j] = x[j] - mean; q += (x[j][0] * x[j][0] + x[j][1] * x[j][1]) + (x[j][2] * x[j][2] + x[j][3] * x[j][3]); }
            const float rstd = frsq(wave_sum(q) * (1.0f / D) + LN_EPS);
            f32x4 hh[4];
#pragma unroll
            for (int j = 0; j < 4; ++j) { const int col = 4 * c.lane + 256 * j; const f32x4 x1 = x[j] * rstd * g4[j] + b4[j]; *(f32x4*)(c.X() + (size_t)tok * D + col) = x1;
                hh[j] = x1 * (1.0f + sc4[j]) + sh4[j]; u32x2 w; w.x = pk2(hh[j][0], hh[j][1]); w.y = pk2(hh[j][2], hh[j][3]); *(u32x2*)(hb + (size_t)tok * D + col) = w; }
            float lg16[16];
#pragma unroll
            for (int e = 0; e < 16; ++e) { float a = 0.0f;
#pragma unroll
                for (int j = 0; j < 4; ++j) { const f32x4 wv = *(const f32x4*)(WR + e * WRS + 4 * c.lane + 256 * j); a += (hh[j][0] * wv[0] + hh[j][1] * wv[1]) + (hh[j][2] * wv[2] + hh[j][3] * wv[3]); }
                lg16[e] = a;
#ifndef CPU_EMU
                asm volatile("" ::: "memory");
#endif
            }
            float mx = -3.0e38f;
#pragma unroll
            for (int e = 0; e < 16; ++e) { lg16[e] = wave_sum(lg16[e]); mx = fmaxf(mx, lg16[e]); }
            float se = 0.0f;
#pragma unroll
            for (int e = 0; e < 16; ++e) { lg16[e] = expf(lg16[e] - mx); se += lg16[e]; }
            const float inv = 1.0f / se; float mine = 0.0f;
#pragma unroll
            for (int e = 0; e < 16; ++e) mine = (c.lane == e) ? lg16[e] * inv : mine;
            if (c.lane < 16) aff[(size_t)tok * NEXP + c.lane] = mine;
        }
    }
}

__device__ __forceinline__ void phase_select(const Ctx& c0) {
    const Ctx c = fresh(c0);
    const Dims& d = c.d; const float* aff = c.ws<float>(d.w_aff); int* inv = c.ws<int>(d.w_inv); float* pgate = c.ws<float>(d.w_pgate);
    const bf16_t* hb = c.ws<bf16_t>(d.w_hb); bf16_t* xe = c.ws<bf16_t>(d.w_xe);
    unsigned long long* KEY = (unsigned long long*)c.lds; int* sel = (int*)(KEY + 1024);
    const int nitems = (d.Bc + d.Bl) * NEXP;
    for (int it = c.vcu; it < nitems; it += c.G) {
        const int e = it % NEXP, bb = it / NEXP, pass = bb >= d.Bc, b = pass ? bb - d.Bc : bb, T = pass ? d.Tl : d.Tc, cap = pass ? d.capl : d.capc;
        const int tok0 = pass ? d.NTc + b * d.Tl : b * d.Tc, row0 = e * d.RPE + (pass ? d.Bc * d.capc + b * d.capl : b * d.capc);
        __syncthreads();
        for (int t = c.tid; t < T; t += NTHREADS) KEY[t] = ((unsigned long long)__builtin_bit_cast(unsigned, aff[(size_t)(tok0 + t) * NEXP + e]) << 32) | (unsigned)(~t);
        __syncthreads();
        { const int t0 = c.tid, t1 = c.tid + NTHREADS; const bool h0 = t0 < T, h1 = t1 < T; const unsigned long long k0 = h0 ? KEY[t0] : ~0ull, k1 = h1 ? KEY[t1] : ~0ull; int rank0 = 0, rank1 = 0;
#pragma unroll 4
          for (int s2 = 0; s2 < T; s2 += 2) { const unsigned long long o0 = KEY[s2], o1 = KEY[s2 + 1];
              rank0 += (o0 > k0 ? 1 : 0) + (o1 > k0 ? 1 : 0); rank1 += (o0 > k1 ? 1 : 0) + (o1 > k1 ? 1 : 0); }
          if (h0) { if (rank0 < cap) { sel[rank0] = t0; pgate[row0 + rank0] = __builtin_bit_cast(float, (unsigned)(k0 >> 32)); inv[(size_t)e * d.NT + tok0 + t0] = row0 + rank0; } else inv[(size_t)e * d.NT + tok0 + t0] = -1; }
          if (h1) { if (rank1 < cap) { sel[rank1] = t1; pgate[row0 + rank1] = __builtin_bit_cast(float, (unsigned)(k1 >> 32)); inv[(size_t)e * d.NT + tok0 + t1] = row0 + rank1; } else inv[(size_t)e * d.NT + tok0 + t1] = -1; } }
        __syncthreads();
        for (int r0 = c.wave * 4; r0 < cap; r0 += NWAVES * 4) {
            u32x4 v[4][2];
            UNR for (int u = 0; u < 4; ++u) { const int r = r0 + u < cap ? r0 + u : cap - 1; const u32x4* src = (const u32x4*)(hb + (size_t)(tok0 + sel[r]) * D); v[u][0] = src[c.lane]; v[u][1] = src[c.lane + 64]; }
            UNR for (int u = 0; u < 4; ++u) { if (r0 + u < cap) { u32x4* dst = (u32x4*)(xe + (size_t)(row0 + r0 + u) * D); dst[c.lane] = v[u][0]; dst[c.lane + 64] = v[u][1]; } }
        }
    }
}

__device__ __forceinline__ void phase_ln2(const Ctx& c0, int l) {
    const Ctx c = fresh(c0);
    const Dims& d = c.d; const float* mods = c.mods(l); const bf16_t* y = c.ws<bf16_t>(d.w_y); const int* inv = c.ws<int>(d.w_inv); bf16_t* hb = c.ws<bf16_t>(d.w_hb);
    const float* lg = c.in(I_LNG) + ((size_t)l * 2 + 1) * D; const float* lb = c.in(I_LNB) + ((size_t)l * 2 + 1) * D;
    const float* modn = (l + 1 < DEPTH) ? c.mods(l + 1) : nullptr;
    const int gw = c.vcu * NWAVES + c.wave, NGW = c.G * NWAVES;
    for (int tok = gw; tok < d.NT; tok += NGW) {
        const int mrow = c.modrow(tok); const float* mr = mods + (size_t)mrow * NMOD; f32x4 ff[4];
#pragma unroll
        for (int j = 0; j < 4; ++j) ff[j] = (f32x4){0.f, 0.f, 0.f, 0.f};
        for (int e = 0; e < NEXP; ++e) { const int row = inv[(size_t)e * d.NT + tok]; if (row >= 0) {
#pragma unroll
            for (int j = 0; j < 4; ++j) { const u32x2 w = *(const u32x2*)(y + (size_t)row * D + 4 * c.lane + 256 * j); ff[j] += (f32x4){bflo(w.x), bfhi(w.x), bflo(w.y), bfhi(w.y)}; } } }
        f32x4 x[4]; float s = 0.0f;
#pragma unroll
        for (int j = 0; j < 4; ++j) { const int col = 4 * c.lane + 256 * j; const f32x4 x1 = *(const f32x4*)(c.X() + (size_t)tok * D + col), g2 = *(const f32x4*)(mr + 5 * D + col);
            x[j] = ALPHA * x1 + g2 * ff[j]; s += (x[j][0] + x[j][1]) + (x[j][2] + x[j][3]); }
        const float mean = wave_sum(s) * (1.0f / D); float q = 0.0f;
#pragma unroll
        for (int j = 0; j < 4; ++j) { x[j] = x[j] - mean; q += (x[j][0] * x[j][0] + x[j][1] * x[j][1]) + (x[j][2] * x[j][2] + x[j][3] * x[j][3]); }
        const float rstd = frsq(wave_sum(q) * (1.0f / D) + LN_EPS);
#pragma unroll
        for (int j = 0; j < 4; ++j) { const int col = 4 * c.lane + 256 * j; const f32x4 g = *(const f32x4*)(lg + col), bb = *(const f32x4*)(lb + col);
            const f32x4 x2 = x[j] * rstd * g + bb; *(f32x4*)(c.X() + (size_t)tok * D + col) = x2;
            if (modn) { const float* mn = modn + (size_t)mrow * NMOD; const f32x4 sh = *(const f32x4*)(mn + col), sc = *(const f32x4*)(mn + D + col); const f32x4 hh = x2 * (1.0f + sc) + sh;
                u32x2 w; w.x = pk2(hh[0], hh[1]); w.y = pk2(hh[2], hh[3]); *(u32x2*)(hb + (size_t)tok * D + col) = w; } }
    }
}

constexpr int N_PHASES = 2 + 10 * DEPTH;
__device__ __forceinline__ void run_phase(const Ctx& c0, int ph, int rep) {
    const Ctx c = fresh(c0); const Dims& d = c.d;
#ifndef PHASE_MASK
#define PHASE_MASK 0xFFFF
#endif
    if (ph == 0) { if (PHASE_MASK & 0x400) phase_prep(c); return; }
    if (ph == 1) { if (PHASE_MASK & 0x800) phase_init(c); return; }
    const int l = (ph - 2) / 10, s = (ph - 2) % 10;
    LAS unsigned char* ldsp = (LAS unsigned char*)c.lds;
    if (!((PHASE_MASK >> s) & 1)) return;
    switch (s) {
    case 0: { pg8::Gemm g{c.ws<bf16_t>(d.w_hb), c.ws<bf16_t>(d.w_win) + (size_t)l * NINP * D, D}; pg8::StaticOrder S; S.init(d.NT, NINP, c.G, (int)blockIdx.x);
              EpiCols E{c.ws<bf16_t>(d.w_cols), c.ws<float>(d.w_small), c.ws<unsigned short>(d.w_gates), c.p->out + d.o_nk, c.p->out + d.o_nv, l, d.NTc, d.Tc}; pg8::gemm_phase<EpiCols, pg8::StaticOrder>(ldsp, g, S, E); } break;
    case 1: phase_mixers(c, l, rep); break;
    case 2: phase_combine(c, l); break;
    case 3: { pg8::Gemm g{c.ws<bf16_t>(d.w_br), c.ws<bf16_t>(d.w_wbr) + (size_t)l * D * D, D}; pg8::StaticOrder S; S.init(d.NT, D, c.G, (int)blockIdx.x);
              EpiWiden E{c.ws<unsigned short>(d.w_gates), c.ws<bf16_t>(d.w_merged)}; pg8::gemm_phase<EpiWiden, pg8::StaticOrder>(ldsp, g, S, E); } break;
    case 4: { pg8::Gemm g{c.ws<bf16_t>(d.w_merged), c.ws<bf16_t>(d.w_wout) + (size_t)l * D * D, D}; pg8::StaticOrder S; S.init(d.NT, D, c.G, (int)blockIdx.x);
              EpiPreLN E{c.X(), c.mods(l), c.ws<float>(d.w_v), d.NTc, d.Tl}; pg8::gemm_phase<EpiPreLN, pg8::StaticOrder>(ldsp, g, S, E); } break;
    case 5: phase_ln1(c, l); break;
    case 6: phase_select(c); break;
    case 7: { pg8::Gemm g{c.ws<bf16_t>(d.w_xe), c.ws<bf16_t>(d.w_wup) + (size_t)l * NEXP * 2 * FF * D, D}; pg8::GroupOrder S; S.init(d.TPE, 2 * FF / 256, NEXP, c.G, c.vcu);
              EpiSwiGLU E{c.ws<bf16_t>(d.w_act)}; pg8::gemm_phase<EpiSwiGLU, pg8::GroupOrder>(ldsp, g, S, E); } break;
    case 8: { pg8::Gemm g{c.ws<bf16_t>(d.w_act), c.ws<bf16_t>(d.w_wdn) + (size_t)l * NEXP * D * FF, FF}; pg8::GroupOrder S; S.init(d.TPE, D / 256, NEXP, c.G, c.vcu);
              EpiDown E{c.ws<float>(d.w_pgate), c.ws<bf16_t>(d.w_y)}; pg8::gemm_phase<EpiDown, pg8::GroupOrder>(ldsp, g, S, E); } break;
    default: phase_ln2(c, l); break;
    }
}

#ifndef CPU_EMU
#define XB_TMO      128
#define XB_XCNT(j)  (256  + 64 * (j))
#define XB_XSUB(j)  (1280 + 64 * (j))
#define XB_XGEN(j)  (2304 + 64 * (j))
#define XB_TOP      3328
#define XB_TOPGEN   3392
#define XB_SPIN_CAP (1u << 20)
__device__ __forceinline__ unsigned xb_ld(unsigned* p)              { return __hip_atomic_load(p, __ATOMIC_RELAXED, __HIP_MEMORY_SCOPE_AGENT); }
__device__ __forceinline__ unsigned xb_add(unsigned* p, unsigned v) { return __hip_atomic_fetch_add(p, v, __ATOMIC_RELAXED, __HIP_MEMORY_SCOPE_AGENT); }
__device__ __forceinline__ unsigned xb_xcc_id() { return (unsigned)__builtin_amdgcn_s_getreg((3 << 11) | 20) & 0xFu; }
#define XB_SPIN(cond, bar) do { unsigned _sp = 0; while (cond) { __builtin_amdgcn_s_sleep(1); \
    if ((++_sp & 255u) == 0u) { if (xb_ld(&(bar)[XB_TMO])) break; if (_sp > XB_SPIN_CAP) { atomicAdd(&(bar)[XB_TMO], 1u); break; } } } } while (0)
struct XcdBarrier { unsigned* bar; unsigned x; volatile LAS unsigned* st; };
__device__ __forceinline__ XcdBarrier xcd_barrier_post(unsigned* bar, volatile LAS unsigned* st) {
    XcdBarrier b; b.bar = bar; b.x = xb_xcc_id(); b.st = st;
    if (threadIdx.x == 0) (void)xb_add(&bar[XB_XCNT(b.x)], 1u);
    return b;
}
__device__ __forceinline__ void xcd_barrier_complete(unsigned* bar, unsigned x, unsigned& nloc, unsigned& nx) {
    const unsigned G = gridDim.x * gridDim.y * gridDim.z;
    unsigned sum, cnt, mine, sp = 0u;
    for (;;) {
        sum = 0u; cnt = 0u; mine = 0u;
#pragma unroll
        for (unsigned j = 0; j < 16; ++j) { const unsigned cc = xb_ld(&bar[XB_XCNT(j)]); sum += cc; cnt += (cc > 0u) ? 1u : 0u; mine = (j == x) ? cc : mine; }
        if (sum == G) break;
        __builtin_amdgcn_s_sleep(1);
        if ((++sp & 255u) == 0u) { if (xb_ld(&bar[XB_TMO])) break; if (sp > XB_SPIN_CAP) { atomicAdd(&bar[XB_TMO], 1u); break; } }
    }
    nloc = mine > 0u ? mine : 1u; nx = cnt > 0u ? cnt : 1u;
}
__device__ __forceinline__ void xcd_barrier(const XcdBarrier& b) {
    asm volatile("s_waitcnt vmcnt(0)" ::: "memory");
    __syncthreads();
    if (threadIdx.x == 0) {
        unsigned* bar = b.bar;
        __builtin_amdgcn_s_waitcnt(0);
        unsigned nloc = b.st[0], nx = b.st[1];
        if (nloc == 0u) { xcd_barrier_complete(bar, b.x, nloc, nx); b.st[0] = nloc; b.st[1] = nx; }
        const unsigned old = xb_add(&bar[XB_XSUB(b.x)], 1u);
        const unsigned gen = old / nloc;
        if (old + 1u == (gen + 1u) * nloc) {
            __builtin_amdgcn_fence(__ATOMIC_RELEASE, "agent");
            asm volatile("s_waitcnt vmcnt(0)" ::: "memory");
            const unsigned og = xb_add(&bar[XB_TOP], 1u);
            const unsigned tg = og / nx;
            if (og + 1u == (tg + 1u) * nx) xb_add(&bar[XB_TOPGEN], 1u);
            else XB_SPIN(xb_ld(&bar[XB_TOPGEN]) == tg, bar);
            __builtin_amdgcn_fence(__ATOMIC_ACQUIRE, "agent");
            xb_add(&bar[XB_XGEN(b.x)], 1u);
            asm volatile("s_waitcnt vmcnt(0)" ::: "memory");
        } else {
            XB_SPIN(xb_ld(&bar[XB_XGEN(b.x)]) == gen, bar);
            __builtin_amdgcn_fence(__ATOMIC_ACQUIRE, "agent");
            asm volatile("s_waitcnt vmcnt(0)" ::: "memory");
        }
    }
    __syncthreads();
}

#ifndef PROBE_DUP
#define PROBE_DUP 0
#endif
constexpr int LDS_BYTES = 163840;
__global__ void __launch_bounds__(NTHREADS, 2) trunk_fwd(Params p) {
    extern __shared__ __attribute__((aligned(16))) unsigned char lds[];
    Ctx c; c.p = &p; c.d = make_dims(p.Bc, p.Tc, p.Bl, p.Tl); c.lds = lds;
    c.tid = threadIdx.x; c.lane = c.tid & 63; c.wave = __builtin_amdgcn_readfirstlane(c.tid >> 6);
    c.G = gridDim.x; { const int bx = blockIdx.x; c.vcu = (c.G % 8 == 0) ? (bx % 8) * (c.G / 8) + bx / 8 : bx; }
    volatile LAS unsigned* st = (volatile LAS unsigned*)((LAS unsigned char*)lds + LDS_BYTES - 64);
    XcdBarrier bar; bar.bar = nullptr; bar.x = 0; bar.st = st;
    if (p.use_bar) { if (c.tid < 2) st[c.tid] = 0u; __syncthreads(); bar = xcd_barrier_post((unsigned*)(p.ws) + CW_BAR, st); }
    for (int ph = p.ph_lo; ph < p.ph_hi; ++ph) {
        run_phase(c, ph, 0);
#if PROBE_DUP
        { const int kind = ph == 0 ? 10 : (ph == 1 ? 11 : (ph - 2) % 10); if ((PROBE_DUP >> kind) & 1) { xcd_barrier(bar); run_phase(c, ph, 1); } }
#endif
        if (ph + 1 < p.ph_hi) xcd_barrier(bar);
    }
}

#ifndef N_LAUNCH_MODE
#define N_LAUNCH_MODE 1
#endif
extern "C" void kernel_launch(void* const* d_in, const int* in_sizes, int n_in, void* d_out, int out_size, void* d_ws, size_t ws_size, hipStream_t stream) {
    static int grid = 0;
    const Dims d = make_dims(32, 256, 8, 1024);
    if (grid == 0) {
        int dev = 0, cus = 0;
        if (n_in != N_INPUTS || (size_t)out_size != d.o_end || ws_size < ((size_t)d.w_end << 8)) { fprintf(stderr, "kernel_launch: unexpected sizes: n_in %d out %d ws %zu (need %zu / %zu)\n", n_in, out_size, ws_size, (size_t)d.o_end, (size_t)d.w_end << 8); grid = -1; return; }
        if (hipGetDevice(&dev) != hipSuccess || hipDeviceGetAttribute(&cus, hipDeviceAttributeMultiprocessorCount, dev) != hipSuccess) { grid = -1; return; }
        if (hipFuncSetAttribute((const void*)trunk_fwd, hipFuncAttributeMaxDynamicSharedMemorySize, LDS_BYTES) != hipSuccess) { fprintf(stderr, "kernel_launch: hipFuncSetAttribute failed\n"); grid = -1; return; }
        int per_cu = 0;
        if (hipOccupancyMaxActiveBlocksPerMultiprocessor(&per_cu, (const void*)trunk_fwd, NTHREADS, LDS_BYTES) != hipSuccess || per_cu < 1) fprintf(stderr, "kernel_launch: occupancy query says %d\n", per_cu);
        (void)hipGetLastError();
        grid = cus;
    }
    if (grid < 0) return;
    (void)hipMemsetAsync((char*)d_ws, 0, CTL_BYTES, stream);
    Params p{};
    for (int i = 0; i < N_INPUTS; ++i) p.in[i] = (const float*)d_in[i];
    p.out = (float*)d_out; p.ws = (unsigned char*)d_ws; p.Bc = 32; p.Tc = 256; p.Bl = 8; p.Tl = 1024;
#if N_LAUNCH_MODE == 1
    p.ph_lo = 0; p.ph_hi = N_PHASES; p.use_bar = 1;
    hipLaunchKernelGGL(trunk_fwd, dim3(grid), dim3(NTHREADS), LDS_BYTES, stream, p);
#else
    for (int ph = 0; ph < N_PHASES; ++ph) { p.ph_lo = ph; p.ph_hi = ph + 1; p.use_bar = 0; hipLaunchKernelGGL(trunk_fwd, dim3(grid), dim3(NTHREADS), LDS_BYTES, stream, p); }
#endif
}
#endif
```

```cpp
#ifndef CPU_EMU
#include <hip/hip_runtime.h>
#include <cstdio>
typedef float f32x16 __attribute__((ext_vector_type(16)));
typedef float f32x4 __attribute__((ext_vector_type(4)));
typedef float f32x2 __attribute__((ext_vector_type(2)));
typedef unsigned u32x4 __attribute__((ext_vector_type(4)));
typedef unsigned u32x2 __attribute__((ext_vector_type(2)));
#define LAS __attribute__((address_space(3)))
#define WAVE_SYNC() asm volatile("s_waitcnt lgkmcnt(0)" ::: "memory")
#else
#define LAS
#define WAVE_SYNC() emu::wave_sync()
#endif
#define UNR _Pragma("unroll")
typedef short bf16x8 __attribute__((ext_vector_type(8)));
typedef unsigned short bf16_t;

constexpr int D = 1024, NH = 4, HD = 64, MIXW = 256, NEXP = 16, FF = 2048, DEPTH = 2, PAST = 256, GRIDW = 64;
constexpr int NIN = 7920, NINP = 7936, NCB = 3584, NSM = 256, NGATE = 4096, NMOD = 6 * D;
constexpr float ALPHA = 1.4142135623730951f, LN_EPS = 1e-5f;
constexpr int NTHREADS = 512, NWAVES = 8;
constexpr int CB_MQ = 0, CB_MK = 1, CB_MV = 2, CB_MO = 3, CB_GQ = 4, CB_GK = 5, CB_GV = 6, CB_GG = 7, CB_RR = 8, CB_RK = 9, CB_RV = 10, CB_NQ = 11, CB_NK = 12, CB_NV = 13;
constexpr int SM_MI = 0, SM_MF = 8, SM_GA = 16, SM_RW = 48, SM_RA = 112, SM_RG = 176;
enum { I_XP = 0, I_XS, I_SC, I_SN, I_SM, I_SG, I_SR, I_CK, I_CV, I_C, I_CCTX, I_WADA, I_BADA, I_WIN, I_BIG, I_BFG, I_WGLA, I_BGLA, I_SHIFT, I_W0, I_WW2, I_A0, I_WA2, I_WG2, I_KK, I_KA, I_RKK,
       I_RPB, I_WBR, I_WOUT, I_LNG, I_LNB, I_WROUTER, I_WUP, I_WDOWN, N_INPUTS };

__host__ __device__ __forceinline__ int prow(int n) { const int rho = n & 31; return (n & ~31) + 8 * ((rho & 15) >> 2) + 4 * (rho >> 4) + (rho & 3); }
__host__ __device__ __forceinline__ int win_col(int p) {
    if (p < 3584) { const int b = p >> 8, w = p & 255; const int base = b < 4 ? b * 256 : (b < 8 ? 1040 + (b - 4) * 256 : (b < 11 ? 2096 + (b - 8) * 256 : 3056 + (b - 11) * 256)); return base + w; }
    if (p < 3840) { const int s = p - 3584; return s < 16 ? 1024 + s : (s < 48 ? 2064 + (s - 16) : (s < 240 ? 2864 + (s - 48) : -1)); }
    return p - 16;
}

struct Params {
    const float* in[N_INPUTS];
    float* out; unsigned char* ws;
    int Bc, Tc, Bl, Tl;
    int ph_lo, ph_hi;
    int use_bar, pad;
};
struct Dims {
    int Bc, Tc, Bl, Tl, NTc, NTl, NT, capc, capl, RPE, TPE, NPR;
    unsigned o_yp, o_ys, o_C, o_n, o_m, o_g, o_r, o_nk, o_nv, o_end;
    unsigned w_ctl, w_win, w_wbr, w_wout, w_wup, w_wdn, w_mods, w_hb, w_cols, w_small, w_gates, w_br, w_scr, w_merged, w_v, w_aff, w_inv, w_pgate, w_xe, w_act, w_y, w_end;
};
constexpr size_t CTL_BYTES = 1u << 20;
constexpr int CW_BAR = 4096, CW_QUEUE = 1024;
__host__ __device__ __forceinline__ unsigned al256(size_t x) { return (unsigned)((x + 255) >> 8); }
__host__ __device__ __forceinline__ Dims make_dims(int Bc, int Tc, int Bl, int Tl) {
    Dims d; d.Bc = Bc; d.Tc = Tc; d.Bl = Bl; d.Tl = Tl; d.NTc = Bc * Tc; d.NTl = Bl * Tl; d.NT = d.NTc + d.NTl;
    d.capc = Tc / 8; d.capl = Tl / 8; d.RPE = ((Bc * d.capc + Bl * d.capl + 255) / 256) * 256; d.TPE = d.RPE / 256; d.NPR = NEXP * d.RPE;
    unsigned o = 0; d.o_yp = o; o += (unsigned)d.NTc * D; d.o_ys = o; o += (unsigned)d.NTl * D;
    d.o_C = o; o += (unsigned)Bc * DEPTH * 2 * NH * HD * HD; d.o_n = o; o += (unsigned)Bc * DEPTH * 2 * NH * HD; d.o_m = o; o += (unsigned)Bc * DEPTH * 2 * NH;
    d.o_g = o; o += (unsigned)Bc * DEPTH * 2 * NH * HD * HD; d.o_r = o; o += (unsigned)Bc * DEPTH * 2 * NH * HD * HD;
    d.o_nk = o; o += (unsigned)Bc * DEPTH * NH * Tc * HD; d.o_nv = o; o += (unsigned)Bc * DEPTH * NH * Tc * HD; d.o_end = o;
    unsigned w = 0; d.w_ctl = w; w += (unsigned)(CTL_BYTES >> 8);
    d.w_win = w; w += al256((size_t)DEPTH * NINP * D * 2); d.w_wbr = w; w += al256((size_t)DEPTH * D * D * 2); d.w_wout = w; w += al256((size_t)DEPTH * D * D * 2);
    d.w_wup = w; w += al256((size_t)DEPTH * NEXP * 2 * FF * D * 2); d.w_wdn = w; w += al256((size_t)DEPTH * NEXP * D * FF * 2);
    d.w_mods = w; w += al256((size_t)DEPTH * (1 + Bl) * NMOD * 4);
    d.w_hb = w; w += al256((size_t)d.NT * D * 2); d.w_cols = w; w += al256((size_t)d.NT * NCB * 2); d.w_small = w; w += al256((size_t)d.NT * NSM * 4); d.w_gates = w; w += al256((size_t)d.NT * NGATE);
    d.w_br = w; w += al256((size_t)d.NT * D * 2); d.w_scr = w; w += al256((size_t)d.NT * 7 * MIXW * 4); d.w_merged = w; w += al256((size_t)d.NT * D * 2);
    d.w_v = w; w += al256((size_t)d.NT * D * 4); d.w_aff = w; w += al256((size_t)d.NT * NEXP * 4); d.w_inv = w; w += al256((size_t)d.NT * NEXP * 4);
    d.w_pgate = w; w += al256((size_t)d.NPR * 4); d.w_xe = w; w += al256((size_t)d.NPR * D * 2); d.w_act = w; w += al256((size_t)d.NPR * FF * 2); d.w_y = w; w += al256((size_t)d.NPR * D * 2);
    d.w_end = w; return d;
}

__device__ __forceinline__ unsigned f2bf(float f) { unsigned u = __builtin_bit_cast(unsigned, f); return (u + 0x7fffu + ((u >> 16) & 1u)) >> 16; }
#ifndef CPU_EMU
__device__ __forceinline__ unsigned cvtpk(float lo, float hi) { unsigned r; asm("v_cvt_pk_bf16_f32 %0, %1, %2" : "=v"(r) : "v"(lo), "v"(hi)); return r; }
__device__ __forceinline__ unsigned pk2(float lo, float hi) { return cvtpk(lo, hi); }
#else
inline unsigned pk2(float lo, float hi) { return f2bf(lo) | (f2bf(hi) << 16); }
inline unsigned cvtpk(float lo, float hi) { return pk2(lo, hi); }
#endif

#ifndef CPU_EMU
template <int CTRL> __device__ __forceinline__ float dppf(float v) { return __builtin_bit_cast(float, __builtin_amdgcn_update_dpp(0, __builtin_bit_cast(int, v), CTRL, 0xF, 0xF, true)); }
__device__ __forceinline__ float x1(float v) { return dppf<0xB1>(v); }
__device__ __forceinline__ float x2(float v) { return dppf<0x4E>(v); }
__device__ __forceinline__ float x4m(float v) { return dppf<0x141>(v); }
__device__ __forceinline__ float x8m(float v) { return dppf<0x140>(v); }
__device__ __forceinline__ float fexp(float x) { return __expf(x); }
__device__ __forceinline__ float flog(float x) { return __logf(x); }
__device__ __forceinline__ float frsq(float x) { return __builtin_amdgcn_rsqf(x); }
#else
inline float x1(float v) { return __shfl_xor(v, 1); }
inline float x2(float v) { return __shfl_xor(v, 2); }
inline float x4m(float v) { return __shfl_xor(v, 4); }
inline float x8m(float v) { return __shfl_xor(v, 8); }
inline float fexp(float x) { return expf(x); }
inline float flog(float x) { return logf(x); }
inline float frsq(float x) { return 1.0f / sqrtf(x); }
#endif
__device__ __forceinline__ float quad_sum(float v) { v += x1(v); v += x2(v); return v; }
__device__ __forceinline__ float oct_sum(float v) { v += x1(v); v += x2(v); v += x4m(v); return v; }
__device__ __forceinline__ float oct_max(float v) { v = fmaxf(v, x1(v)); v = fmaxf(v, x2(v)); v = fmaxf(v, x4m(v)); return v; }
__device__ __forceinline__ float sigmoidf_(float x) { return __builtin_amdgcn_rcpf(1.0f + fexp(-x)); }
__device__ __forceinline__ float logsigmoidf_(float x) { return fminf(x, 0.0f) - flog(1.0f + fexp(-fabsf(x))); }
__device__ __forceinline__ float softplusf_(float x) { return fmaxf(x, 0.0f) + flog(1.0f + fexp(-fabsf(x))); }
__device__ __forceinline__ float tanhf_(float x) { const float e = fexp(-2.0f * fabsf(x)); const float t = (1.0f - e) * __builtin_amdgcn_rcpf(1.0f + e); return x < 0.0f ? -t : t; }
__device__ __forceinline__ float siluf_(float x) { return x * __builtin_amdgcn_rcpf(1.0f + fexp(-x)); }
#ifndef CPU_EMU
__device__ __forceinline__ float rlane(float v, int l) { return __builtin_bit_cast(float, __builtin_amdgcn_readlane(__builtin_bit_cast(int, v), l)); }
__device__ __forceinline__ float wave_sum(float v) {
    v += x1(v); v += x2(v); v += x4m(v); v += x8m(v);
    return (rlane(v, 0) + rlane(v, 16)) + (rlane(v, 32) + rlane(v, 48));
}
#else
inline float wave_sum(float v) { for (int o = 1; o < 64; o <<= 1) v += __shfl_xor(v, o); return v; }
#endif
__device__ __forceinline__ unsigned pkh2(float a, float b) { const _Float16 x = (_Float16)a, y = (_Float16)b; return (unsigned)__builtin_bit_cast(unsigned short, x) | ((unsigned)__builtin_bit_cast(unsigned short, y) << 16); }
#ifndef CPU_EMU
__device__ __forceinline__ float frcp(float x) { return __builtin_amdgcn_rcpf(x); }
#else
inline float frcp(float x) { return 1.0f / x; }
#endif
__device__ __forceinline__ float bf2f(unsigned v) { return __builtin_bit_cast(float, v << 16); }
__device__ __forceinline__ float bflo(unsigned w) { return __builtin_bit_cast(float, w << 16); }
__device__ __forceinline__ float bfhi(unsigned w) { return __builtin_bit_cast(float, w & 0xffff0000u); }
__device__ __forceinline__ float h2f(unsigned short h) { return (float)__builtin_bit_cast(_Float16, h); }

#ifndef CPU_EMU
__device__ __forceinline__ int opqv(int x) { asm volatile("" : "+v"(x)); return x; }
__device__ __forceinline__ int opqs(int x) { asm volatile("" : "+s"(x)); return x; }
#else
inline int opqv(int x) { return x; }
inline int opqs(int x) { return x; }
#endif
namespace pg8 {
constexpr int BM = 256, BK = 64, HALF = 128, HTB = HALF * BK * 2, STAGE_BYTES = 8 * HTB, NXCD = 8, WGM = 8;
__host__ __device__ __forceinline__ int lds_byte(int r, int c) { const int st = (r >> 4) * 2 + (c >> 5), rr = r & 15, cc = c & 31, ob = rr * 64 + cc * 2; return st * 1024 + (ob ^ (((ob >> 9) & 1) << 5)); }
__host__ __device__ __forceinline__ void stage_rc(int b, int& R, int& C) { const int st = b / 1024, sb = b % 1024, swz = sb ^ (((sb >> 9) & 1) << 5); R = (st >> 1) * 16 + swz / 64; C = (st & 1) * 32 + (swz % 64) / 2; }
struct Unit { int pm, pn, ta, tb; };
struct Gemm { const bf16_t* A; const bf16_t* Bt; int K; };
struct StaticOrder {
    int nM, nN, nwg, G, c;
    __device__ __forceinline__ void init(int M, int N, int G_, int c_) { nM = M / BM; nN = N / BM; nwg = nM * nN; G = G_; c = c_; }
    __device__ __forceinline__ bool next(int i, Unit& u) const {
        const long L = (long)i * G + c; if (L >= nwg) return false;
        int wgid = (int)L; { const int q = nwg / NXCD, r = nwg % NXCD, xcd = wgid % NXCD, off = wgid / NXCD; wgid = (xcd < r ? xcd * (q + 1) : r * (q + 1) + (xcd - r) * q) + off; }
        const int nig = WGM * nN, gid = wgid / nig, fm = gid * WGM, gsz = (nM - fm) < WGM ? (nM - fm) : WGM;
        u.pm = fm + ((wgid % nig) % gsz); u.pn = (wgid % nig) / gsz; u.ta = u.pm; u.tb = u.pn; return true;
    }
};
struct GroupOrder {
    int tpe, nN, nE, G, c;
    __device__ __forceinline__ void init(int tpe_, int nN_, int nE_, int G_, int c_) { tpe = tpe_; nN = nN_; nE = nE_; G = G_; c = c_; }
    __device__ __forceinline__ bool next(int i, Unit& u) const {
        const long L = (long)i * G + c; if (L >= (long)nE * tpe * nN) return false;
        const int per = tpe * nN, e = (int)(L / per), r = (int)(L % per), pn = r / tpe, pm = r % tpe;
        u.ta = e * tpe + pm; u.tb = e * nN + pn; u.pm = u.ta; u.pn = pn; return true;
    }
};
#ifndef CPU_EMU
template <class Epi, class Sched>
__device__ __forceinline__ void gemm_phase(LAS unsigned char* lds, const Gemm g, const Sched& S, const Epi& E) {
    const int tid = opqv((int)threadIdx.x), wid = __builtin_amdgcn_readfirstlane(tid >> 6), lane = tid & 63, wr = wid >> 2, wc = wid & 3, fr = lane & 15, fq = lane >> 4;
    const int K = g.K, nt = K / BK;
    unsigned voffA[2];
#pragma unroll
    for (int i = 0; i < 2; ++i) { int R, C; stage_rc(tid * 16 + i * 8192, R, C); voffA[i] = (unsigned)(R * K + C) * 2u; }
    const size_t kstep = (size_t)(BK * 2), hstep = (size_t)HALF * K * 2, tstep = 2 * hstep;
    const unsigned ldsw = (unsigned)wid * 1024u;
    const int aoff = lds_byte(wr * 64 + fr, fq * 8), boff = lds_byte(wc * 32 + fr, fq * 8);
#define PG8_SA(b, h) (((b) * 2 + (h)) * HTB)
#define PG8_SB(b, h) ((4 + (b) * 2 + (h)) * HTB)
#define PG8_STAGE(bufoff, gbase) do { _Pragma("unroll") for (int _i = 0; _i < 2; ++_i) \
        __builtin_amdgcn_global_load_lds((const unsigned*)((const char*)(gbase) + voffA[_i]), (LAS unsigned*)(lds + (bufoff) + ldsw + _i * 8192), 16, 0, 0); } while (0)
#define PG8_LDA(dst, b, h) do { _Pragma("unroll") for (int m = 0; m < 4; ++m) _Pragma("unroll") for (int k = 0; k < 2; ++k) dst[m][k] = *(const LAS bf16x8*)(lds + PG8_SA(b, h) + aoff + m * 2048 + k * 1024); } while (0)
#define PG8_LDB(dst, b, h) do { _Pragma("unroll") for (int n = 0; n < 2; ++n) _Pragma("unroll") for (int k = 0; k < 2; ++k) dst[n][k] = *(const LAS bf16x8*)(lds + PG8_SB(b, h) + boff + n * 2048 + k * 1024); } while (0)
#define PG8_MMA(ai, bj, At, Bt) do { __builtin_amdgcn_s_setprio(1); _Pragma("unroll") for (int m = 0; m < 4; ++m) _Pragma("unroll") for (int n = 0; n < 2; ++n) _Pragma("unroll") for (int k = 0; k < 2; ++k) \
        acc[ai][bj][m][n] = __builtin_amdgcn_mfma_f32_16x16x32_bf16(Bt[n][k], At[m][k], acc[ai][bj][m][n], 0, 0, 0); __builtin_amdgcn_s_setprio(0); } while (0)
#define PG8_WAIT_V(n) asm volatile("s_waitcnt vmcnt(" #n ")" ::: "memory")
#define PG8_WAIT_L(n) asm volatile("s_waitcnt lgkmcnt(" #n ")" ::: "memory")
#define PG8_BAR __builtin_amdgcn_s_barrier()
#define PG8_SCHED __builtin_amdgcn_sched_barrier(0)
    Unit cur, nxt; int ui = 0;
    if (!S.next(0, cur)) return;
    f32x4 acc[2][2][4][2];
#pragma unroll
    for (int a = 0; a < 2; ++a)
#pragma unroll
        for (int b = 0; b < 2; ++b)
#pragma unroll
            for (int m = 0; m < 4; ++m)
#pragma unroll
                for (int n = 0; n < 2; ++n) acc[a][b][m][n] = (f32x4){0.f, 0.f, 0.f, 0.f};
    bf16x8 At[4][2], B0[2][2], B1[2][2];
    const char* cA = (const char*)g.A + (size_t)cur.ta * tstep; const char* cB = (const char*)g.Bt + (size_t)cur.tb * tstep;
    PG8_STAGE(PG8_SB(0, 0), cB); PG8_STAGE(PG8_SB(0, 1), cB + hstep); PG8_STAGE(PG8_SA(0, 0), cA); PG8_STAGE(PG8_SA(0, 1), cA + hstep);
    if (wr == 1) PG8_BAR;
    PG8_WAIT_V(2); PG8_BAR;
    PG8_STAGE(PG8_SB(1, 0), cB + kstep); PG8_STAGE(PG8_SA(1, 0), cA + kstep); PG8_STAGE(PG8_SB(1, 1), cB + hstep + kstep);
    PG8_WAIT_V(6); PG8_BAR;
    for (;;) {
        const bool has_next = S.next(ui + 1, nxt);
        const char* nA = has_next ? (const char*)g.A + (size_t)nxt.ta * tstep : cA; const char* nB = has_next ? (const char*)g.Bt + (size_t)nxt.tb * tstep : cB;
        for (int t = 0; t < nt; t += 2) {
            const bool last = (t == nt - 2);
            const char* a1 = cA + (size_t)(t + 1) * kstep;
            const char* a2 = last ? nA : cA + (size_t)(t + 2) * kstep; const char* b2 = last ? nB : cB + (size_t)(t + 2) * kstep;
            const char* a3 = a2 + kstep; const char* b3 = b2 + kstep;
            if constexpr (Epi::MID) { if (t != 0 && (t & 3) == 0) E.mid(acc, cur, t >> 2, wr, wc, fr, fq); }
            PG8_LDB(B0, 0, 0); PG8_LDB(B1, 0, 1); PG8_SCHED; PG8_LDA(At, 0, 0); PG8_STAGE(PG8_SA(1, 1), a1 + hstep);
            PG8_WAIT_V(8); PG8_WAIT_L(0); PG8_BAR; PG8_MMA(0, 0, At, B0); PG8_MMA(0, 1, At, B1); PG8_BAR; PG8_SCHED;
            PG8_LDA(At, 0, 1); PG8_STAGE(PG8_SB(0, 0), b2); PG8_STAGE(PG8_SB(0, 1), b2 + hstep); PG8_STAGE(PG8_SA(0, 0), a2);
            PG8_WAIT_V(8); PG8_WAIT_L(0); PG8_BAR; PG8_MMA(1, 0, At, B0); PG8_MMA(1, 1, At, B1); PG8_BAR; PG8_SCHED;
            PG8_LDB(B0, 1, 0); PG8_LDB(B1, 1, 1); PG8_SCHED; PG8_LDA(At, 1, 0); PG8_STAGE(PG8_SA(0, 1), a2 + hstep);
            PG8_WAIT_V(8); PG8_WAIT_L(0); PG8_BAR; PG8_MMA(0, 0, At, B0); PG8_MMA(0, 1, At, B1); PG8_BAR; PG8_SCHED;
            PG8_LDA(At, 1, 1); PG8_STAGE(PG8_SB(1, 0), b3); PG8_STAGE(PG8_SB(1, 1), b3 + hstep); PG8_STAGE(PG8_SA(1, 0), a3);
            PG8_WAIT_V(8); PG8_WAIT_L(0); PG8_BAR; PG8_MMA(1, 0, At, B0); PG8_MMA(1, 1, At, B1); PG8_BAR; PG8_SCHED;
        }
        if (wr == 0) PG8_BAR;
        E(acc, cur, wr, wc, fr, fq);
        if (!has_next) break;
#pragma unroll
        for (int a = 0; a < 2; ++a)
#pragma unroll
            for (int b = 0; b < 2; ++b)
#pragma unroll
                for (int m = 0; m < 4; ++m)
#pragma unroll
                    for (int n = 0; n < 2; ++n) acc[a][b][m][n] = (f32x4){0.f, 0.f, 0.f, 0.f};
        cur = nxt; cA = nA; cB = nB; ++ui;
        if (wr == 1) PG8_BAR;
    }
    PG8_WAIT_V(0);
    PG8_BAR;
#undef PG8_SA
#undef PG8_SB
#undef PG8_STAGE
#undef PG8_LDA
#undef PG8_LDB
#undef PG8_MMA
#undef PG8_WAIT_V
#undef PG8_WAIT_L
#undef PG8_BAR
#undef PG8_SCHED
}
#else
template <class Epi, class Sched> void gemm_phase(unsigned char* lds, const Gemm g, const Sched& S, const Epi& E);
#endif
}
typedef f32x4 AccT[2][2][4][2];

struct Ctx {
    const Params* p; Dims d; unsigned char* lds; int tid, lane, wave, G, vcu;
    template <class T> __device__ __forceinline__ T* ws(unsigned off) const { return (T*)(p->ws + ((size_t)off << 8)); }
    __device__ __forceinline__ const float* in(int i) const { return p->in[i]; }
    __device__ __forceinline__ int modrow(int tok) const { return tok < d.NTc ? 0 : 1 + (tok - d.NTc) / d.Tl; }
    __device__ __forceinline__ const float* mods(int l) const { return ws<float>(d.w_mods) + (size_t)l * (1 + d.Bl) * NMOD; }
    __device__ __forceinline__ float* X() const { return p->out; }
};

__device__ __forceinline__ Ctx fresh(const Ctx& c0) {
    Ctx c; c.p = c0.p; c.lds = c0.lds; c.tid = opqv(c0.tid); c.lane = c.tid & 63; c.wave = opqs(c0.wave); c.G = opqs(c0.G); c.vcu = opqs(c0.vcu);
    c.d = make_dims(opqs(c0.p->Bc), opqs(c0.p->Tc), opqs(c0.p->Bl), opqs(c0.p->Tl)); return c;
}

__device__ __forceinline__ u32x4 pk8(const f32x4 a, const f32x4 b) { u32x4 w; w.x = pk2(a[0], a[1]); w.y = pk2(a[2], a[3]); w.z = pk2(b[0], b[1]); w.w = pk2(b[2], b[3]); return w; }
__device__ __forceinline__ unsigned gq(float x) { const float g = sigmoidf_(x) * 255.0f + 0.5f; const unsigned q = (unsigned)g; return q < 1u ? 1u : (q > 255u ? 255u : q); }
__device__ __forceinline__ float ub(unsigned w, int i) { return (float)((w >> (8 * i)) & 0xffu); }
struct EpiCols {
    static constexpr bool MID = false;
    bf16_t* cols; float* small; unsigned char* gates; float* onk; float* onv; int l, NTc, Tc;
    __device__ __forceinline__ void operator()(const AccT& acc, const pg8::Unit& u, int wr, int wc, int fr, int fq) const {
        const int row0 = u.pm * 256 + wr * 64 + fr, cw = wc * 32 + 8 * fq;
        if (u.pn < 14) {
            float* okv = u.pn == 12 ? onk : (u.pn == 13 ? onv : nullptr);
#pragma unroll
            for (int ai = 0; ai < 2; ++ai)
#pragma unroll
                for (int m = 0; m < 4; ++m) { const int row = row0 + ai * 128 + m * 16; bf16_t* rp = cols + (size_t)row * NCB + u.pn * 256 + cw;
#pragma unroll
                    for (int bj = 0; bj < 2; ++bj) { *(u32x4*)(rp + bj * 128) = pk8(acc[ai][bj][m][0], acc[ai][bj][m][1]);
                        if (okv && row < NTc) { const int cc = bj * 128 + cw, b = row / Tc, t = row - b * Tc; float* op = okv + ((((size_t)b * DEPTH + l) * NH + (cc >> 6)) * Tc + t) * HD + (cc & 63);
                            *(f32x4*)op = acc[ai][bj][m][0]; *(f32x4*)(op + 4) = acc[ai][bj][m][1]; } } }
        } else if (u.pn == 14) {
#pragma unroll
            for (int ai = 0; ai < 2; ++ai)
#pragma unroll
                for (int m = 0; m < 4; ++m) { float* rp = small + (size_t)(row0 + ai * 128 + m * 16) * NSM + cw;
#pragma unroll
                    for (int bj = 0; bj < 2; ++bj) { *(f32x4*)(rp + bj * 128) = acc[ai][bj][m][0]; *(f32x4*)(rp + bj * 128 + 4) = acc[ai][bj][m][1]; } }
        } else {
#pragma unroll
            for (int ai = 0; ai < 2; ++ai)
#pragma unroll
                for (int m = 0; m < 4; ++m) { unsigned char* rp = gates + (size_t)(row0 + ai * 128 + m * 16) * NGATE + (u.pn - 15) * 256 + cw;
#pragma unroll
                    for (int bj = 0; bj < 2; ++bj) { const f32x4 a = acc[ai][bj][m][0], b = acc[ai][bj][m][1]; u32x2 w;
                        w.x = gq(a[0]) | (gq(a[1]) << 8) | (gq(a[2]) << 16) | (gq(a[3]) << 24); w.y = gq(b[0]) | (gq(b[1]) << 8) | (gq(b[2]) << 16) | (gq(b[3]) << 24);
                        *(u32x2*)(rp + bj * 128) = w; } }
        }
    }
};
struct EpiWiden {
    static constexpr bool MID = true;
    const unsigned char* gates; bf16_t* merged;
    __device__ __forceinline__ void mid(AccT& acc, const pg8::Unit& u, int z1, int wr, int wc, int fr, int fq) const {
        const int row0 = opqv(u.pm * 256 + wr * 64 + fr), col0 = opqv(u.pn * 256 + wc * 32 + 8 * fq);
#pragma unroll
        for (int ai = 0; ai < 2; ++ai)
#pragma unroll
            for (int m = 0; m < 4; ++m) { const unsigned char* rp = gates + (size_t)(row0 + ai * 128 + m * 16) * NGATE + col0;
#pragma unroll
                for (int bj = 0; bj < 2; ++bj) { const u32x2 a = *(const u32x2*)(rp + (z1 - 1) * 1024 + bj * 128), b = *(const u32x2*)(rp + z1 * 1024 + bj * 128);
                    f32x4 r0, r1;
                    UNR for (int e = 0; e < 4; ++e) { r0[e] = ub(a.x, e) * frcp(ub(b.x, e)); r1[e] = ub(a.y, e) * frcp(ub(b.y, e)); }
                    acc[ai][bj][m][0] *= r0; acc[ai][bj][m][1] *= r1;
#ifndef CPU_EMU
                    asm volatile("" ::: "memory");
#endif
                } }
    }
    __device__ __forceinline__ void operator()(const AccT& acc, const pg8::Unit& u, int wr, int wc, int fr, int fq) const {
        const int row0 = u.pm * 256 + wr * 64 + fr, col0 = u.pn * 256 + wc * 32 + 8 * fq;
#pragma unroll
        for (int ai = 0; ai < 2; ++ai)
#pragma unroll
            for (int m = 0; m < 4; ++m) { const size_t ro = (size_t)(row0 + ai * 128 + m * 16);
#pragma unroll
                for (int bj = 0; bj < 2; ++bj) { const u32x2 b = *(const u32x2*)(gates + ro * NGATE + 3 * 1024 + col0 + bj * 128); f32x4 a0 = acc[ai][bj][m][0], a1 = acc[ai][bj][m][1];
                    UNR for (int e = 0; e < 4; ++e) { a0[e] *= ub(b.x, e) * (1.0f / 255.0f); a1[e] *= ub(b.y, e) * (1.0f / 255.0f); }
                    *(u32x4*)(merged + ro * D + col0 + bj * 128) = pk8(a0, a1); } }
    }
};
struct EpiPreLN {
    static constexpr bool MID = false;
    const float* x; const float* mods; float* v; int NTc, Tl;
    __device__ __forceinline__ void operator()(const AccT& acc, const pg8::Unit& u, int wr, int wc, int fr, int fq) const {
        const int row0 = u.pm * 256 + wr * 64 + fr, col0 = u.pn * 256 + wc * 32 + 8 * fq;
#pragma unroll
        for (int ai = 0; ai < 2; ++ai)
#pragma unroll
            for (int m = 0; m < 4; ++m) { const int row = row0 + ai * 128 + m * 16; const int mr = row < NTc ? 0 : 1 + (row - NTc) / Tl; const float* g1 = mods + (size_t)mr * NMOD + 2 * D + col0;
                const size_t ro = (size_t)row * D + col0;
#pragma unroll
                for (int bj = 0; bj < 2; ++bj)
#pragma unroll
                    for (int n = 0; n < 2; ++n) { const int o = bj * 128 + n * 4; const f32x4 xv = *(const f32x4*)(x + ro + o), gv = *(const f32x4*)(g1 + o);
                        *(f32x4*)(v + ro + o) = ALPHA * xv + gv * acc[ai][bj][m][n]; } }
    }
};
struct EpiSwiGLU {
    static constexpr bool MID = false;
    bf16_t* act;
    __device__ __forceinline__ void operator()(const AccT& acc, const pg8::Unit& u, int wr, int wc, int fr, int fq) const {
        const int row0 = u.pm * 256 + wr * 64 + fr, col0 = u.pn * 128 + wc * 32 + 8 * fq;
#pragma unroll
        for (int ai = 0; ai < 2; ++ai)
#pragma unroll
            for (int m = 0; m < 4; ++m) { bf16_t* rp = act + (size_t)(row0 + ai * 128 + m * 16) * FF + col0; f32x4 o[2];
#pragma unroll
                for (int n = 0; n < 2; ++n) { const f32x4 a = acc[ai][0][m][n], b = acc[ai][1][m][n]; o[n][0] = siluf_(a[0]) * b[0]; o[n][1] = siluf_(a[1]) * b[1]; o[n][2] = siluf_(a[2]) * b[2]; o[n][3] = siluf_(a[3]) * b[3]; }
                *(u32x4*)rp = pk8(o[0], o[1]); }
    }
};
struct EpiDown {
    static constexpr bool MID = false;
    const float* pgate; bf16_t* y;
    __device__ __forceinline__ void operator()(const AccT& acc, const pg8::Unit& u, int wr, int wc, int fr, int fq) const {
        const int row0 = u.pm * 256 + wr * 64 + fr, col0 = u.pn * 256 + wc * 32 + 8 * fq;
#pragma unroll
        for (int ai = 0; ai < 2; ++ai)
#pragma unroll
            for (int m = 0; m < 4; ++m) { const int row = row0 + ai * 128 + m * 16; const float gt = pgate[row]; bf16_t* rp = y + (size_t)row * D + col0;
#pragma unroll
                for (int bj = 0; bj < 2; ++bj) *(u32x4*)(rp + bj * 128) = pk8(gt * acc[ai][bj][m][0], gt * acc[ai][bj][m][1]); }
    }
};

template <class ColMap>
__device__ __forceinline__ void tr_item(const float* src, int src_ld, const ColMap& cm, bf16_t* dst, int dst_ld, int dst_koff, int n0, int k0, float* scr, int lane) {
    const int r = lane >> 4, c4 = (lane & 15) * 4; const int sc = cm(prow(n0 + c4));
    f32x4 v[16];
    UNR for (int i = 0; i < 16; ++i) v[i] = sc >= 0 ? *(const f32x4*)(src + (size_t)(k0 + i * 4 + r) * src_ld + sc) : (f32x4){0.f, 0.f, 0.f, 0.f};
    UNR for (int i = 0; i < 16; ++i) { float* p = scr + (i * 4 + r) * 65 + c4; p[0] = v[i][0]; p[1] = v[i][1]; p[2] = v[i][2]; p[3] = v[i][3]; }
    WAVE_SYNC();
    const int kc = lane & 7;
    UNR for (int j = 0; j < 8; ++j) { const int n = (lane >> 3) + 8 * j; const float* p = scr + (8 * kc) * 65 + n;
        u32x4 o; o.x = pk2(p[0 * 65], p[1 * 65]); o.y = pk2(p[2 * 65], p[3 * 65]); o.z = pk2(p[4 * 65], p[5 * 65]); o.w = pk2(p[6 * 65], p[7 * 65]);
        *(u32x4*)(dst + (size_t)(n0 + n) * dst_ld + dst_koff + k0 + 8 * kc) = o; }
    WAVE_SYNC();
}
struct CmId { __device__ __forceinline__ int operator()(int n) const { return n; } };
struct CmWin { __device__ __forceinline__ int operator()(int n) const { return win_col(n); } };
struct CmUp { __device__ __forceinline__ int operator()(int n) const { const int u = n >> 8, w = n & 255; return (w < 128 ? 0 : FF) + u * 128 + (w & 127); } };

__device__ __forceinline__ void phase_prep(const Ctx& c0) {
    const Ctx c = fresh(c0);
    const Dims& d = c.d;
    float* L = (float*)c.lds;
    const int nrow = 1 + d.Bl;
    const int gw = c.vcu * NWAVES + c.wave, NGW = c.G * NWAVES;
    const int nmod_items = DEPTH * (NMOD / 64);
    if (c.vcu < nmod_items) {
        const int l = c.vcu / (NMOD / 64), j = (c.vcu % (NMOD / 64)) * 64 + c.lane, kw = c.wave * 128;
        const float* w = c.in(I_WADA) + ((size_t)l * D + kw) * NMOD + j;
        float* cond = L + c.wave * 4160;
        for (int i = c.lane; i < 9 * 128; i += 64) { const int r = i >> 7, k = kw + (i & 127); const float v = r == 0 ? c.in(I_CCTX)[k] : (r < nrow ? c.in(I_C)[(size_t)(r - 1) * D + k] : 0.0f); cond[i] = siluf_(v); }
        WAVE_SYNC();
        float a[9];
        UNR for (int r = 0; r < 9; ++r) a[r] = 0.0f;
#pragma unroll 8
        for (int k = 0; k < 128; ++k) { const float wv = w[(size_t)k * NMOD]; UNR for (int r = 0; r < 9; ++r) a[r] += cond[r * 128 + k] * wv; }
        UNR for (int r = 0; r < 9; ++r) cond[1152 + r * 64 + c.lane] = a[r];
        __syncthreads();
        if (c.wave == 0) { const float bias = c.in(I_BADA)[(size_t)l * NMOD + j]; float* mo = c.ws<float>(d.w_mods) + (size_t)l * nrow * NMOD + j;
            UNR for (int r = 0; r < 9; ++r) { float t = bias; UNR for (int ww = 0; ww < 8; ++ww) t += L[ww * 4160 + 1152 + r * 64 + c.lane]; if (r < nrow) mo[(size_t)r * NMOD] = t; } }
        __syncthreads();
    }
    float* scr = L + c.wave * 4160;
    const int I_IN = (D / 64) * (NINP / 64), I_BR = 4 * (MIXW / 64) * (D / 64), I_OUT = (D / 64) * (D / 64), I_UP = NEXP * (D / 64) * (2 * FF / 64), I_DN = NEXP * (FF / 64) * (D / 64);
    const int PER_L = I_IN + I_BR + I_OUT + I_UP + I_DN;
    for (int it = gw; it < DEPTH * PER_L; it += NGW) {
        const int l = it / PER_L; int r = it % PER_L;
        if (r < I_IN) { const int nb = NINP / 64, kb = r / nb, n0 = (r % nb) * 64;
            tr_item(c.in(I_WIN) + (size_t)l * D * NIN, NIN, CmWin(), c.ws<bf16_t>(d.w_win) + (size_t)l * NINP * D, D, 0, n0, kb * 64, scr, c.lane); continue; } r -= I_IN;
        if (r < I_BR) { const int per = (MIXW / 64) * (D / 64), z = r / per, q = r % per, kb = q / (D / 64), n0 = (q % (D / 64)) * 64;
            tr_item(c.in(I_WBR) + ((size_t)l * 4 + z) * MIXW * D, D, CmId(), c.ws<bf16_t>(d.w_wbr) + (size_t)l * D * D, D, z * MIXW, n0, kb * 64, scr, c.lane); continue; } r -= I_BR;
        if (r < I_OUT) { const int kb = r / (D / 64), n0 = (r % (D / 64)) * 64;
            tr_item(c.in(I_WOUT) + (size_t)l * D * D, D, CmId(), c.ws<bf16_t>(d.w_wout) + (size_t)l * D * D, D, 0, n0, kb * 64, scr, c.lane); continue; } r -= I_OUT;
        if (r < I_UP) { const int per = (D / 64) * (2 * FF / 64), e = r / per, q = r % per, kb = q / (2 * FF / 64), n0 = (q % (2 * FF / 64)) * 64;
            tr_item(c.in(I_WUP) + ((size_t)l * NEXP + e) * D * 2 * FF, 2 * FF, CmUp(), c.ws<bf16_t>(d.w_wup) + ((size_t)l * NEXP + e) * 2 * FF * D, D, 0, n0, kb * 64, scr, c.lane); continue; } r -= I_UP;
        { const int per = (FF / 64) * (D / 64), e = r / per, q = r % per, kb = q / (D / 64), n0 = (q % (D / 64)) * 64;
            tr_item(c.in(I_WDOWN) + ((size_t)l * NEXP + e) * FF * D, D, CmId(), c.ws<bf16_t>(d.w_wdn) + ((size_t)l * NEXP + e) * D * FF, FF, 0, n0, kb * 64, scr, c.lane); }
    }
}

__device__ __forceinline__ void phase_init(const Ctx& c0) {
    const Ctx c = fresh(c0);
    const Dims& d = c.d; const float* mods = c.mods(0); bf16_t* hb = c.ws<bf16_t>(d.w_hb);
    const int gw = c.vcu * NWAVES + c.wave, NGW = c.G * NWAVES;
    for (int tok = gw; tok < d.NT; tok += NGW) {
        const float* xr = tok < d.NTc ? c.in(I_XP) + (size_t)tok * D : c.in(I_XS) + (size_t)(tok - d.NTc) * D;
        const float* mr = mods + (size_t)c.modrow(tok) * NMOD;
#pragma unroll
        for (int j = 0; j < 4; ++j) { const int col = 4 * c.lane + 256 * j; const f32x4 x = *(const f32x4*)(xr + col), sh = *(const f32x4*)(mr + col), sc = *(const f32x4*)(mr + D + col);
            *(f32x4*)(c.X() + (size_t)tok * D + col) = x; const f32x4 h = x * (1.0f + sc) + sh;
            u32x2 w; w.x = pk2(h[0], h[1]); w.y = pk2(h[2], h[3]); *(u32x2*)(hb + (size_t)tok * D + col) = w; }
    }
}

__device__ __forceinline__ f32x16 mm32(int lane, f32x16 acc, const float* A, int sai, int sak, const float* Bm, int sbk, int sbj, int K) {
    const int i = lane & 31, kk = lane >> 5;
    const float* ap = A + i * sai + kk * sak; const float* bp = Bm + kk * sbk + i * sbj;
#pragma unroll 8
    for (int k = 0; k < K; k += 2) acc = __builtin_amdgcn_mfma_f32_32x32x2f32(ap[k * sak], bp[k * sbk], acc, 0, 0, 0);
    return acc;
}
#define ACC_ROW(r, lane) (((r) & 3) + 8 * ((r) >> 2) + 4 * ((lane) >> 5))
__device__ __forceinline__ f32x16 zero16() { f32x16 z; UNR for (int r = 0; r < 16; ++r) z[r] = 0.0f; return z; }
constexpr int S65 = 65, MSZ = 64 * 65;

__device__ __forceinline__ void build_rope(float* cosT, float* sinT, int tid) {
    for (int i = tid; i < 1024; i += NTHREADS) { const int pos = i >> 4, f = i & 15; const float inv = powf(10000.0f, -(float)f / 16.0f); const float ang = (float)pos * inv; cosT[i] = cosf(ang); sinT[i] = sinf(ang); }
}
__device__ __forceinline__ float rope_elem(const float* rowp, int dd, int t, const float* cosT, const float* sinT) {
    const int f = dd & 15, second = (dd >> 4) & 1, pos = (dd < 32) ? (t / GRIDW) : (t % GRIDW);
    const float x = rowp[dd], xp = rowp[second ? dd - 16 : dd + 16], cs = cosT[pos * 16 + f], sn = sinT[pos * 16 + f];
    return second ? (xp * sn + x * cs) : (x * cs - xp * sn);
}

constexpr int SL_MF = 0, SL_MB = 1, SL_GF = 2, SL_GB = 3, SL_RF = 4, SL_RB = 5, SL_RBONUS = 6, NSLOT = 7;

struct ChunkRegs { u32x4 q, qp, k, kp, v; };
__device__ __forceinline__ float bfel(const u32x4 w, int e) { const unsigned x = w[e >> 1]; return (e & 1) ? bfhi(x) : bflo(x); }
__device__ __forceinline__ void chunk_load(ChunkRegs& R, const bf16_t* cols, size_t tok0, int T, int dir, int ci, int h, int cbq, int tid) {
    const int j = tid >> 3, g = tid & 7, t = dir ? T - 1 - (ci * 64 + j) : ci * 64 + j; const bf16_t* rp = cols + (tok0 + t) * NCB + cbq * 256 + h * 64;
    R.q = *(const u32x4*)(rp + 8 * g); R.qp = *(const u32x4*)(rp + 8 * (g ^ 2)); R.k = *(const u32x4*)(rp + 256 + 8 * g); R.kp = *(const u32x4*)(rp + 256 + 8 * (g ^ 2)); R.v = *(const u32x4*)(rp + 512 + 8 * g);
}
__device__ __forceinline__ void chunk_store(const ChunkRegs& R, float* Q, float* K, float* V, int T, int dir, int ci, int pass, float qs, float ks, const float* cosT, const float* sinT, int tid) {
    const int j = tid >> 3, g = tid & 7, t = dir ? T - 1 - (ci * 64 + j) : ci * 64 + j, second = (g >> 1) & 1, pos = g < 4 ? (t / GRIDW) : (t % GRIDW), o = j * S65 + 8 * g;
    UNR for (int e = 0; e < 8; ++e) { float q = bfel(R.q, e), k = bfel(R.k, e);
        if (pass) { const float qp = bfel(R.qp, e), kp = bfel(R.kp, e), cs = cosT[pos * 16 + 8 * (g & 1) + e], sn = sinT[pos * 16 + 8 * (g & 1) + e];
            q = second ? qp * sn + q * cs : q * cs - qp * sn; k = second ? kp * sn + k * cs : k * cs - kp * sn; }
        Q[o + e] = q * qs; K[o + e] = k * ks; V[o + e] = bfel(R.v, e); }
}

__device__ __forceinline__ void mix_mlstm(const Ctx& c0, int l, int pass, int b, int h, int dir) {
    const Ctx c = fresh(c0);
    const Dims& d = c.d; const int T = pass ? d.Tl : d.Tc, nc = T / 64, tid = c.tid, lane = c.lane, wave = c.wave; const size_t tok0 = pass ? d.NTc + (size_t)b * d.Tl : (size_t)b * d.Tc;
    float* L = (float*)c.lds;
    float *Q = L, *K = L + MSZ, *V = L + 2 * MSZ, *C = L + 3 * MSZ, *Sm = L + 4 * MSZ, *QC = L + 5 * MSZ, *vec = L + 6 * MSZ;
    float *nv = vec, *ig = vec + 64, *lf = vec + 128, *bc = vec + 192, *lw = vec + 256, *wint = vec + 320, *rden = vec + 384, *scal = vec + 448, *npart = vec + 512, *cosT = vec + 1024, *sinT = vec + 2048;
    const bf16_t* cols = c.ws<bf16_t>(d.w_cols); const float* small = c.ws<float>(d.w_small); float* scr = c.ws<float>(d.w_scr);
    __syncthreads();
    if (pass) build_rope(cosT, sinT, tid);
    if (pass) { const float* C0 = c.in(I_SC) + ((((size_t)b * DEPTH + l) * 2 + dir) * NH + h) * HD * HD;
        _Pragma("unroll 2") for (int i = tid; i < 4096; i += NTHREADS) C[(i >> 6) * S65 + (i & 63)] = C0[i];
        if (tid < 64) nv[tid] = c.in(I_SN)[((((size_t)b * DEPTH + l) * 2 + dir) * NH + h) * HD + tid];
        if (tid == 0) scal[0] = c.in(I_SM)[(((size_t)b * DEPTH + l) * 2 + dir) * NH + h];
    } else { _Pragma("unroll 2") for (int i = tid; i < 4096; i += NTHREADS) C[(i >> 6) * S65 + (i & 63)] = 0.0f; if (tid < 64) nv[tid] = 0.0f; if (tid == 0) scal[0] = 0.0f; }
    const float big = c.in(I_BIG)[((size_t)l * 2 + dir) * NH + h], bfg = c.in(I_BFG)[((size_t)l * 2 + dir) * NH + h];
    ChunkRegs R; float rig = 0.0f, rlf = 0.0f;
    chunk_load(R, cols, tok0, T, dir, 0, h, CB_MQ, tid);
    if (tid < 64) { const int t = dir ? T - 1 - tid : tid; const float* rp = small + (tok0 + t) * NSM; rig = rp[SM_MI + dir * 4 + h]; rlf = rp[SM_MF + dir * 4 + h]; }
    __syncthreads();
    chunk_store(R, Q, K, V, T, dir, 0, pass, 1.0f, 0.125f, cosT, sinT, tid);
    if (tid < 64) { ig[tid] = rig + big; lf[tid] = logsigmoidf_(rlf + bfg); }
    for (int ci = 0; ci < nc; ++ci) {
        if (ci + 1 < nc) {
            chunk_load(R, cols, tok0, T, dir, ci + 1, h, CB_MQ, tid);
            if (tid < 64) { const int t = dir ? T - 1 - ((ci + 1) * 64 + tid) : (ci + 1) * 64 + tid; const float* rp = small + (tok0 + t) * NSM; rig = rp[SM_MI + dir * 4 + h]; rlf = rp[SM_MF + dir * 4 + h]; }
        }
        __syncthreads();
        if (wave == 0) { float run = lf[lane];
            UNR for (int o = 1; o < 64; o <<= 1) { const float up = __shfl(run, lane >= o ? lane - o : lane); run += lane >= o ? up : 0.0f; }
            const float bend = __shfl(run, 63), m = scal[0], w = bend - run + ig[lane]; float mx = w;
            mx = fmaxf(mx, x1(mx)); mx = fmaxf(mx, x2(mx)); mx = fmaxf(mx, x4m(mx)); mx = fmaxf(mx, x8m(mx)); mx = fmaxf(mx, __shfl_xor(mx, 16)); mx = fmaxf(mx, __shfl_xor(mx, 32));
            const float mnew = fmaxf(bend + m, mx); bc[lane] = run; lw[lane] = w; if (lane == 0) { scal[1] = mnew; scal[2] = fexp(bend + m - mnew); } }
        { const int ti = (wave >> 1) & 1, tj = wave & 1; f32x16 acc = zero16();
          if (wave < 4) { acc = mm32(lane, acc, Q + ti * 32 * S65, S65, 1, K + tj * 32 * S65, 1, S65, 64); UNR for (int r = 0; r < 16; ++r) Sm[(ti * 32 + ACC_ROW(r, lane)) * S65 + tj * 32 + (lane & 31)] = acc[r]; }
          else { acc = mm32(lane, acc, Q + ti * 32 * S65, S65, 1, C + tj * 32, S65, 1, 64); UNR for (int r = 0; r < 16; ++r) QC[(ti * 32 + ACC_ROW(r, lane)) * S65 + tj * 32 + (lane & 31)] = acc[r]; } }
        __syncthreads();
        { const int t = tid >> 3, g = tid & 7; const float m = scal[0], mnew = scal[1], bt = bc[t]; float mx = -3.0e38f;
          UNR for (int e = 0; e < 8; ++e) { const int s = g * 8 + e; if (s <= t) mx = fmaxf(mx, bt - bc[s] + ig[s]); }
          mx = fmaxf(mx, x1(mx)); mx = fmaxf(mx, x2(mx)); mx = fmaxf(mx, x4m(mx));
          const float minter = bt + m, mt = fmaxf(minter, mx); float den = 0.0f, qn = 0.0f;
          UNR for (int e = 0; e < 8; ++e) { const int s = g * 8 + e; float sv = 0.0f; if (s <= t) sv = Sm[t * S65 + s] * fexp(bt - bc[s] + ig[s] - mt); Sm[t * S65 + s] = sv; den += sv; qn += Q[t * S65 + s] * nv[s]; }
          den += x1(den); den += x2(den); den += x4m(den); qn += x1(qn); qn += x2(qn); qn += x4m(qn);
          const float wi = fexp(minter - mt); den += wi * qn;
          if (g == 0) { wint[t] = wi; rden[t] = 1.0f / fmaxf(fabsf(den), fexp(-mt)); }
          const float ks = fexp(lw[t] - mnew); UNR for (int e = 0; e < 8; ++e) K[t * S65 + g * 8 + e] *= ks; }
        __syncthreads();
        { const int ti = (wave >> 1) & 1, tj = wave & 1;
          if (wave < 4) { f32x16 acc = zero16(); acc = mm32(lane, acc, Sm + ti * 32 * S65, S65, 1, V + tj * 32, S65, 1, 64);
              UNR for (int r = 0; r < 16; ++r) { const int row = ti * 32 + ACC_ROW(r, lane), o = row * S65 + tj * 32 + (lane & 31); QC[o] = (acc[r] + wint[row] * QC[o]) * rden[row]; } }
          else { const float carry = scal[2]; f32x16 acc; UNR for (int r = 0; r < 16; ++r) acc[r] = carry * C[(ti * 32 + ACC_ROW(r, lane)) * S65 + tj * 32 + (lane & 31)];
              acc = mm32(lane, acc, K + ti * 32, 1, S65, V + tj * 32, S65, 1, 64);
              UNR for (int r = 0; r < 16; ++r) C[(ti * 32 + ACC_ROW(r, lane)) * S65 + tj * 32 + (lane & 31)] = acc[r]; }
          float s = 0.0f; UNR for (int e = 0; e < 8; ++e) s += K[(wave * 8 + e) * S65 + lane]; npart[wave * 64 + lane] = s; }
        __syncthreads();
        if (tid < 64) { float s = 0.0f; UNR for (int e = 0; e < 8; ++e) s += npart[e * 64 + tid]; nv[tid] = scal[2] * nv[tid] + s; }
        { const int j = tid >> 3, g = tid & 7, t = dir ? T - 1 - (ci * 64 + j) : ci * 64 + j; float* sp = scr + ((tok0 + t) * NSLOT + (dir ? SL_MB : SL_MF)) * MIXW + h * 64 + g * 8; const float* hp = QC + j * S65 + g * 8;
          *(f32x4*)sp = (f32x4){hp[0], hp[1], hp[2], hp[3]}; *(f32x4*)(sp + 4) = (f32x4){hp[4], hp[5], hp[6], hp[7]}; }
        if (ci + 1 < nc) { chunk_store(R, Q, K, V, T, dir, ci + 1, pass, 1.0f, 0.125f, cosT, sinT, tid); if (tid < 64) { ig[tid] = rig + big; lf[tid] = logsigmoidf_(rlf + bfg); } }
        if (tid == 0) scal[0] = scal[1];
    }
    __syncthreads();
    if (!pass) {
        float* Co = c.p->out + d.o_C + ((((size_t)b * DEPTH + l) * 2 + dir) * NH + h) * HD * HD;
        _Pragma("unroll 2") for (int i = tid; i < 4096; i += NTHREADS) Co[i] = C[(i >> 6) * S65 + (i & 63)];
        if (tid < 64) c.p->out[d.o_n + ((((size_t)b * DEPTH + l) * 2 + dir) * NH + h) * HD + tid] = nv[tid];
        if (tid == 0) c.p->out[d.o_m + (((size_t)b * DEPTH + l) * 2 + dir) * NH + h] = scal[0];
    }
    __syncthreads();
}

__device__ __forceinline__ void mix_gla(const Ctx& c0, int l, int pass, int b, int h, int dir) {
    const Ctx c = fresh(c0);
    const Dims& d = c.d; const int T = pass ? d.Tl : d.Tc, nc = T / 64, tid = c.tid, lane = c.lane, wave = c.wave; const size_t tok0 = pass ? d.NTc + (size_t)b * d.Tl : (size_t)b * d.Tc;
    float* L = (float*)c.lds;
    float *Q = L, *K = L + MSZ, *V = L + 2 * MSZ, *S = L + 3 * MSZ, *Gm = L + 4 * MSZ, *O2 = L + 5 * MSZ, *vec = L + 6 * MSZ;
    float *gend = vec, *bA = vec + 64, *gpart = vec + 128, *GA = vec + 640, *wA = vec + 640 + 1024, *cosT = vec + 640 + 2048, *sinT = vec + 640 + 3072;
    const bf16_t* cols = c.ws<bf16_t>(d.w_cols); const float* small = c.ws<float>(d.w_small); float* scr = c.ws<float>(d.w_scr);
    __syncthreads();
    if (pass) build_rope(cosT, sinT, tid);
    if (pass) { const float* S0 = c.in(I_SG) + ((((size_t)b * DEPTH + l) * 2 + dir) * NH + h) * HD * HD; _Pragma("unroll 2") for (int i = tid; i < 4096; i += NTHREADS) S[(i >> 6) * S65 + (i & 63)] = S0[i]; }
    else { _Pragma("unroll 2") for (int i = tid; i < 4096; i += NTHREADS) S[(i >> 6) * S65 + (i & 63)] = 0.0f; }
    for (int i = tid; i < 1024; i += NTHREADS) wA[i] = c.in(I_WGLA)[(((size_t)l * 2 + dir) * 16 + (i >> 6)) * MIXW + h * 64 + (i & 63)];
    if (tid < 64) bA[tid] = c.in(I_BGLA)[((size_t)l * 2 + dir) * MIXW + h * 64 + tid];
    ChunkRegs R; f32x4 rga = (f32x4){0.f, 0.f, 0.f, 0.f};
    chunk_load(R, cols, tok0, T, dir, 0, h, CB_GQ, tid);
    if (tid < 256) { const int j = tid >> 2, t = dir ? T - 1 - j : j; rga = *(const f32x4*)(small + (tok0 + t) * NSM + SM_GA + dir * 16 + (tid & 3) * 4); }
    __syncthreads();
    chunk_store(R, Q, K, V, T, dir, 0, pass, 0.125f, 1.0f, cosT, sinT, tid);
    if (tid < 256) *(f32x4*)(GA + (tid >> 2) * 16 + (tid & 3) * 4) = rga;
    for (int ci = 0; ci < nc; ++ci) {
        if (ci + 1 < nc) {
            chunk_load(R, cols, tok0, T, dir, ci + 1, h, CB_GQ, tid);
            if (tid < 256) { const int j = tid >> 2, t = dir ? T - 1 - ((ci + 1) * 64 + j) : (ci + 1) * 64 + j; rga = *(const f32x4*)(small + (tok0 + t) * NSM + SM_GA + dir * 16 + (tid & 3) * 4); }
        }
        __syncthreads();
        float gl[8];
        { float run = 0.0f;
          UNR for (int e = 0; e < 8; ++e) { const float* ga = GA + (wave * 8 + e) * 16; float a = bA[lane];
              UNR for (int r = 0; r < 16; ++r) a += ga[r] * wA[r * 64 + lane];
              run += logsigmoidf_(a) * (1.0f / 16.0f); gl[e] = run; }
          gpart[wave * 64 + lane] = run; }
        __syncthreads();
        { float pre = 0.0f; UNR for (int e = 0; e < 8; ++e) pre += (e < wave) ? gpart[e * 64 + lane] : 0.0f;
          UNR for (int e = 0; e < 8; ++e) { const float g = gl[e] + pre; const int o = (wave * 8 + e) * S65 + lane; Q[o] *= fexp(g); K[o] *= fexp(-g); if (wave == 7 && e == 7) gend[lane] = g; } }
        __syncthreads();
        { const int ti = (wave >> 1) & 1, tj = wave & 1; f32x16 acc = zero16();
          if (wave < 4) { acc = mm32(lane, acc, Q + ti * 32 * S65, S65, 1, K + tj * 32 * S65, 1, S65, 64);
              UNR for (int r = 0; r < 16; ++r) { const int row = ti * 32 + ACC_ROW(r, lane), col = tj * 32 + (lane & 31); Gm[row * S65 + col] = col <= row ? acc[r] : 0.0f; } }
          else { acc = mm32(lane, acc, Q + ti * 32 * S65, S65, 1, S + tj * 32, S65, 1, 64); UNR for (int r = 0; r < 16; ++r) O2[(ti * 32 + ACC_ROW(r, lane)) * S65 + tj * 32 + (lane & 31)] = acc[r]; } }
        __syncthreads();
        { const int ti = (wave >> 1) & 1, tj = wave & 1;
          if (wave < 4) { f32x16 acc; UNR for (int r = 0; r < 16; ++r) acc[r] = O2[(ti * 32 + ACC_ROW(r, lane)) * S65 + tj * 32 + (lane & 31)];
              acc = mm32(lane, acc, Gm + ti * 32 * S65, S65, 1, V + tj * 32, S65, 1, 64);
              UNR for (int r = 0; r < 16; ++r) O2[(ti * 32 + ACC_ROW(r, lane)) * S65 + tj * 32 + (lane & 31)] = acc[r]; }
          else { f32x16 acc; UNR for (int r = 0; r < 16; ++r) acc[r] = S[(ti * 32 + ACC_ROW(r, lane)) * S65 + tj * 32 + (lane & 31)];
              acc = mm32(lane, acc, K + ti * 32, 1, S65, V + tj * 32, S65, 1, 64);
              UNR for (int r = 0; r < 16; ++r) { const int row = ti * 32 + ACC_ROW(r, lane); S[row * S65 + tj * 32 + (lane & 31)] = fexp(gend[row]) * acc[r]; } } }
        __syncthreads();
        { const int j = tid >> 3, g = tid & 7, t = dir ? T - 1 - (ci * 64 + j) : ci * 64 + j; float* sp = scr + ((tok0 + t) * NSLOT + (dir ? SL_GB : SL_GF)) * MIXW + h * 64 + g * 8; const float* hp = O2 + j * S65 + g * 8;
          *(f32x4*)sp = (f32x4){hp[0], hp[1], hp[2], hp[3]}; *(f32x4*)(sp + 4) = (f32x4){hp[4], hp[5], hp[6], hp[7]}; }
        if (ci + 1 < nc) { chunk_store(R, Q, K, V, T, dir, ci + 1, pass, 0.125f, 1.0f, cosT, sinT, tid); if (tid < 256) *(f32x4*)(GA + (tid >> 2) * 16 + (tid & 3) * 4) = rga; }
    }
    __syncthreads();
    if (!pass) { float* So = c.p->out + d.o_g + ((((size_t)b * DEPTH + l) * 2 + dir) * NH + h) * HD * HD; _Pragma("unroll 2") for (int i = tid; i < 4096; i += NTHREADS) So[i] = S[(i >> 6) * S65 + (i & 63)]; }
    __syncthreads();
}

#define RW_LOAD(i_, R_, K_, W_, A_, H_, v_) do { const float* Pi_ = buf + (i_) * VST + q * 16; \
    UNR for (int u_ = 0; u_ < 4; ++u_) { R_[u_] = *(const f32x4*)(Pi_ + 4 * u_); K_[u_] = *(const f32x4*)(Pi_ + 64 + 4 * u_); W_[u_] = *(const f32x4*)(Pi_ + 192 + 4 * u_); \
        A_[u_] = *(const f32x4*)(Pi_ + 256 + 4 * u_); H_[u_] = *(const f32x4*)(Pi_ + 320 + 4 * u_); } v_ = buf[(i_) * VST + 128 + vrow]; } while (0)
#define RW_STEP(R_, K_, W_, A_, H_, v_) do { f32x4 d_ = Sv[0] * K_[0]; d_ += Sv[1] * K_[1]; d_ += Sv[2] * K_[2]; d_ += Sv[3] * K_[3]; \
    const float sk_ = quad_sum((d_[0] + d_[1]) + (d_[2] + d_[3])); f32x4 y_ = (f32x4){0.f, 0.f, 0.f, 0.f}; \
    UNR for (int u_ = 0; u_ < 4; ++u_) { Sv[u_] = Sv[u_] * W_[u_] - sk_ * A_[u_] + v_ * H_[u_]; y_ += Sv[u_] * R_[u_]; } \
    const float yy_ = quad_sum((y_[0] + y_[1]) + (y_[2] + y_[3])); if (q == 0) *yp = yy_; yp += ystep; } while (0)
__device__ __forceinline__ void mix_rwkv(const Ctx& c0, int l, int pass, int b, int h, int dir) {
    const Ctx c = fresh(c0);
    const Dims& d = c.d; const int T = pass ? d.Tl : d.Tc, tid = c.tid, lane = c.lane, wave = c.wave; const size_t tok0 = pass ? d.NTc + (size_t)b * d.Tl : (size_t)b * d.Tc;
    float* L = (float*)c.lds;
    const bf16_t* cols = c.ws<bf16_t>(d.w_cols); const float* small = c.ws<float>(d.w_small); float* scr = c.ws<float>(d.w_scr);
    constexpr int TB = 32, VST = 6 * 64;
    float *VEC = L, *LWA = L + 2 * TB * VST, *STG = LWA + 2 * 2 * TB * 64;
    const int nb = T / TB;
    __syncthreads();
    if (wave < 4) {
        const int vrow = tid >> 2, q = tid & 3;
        f32x4 Sv[4];
        if (pass) { const float* S0 = c.in(I_SR) + ((((size_t)b * DEPTH + l) * 2 + dir) * NH + h) * HD * HD + vrow * 64 + q * 16; UNR for (int u = 0; u < 4; ++u) Sv[u] = *(const f32x4*)(S0 + 4 * u); }
        else { UNR for (int u = 0; u < 4; ++u) Sv[u] = (f32x4){0.f, 0.f, 0.f, 0.f}; }
        float* yp = scr + ((tok0 + (dir ? T - 1 : 0)) * NSLOT + (dir ? SL_RB : SL_RF)) * MIXW + h * 64 + vrow; const long ystep = dir ? -(long)(NSLOT * MIXW) : (long)(NSLOT * MIXW);
        __syncthreads(); __syncthreads();
        for (int jb = 0; jb < nb; ++jb) {
            const float* buf = VEC + (jb & 1) * TB * VST;
            f32x4 aR[4], aK[4], aW[4], aA[4], aH[4], bR[4], bK[4], bW[4], bA[4], bH[4]; float av, bv;
            RW_LOAD(0, aR, aK, aW, aA, aH, av);
#pragma unroll 1
            for (int i = 0; i < TB; i += 2) {
                RW_LOAD(i + 1, bR, bK, bW, bA, bH, bv);
                RW_STEP(aR, aK, aW, aA, aH, av);
                if (i + 2 < TB) RW_LOAD(i + 2, aR, aK, aW, aA, aH, av);
                RW_STEP(bR, bK, bW, bA, bH, bv);
            }
            __syncthreads();
        }
        if (!pass) { float* So = c.p->out + d.o_r + ((((size_t)b * DEPTH + l) * 2 + dir) * NH + h) * HD * HD + vrow * 64 + q * 16; UNR for (int u = 0; u < 4; ++u) *(f32x4*)(So + 4 * u) = Sv[u]; }
    } else {
        const int pw = wave - 4, kind = pw >> 1, tj = pw & 1, ch = h * 64 + lane;
        float* stg = STG + pw * (32 * 33);
        float bw[16];
        { const float* Wg = c.in(kind ? I_WA2 : I_WW2) + ((size_t)l * 2 + dir) * 32 * MIXW + h * 64 + tj * 32 + (lane & 31);
          UNR for (int ks = 0; ks < 16; ++ks) bw[ks] = Wg[(size_t)(2 * ks + (lane >> 5)) * MIXW]; }
        const float* tp = c.in(I_SHIFT) + (size_t)l * 3 * 768 + ch;
        const float t0r = tp[0], t1r = tp[768], t2r = tp[1536], t0k = tp[256], t1k = tp[768 + 256], t2k = tp[1536 + 256], t0v = tp[512], t1v = tp[768 + 512], t2v = tp[1536 + 512];
        const float w0c = c.in(I_W0)[((size_t)l * 2 + dir) * MIXW + ch], a0c = c.in(I_A0)[((size_t)l * 2 + dir) * MIXW + ch], kkc = c.in(I_KK)[(size_t)l * MIXW + ch], kac = c.in(I_KA)[(size_t)l * MIXW + ch], rkc = c.in(I_RKK)[(size_t)l * MIXW + ch];
        float xs[16], xr[10], xk[10], xv[10];
#define RW_LOAD_XS(m_) do { UNR for (int e_ = 0; e_ < 16; ++e_) { const int idx_ = e_ * 64 + lane, stp_ = idx_ >> 5, r_ = idx_ & 31, pi_ = (m_) * TB + stp_, t_ = dir ? T - 1 - pi_ : pi_; \
            xs[e_] = small[(tok0 + t_) * NSM + (kind ? SM_RA : SM_RW) + dir * 32 + r_]; } } while (0)
#define RW_LOAD_RAW(m_) do { const int pi0_ = (m_) * TB + pw * 8, tlo_ = dir ? T - 1 - (pi0_ + 7) : pi0_; \
            UNR for (int e_ = 0; e_ < 10; ++e_) { const int tt_ = tlo_ - 1 + e_; const bool ok_ = tt_ >= 0 && tt_ < T; const bf16_t* rp_ = cols + (tok0 + (ok_ ? tt_ : 0)) * NCB + ch; \
                xr[e_] = ok_ ? bf2f(rp_[CB_RR * 256]) : 0.0f; xk[e_] = ok_ ? bf2f(rp_[CB_RK * 256]) : 0.0f; xv[e_] = ok_ ? bf2f(rp_[CB_RV * 256]) : 0.0f; } } while (0)
        RW_LOAD_XS(0);
        for (int jb = -2; jb < nb; ++jb) {
            const int mB = jb + 1, mA = jb + 2;
            if (mA < nb) {
                UNR for (int e = 0; e < 16; ++e) { const int idx = e * 64 + lane; stg[(idx >> 5) * 33 + (idx & 31)] = kind ? xs[e] : tanhf_(xs[e]); }
                WAVE_SYNC();
                const float* ap = stg + (lane & 31) * 33 + (lane >> 5); float av[16];
                UNR for (int ks = 0; ks < 16; ++ks) av[ks] = ap[2 * ks];
                f32x16 acc = zero16();
                UNR for (int ks = 0; ks < 16; ++ks) acc = __builtin_amdgcn_mfma_f32_32x32x2f32(av[ks], bw[ks], acc, 0, 0, 0);
                float* lo = LWA + (((mA & 1) * 2 + kind) * TB) * 64 + tj * 32 + (lane & 31);
                UNR for (int r = 0; r < 16; ++r) lo[ACC_ROW(r, lane) * 64] = acc[r];
                WAVE_SYNC();
            }
            if (mB >= 0 && mB < nb) {
                float* buf = VEC + (mB & 1) * TB * VST; const float* lwp = LWA + (((mB & 1) * 2 + 0) * TB) * 64 + lane; const float* lap = LWA + (((mB & 1) * 2 + 1) * TB) * 64 + lane;
                const int pi0 = mB * TB + pw * 8;
                float rr[8], kk[8], vv8[8], kp[8], ss[8], bn[8];
                UNR for (int s8 = 0; s8 < 8; ++s8) {
                    rr[s8] = t0r * (dir ? xr[7 - s8] : xr[s8]) + t1r * (dir ? xr[8 - s8] : xr[s8 + 1]) + t2r * (dir ? xr[9 - s8] : xr[s8 + 2]);
                    kk[s8] = t0k * (dir ? xk[7 - s8] : xk[s8]) + t1k * (dir ? xk[8 - s8] : xk[s8 + 1]) + t2k * (dir ? xk[9 - s8] : xk[s8 + 2]);
                    vv8[s8] = t0v * (dir ? xv[7 - s8] : xv[s8]) + t1v * (dir ? xv[8 - s8] : xv[s8 + 1]) + t2v * (dir ? xv[9 - s8] : xv[s8 + 2]);
                    kp[s8] = kk[s8] * kkc; ss[s8] = kp[s8] * kp[s8]; bn[s8] = rr[s8] * kk[s8] * rkc; }
                UNR for (int s8 = 0; s8 < 8; ++s8) ss[s8] = wave_sum(ss[s8]);
                if (dir == 0) { UNR for (int s8 = 0; s8 < 8; ++s8) bn[s8] = wave_sum(bn[s8]); }
                UNR for (int s8 = 0; s8 < 8; ++s8) {
                    const float lw = lwp[(pw * 8 + s8) * 64], la = lap[(pw * 8 + s8) * 64];
                    const float decay = fexp(-fexp(-softplusf_(-(w0c + lw)) - 0.5f)), a = sigmoidf_(a0c + la);
                    const float kap = kp[s8] * frsq(ss[s8] + LN_EPS), khat = kk[s8] * (1.0f + (a - 1.0f) * kac);
                    float* P = buf + (pw * 8 + s8) * VST + lane;
                    P[0] = rr[s8]; P[64] = kap; P[128] = vv8[s8]; P[192] = decay; P[256] = a * kap; P[320] = khat;
                    if (dir == 0) scr[((tok0 + pi0 + s8) * NSLOT + SL_RBONUS) * MIXW + ch] = bn[s8] * vv8[s8];
                }
            }
            if (mA + 1 < nb) RW_LOAD_XS(mA + 1);
            if (mB + 1 < nb) RW_LOAD_RAW(mB + 1);
            __syncthreads();
        }
#undef RW_LOAD_XS
#undef RW_LOAD_RAW
    }
    __syncthreads();
}
#undef RW_LOAD
#undef RW_STEP

__device__ __forceinline__ void phase_combine(const Ctx& c0, int l) {
    const Ctx c = fresh(c0);
    const Dims& d = c.d; const int tid = c.tid, lane = c.lane, wave = c.wave;
    float* L = (float*)c.lds; float *SG = L, *G2 = L + MSZ, *GT = L + MSZ + 64 * 256;
    const bf16_t* cols = c.ws<bf16_t>(d.w_cols); const float* small = c.ws<float>(d.w_small); const float* scr = c.ws<float>(d.w_scr); bf16_t* br = c.ws<bf16_t>(d.w_br);
    __syncthreads();
    for (int i = tid; i < 64 * 256; i += NTHREADS) G2[i] = c.in(I_WG2)[(size_t)l * 64 * MIXW + i];
    for (int blk = c.vcu; blk < d.NT / 64; blk += c.G) {
        const size_t tb = (size_t)blk * 64;
        __syncthreads();
        { const int j = tid >> 3, g = tid & 7; const float* rp = small + (tb + j) * NSM + SM_RG + g * 8; const f32x4 a = *(const f32x4*)rp, b2 = *(const f32x4*)(rp + 4); float* sp = SG + j * S65 + g * 8;
          sp[0] = sigmoidf_(a[0]); sp[1] = sigmoidf_(a[1]); sp[2] = sigmoidf_(a[2]); sp[3] = sigmoidf_(a[3]); sp[4] = sigmoidf_(b2[0]); sp[5] = sigmoidf_(b2[1]); sp[6] = sigmoidf_(b2[2]); sp[7] = sigmoidf_(b2[3]); }
        __syncthreads();
        UNR for (int u = 0; u < 2; ++u) { const int tl = wave * 2 + u, ti = tl >> 3, tj = tl & 7; f32x16 acc = zero16();
            acc = mm32(lane, acc, SG + ti * 32 * S65, S65, 1, G2 + tj * 32, 256, 1, 64);
            UNR for (int r = 0; r < 16; ++r) GT[(ti * 32 + ACC_ROW(r, lane)) * 257 + tj * 32 + (lane & 31)] = acc[r]; }
        __syncthreads();
        for (int hh = 0; hh < NH; ++hh) {
            const int j = tid >> 3, g = tid & 7; const size_t tok = tb + j; const int cb = hh * 64 + g * 8; const float* sp = scr + tok * NSLOT * MIXW + cb;
            {
              const f32x4 a0 = *(const f32x4*)(sp + SL_MF * MIXW), a1 = *(const f32x4*)(sp + SL_MF * MIXW + 4), b0 = *(const f32x4*)(sp + SL_MB * MIXW), b1 = *(const f32x4*)(sp + SL_MB * MIXW + 4);
              float x[8]; float s = 0.0f; UNR for (int e = 0; e < 4; ++e) { x[e] = a0[e] + b0[e]; x[4 + e] = a1[e] + b1[e]; } UNR for (int e = 0; e < 8; ++e) s += x[e];
              s += x1(s); s += x2(s); s += x4m(s); const float mean = s * (1.0f / 64.0f); float qv = 0.0f;
              UNR for (int e = 0; e < 8; ++e) { x[e] -= mean; qv += x[e] * x[e]; }
              qv += x1(qv); qv += x2(qv); qv += x4m(qv); const float rs = frsq(qv * (1.0f / 64.0f) + LN_EPS);
              const u32x4 ow = *(const u32x4*)(cols + tok * NCB + CB_MO * 256 + cb); const f32x4 o0 = (f32x4){bflo(ow.x), bfhi(ow.x), bflo(ow.y), bfhi(ow.y)}, o1 = (f32x4){bflo(ow.z), bfhi(ow.z), bflo(ow.w), bfhi(ow.w)};
              u32x4 w; w.x = pk2(x[0] * rs * sigmoidf_(o0[0]), x[1] * rs * sigmoidf_(o0[1])); w.y = pk2(x[2] * rs * sigmoidf_(o0[2]), x[3] * rs * sigmoidf_(o0[3]));
              w.z = pk2(x[4] * rs * sigmoidf_(o1[0]), x[5] * rs * sigmoidf_(o1[1])); w.w = pk2(x[6] * rs * sigmoidf_(o1[2]), x[7] * rs * sigmoidf_(o1[3])); *(u32x4*)(br + tok * D + 0 * MIXW + cb) = w; }
            {
              const f32x4 a0 = *(const f32x4*)(sp + SL_GF * MIXW), a1 = *(const f32x4*)(sp + SL_GF * MIXW + 4), b0 = *(const f32x4*)(sp + SL_GB * MIXW), b1 = *(const f32x4*)(sp + SL_GB * MIXW + 4);
              float x[8]; float qv = 0.0f; UNR for (int e = 0; e < 4; ++e) { x[e] = a0[e] + b0[e]; x[4 + e] = a1[e] + b1[e]; } UNR for (int e = 0; e < 8; ++e) qv += x[e] * x[e];
              qv += x1(qv); qv += x2(qv); qv += x4m(qv); const float rs = frsq(qv * (1.0f / 64.0f) + LN_EPS);
              const u32x4 ow = *(const u32x4*)(cols + tok * NCB + CB_GG * 256 + cb); const f32x4 o0 = (f32x4){bflo(ow.x), bfhi(ow.x), bflo(ow.y), bfhi(ow.y)}, o1 = (f32x4){bflo(ow.z), bfhi(ow.z), bflo(ow.w), bfhi(ow.w)};
              u32x4 w; w.x = pk2(x[0] * rs * siluf_(o0[0]), x[1] * rs * siluf_(o0[1])); w.y = pk2(x[2] * rs * siluf_(o0[2]), x[3] * rs * siluf_(o0[3]));
              w.z = pk2(x[4] * rs * siluf_(o1[0]), x[5] * rs * siluf_(o1[1])); w.w = pk2(x[6] * rs * siluf_(o1[2]), x[7] * rs * siluf_(o1[3])); *(u32x4*)(br + tok * D + 1 * MIXW + cb) = w; }
            {
              const f32x4 a0 = *(const f32x4*)(sp + SL_RF * MIXW), a1 = *(const f32x4*)(sp + SL_RF * MIXW + 4), b0 = *(const f32x4*)(sp + SL_RB * MIXW), b1 = *(const f32x4*)(sp + SL_RB * MIXW + 4);
              const f32x4 n0 = *(const f32x4*)(sp + SL_RBONUS * MIXW), n1 = *(const f32x4*)(sp + SL_RBONUS * MIXW + 4);
              float x[8]; float s = 0.0f; UNR for (int e = 0; e < 4; ++e) { x[e] = a0[e] + b0[e]; x[4 + e] = a1[e] + b1[e]; } UNR for (int e = 0; e < 8; ++e) s += x[e];
              s += x1(s); s += x2(s); s += x4m(s); const float mean = s * (1.0f / 64.0f); float qv = 0.0f;
              UNR for (int e = 0; e < 8; ++e) { x[e] -= mean; qv += x[e] * x[e]; }
              qv += x1(qv); qv += x2(qv); qv += x4m(qv); const float rs = frsq(qv * (1.0f / 64.0f) + LN_EPS);
              const float* gp = GT + j * 257 + cb;
              u32x4 w; w.x = pk2((x[0] * rs + n0[0]) * gp[0], (x[1] * rs + n0[1]) * gp[1]); w.y = pk2((x[2] * rs + n0[2]) * gp[2], (x[3] * rs + n0[3]) * gp[3]);
              w.z = pk2((x[4] * rs + n1[0]) * gp[4], (x[5] * rs + n1[1]) * gp[5]); w.w = pk2((x[6] * rs + n1[2]) * gp[6], (x[7] * rs + n1[3]) * gp[7]); *(u32x4*)(br + tok * D + 2 * MIXW + cb) = w; }
        }
    }
    __syncthreads();
}

__device__ __forceinline__ void mix_na(const Ctx& c0, int l, int pass, int b, int h, int qb) {
    const Ctx c = fresh(c0);
    const Dims& d = c.d; const int tid = c.tid, lane = c.lane, wave = c.wave; const size_t tok0 = pass ? d.NTc + (size_t)b * d.Tl : (size_t)b * d.Tc;
    constexpr int KST = 72, VST_ = 136;
    unsigned char* LB = c.lds;
    bf16_t* Kt = (bf16_t*)LB;
    bf16_t* Vt = (bf16_t*)(LB + 2 * 128 * KST * 2);
    float* rpbs = (float*)(LB + 2 * 128 * KST * 2 + 2 * 64 * VST_ * 2);
    float* Om = (float*)LB;
    float* Lm = Om + 8 * 32 * 64;
    const bf16_t* cols = c.ws<bf16_t>(d.w_cols); bf16_t* br = c.ws<bf16_t>(d.w_br);
    const int rows = d.Tl / GRIDW, kr = rows < 8 ? rows : 8; int rs = qb - kr / 2; rs = rs < 0 ? 0 : (rs > rows - kr ? rows - kr : rs);
    const int nloc = pass ? kr / 2 : 0, ntile = pass ? nloc + PAST / 128 : d.Tc / 128;
    const int qt = wave & 1, kq = wave >> 1, hh = lane >> 5, ql = lane & 31;
    __syncthreads();
    if (pass) for (int i = tid; i < 15 * 31; i += NTHREADS) rpbs[i] = c.in(I_RPB)[((size_t)l * NH + h) * 15 * 31 + i];
    bf16x8 qf[4];
    { const bf16_t* qp = cols + (tok0 + qb * 64 + qt * 32 + ql) * NCB + CB_NQ * 256 + h * 64 + 8 * hh;
      UNR for (int s4 = 0; s4 < 4; ++s4) qf[s4] = *(const bf16x8*)(qp + 16 * s4); }
    const int jp = tid >> 3, d8 = (tid & 7) * 8;
    u32x4 pk[2], pv[2];
#define NA_LOAD(kt_) do { UNR for (int u_ = 0; u_ < 2; ++u_) { const int j_ = 2 * jp + u_; \
        if (pass && (kt_) >= nloc) { const size_t o_ = ((((size_t)b * DEPTH + l) * NH + h) * PAST + ((kt_) - nloc) * 128 + j_) * HD + d8; const float* kp_ = c.in(I_CK) + o_; const float* vp_ = c.in(I_CV) + o_; \
            pk[u_] = pk8(*(const f32x4*)kp_, *(const f32x4*)(kp_ + 4)); pv[u_] = pk8(*(const f32x4*)vp_, *(const f32x4*)(vp_ + 4)); } \
        else { const size_t tk_ = pass ? tok0 + (size_t)(rs + 2 * (kt_) + (j_ >> 6)) * 64 + (j_ & 63) : tok0 + (kt_) * 128 + j_; const bf16_t* rp_ = cols + tk_ * NCB + h * 64 + d8; \
            pk[u_] = *(const u32x4*)(rp_ + CB_NK * 256); pv[u_] = *(const u32x4*)(rp_ + CB_NV * 256); } } } while (0)
#define NA_STORE(buf_) do { bf16_t* kb_ = Kt + (buf_) * 128 * KST; bf16_t* vb_ = Vt + (buf_) * 64 * VST_; \
        UNR for (int u_ = 0; u_ < 2; ++u_) *(u32x4*)(kb_ + (2 * jp + u_) * KST + d8) = pk[u_]; \
        UNR for (int e_ = 0; e_ < 8; ++e_) { const unsigned a_ = pv[0][e_ >> 1], b_ = pv[1][e_ >> 1]; \
            *(unsigned*)(vb_ + (d8 + e_) * VST_ + 2 * jp) = (e_ & 1) ? ((a_ >> 16) | (b_ & 0xffff0000u)) : ((a_ & 0xffffu) | (b_ << 16)); } } while (0)
    NA_LOAD(0);
    NA_STORE(0);
    f32x16 o0 = zero16(), o1 = zero16(); float lsum = 0.0f;
    __syncthreads();
    for (int kt = 0; kt < ntile; ++kt) {
        if (kt + 1 < ntile) NA_LOAD(kt + 1);
        const bf16_t* kb = Kt + (kt & 1) * 128 * KST + (32 * kq + ql) * KST + 8 * hh; const bf16_t* vb = Vt + (kt & 1) * 64 * VST_ + 32 * kq + 4 * hh;
        f32x16 sc = zero16();
        UNR for (int s4 = 0; s4 < 4; ++s4) sc = __builtin_amdgcn_mfma_f32_32x32x16_bf16(*(const bf16x8*)(kb + 16 * s4), qf[s4], sc, 0, 0, 0);
        if (pass && kt < nloc) {
            const int qc = 32 * qt + ql; int cs = qc - 8; cs = cs < 0 ? 0 : (cs > 48 ? 48 : cs);
            UNR for (int r = 0; r < 16; ++r) { const int jj = 32 * kq + ACC_ROW(r, lane), krow = rs + 2 * kt + (jj >> 6), kc = jj & 63; const bool ok = kc >= cs && kc < cs + 16;
                const float bias = rpbs[ok ? (krow - qb + 7) * 31 + (kc - qc + 15) : 0]; sc[r] = ok ? fexp(fminf(sc[r] * 0.125f + bias, 80.0f)) : 0.0f; }
        } else { UNR for (int r = 0; r < 16; ++r) sc[r] = fexp(fminf(sc[r] * 0.125f, 80.0f)); }
        UNR for (int r = 0; r < 16; ++r) lsum += sc[r];
        UNR for (int s2 = 0; s2 < 2; ++s2) { u32x4 w; w.x = cvtpk(sc[8 * s2], sc[8 * s2 + 1]); w.y = cvtpk(sc[8 * s2 + 2], sc[8 * s2 + 3]); w.z = cvtpk(sc[8 * s2 + 4], sc[8 * s2 + 5]); w.w = cvtpk(sc[8 * s2 + 6], sc[8 * s2 + 7]);
            const bf16x8 pf = __builtin_bit_cast(bf16x8, w);
            { const u32x2 v0 = *(const u32x2*)(vb + ql * VST_ + 16 * s2), v1 = *(const u32x2*)(vb + ql * VST_ + 16 * s2 + 8); u32x4 vw; vw.x = v0.x; vw.y = v0.y; vw.z = v1.x; vw.w = v1.y;
              o0 = __builtin_amdgcn_mfma_f32_32x32x16_bf16(pf, __builtin_bit_cast(bf16x8, vw), o0, 0, 0, 0); }
            { const u32x2 v0 = *(const u32x2*)(vb + (32 + ql) * VST_ + 16 * s2), v1 = *(const u32x2*)(vb + (32 + ql) * VST_ + 16 * s2 + 8); u32x4 vw; vw.x = v0.x; vw.y = v0.y; vw.z = v1.x; vw.w = v1.y;
              o1 = __builtin_amdgcn_mfma_f32_32x32x16_bf16(pf, __builtin_bit_cast(bf16x8, vw), o1, 0, 0, 0); } }
        if (kt + 1 < ntile) NA_STORE((kt + 1) & 1);
        __syncthreads();
    }
#undef NA_LOAD
#undef NA_STORE
    { float* om = Om + wave * 32 * 64; UNR for (int r = 0; r < 16; ++r) { om[ACC_ROW(r, lane) * 64 + ql] = o0[r]; om[ACC_ROW(r, lane) * 64 + 32 + ql] = o1[r]; }
      const float lt = lsum + __shfl_xor(lsum, 32); if (lane < 32) Lm[wave * 32 + lane] = lt; }
    __syncthreads();
    { const int q = tid >> 3, g = tid & 7, qt2 = q >> 5, q2 = q & 31; float ls = 0.0f; f32x4 a0 = (f32x4){0.f, 0.f, 0.f, 0.f}, a1 = a0;
      UNR for (int kq2 = 0; kq2 < 4; ++kq2) { const int w = kq2 * 2 + qt2; ls += Lm[w * 32 + q2]; const float* op = Om + w * 32 * 64 + q2 * 64 + g * 8; a0 += *(const f32x4*)op; a1 += *(const f32x4*)(op + 4); }
      const float il = 1.0f / ls; const size_t tok = tok0 + qb * 64 + q; bf16_t* bp = br + tok * D + 3 * MIXW + h * 64 + g * 8;
      u32x4 w; w.x = pk2(a0[0] * il, a0[1] * il); w.y = pk2(a0[2] * il, a0[3] * il); w.z = pk2(a1[0] * il, a1[1] * il); w.w = pk2(a1[2] * il, a1[3] * il); *(u32x4*)bp = w; }
    __syncthreads();
}

__device__ __forceinline__ void phase_mixers(const Ctx& c0, int l, int rep) {
    const Ctx c = fresh(c0);
    const Dims& d = c.d; const int rows = d.Tl / GRIDW;
    const int nL = d.Bl * NH, nC = d.Bc * NH, nNAl = nL * rows, nq = d.Tc / 64, nNAc = nC * nq, nR = 2 * (nL + nC);
    const int e0 = nR, e1 = e0 + nR, e2 = e1 + nR, e3 = e2 + nNAl + nNAc;
    unsigned* qctr = c.ws<unsigned>(c.d.w_ctl) + CW_QUEUE + 64 * (l + DEPTH * rep);
    int* slot = (int*)(c.lds + 163840 - 128);
#ifndef MIX_MASK
#define MIX_MASK 15
#endif
#ifndef MIX_DUP
#define MIX_DUP 15
#endif
#define MIX_FETCH() do { __syncthreads(); if (c.tid == 0) *slot = (int)atomicAdd(qctr, 1u); __syncthreads(); it = __builtin_amdgcn_readfirstlane(*slot); } while (0)
    int it; MIX_FETCH();
    while (it < e0) { const int r = it, ps = r < 2 * nL ? 1 : 0, q = ps ? r : r - 2 * nL; if ((MIX_MASK & 1) && (rep == 0 || (MIX_DUP & 1))) mix_rwkv(c, l, opqs(__builtin_amdgcn_readfirstlane(ps)), (q >> 1) / NH, (q >> 1) % NH, q & 1); MIX_FETCH(); }
    while (it < e1) { const int r = it - e0, ps = r < 2 * nL ? 1 : 0, q = ps ? r : r - 2 * nL; if ((MIX_MASK & 2) && (rep == 0 || (MIX_DUP & 2))) mix_mlstm(c, l, opqs(__builtin_amdgcn_readfirstlane(ps)), (q >> 1) / NH, (q >> 1) % NH, q & 1); MIX_FETCH(); }
    while (it < e2) { const int r = it - e1, ps = r < 2 * nL ? 1 : 0, q = ps ? r : r - 2 * nL; if ((MIX_MASK & 4) && (rep == 0 || (MIX_DUP & 4))) mix_gla(c, l, opqs(__builtin_amdgcn_readfirstlane(ps)), (q >> 1) / NH, (q >> 1) % NH, q & 1); MIX_FETCH(); }
    while (it < e3) { const int r = it - e2, ps = r < nNAl ? 1 : 0, q = ps ? r : r - nNAl, nr = ps ? rows : nq; if ((MIX_MASK & 8) && (rep == 0 || (MIX_DUP & 8))) mix_na(c, l, opqs(__builtin_amdgcn_readfirstlane(ps)), q / (NH * nr), (q / nr) % NH, q % nr); MIX_FETCH(); }
#undef MIX_FETCH
}

__device__ __forceinline__ void phase_ln1(const Ctx& c0, int l) {
    const Ctx c = fresh(c0);
    const Dims& d = c.d; const float* mods = c.mods(l); const float* v = c.ws<float>(d.w_v); bf16_t* hb = c.ws<bf16_t>(d.w_hb); float* aff = c.ws<float>(d.w_aff);
    const float* lg = c.in(I_LNG) + ((size_t)l * 2 + 0) * D; const float* lb = c.in(I_LNB) + ((size_t)l * 2 + 0) * D;
    constexpr int WRS = D + 4;
    float* WR = (float*)c.lds;
    __syncthreads();
    for (int i = c.tid; i < D * NEXP; i += NTHREADS) WR[(i & 15) * WRS + (i >> 4)] = c.in(I_WROUTER)[(size_t)l * D * NEXP + i];
    __syncthreads();
    f32x4 g4[4], b4[4];
#pragma unroll
    for (int j = 0; j < 4; ++j) { g4[j] = *(const f32x4*)(lg + 4 * c.lane + 256 * j); b4[j] = *(const f32x4*)(lb + 4 * c.lane + 256 * j); }
    for (int blk = c.vcu * NWAVES + c.wave; blk < d.NT / 8; blk += c.G * NWAVES) {
        const int tokb = blk * 8; const float* mr = mods + (size_t)c.modrow(tokb) * NMOD;
        f32x4 sh4[4], sc4[4], xn[4];
#pragma unroll
        for (int j = 0; j < 4; ++j) { sh4[j] = *(const f32x4*)(mr + 3 * D + 4 * c.lane + 256 * j); sc4[j] = *(const f32x4*)(mr + 4 * D + 4 * c.lane + 256 * j); xn[j] = *(const f32x4*)(v + (size_t)tokb * D + 4 * c.lane + 256 * j); }
        for (int ti = 0; ti < 8; ++ti) {
            const int tok = tokb + ti; f32x4 x[4]; float s = 0.0f;
#pragma unroll
            for (int j = 0; j < 4; ++j) { x[j] = xn[j]; s += (x[j][0] + x[j][1]) + (x[j][2] + x[j][3]); }
            if (ti + 1 < 8) {
#pragma unroll
                for (int j = 0; j < 4; ++j) xn[j] = *(const f32x4*)(v + (size_t)(tok + 1) * D + 4 * c.lane + 256 * j); }
            const float mean = wave_sum(s) * (1.0f / D); float q = 0.0f;
#pragma unroll
            for (int j = 0; j < 4; ++j) { x[j] = x[j] - mean; q += (x[j][0] * x[j][0] + x[j][1] * x[j][1]) + (x[j][2] * x[j][2] + x[j][3] * x[j][3]); }
            const float rstd = frsq(wave_sum(q) * (1.0f / D) + LN_EPS);
            f32x4 hh[4];
#pragma unroll
            for (int j = 0; j < 4; ++j) { const int col = 4 * c.lane + 256 * j; const f32x4 x1 = x[j] * rstd * g4[j] + b4[j]; *(f32x4*)(c.X() + (size_t)tok * D + col) = x1;
                hh[j] = x1 * (1.0f + sc4[j]) + sh4[j]; u32x2 w; w.x = pk2(hh[j][0], hh[j][1]); w.y = pk2(hh[j][2], hh[j][3]); *(u32x2*)(hb + (size_t)tok * D + col) = w; }
            float lg16[16];
#pragma unroll
            for (int e = 0; e < 16; ++e) { float a = 0.0f;
#pragma unroll
                for (int j = 0; j < 4; ++j) { const f32x4 wv = *(const f32x4*)(WR + e * WRS + 4 * c.lane + 256 * j); a += (hh[j][0] * wv[0] + hh[j][1] * wv[1]) + (hh[j][2] * wv[2] + hh[j][3] * wv[3]); }
                lg16[e] = a;
#ifndef CPU_EMU
                asm volatile("" ::: "memory");
#endif
            }
            float mx = -3.0e38f;
#pragma unroll
            for (int e = 0; e < 16; ++e) { lg16[e] = wave_sum(lg16[e]); mx = fmaxf(mx, lg16[e]); }
            float se = 0.0f;
#pragma unroll
            for (int e = 0; e < 16; ++e) { lg16[e] = expf(lg16[e] - mx); se += lg16[e]; }
            const float inv = 1.0f / se; float mine = 0.0f;
#pragma unroll
            for (int e = 0; e < 16; ++e) mine = (c.lane == e) ? lg16[e] * inv : mine;
            if (c.lane < 16) aff[(size_t)tok * NEXP + c.lane] = mine;
        }
    }
}

__device__ __forceinline__ void phase_select(const Ctx& c0) {
    const Ctx c = fresh(c0);
    const Dims& d = c.d; const float* aff = c.ws<float>(d.w_aff); int* inv = c.ws<int>(d.w_inv); float* pgate = c.ws<float>(d.w_pgate);
    const bf16_t* hb = c.ws<bf16_t>(d.w_hb); bf16_t* xe = c.ws<bf16_t>(d.w_xe);
    unsigned long long* KEY = (unsigned long long*)c.lds; int* sel = (int*)(KEY + 1024);
    const int nitems = (d.Bc + d.Bl) * NEXP;
    for (int it = c.vcu; it < nitems; it += c.G) {
        const int e = it % NEXP, bb = it / NEXP, pass = bb >= d.Bc, b = pass ? bb - d.Bc : bb, T = pass ? d.Tl : d.Tc, cap = pass ? d.capl : d.capc;
        const int tok0 = pass ? d.NTc + b * d.Tl : b * d.Tc, row0 = e * d.RPE + (pass ? d.Bc * d.capc + b * d.capl : b * d.capc);
        __syncthreads();
        for (int t = c.tid; t < T; t += NTHREADS) KEY[t] = ((unsigned long long)__builtin_bit_cast(unsigned, aff[(size_t)(tok0 + t) * NEXP + e]) << 32) | (unsigned)(~t);
        __syncthreads();
        { const int t0 = c.tid, t1 = c.tid + NTHREADS; const bool h0 = t0 < T, h1 = t1 < T; const unsigned long long k0 = h0 ? KEY[t0] : ~0ull, k1 = h1 ? KEY[t1] : ~0ull; int rank0 = 0, rank1 = 0;
#pragma unroll 4
          for (int s2 = 0; s2 < T; s2 += 2) { const unsigned long long o0 = KEY[s2], o1 = KEY[s2 + 1];
              rank0 += (o0 > k0 ? 1 : 0) + (o1 > k0 ? 1 : 0); rank1 += (o0 > k1 ? 1 : 0) + (o1 > k1 ? 1 : 0); }
          if (h0) { if (rank0 < cap) { sel[rank0] = t0; pgate[row0 + rank0] = __builtin_bit_cast(float, (unsigned)(k0 >> 32)); inv[(size_t)e * d.NT + tok0 + t0] = row0 + rank0; } else inv[(size_t)e * d.NT + tok0 + t0] = -1; }
          if (h1) { if (rank1 < cap) { sel[rank1] = t1; pgate[row0 + rank1] = __builtin_bit_cast(float, (unsigned)(k1 >> 32)); inv[(size_t)e * d.NT + tok0 + t1] = row0 + rank1; } else inv[(size_t)e * d.NT + tok0 + t1] = -1; } }
        __syncthreads();
        for (int r0 = c.wave * 4; r0 < cap; r0 += NWAVES * 4) {
            u32x4 v[4][2];
            UNR for (int u = 0; u < 4; ++u) { const int r = r0 + u < cap ? r0 + u : cap - 1; const u32x4* src = (const u32x4*)(hb + (size_t)(tok0 + sel[r]) * D); v[u][0] = src[c.lane]; v[u][1] = src[c.lane + 64]; }
            UNR for (int u = 0; u < 4; ++u) { if (r0 + u < cap) { u32x4* dst = (u32x4*)(xe + (size_t)(row0 + r0 + u) * D); dst[c.lane] = v[u][0]; dst[c.lane + 64] = v[u][1]; } }
        }
    }
}

__device__ __forceinline__ void phase_ln2(const Ctx& c0, int l) {
    const Ctx c = fresh(c0);
    const Dims& d = c.d; const float* mods = c.mods(l); const bf16_t* y = c.ws<bf16_t>(d.w_y); const int* inv = c.ws<int>(d.w_inv); bf16_t* hb = c.ws<bf16_t>(d.w_hb);
    const float* lg = c.in(I_LNG) + ((size_t)l * 2 + 1) * D; const float* lb = c.in(I_LNB) + ((size_t)l * 2 + 1) * D;
    const float* modn = (l + 1 < DEPTH) ? c.mods(l + 1) : nullptr;
    const int gw = c.vcu * NWAVES + c.wave, NGW = c.G * NWAVES;
    for (int tok = gw; tok < d.NT; tok += NGW) {
        const int mrow = c.modrow(tok); const float* mr = mods + (size_t)mrow * NMOD; f32x4 ff[4];
#pragma unroll
        for (int j = 0; j < 4; ++j) ff[j] = (f32x4){0.f, 0.f, 0.f, 0.f};
        for (int e = 0; e < NEXP; ++e) { const int row = inv[(size_t)e * d.NT + tok]; if (row >= 0) {
#pragma unroll
            for (int j = 0; j < 4; ++j) { const u32x2 w = *(const u32x2*)(y + (size_t)row * D + 4 * c.lane + 256 * j); ff[j] += (f32x4){bflo(w.x), bfhi(w.x), bflo(w.y), bfhi(w.y)}; } } }
        f32x4 x[4]; float s = 0.0f;
#pragma unroll
        for (int j = 0; j < 4; ++j) { const int col = 4 * c.lane + 256 * j; const f32x4 x1 = *(const f32x4*)(c.X() + (size_t)tok * D + col), g2 = *(const f32x4*)(mr + 5 * D + col);
            x[j] = ALPHA * x1 + g2 * ff[j]; s += (x[j][0] + x[j][1]) + (x[j][2] + x[j][3]); }
        const float mean = wave_sum(s) * (1.0f / D); float q = 0.0f;
#pragma unroll
        for (int j = 0; j < 4; ++j) { x[j] = x[j] - mean; q += (x[j][0] * x[j][0] + x[j][1] * x[j][1]) + (x[j][2] * x[j][2] + x[j][3] * x[j][3]); }
        const float rstd = frsq(wave_sum(q) * (1.0f / D) + LN_EPS);
#pragma unroll
        for (int j = 0; j < 4; ++j) { const int col = 4 * c.lane + 256 * j; const f32x4 g = *(const f32x4*)(lg + col), bb = *(const f32x4*)(lb + col);
            const f32x4 x2 = x[j] * rstd * g + bb; *(f32x4*)(c.X() + (size_t)tok * D + col) = x2;
            if (modn) { const float* mn = modn + (size_t)mrow * NMOD; const f32x4 sh = *(const f32x4*)(mn + col), sc = *(const f32x4*)(mn + D + col); const f32x4 hh = x2 * (1.0f + sc) + sh;
                u32x2 w; w.x = pk2(hh[0], hh[1]); w.y = pk2(hh[2], hh[3]); *(u32x2*)(hb + (size_t)tok * D + col) = w; } }
    }
}

constexpr int N_PHASES = 2 + 10 * DEPTH;
__device__ __forceinline__ void run_phase(const Ctx& c0, int ph, int rep) {
    const Ctx c = fresh(c0); const Dims& d = c.d;
#ifndef PHASE_MASK
#define PHASE_MASK 0xFFFF
#endif
    if (ph == 0) { if (PHASE_MASK & 0x400) phase_prep(c); return; }
    if (ph == 1) { if (PHASE_MASK & 0x800) phase_init(c); return; }
    const int l = (ph - 2) / 10, s = (ph - 2) % 10;
    LAS unsigned char* ldsp = (LAS unsigned char*)c.lds;
    if (!((PHASE_MASK >> s) & 1)) return;
    switch (s) {
    case 0: { pg8::Gemm g{c.ws<bf16_t>(d.w_hb), c.ws<bf16_t>(d.w_win) + (size_t)l * NINP * D, D}; pg8::StaticOrder S; S.init(d.NT, NINP, c.G, (int)blockIdx.x);
              EpiCols E{c.ws<bf16_t>(d.w_cols), c.ws<float>(d.w_small), c.ws<unsigned char>(d.w_gates), c.p->out + d.o_nk, c.p->out + d.o_nv, l, d.NTc, d.Tc}; pg8::gemm_phase<EpiCols, pg8::StaticOrder>(ldsp, g, S, E); } break;
    case 1: phase_mixers(c, l, rep); break;
    case 2: phase_combine(c, l); break;
    case 3: { pg8::Gemm g{c.ws<bf16_t>(d.w_br), c.ws<bf16_t>(d.w_wbr) + (size_t)l * D * D, D}; pg8::StaticOrder S; S.init(d.NT, D, c.G, (int)blockIdx.x);
              EpiWiden E{c.ws<unsigned char>(d.w_gates), c.ws<bf16_t>(d.w_merged)}; pg8::gemm_phase<EpiWiden, pg8::StaticOrder>(ldsp, g, S, E); } break;
    case 4: { pg8::Gemm g{c.ws<bf16_t>(d.w_merged), c.ws<bf16_t>(d.w_wout) + (size_t)l * D * D, D}; pg8::StaticOrder S; S.init(d.NT, D, c.G, (int)blockIdx.x);
              EpiPreLN E{c.X(), c.mods(l), c.ws<float>(d.w_v), d.NTc, d.Tl}; pg8::gemm_phase<EpiPreLN, pg8::StaticOrder>(ldsp, g, S, E); } break;
    case 5: phase_ln1(c, l); break;
    case 6: phase_select(c); break;
    case 7: { pg8::Gemm g{c.ws<bf16_t>(d.w_xe), c.ws<bf16_t>(d.w_wup) + (size_t)l * NEXP * 2 * FF * D, D}; pg8::GroupOrder S; S.init(d.TPE, 2 * FF / 256, NEXP, c.G, c.vcu);
              EpiSwiGLU E{c.ws<bf16_t>(d.w_act)}; pg8::gemm_phase<EpiSwiGLU, pg8::GroupOrder>(ldsp, g, S, E); } break;
    case 8: { pg8::Gemm g{c.ws<bf16_t>(d.w_act), c.ws<bf16_t>(d.w_wdn) + (size_t)l * NEXP * D * FF, FF}; pg8::GroupOrder S; S.init(d.TPE, D / 256, NEXP, c.G, c.vcu);
              EpiDown E{c.ws<float>(d.w_pgate), c.ws<bf16_t>(d.w_y)}; pg8::gemm_phase<EpiDown, pg8::GroupOrder>(ldsp, g, S, E); } break;
    default: phase_ln2(c, l); break;
    }
}

#ifndef CPU_EMU
#define XB_TMO      128
#define XB_XCNT(j)  (256  + 64 * (j))
#define XB_XSUB(j)  (1280 + 64 * (j))
#define XB_XGEN(j)  (2304 + 64 * (j))
#define XB_TOP      3328
#define XB_TOPGEN   3392
#define XB_SPIN_CAP (1u << 20)
__device__ __forceinline__ unsigned xb_ld(unsigned* p)              { return __hip_atomic_load(p, __ATOMIC_RELAXED, __HIP_MEMORY_SCOPE_AGENT); }
__device__ __forceinline__ unsigned xb_add(unsigned* p, unsigned v) { return __hip_atomic_fetch_add(p, v, __ATOMIC_RELAXED, __HIP_MEMORY_SCOPE_AGENT); }
__device__ __forceinline__ unsigned xb_xcc_id() { return (unsigned)__builtin_amdgcn_s_getreg((3 << 11) | 20) & 0xFu; }
#define XB_SPIN(cond, bar) do { unsigned _sp = 0; while (cond) { __builtin_amdgcn_s_sleep(1); \
    if ((++_sp & 255u) == 0u) { if (xb_ld(&(bar)[XB_TMO])) break; if (_sp > XB_SPIN_CAP) { atomicAdd(&(bar)[XB_TMO], 1u); break; } } } } while (0)
struct XcdBarrier { unsigned* bar; unsigned x; volatile LAS unsigned* st; };
__device__ __forceinline__ XcdBarrier xcd_barrier_post(unsigned* bar, volatile LAS unsigned* st) {
    XcdBarrier b; b.bar = bar; b.x = xb_xcc_id(); b.st = st;
    if (threadIdx.x == 0) (void)xb_add(&bar[XB_XCNT(b.x)], 1u);
    return b;
}
__device__ __forceinline__ void xcd_barrier_complete(unsigned* bar, unsigned x, unsigned& nloc, unsigned& nx) {
    const unsigned G = gridDim.x * gridDim.y * gridDim.z;
    unsigned sum, cnt, mine, sp = 0u;
    for (;;) {
        sum = 0u; cnt = 0u; mine = 0u;
#pragma unroll
        for (unsigned j = 0; j < 16; ++j) { const unsigned cc = xb_ld(&bar[XB_XCNT(j)]); sum += cc; cnt += (cc > 0u) ? 1u : 0u; mine = (j == x) ? cc : mine; }
        if (sum == G) break;
        __builtin_amdgcn_s_sleep(1);
        if ((++sp & 255u) == 0u) { if (xb_ld(&bar[XB_TMO])) break; if (sp > XB_SPIN_CAP) { atomicAdd(&bar[XB_TMO], 1u); break; } }
    }
    nloc = mine > 0u ? mine : 1u; nx = cnt > 0u ? cnt : 1u;
}
__device__ __forceinline__ void xcd_barrier(const XcdBarrier& b) {
    asm volatile("s_waitcnt vmcnt(0)" ::: "memory");
    __syncthreads();
    if (threadIdx.x == 0) {
        unsigned* bar = b.bar;
        __builtin_amdgcn_s_waitcnt(0);
        unsigned nloc = b.st[0], nx = b.st[1];
        if (nloc == 0u) { xcd_barrier_complete(bar, b.x, nloc, nx); b.st[0] = nloc; b.st[1] = nx; }
        const unsigned old = xb_add(&bar[XB_XSUB(b.x)], 1u);
        const unsigned gen = old / nloc;
        if (old + 1u == (gen + 1u) * nloc) {
            __builtin_amdgcn_fence(__ATOMIC_RELEASE, "agent");
            asm volatile("s_waitcnt vmcnt(0)" ::: "memory");
            const unsigned og = xb_add(&bar[XB_TOP], 1u);
            const unsigned tg = og / nx;
            if (og + 1u == (tg + 1u) * nx) xb_add(&bar[XB_TOPGEN], 1u);
            else XB_SPIN(xb_ld(&bar[XB_TOPGEN]) == tg, bar);
            __builtin_amdgcn_fence(__ATOMIC_ACQUIRE, "agent");
            xb_add(&bar[XB_XGEN(b.x)], 1u);
            asm volatile("s_waitcnt vmcnt(0)" ::: "memory");
        } else {
            XB_SPIN(xb_ld(&bar[XB_XGEN(b.x)]) == gen, bar);
            __builtin_amdgcn_fence(__ATOMIC_ACQUIRE, "agent");
            asm volatile("s_waitcnt vmcnt(0)" ::: "memory");
        }
    }
    __syncthreads();
}

#ifndef PROBE_DUP
#define PROBE_DUP 0
#endif
constexpr int LDS_BYTES = 163840;
__global__ void __launch_bounds__(NTHREADS, 2) trunk_fwd(Params p) {
    extern __shared__ __attribute__((aligned(16))) unsigned char lds[];
    Ctx c; c.p = &p; c.d = make_dims(p.Bc, p.Tc, p.Bl, p.Tl); c.lds = lds;
    c.tid = threadIdx.x; c.lane = c.tid & 63; c.wave = __builtin_amdgcn_readfirstlane(c.tid >> 6);
    c.G = gridDim.x; { const int bx = blockIdx.x; c.vcu = (c.G % 8 == 0) ? (bx % 8) * (c.G / 8) + bx / 8 : bx; }
    volatile LAS unsigned* st = (volatile LAS unsigned*)((LAS unsigned char*)lds + LDS_BYTES - 64);
    XcdBarrier bar; bar.bar = nullptr; bar.x = 0; bar.st = st;
    if (p.use_bar) { if (c.tid < 2) st[c.tid] = 0u; __syncthreads(); bar = xcd_barrier_post((unsigned*)(p.ws) + CW_BAR, st); }
    for (int ph = p.ph_lo; ph < p.ph_hi; ++ph) {
        run_phase(c, ph, 0);
#if PROBE_DUP
        { const int kind = ph == 0 ? 10 : (ph == 1 ? 11 : (ph - 2) % 10); if ((PROBE_DUP >> kind) & 1) { xcd_barrier(bar); run_phase(c, ph, 1); } }
#endif
        if (ph + 1 < p.ph_hi) xcd_barrier(bar);
    }
}

#ifndef N_LAUNCH_MODE
#define N_LAUNCH_MODE 1
#endif
extern "C" void kernel_launch(void* const* d_in, const int* in_sizes, int n_in, void* d_out, int out_size, void* d_ws, size_t ws_size, hipStream_t stream) {
    static int grid = 0;
    const Dims d = make_dims(32, 256, 8, 1024);
    if (grid == 0) {
        int dev = 0, cus = 0;
        if (n_in != N_INPUTS || (size_t)out_size != d.o_end || ws_size < ((size_t)d.w_end << 8)) { fprintf(stderr, "kernel_launch: unexpected sizes: n_in %d out %d ws %zu (need %zu / %zu)\n", n_in, out_size, ws_size, (size_t)d.o_end, (size_t)d.w_end << 8); grid = -1; return; }
        if (hipGetDevice(&dev) != hipSuccess || hipDeviceGetAttribute(&cus, hipDeviceAttributeMultiprocessorCount, dev) != hipSuccess) { grid = -1; return; }
        if (hipFuncSetAttribute((const void*)trunk_fwd, hipFuncAttributeMaxDynamicSharedMemorySize, LDS_BYTES) != hipSuccess) { fprintf(stderr, "kernel_launch: hipFuncSetAttribute failed\n"); grid = -1; return; }
        int per_cu = 0;
        if (hipOccupancyMaxActiveBlocksPerMultiprocessor(&per_cu, (const void*)trunk_fwd, NTHREADS, LDS_BYTES) != hipSuccess || per_cu < 1) fprintf(stderr, "kernel_launch: occupancy query says %d\n", per_cu);
        (void)hipGetLastError();
        grid = cus;
    }
    if (grid < 0) return;
    (void)hipMemsetAsync((char*)d_ws, 0, CTL_BYTES, stream);
    Params p{};
    for (int i = 0; i < N_INPUTS; ++i) p.in[i] = (const float*)d_in[i];
    p.out = (float*)d_out; p.ws = (unsigned char*)d_ws; p.Bc = 32; p.Tc = 256; p.Bl = 8; p.Tl = 1024;
#if N_LAUNCH_MODE == 1
    p.ph_lo = 0; p.ph_hi = N_PHASES; p.use_bar = 1;
    hipLaunchKernelGGL(trunk_fwd, dim3(grid), dim3(NTHREADS), LDS_BYTES, stream, p);
#else
    for (int ph = 0; ph < N_PHASES; ++ph) { p.ph_lo = ph; p.ph_hi = ph + 1; p.use_bar = 0; hipLaunchKernelGGL(trunk_fwd, dim3(grid), dim3(NTHREADS), LDS_BYTES, stream, p); }
#endif
}
#endif
```

```cpp
#ifndef CPU_EMU
#include <hip/hip_runtime.h>
#include <cstdio>
typedef float f32x16 __attribute__((ext_vector_type(16)));
typedef float f32x4 __attribute__((ext_vector_type(4)));
typedef float f32x2 __attribute__((ext_vector_type(2)));
typedef unsigned u32x4 __attribute__((ext_vector_type(4)));
typedef unsigned u32x2 __attribute__((ext_vector_type(2)));
#define LAS __attribute__((address_space(3)))
#define WAVE_SYNC() asm volatile("s_waitcnt lgkmcnt(0)" ::: "memory")
#else
#define LAS
#define WAVE_SYNC() emu::wave_sync()
#endif
#define UNR _Pragma("unroll")
#ifndef CPU_EMU
#define LDS_BARRIER() do { asm volatile("s_waitcnt lgkmcnt(0)\n\ts_barrier" ::: "memory"); } while (0)
#else
#define LDS_BARRIER() __syncthreads()
#endif
typedef short bf16x8 __attribute__((ext_vector_type(8)));
typedef unsigned short bf16_t;

constexpr int D = 1024, NH = 4, HD = 64, MIXW = 256, NEXP = 16, FF = 2048, DEPTH = 2, PAST = 256, GRIDW = 64;
constexpr int NIN = 7920, NINP = 7936, NCB = 3584, NSM = 256, NGATE = 4096, NMOD = 6 * D;
constexpr float ALPHA = 1.4142135623730951f, LN_EPS = 1e-5f;
constexpr int NTHREADS = 512, NWAVES = 8;
constexpr int CB_MQ = 0, CB_MK = 1, CB_MV = 2, CB_MO = 3, CB_GQ = 4, CB_GK = 5, CB_GV = 6, CB_GG = 7, CB_RR = 8, CB_RK = 9, CB_RV = 10, CB_NQ = 11, CB_NK = 12, CB_NV = 13;
constexpr int SM_MI = 0, SM_MF = 8, SM_GA = 16, SM_RW = 48, SM_RA = 112, SM_RG = 176;
enum { I_XP = 0, I_XS, I_SC, I_SN, I_SM, I_SG, I_SR, I_CK, I_CV, I_C, I_CCTX, I_WADA, I_BADA, I_WIN, I_BIG, I_BFG, I_WGLA, I_BGLA, I_SHIFT, I_W0, I_WW2, I_A0, I_WA2, I_WG2, I_KK, I_KA, I_RKK,
       I_RPB, I_WBR, I_WOUT, I_LNG, I_LNB, I_WROUTER, I_WUP, I_WDOWN, N_INPUTS };

__host__ __device__ __forceinline__ int prow(int n) { const int rho = n & 31; return (n & ~31) + 8 * ((rho & 15) >> 2) + 4 * (rho >> 4) + (rho & 3); }
__host__ __device__ __forceinline__ int win_col(int p) {
    if (p < 3584) { const int b = p >> 8, w = p & 255; const int base = b < 4 ? b * 256 : (b < 8 ? 1040 + (b - 4) * 256 : (b < 11 ? 2096 + (b - 8) * 256 : 3056 + (b - 11) * 256)); return base + w; }
    if (p < 3840) { const int s = p - 3584; return s < 16 ? 1024 + s : (s < 48 ? 2064 + (s - 16) : (s < 240 ? 2864 + (s - 48) : -1)); }
    return p - 16;
}

struct Params {
    const float* in[N_INPUTS];
    float* out; unsigned char* ws;
    int Bc, Tc, Bl, Tl;
    int ph_lo, ph_hi;
    int use_bar, pad;
};
struct Dims {
    int Bc, Tc, Bl, Tl, NTc, NTl, NT, capc, capl, RPE, TPE, NPR;
    unsigned o_yp, o_ys, o_C, o_n, o_m, o_g, o_r, o_nk, o_nv, o_end;
    unsigned w_ctl, w_win, w_wbr, w_wout, w_wup, w_wdn, w_mods, w_hb, w_cols, w_small, w_vecs, w_gates, w_br, w_scr, w_merged, w_v, w_aff, w_inv, w_pgate, w_xe, w_act, w_y, w_end;
};
constexpr size_t CTL_BYTES = 1u << 20;
constexpr int CW_BAR = 4096, CW_QUEUE = 1024;
__host__ __device__ __forceinline__ unsigned al256(size_t x) { return (unsigned)((x + 255) >> 8); }
__host__ __device__ __forceinline__ Dims make_dims(int Bc, int Tc, int Bl, int Tl) {
    Dims d; d.Bc = Bc; d.Tc = Tc; d.Bl = Bl; d.Tl = Tl; d.NTc = Bc * Tc; d.NTl = Bl * Tl; d.NT = d.NTc + d.NTl;
    d.capc = Tc / 8; d.capl = Tl / 8; d.RPE = ((Bc * d.capc + Bl * d.capl + 255) / 256) * 256; d.TPE = d.RPE / 256; d.NPR = NEXP * d.RPE;
    unsigned o = 0; d.o_yp = o; o += (unsigned)d.NTc * D; d.o_ys = o; o += (unsigned)d.NTl * D;
    d.o_C = o; o += (unsigned)Bc * DEPTH * 2 * NH * HD * HD; d.o_n = o; o += (unsigned)Bc * DEPTH * 2 * NH * HD; d.o_m = o; o += (unsigned)Bc * DEPTH * 2 * NH;
    d.o_g = o; o += (unsigned)Bc * DEPTH * 2 * NH * HD * HD; d.o_r = o; o += (unsigned)Bc * DEPTH * 2 * NH * HD * HD;
    d.o_nk = o; o += (unsigned)Bc * DEPTH * NH * Tc * HD; d.o_nv = o; o += (unsigned)Bc * DEPTH * NH * Tc * HD; d.o_end = o;
    unsigned w = 0; d.w_ctl = w; w += (unsigned)(CTL_BYTES >> 8);
    d.w_win = w; w += al256((size_t)DEPTH * NINP * D * 2); d.w_wbr = w; w += al256((size_t)DEPTH * D * D * 2); d.w_wout = w; w += al256((size_t)DEPTH * D * D * 2);
    d.w_wup = w; w += al256((size_t)DEPTH * NEXP * 2 * FF * D * 2); d.w_wdn = w; w += al256((size_t)DEPTH * NEXP * D * FF * 2);
    d.w_mods = w; w += al256((size_t)DEPTH * (1 + Bl) * NMOD * 4);
    d.w_hb = w; w += al256((size_t)d.NT * D * 2); d.w_cols = w; w += al256((size_t)d.NT * NCB * 2); d.w_small = w; w += al256((size_t)d.NT * NSM * 4); d.w_vecs = w; w += al256((size_t)d.NT * NH * 576 * 4); d.w_gates = w; w += al256((size_t)d.NT * NGATE);
    d.w_br = w; w += al256((size_t)d.NT * D * 2); d.w_scr = w; w += al256((size_t)d.NT * 7 * MIXW * 2); d.w_merged = w; w += al256((size_t)d.NT * D * 2);
    d.w_v = w; w += al256((size_t)d.NT * D * 4); d.w_aff = w; w += al256((size_t)d.NT * NEXP * 4); d.w_inv = w; w += al256((size_t)d.NT * NEXP * 4);
    d.w_pgate = w; w += al256((size_t)d.NPR * 4); d.w_xe = w; w += al256((size_t)d.NPR * D * 2); d.w_act = w; w += al256((size_t)d.NPR * FF * 2); d.w_y = w; w += al256((size_t)d.NPR * D * 2);
    d.w_end = w; return d;
}

__device__ __forceinline__ unsigned f2bf(float f) { unsigned u = __builtin_bit_cast(unsigned, f); return (u + 0x7fffu + ((u >> 16) & 1u)) >> 16; }
#ifndef CPU_EMU
__device__ __forceinline__ unsigned cvtpk(float lo, float hi) { unsigned r; asm("v_cvt_pk_bf16_f32 %0, %1, %2" : "=v"(r) : "v"(lo), "v"(hi)); return r; }
__device__ __forceinline__ unsigned pk2(float lo, float hi) { return cvtpk(lo, hi); }
#else
inline unsigned pk2(float lo, float hi) { return f2bf(lo) | (f2bf(hi) << 16); }
inline unsigned cvtpk(float lo, float hi) { return pk2(lo, hi); }
#endif

#ifndef CPU_EMU
template <int CTRL> __device__ __forceinline__ float dppf(float v) { return __builtin_bit_cast(float, __builtin_amdgcn_update_dpp(0, __builtin_bit_cast(int, v), CTRL, 0xF, 0xF, true)); }
__device__ __forceinline__ float x1(float v) { return dppf<0xB1>(v); }
__device__ __forceinline__ float x2(float v) { return dppf<0x4E>(v); }
__device__ __forceinline__ float x4m(float v) { return dppf<0x141>(v); }
__device__ __forceinline__ float x8m(float v) { return dppf<0x140>(v); }
__device__ __forceinline__ float fexp(float x) { return __expf(x); }
__device__ __forceinline__ float flog(float x) { return __logf(x); }
__device__ __forceinline__ float frsq(float x) { return __builtin_amdgcn_rsqf(x); }
#else
inline float x1(float v) { return __shfl_xor(v, 1); }
inline float x2(float v) { return __shfl_xor(v, 2); }
inline float x4m(float v) { return __shfl_xor(v, 4); }
inline float x8m(float v) { return __shfl_xor(v, 8); }
inline float fexp(float x) { return expf(x); }
inline float flog(float x) { return logf(x); }
inline float frsq(float x) { return 1.0f / sqrtf(x); }
#endif
__device__ __forceinline__ float quad_sum(float v) { v += x1(v); v += x2(v); return v; }
__device__ __forceinline__ float oct_sum(float v) { v += x1(v); v += x2(v); v += x4m(v); return v; }
__device__ __forceinline__ float oct_max(float v) { v = fmaxf(v, x1(v)); v = fmaxf(v, x2(v)); v = fmaxf(v, x4m(v)); return v; }
__device__ __forceinline__ float sigmoidf_(float x) { return __builtin_amdgcn_rcpf(1.0f + fexp(-x)); }
__device__ __forceinline__ float logsigmoidf_(float x) { return fminf(x, 0.0f) - flog(1.0f + fexp(-fabsf(x))); }
__device__ __forceinline__ float softplusf_(float x) { return fmaxf(x, 0.0f) + flog(1.0f + fexp(-fabsf(x))); }
__device__ __forceinline__ float tanhf_(float x) { const float e = fexp(-2.0f * fabsf(x)); const float t = (1.0f - e) * __builtin_amdgcn_rcpf(1.0f + e); return x < 0.0f ? -t : t; }
__device__ __forceinline__ float siluf_(float x) { return x * __builtin_amdgcn_rcpf(1.0f + fexp(-x)); }
#ifndef CPU_EMU
__device__ __forceinline__ float rlane(float v, int l) { return __builtin_bit_cast(float, __builtin_amdgcn_readlane(__builtin_bit_cast(int, v), l)); }
__device__ __forceinline__ float wave_sum(float v) {
    v += x1(v); v += x2(v); v += x4m(v); v += x8m(v);
    return (rlane(v, 0) + rlane(v, 16)) + (rlane(v, 32) + rlane(v, 48));
}
#else
inline float wave_sum(float v) { for (int o = 1; o < 64; o <<= 1) v += __shfl_xor(v, o); return v; }
#endif
__device__ __forceinline__ unsigned pkh2(float a, float b) { const _Float16 x = (_Float16)a, y = (_Float16)b; return (unsigned)__builtin_bit_cast(unsigned short, x) | ((unsigned)__builtin_bit_cast(unsigned short, y) << 16); }
#ifndef CPU_EMU
__device__ __forceinline__ float frcp(float x) { return __builtin_amdgcn_rcpf(x); }
#else
inline float frcp(float x) { return 1.0f / x; }
#endif
__device__ __forceinline__ float bf2f(unsigned v) { return __builtin_bit_cast(float, v << 16); }
__device__ __forceinline__ float bflo(unsigned w) { return __builtin_bit_cast(float, w << 16); }
__device__ __forceinline__ float bfhi(unsigned w) { return __builtin_bit_cast(float, w & 0xffff0000u); }
__device__ __forceinline__ float h2f(unsigned short h) { return (float)__builtin_bit_cast(_Float16, h); }

#ifndef CPU_EMU
__device__ __forceinline__ int opqv(int x) { asm volatile("" : "+v"(x)); return x; }
__device__ __forceinline__ int opqs(int x) { asm volatile("" : "+s"(x)); return x; }
#else
inline int opqv(int x) { return x; }
inline int opqs(int x) { return x; }
#endif
namespace pg8 {
constexpr int BM = 256, BK = 64, HALF = 128, HTB = HALF * BK * 2, STAGE_BYTES = 8 * HTB, NXCD = 8, WGM = 8;
__host__ __device__ __forceinline__ int lds_byte(int r, int c) { const int st = (r >> 4) * 2 + (c >> 5), rr = r & 15, cc = c & 31, ob = rr * 64 + cc * 2; return st * 1024 + (ob ^ (((ob >> 9) & 1) << 5)); }
__host__ __device__ __forceinline__ void stage_rc(int b, int& R, int& C) { const int st = b / 1024, sb = b % 1024, swz = sb ^ (((sb >> 9) & 1) << 5); R = (st >> 1) * 16 + swz / 64; C = (st & 1) * 32 + (swz % 64) / 2; }
struct Unit { int pm, pn, ta, tb; };
struct Gemm { const bf16_t* A; const bf16_t* Bt; int K; };
struct StaticOrder {
    int nM, nN, nwg, G, c;
    __device__ __forceinline__ void init(int M, int N, int G_, int c_) { nM = M / BM; nN = N / BM; nwg = nM * nN; G = G_; c = c_; }
    __device__ __forceinline__ bool next(int i, Unit& u) const {
        const long L = (long)i * G + c; if (L >= nwg) return false;
        int wgid = (int)L; { const int q = nwg / NXCD, r = nwg % NXCD, xcd = wgid % NXCD, off = wgid / NXCD; wgid = (xcd < r ? xcd * (q + 1) : r * (q + 1) + (xcd - r) * q) + off; }
        const int nig = WGM * nN, gid = wgid / nig, fm = gid * WGM, gsz = (nM - fm) < WGM ? (nM - fm) : WGM;
        u.pm = fm + ((wgid % nig) % gsz); u.pn = (wgid % nig) / gsz; u.ta = u.pm; u.tb = u.pn; return true;
    }
};
struct GroupOrder {
    int tpe, nN, nE, G, c;
    __device__ __forceinline__ void init(int tpe_, int nN_, int nE_, int G_, int c_) { tpe = tpe_; nN = nN_; nE = nE_; G = G_; c = c_; }
    __device__ __forceinline__ bool next(int i, Unit& u) const {
        const long L = (long)i * G + c; if (L >= (long)nE * tpe * nN) return false;
        const int per = tpe * nN, e = (int)(L / per), r = (int)(L % per), pn = r / tpe, pm = r % tpe;
        u.ta = e * tpe + pm; u.tb = e * nN + pn; u.pm = u.ta; u.pn = pn; return true;
    }
};
#ifndef CPU_EMU
template <class Epi, class Sched>
__device__ __forceinline__ void gemm_phase(LAS unsigned char* lds, const Gemm g, const Sched& S, const Epi& E) {
    const int tid = opqv((int)threadIdx.x), wid = __builtin_amdgcn_readfirstlane(tid >> 6), lane = tid & 63, wr = wid >> 2, wc = wid & 3, fr = lane & 15, fq = lane >> 4;
    const int K = g.K, nt = K / BK;
    unsigned voffA[2];
#pragma unroll
    for (int i = 0; i < 2; ++i) { int R, C; stage_rc(tid * 16 + i * 8192, R, C); voffA[i] = (unsigned)(R * K + C) * 2u; }
    const size_t kstep = (size_t)(BK * 2), hstep = (size_t)HALF * K * 2, tstep = 2 * hstep;
    const unsigned ldsw = (unsigned)wid * 1024u;
    const int aoff = lds_byte(wr * 64 + fr, fq * 8), boff = lds_byte(wc * 32 + fr, fq * 8);
#define PG8_SA(b, h) (((b) * 2 + (h)) * HTB)
#define PG8_SB(b, h) ((4 + (b) * 2 + (h)) * HTB)
#define PG8_STAGE(bufoff, gbase) do { _Pragma("unroll") for (int _i = 0; _i < 2; ++_i) \
        __builtin_amdgcn_global_load_lds((const unsigned*)((const char*)(gbase) + voffA[_i]), (LAS unsigned*)(lds + (bufoff) + ldsw + _i * 8192), 16, 0, 0); } while (0)
#define PG8_LDA(dst, b, h) do { _Pragma("unroll") for (int m = 0; m < 4; ++m) _Pragma("unroll") for (int k = 0; k < 2; ++k) dst[m][k] = *(const LAS bf16x8*)(lds + PG8_SA(b, h) + aoff + m * 2048 + k * 1024); } while (0)
#define PG8_LDB(dst, b, h) do { _Pragma("unroll") for (int n = 0; n < 2; ++n) _Pragma("unroll") for (int k = 0; k < 2; ++k) dst[n][k] = *(const LAS bf16x8*)(lds + PG8_SB(b, h) + boff + n * 2048 + k * 1024); } while (0)
#define PG8_MMA(ai, bj, At, Bt) do { __builtin_amdgcn_s_setprio(1); _Pragma("unroll") for (int m = 0; m < 4; ++m) _Pragma("unroll") for (int n = 0; n < 2; ++n) _Pragma("unroll") for (int k = 0; k < 2; ++k) \
        acc[ai][bj][m][n] = __builtin_amdgcn_mfma_f32_16x16x32_bf16(Bt[n][k], At[m][k], acc[ai][bj][m][n], 0, 0, 0); __builtin_amdgcn_s_setprio(0); } while (0)
#define PG8_WAIT_V(n) asm volatile("s_waitcnt vmcnt(" #n ")" ::: "memory")
#define PG8_WAIT_L(n) asm volatile("s_waitcnt lgkmcnt(" #n ")" ::: "memory")
#define PG8_BAR __builtin_amdgcn_s_barrier()
#define PG8_SCHED __builtin_amdgcn_sched_barrier(0)
    Unit cur, nxt; int ui = 0;
    if (!S.next(0, cur)) return;
    f32x4 acc[2][2][4][2];
#pragma unroll
    for (int a = 0; a < 2; ++a)
#pragma unroll
        for (int b = 0; b < 2; ++b)
#pragma unroll
            for (int m = 0; m < 4; ++m)
#pragma unroll
                for (int n = 0; n < 2; ++n) acc[a][b][m][n] = (f32x4){0.f, 0.f, 0.f, 0.f};
    bf16x8 At[4][2], B0[2][2], B1[2][2];
    const char* cA = (const char*)g.A + (size_t)cur.ta * tstep; const char* cB = (const char*)g.Bt + (size_t)cur.tb * tstep;
    PG8_STAGE(PG8_SB(0, 0), cB); PG8_STAGE(PG8_SB(0, 1), cB + hstep); PG8_STAGE(PG8_SA(0, 0), cA); PG8_STAGE(PG8_SA(0, 1), cA + hstep);
    if (wr == 1) PG8_BAR;
    PG8_WAIT_V(2); PG8_BAR;
    PG8_STAGE(PG8_SB(1, 0), cB + kstep); PG8_STAGE(PG8_SA(1, 0), cA + kstep); PG8_STAGE(PG8_SB(1, 1), cB + hstep + kstep);
    PG8_WAIT_V(6); PG8_BAR;
    for (;;) {
        const bool has_next = S.next(ui + 1, nxt);
        const char* nA = has_next ? (const char*)g.A + (size_t)nxt.ta * tstep : cA; const char* nB = has_next ? (const char*)g.Bt + (size_t)nxt.tb * tstep : cB;
        for (int t = 0; t < nt; t += 2) {
            const bool last = (t == nt - 2);
            const char* a1 = cA + (size_t)(t + 1) * kstep;
            const char* a2 = last ? nA : cA + (size_t)(t + 2) * kstep; const char* b2 = last ? nB : cB + (size_t)(t + 2) * kstep;
            const char* a3 = a2 + kstep; const char* b3 = b2 + kstep;
            if constexpr (Epi::MID) { if (t != 0 && (t & 3) == 0) E.mid(acc, cur, t >> 2, wr, wc, fr, fq); }
            PG8_LDB(B0, 0, 0); PG8_LDB(B1, 0, 1); PG8_SCHED; PG8_LDA(At, 0, 0); PG8_STAGE(PG8_SA(1, 1), a1 + hstep);
            PG8_WAIT_V(8); PG8_WAIT_L(0); PG8_BAR; PG8_MMA(0, 0, At, B0); PG8_MMA(0, 1, At, B1); PG8_BAR; PG8_SCHED;
            PG8_LDA(At, 0, 1); PG8_STAGE(PG8_SB(0, 0), b2); PG8_STAGE(PG8_SB(0, 1), b2 + hstep); PG8_STAGE(PG8_SA(0, 0), a2);
            PG8_WAIT_V(8); PG8_WAIT_L(0); PG8_BAR; PG8_MMA(1, 0, At, B0); PG8_MMA(1, 1, At, B1); PG8_BAR; PG8_SCHED;
            PG8_LDB(B0, 1, 0); PG8_LDB(B1, 1, 1); PG8_SCHED; PG8_LDA(At, 1, 0); PG8_STAGE(PG8_SA(0, 1), a2 + hstep);
            PG8_WAIT_V(8); PG8_WAIT_L(0); PG8_BAR; PG8_MMA(0, 0, At, B0); PG8_MMA(0, 1, At, B1); PG8_BAR; PG8_SCHED;
            PG8_LDA(At, 1, 1); PG8_STAGE(PG8_SB(1, 0), b3); PG8_STAGE(PG8_SB(1, 1), b3 + hstep); PG8_STAGE(PG8_SA(1, 0), a3);
            PG8_WAIT_V(8); PG8_WAIT_L(0); PG8_BAR; PG8_MMA(1, 0, At, B0); PG8_MMA(1, 1, At, B1); PG8_BAR; PG8_SCHED;
        }
        if (wr == 0) PG8_BAR;
        E(acc, cur, wr, wc, fr, fq);
        if (!has_next) break;
#pragma unroll
        for (int a = 0; a < 2; ++a)
#pragma unroll
            for (int b = 0; b < 2; ++b)
#pragma unroll
                for (int m = 0; m < 4; ++m)
#pragma unroll
                    for (int n = 0; n < 2; ++n) acc[a][b][m][n] = (f32x4){0.f, 0.f, 0.f, 0.f};
        cur = nxt; cA = nA; cB = nB; ++ui;
        if (wr == 1) PG8_BAR;
    }
    PG8_WAIT_V(0);
    PG8_BAR;
#undef PG8_SA
#undef PG8_SB
#undef PG8_STAGE
#undef PG8_LDA
#undef PG8_LDB
#undef PG8_MMA
#undef PG8_WAIT_V
#undef PG8_WAIT_L
#undef PG8_BAR
#undef PG8_SCHED
}
#else
template <class Epi, class Sched> void gemm_phase(unsigned char* lds, const Gemm g, const Sched& S, const Epi& E);
#endif
}
typedef f32x4 AccT[2][2][4][2];

struct Ctx {
    const Params* p; Dims d; unsigned char* lds; int tid, lane, wave, G, vcu;
    template <class T> __device__ __forceinline__ T* ws(unsigned off) const { return (T*)(p->ws + ((size_t)off << 8)); }
    __device__ __forceinline__ const float* in(int i) const { return p->in[i]; }
    __device__ __forceinline__ int modrow(int tok) const { return tok < d.NTc ? 0 : 1 + (tok - d.NTc) / d.Tl; }
    __device__ __forceinline__ const float* mods(int l) const { return ws<float>(d.w_mods) + (size_t)l * (1 + d.Bl) * NMOD; }
    __device__ __forceinline__ float* X() const { return p->out; }
};

__device__ __forceinline__ Ctx fresh(const Ctx& c0) {
    Ctx c; c.p = c0.p; c.lds = c0.lds; c.tid = opqv(c0.tid); c.lane = c.tid & 63; c.wave = opqs(c0.wave); c.G = opqs(c0.G); c.vcu = opqs(c0.vcu);
    c.d = make_dims(opqs(c0.p->Bc), opqs(c0.p->Tc), opqs(c0.p->Bl), opqs(c0.p->Tl)); return c;
}

__device__ __forceinline__ u32x4 pk8(const f32x4 a, const f32x4 b) { u32x4 w; w.x = pk2(a[0], a[1]); w.y = pk2(a[2], a[3]); w.z = pk2(b[0], b[1]); w.w = pk2(b[2], b[3]); return w; }
__device__ __forceinline__ unsigned gq(float x) { const float g = sigmoidf_(x) * 255.0f + 0.5f; const unsigned q = (unsigned)g; return q < 1u ? 1u : (q > 255u ? 255u : q); }
__device__ __forceinline__ float ub(unsigned w, int i) { return (float)((w >> (8 * i)) & 0xffu); }
struct EpiCols {
    static constexpr bool MID = false;
    bf16_t* cols; float* small; unsigned char* gates; float* onk; float* onv; int l, NTc, Tc;
    __device__ __forceinline__ void operator()(const AccT& acc, const pg8::Unit& u, int wr, int wc, int fr, int fq) const {
        const int row0 = u.pm * 256 + wr * 64 + fr, cw = wc * 32 + 8 * fq;
        if (u.pn < 14) {
            float* okv = u.pn == 12 ? onk : (u.pn == 13 ? onv : nullptr);
#pragma unroll
            for (int ai = 0; ai < 2; ++ai)
#pragma unroll
                for (int m = 0; m < 4; ++m) { const int row = row0 + ai * 128 + m * 16; bf16_t* rp = cols + (size_t)row * NCB + u.pn * 256 + cw;
#pragma unroll
                    for (int bj = 0; bj < 2; ++bj) { *(u32x4*)(rp + bj * 128) = pk8(acc[ai][bj][m][0], acc[ai][bj][m][1]);
                        if (okv && row < NTc) { const int cc = bj * 128 + cw, b = row / Tc, t = row - b * Tc; float* op = okv + ((((size_t)b * DEPTH + l) * NH + (cc >> 6)) * Tc + t) * HD + (cc & 63);
                            *(f32x4*)op = acc[ai][bj][m][0]; *(f32x4*)(op + 4) = acc[ai][bj][m][1]; } } }
        } else if (u.pn == 14) {
#pragma unroll
            for (int ai = 0; ai < 2; ++ai)
#pragma unroll
                for (int m = 0; m < 4; ++m) { float* rp = small + (size_t)(row0 + ai * 128 + m * 16) * NSM + cw;
#pragma unroll
                    for (int bj = 0; bj < 2; ++bj) { *(f32x4*)(rp + bj * 128) = acc[ai][bj][m][0]; *(f32x4*)(rp + bj * 128 + 4) = acc[ai][bj][m][1]; } }
        } else {
#pragma unroll
            for (int ai = 0; ai < 2; ++ai)
#pragma unroll
                for (int m = 0; m < 4; ++m) { unsigned char* rp = gates + (size_t)(row0 + ai * 128 + m * 16) * NGATE + (u.pn - 15) * 256 + cw;
#pragma unroll
                    for (int bj = 0; bj < 2; ++bj) { const f32x4 a = acc[ai][bj][m][0], b = acc[ai][bj][m][1]; u32x2 w;
                        w.x = gq(a[0]) | (gq(a[1]) << 8) | (gq(a[2]) << 16) | (gq(a[3]) << 24); w.y = gq(b[0]) | (gq(b[1]) << 8) | (gq(b[2]) << 16) | (gq(b[3]) << 24);
                        *(u32x2*)(rp + bj * 128) = w; } }
        }
    }
};
struct EpiWiden {
    static constexpr bool MID = true;
    const unsigned char* gates; bf16_t* merged;
    __device__ __forceinline__ void mid(AccT& acc, const pg8::Unit& u, int z1, int wr, int wc, int fr, int fq) const {
        const int row0 = opqv(u.pm * 256 + wr * 64 + fr), col0 = opqv(u.pn * 256 + wc * 32 + 8 * fq);
#pragma unroll
        for (int ai = 0; ai < 2; ++ai)
#pragma unroll
            for (int m = 0; m < 4; ++m) { const unsigned char* rp = gates + (size_t)(row0 + ai * 128 + m * 16) * NGATE + col0;
#pragma unroll
                for (int bj = 0; bj < 2; ++bj) { const u32x2 a = *(const u32x2*)(rp + (z1 - 1) * 1024 + bj * 128), b = *(const u32x2*)(rp + z1 * 1024 + bj * 128);
                    f32x4 r0, r1;
                    UNR for (int e = 0; e < 4; ++e) { r0[e] = ub(a.x, e) * frcp(ub(b.x, e)); r1[e] = ub(a.y, e) * frcp(ub(b.y, e)); }
                    acc[ai][bj][m][0] *= r0; acc[ai][bj][m][1] *= r1;
#ifndef CPU_EMU
                    asm volatile("" ::: "memory");
#endif
                } }
    }
    __device__ __forceinline__ void operator()(const AccT& acc, const pg8::Unit& u, int wr, int wc, int fr, int fq) const {
        const int row0 = u.pm * 256 + wr * 64 + fr, col0 = u.pn * 256 + wc * 32 + 8 * fq;
#pragma unroll
        for (int ai = 0; ai < 2; ++ai)
#pragma unroll
            for (int m = 0; m < 4; ++m) { const size_t ro = (size_t)(row0 + ai * 128 + m * 16);
#pragma unroll
                for (int bj = 0; bj < 2; ++bj) { const u32x2 b = *(const u32x2*)(gates + ro * NGATE + 3 * 1024 + col0 + bj * 128); f32x4 a0 = acc[ai][bj][m][0], a1 = acc[ai][bj][m][1];
                    UNR for (int e = 0; e < 4; ++e) { a0[e] *= ub(b.x, e) * (1.0f / 255.0f); a1[e] *= ub(b.y, e) * (1.0f / 255.0f); }
                    *(u32x4*)(merged + ro * D + col0 + bj * 128) = pk8(a0, a1); } }
    }
};
struct EpiPreLN {
    static constexpr bool MID = false;
    const float* xa; const float* xb; const float* mods; float* v; int NTc, Tl;
    __device__ __forceinline__ void operator()(const AccT& acc, const pg8::Unit& u, int wr, int wc, int fr, int fq) const {
        const int row0 = u.pm * 256 + wr * 64 + fr, col0 = u.pn * 256 + wc * 32 + 8 * fq;
#pragma unroll
        for (int ai = 0; ai < 2; ++ai)
#pragma unroll
            for (int m = 0; m < 4; ++m) { const int row = row0 + ai * 128 + m * 16; const int mr = row < NTc ? 0 : 1 + (row - NTc) / Tl; const float* g1 = mods + (size_t)mr * NMOD + 2 * D + col0;
                const size_t ro = (size_t)row * D + col0; const float* x = row < NTc ? xa : xb;
#pragma unroll
                for (int bj = 0; bj < 2; ++bj)
#pragma unroll
                    for (int n = 0; n < 2; ++n) { const int o = bj * 128 + n * 4; const f32x4 xv = *(const f32x4*)(x + ro + o), gv = *(const f32x4*)(g1 + o);
                        *(f32x4*)(v + ro + o) = ALPHA * xv + gv * acc[ai][bj][m][n]; } }
    }
};
struct EpiSwiGLU {
    static constexpr bool MID = false;
    bf16_t* act;
    __device__ __forceinline__ void operator()(const AccT& acc, const pg8::Unit& u, int wr, int wc, int fr, int fq) const {
        const int row0 = u.pm * 256 + wr * 64 + fr, col0 = u.pn * 128 + wc * 32 + 8 * fq;
#pragma unroll
        for (int ai = 0; ai < 2; ++ai)
#pragma unroll
            for (int m = 0; m < 4; ++m) { bf16_t* rp = act + (size_t)(row0 + ai * 128 + m * 16) * FF + col0; f32x4 o[2];
#pragma unroll
                for (int n = 0; n < 2; ++n) { const f32x4 a = acc[ai][0][m][n], b = acc[ai][1][m][n]; o[n][0] = siluf_(a[0]) * b[0]; o[n][1] = siluf_(a[1]) * b[1]; o[n][2] = siluf_(a[2]) * b[2]; o[n][3] = siluf_(a[3]) * b[3]; }
                *(u32x4*)rp = pk8(o[0], o[1]); }
    }
};
struct EpiDown {
    static constexpr bool MID = false;
    const float* pgate; bf16_t* y;
    __device__ __forceinline__ void operator()(const AccT& acc, const pg8::Unit& u, int wr, int wc, int fr, int fq) const {
        const int row0 = u.pm * 256 + wr * 64 + fr, col0 = u.pn * 256 + wc * 32 + 8 * fq;
#pragma unroll
        for (int ai = 0; ai < 2; ++ai)
#pragma unroll
            for (int m = 0; m < 4; ++m) { const int row = row0 + ai * 128 + m * 16; const float gt = pgate[row]; bf16_t* rp = y + (size_t)row * D + col0;
#pragma unroll
                for (int bj = 0; bj < 2; ++bj) *(u32x4*)(rp + bj * 128) = pk8(gt * acc[ai][bj][m][0], gt * acc[ai][bj][m][1]); }
    }
};

template <class ColMap>
__device__ __forceinline__ void tr_item(const float* src, int src_ld, const ColMap& cm, bf16_t* dst, int dst_ld, int dst_koff, int n0, int k0, float* scr, int lane) {
    const int r = lane >> 4, c4 = (lane & 15) * 4; const int sc = cm(prow(n0 + c4));
    f32x4 v[16];
    UNR for (int i = 0; i < 16; ++i) v[i] = sc >= 0 ? *(const f32x4*)(src + (size_t)(k0 + i * 4 + r) * src_ld + sc) : (f32x4){0.f, 0.f, 0.f, 0.f};
    UNR for (int i = 0; i < 16; ++i) { float* p = scr + (i * 4 + r) * 65 + c4; p[0] = v[i][0]; p[1] = v[i][1]; p[2] = v[i][2]; p[3] = v[i][3]; }
    WAVE_SYNC();
    const int kc = lane & 7;
    UNR for (int j = 0; j < 8; ++j) { const int n = (lane >> 3) + 8 * j; const float* p = scr + (8 * kc) * 65 + n;
        u32x4 o; o.x = pk2(p[0 * 65], p[1 * 65]); o.y = pk2(p[2 * 65], p[3 * 65]); o.z = pk2(p[4 * 65], p[5 * 65]); o.w = pk2(p[6 * 65], p[7 * 65]);
        *(u32x4*)(dst + (size_t)(n0 + n) * dst_ld + dst_koff + k0 + 8 * kc) = o; }
    WAVE_SYNC();
}
struct CmId { __device__ __forceinline__ int operator()(int n) const { return n; } };
struct CmWin { __device__ __forceinline__ int operator()(int n) const { return win_col(n); } };
struct CmUp { __device__ __forceinline__ int operator()(int n) const { const int u = n >> 8, w = n & 255; return (w < 128 ? 0 : FF) + u * 128 + (w & 127); } };

__device__ __forceinline__ void phase_prep(const Ctx& c0) {
    const Ctx c = fresh(c0);
    const Dims& d = c.d;
    float* L = (float*)c.lds;
    const int nrow = 1 + d.Bl;
    const int gw = c.vcu * NWAVES + c.wave, NGW = c.G * NWAVES;
    const int nmod_items = DEPTH * (NMOD / 64);
    if (c.vcu < nmod_items) {
        const int l = c.vcu / (NMOD / 64), j = (c.vcu % (NMOD / 64)) * 64 + c.lane, kw = c.wave * 128;
        const float* w = c.in(I_WADA) + ((size_t)l * D + kw) * NMOD + j;
        float* cond = L + c.wave * 4160;
        for (int i = c.lane; i < 9 * 128; i += 64) { const int r = i >> 7, k = kw + (i & 127); const float v = r == 0 ? c.in(I_CCTX)[k] : (r < nrow ? c.in(I_C)[(size_t)(r - 1) * D + k] : 0.0f); cond[i] = siluf_(v); }
        WAVE_SYNC();
        float a[9];
        UNR for (int r = 0; r < 9; ++r) a[r] = 0.0f;
#pragma unroll 8
        for (int k = 0; k < 128; ++k) { const float wv = w[(size_t)k * NMOD]; UNR for (int r = 0; r < 9; ++r) a[r] += cond[r * 128 + k] * wv; }
        UNR for (int r = 0; r < 9; ++r) cond[1152 + r * 64 + c.lane] = a[r];
        __syncthreads();
        if (c.wave == 0) { const float bias = c.in(I_BADA)[(size_t)l * NMOD + j]; float* mo = c.ws<float>(d.w_mods) + (size_t)l * nrow * NMOD + j;
            UNR for (int r = 0; r < 9; ++r) { float t = bias; UNR for (int ww = 0; ww < 8; ++ww) t += L[ww * 4160 + 1152 + r * 64 + c.lane]; if (r < nrow) mo[(size_t)r * NMOD] = t; } }
        __syncthreads();
    }
    float* scr = L + c.wave * 4160;
    const int I_IN = (D / 64) * (NINP / 64), I_BR = 4 * (MIXW / 64) * (D / 64), I_OUT = (D / 64) * (D / 64), I_UP = NEXP * (D / 64) * (2 * FF / 64), I_DN = NEXP * (FF / 64) * (D / 64);
    const int PER_L = I_IN + I_BR + I_OUT + I_UP + I_DN;
    for (int it = gw; it < DEPTH * PER_L; it += NGW) {
        const int l = it / PER_L; int r = it % PER_L;
        if (r < I_IN) { const int nb = NINP / 64, kb = r / nb, n0 = (r % nb) * 64;
            tr_item(c.in(I_WIN) + (size_t)l * D * NIN, NIN, CmWin(), c.ws<bf16_t>(d.w_win) + (size_t)l * NINP * D, D, 0, n0, kb * 64, scr, c.lane); continue; } r -= I_IN;
        if (r < I_BR) { const int per = (MIXW / 64) * (D / 64), z = r / per, q = r % per, kb = q / (D / 64), n0 = (q % (D / 64)) * 64;
            tr_item(c.in(I_WBR) + ((size_t)l * 4 + z) * MIXW * D, D, CmId(), c.ws<bf16_t>(d.w_wbr) + (size_t)l * D * D, D, z * MIXW, n0, kb * 64, scr, c.lane); continue; } r -= I_BR;
        if (r < I_OUT) { const int kb = r / (D / 64), n0 = (r % (D / 64)) * 64;
            tr_item(c.in(I_WOUT) + (size_t)l * D * D, D, CmId(), c.ws<bf16_t>(d.w_wout) + (size_t)l * D * D, D, 0, n0, kb * 64, scr, c.lane); continue; } r -= I_OUT;
        if (r < I_UP) { const int per = (D / 64) * (2 * FF / 64), e = r / per, q = r % per, kb = q / (2 * FF / 64), n0 = (q % (2 * FF / 64)) * 64;
            tr_item(c.in(I_WUP) + ((size_t)l * NEXP + e) * D * 2 * FF, 2 * FF, CmUp(), c.ws<bf16_t>(d.w_wup) + ((size_t)l * NEXP + e) * 2 * FF * D, D, 0, n0, kb * 64, scr, c.lane); continue; } r -= I_UP;
        { const int per = (FF / 64) * (D / 64), e = r / per, q = r % per, kb = q / (D / 64), n0 = (q % (D / 64)) * 64;
            tr_item(c.in(I_WDOWN) + ((size_t)l * NEXP + e) * FF * D, D, CmId(), c.ws<bf16_t>(d.w_wdn) + ((size_t)l * NEXP + e) * D * FF, FF, 0, n0, kb * 64, scr, c.lane); }
    }
}

__device__ __forceinline__ void phase_init(const Ctx& c0) {
    const Ctx c = fresh(c0);
    const Dims& d = c.d; const float* mods = c.mods(0); bf16_t* hb = c.ws<bf16_t>(d.w_hb);
    const int gw = c.vcu * NWAVES + c.wave, NGW = c.G * NWAVES;
    for (int tok = gw; tok < d.NT; tok += NGW) {
        const float* xr = tok < d.NTc ? c.in(I_XP) + (size_t)tok * D : c.in(I_XS) + (size_t)(tok - d.NTc) * D;
        const float* mr = mods + (size_t)c.modrow(tok) * NMOD;
#pragma unroll
        for (int j = 0; j < 4; ++j) { const int col = 4 * c.lane + 256 * j; const f32x4 x = *(const f32x4*)(xr + col), sh = *(const f32x4*)(mr + col), sc = *(const f32x4*)(mr + D + col);
            const f32x4 h = x * (1.0f + sc) + sh;
            u32x2 w; w.x = pk2(h[0], h[1]); w.y = pk2(h[2], h[3]); *(u32x2*)(hb + (size_t)tok * D + col) = w; }
    }
}

__device__ __forceinline__ f32x16 mm32(int lane, f32x16 acc, const float* A, int sai, int sak, const float* Bm, int sbk, int sbj, int K) {
    const int i = lane & 31, kk = lane >> 5;
    const float* ap = A + i * sai + kk * sak; const float* bp = Bm + kk * sbk + i * sbj;
#pragma unroll 8
    for (int k = 0; k < K; k += 2) acc = __builtin_amdgcn_mfma_f32_32x32x2f32(ap[k * sak], bp[k * sbk], acc, 0, 0, 0);
    return acc;
}
__device__ __forceinline__ f32x16 mmb(int lane, f32x16 acc, const bf16_t* A, int sa, const bf16_t* Bt, int sb, int K) {
    const bf16_t* ap = A + (lane & 31) * sa + 8 * (lane >> 5); const bf16_t* bp = Bt + (lane & 31) * sb + 8 * (lane >> 5);
    for (int k = 0; k < K; k += 16) acc = __builtin_amdgcn_mfma_f32_32x32x16_bf16(*(const bf16x8*)(ap + k), *(const bf16x8*)(bp + k), acc, 0, 0, 0);
    return acc;
}
__device__ __forceinline__ int tsw(int row, int col) { return row * 72 + ((col + 8 * ((row >> 3) & 7)) & 63); }
template <bool SWA, bool SWB>
__device__ __forceinline__ f32x16 mmb64(int lane, f32x16 acc, const bf16_t* A, int arow0, const bf16_t* Bt, int brow0) {
    const int ra = arow0 + (lane & 31), rb = brow0 + (lane & 31), h8 = 8 * (lane >> 5), sa = SWA ? 8 * ((ra >> 3) & 7) : 0, sb = SWB ? 8 * ((rb >> 3) & 7) : 0;
#pragma unroll
    for (int k = 0; k < 64; k += 16) acc = __builtin_amdgcn_mfma_f32_32x32x16_bf16(*(const bf16x8*)(A + ra * 72 + ((h8 + k + sa) & 63)), *(const bf16x8*)(Bt + rb * 72 + ((h8 + k + sb) & 63)), acc, 0, 0, 0);
    return acc;
}
#define ACC_ROW(r, lane) (((r) & 3) + 8 * ((r) >> 2) + 4 * ((lane) >> 5))
__device__ __forceinline__ f32x16 zero16() { f32x16 z; UNR for (int r = 0; r < 16; ++r) z[r] = 0.0f; return z; }
constexpr int S65 = 65, MSZ = 64 * 65;

__device__ __forceinline__ void build_rope(float* cosT, float* sinT, int tid) {
    for (int i = tid; i < 1024; i += NTHREADS) { const int pos = i >> 4, f = i & 15; const float inv = powf(10000.0f, -(float)f / 16.0f); const float ang = (float)pos * inv; cosT[i] = cosf(ang); sinT[i] = sinf(ang); }
}
__device__ __forceinline__ float rope_elem(const float* rowp, int dd, int t, const float* cosT, const float* sinT) {
    const int f = dd & 15, second = (dd >> 4) & 1, pos = (dd < 32) ? (t / GRIDW) : (t % GRIDW);
    const float x = rowp[dd], xp = rowp[second ? dd - 16 : dd + 16], cs = cosT[pos * 16 + f], sn = sinT[pos * 16 + f];
    return second ? (xp * sn + x * cs) : (x * cs - xp * sn);
}

constexpr int SL_MF = 0, SL_MB = 1, SL_GF = 2, SL_GB = 3, SL_RF = 4, SL_RB = 5, SL_RBONUS = 6, NSLOT = 7;

struct ChunkRegs { u32x4 q, qp, k, kp, v; };
__device__ __forceinline__ float bfel(const u32x4 w, int e) { const unsigned x = w[e >> 1]; return (e & 1) ? bfhi(x) : bflo(x); }
__device__ __forceinline__ void chunk_load(ChunkRegs& R, const bf16_t* cols, size_t tok0, int T, int dir, int ci, int h, int cbq, int tid) {
    const int j = tid >> 3, g = tid & 7, t = dir ? T - 1 - (ci * 64 + j) : ci * 64 + j; const bf16_t* rp = cols + (tok0 + t) * NCB + cbq * 256 + h * 64;
    R.q = *(const u32x4*)(rp + 8 * g); R.qp = *(const u32x4*)(rp + 8 * (g ^ 2)); R.k = *(const u32x4*)(rp + 256 + 8 * g); R.kp = *(const u32x4*)(rp + 256 + 8 * (g ^ 2)); R.v = *(const u32x4*)(rp + 512 + 8 * g);
}
__device__ __forceinline__ void chunk_store(const ChunkRegs& R, float* Q, float* K, float* V, int T, int dir, int ci, int pass, float qs, float ks, const float* cosT, const float* sinT, int tid) {
    const int j = tid >> 3, g = tid & 7, t = dir ? T - 1 - (ci * 64 + j) : ci * 64 + j, second = (g >> 1) & 1, pos = g < 4 ? (t / GRIDW) : (t % GRIDW), o = j * S65 + 8 * g;
    UNR for (int e = 0; e < 8; ++e) { float q = bfel(R.q, e), k = bfel(R.k, e);
        if (pass) { const float qp = bfel(R.qp, e), kp = bfel(R.kp, e), cs = cosT[pos * 16 + 8 * (g & 1) + e], sn = sinT[pos * 16 + 8 * (g & 1) + e];
            q = second ? qp * sn + q * cs : q * cs - qp * sn; k = second ? kp * sn + k * cs : k * cs - kp * sn; }
        Q[o + e] = q * qs; K[o + e] = k * ks; V[o + e] = bfel(R.v, e); }
}

__device__ __forceinline__ void chunk_store_ml(const ChunkRegs& R, float* Q, float* K, bf16_t* Qb, bf16_t* Kb, bf16_t* VbT, int T, int dir, int ci, int pass, const float* cosT, const float* sinT, int tid) {
    const int j = tid >> 3, g = tid & 7, t = dir ? T - 1 - (ci * 64 + j) : ci * 64 + j, second = (g >> 1) & 1, pos = g < 4 ? (t / GRIDW) : (t % GRIDW), o = j * S65 + 8 * g;
    float qv[8], kv[8];
    UNR for (int e = 0; e < 8; ++e) { float q = bfel(R.q, e), k = bfel(R.k, e);
        if (pass) { const float qp = bfel(R.qp, e), kp = bfel(R.kp, e), cs = cosT[pos * 16 + 8 * (g & 1) + e], sn = sinT[pos * 16 + 8 * (g & 1) + e];
            q = second ? qp * sn + q * cs : q * cs - qp * sn; k = second ? kp * sn + k * cs : k * cs - kp * sn; }
        qv[e] = q; kv[e] = k * 0.125f; Q[o + e] = qv[e]; K[o + e] = kv[e]; }
    u32x4 w; w.x = cvtpk(qv[0], qv[1]); w.y = cvtpk(qv[2], qv[3]); w.z = cvtpk(qv[4], qv[5]); w.w = cvtpk(qv[6], qv[7]); *(u32x4*)(Qb + j * 72 + 8 * g) = w;
    w.x = cvtpk(kv[0], kv[1]); w.y = cvtpk(kv[2], kv[3]); w.z = cvtpk(kv[4], kv[5]); w.w = cvtpk(kv[6], kv[7]); *(u32x4*)(Kb + j * 72 + 8 * g) = w;
    UNR for (int e = 0; e < 8; ++e) VbT[tsw(8 * g + e, j)] = (bf16_t)(R.v[e >> 1] >> (16 * (e & 1)));
}
__device__ __forceinline__ void mix_mlstm(const Ctx& c0, int l, int pass, int b, int h, int dir) {
    const Ctx c = fresh(c0);
    const Dims& d = c.d; const int T = pass ? d.Tl : d.Tc, nc = T / 64, tid = c.tid, lane = c.lane, wave = c.wave; const size_t tok0 = pass ? d.NTc + (size_t)b * d.Tl : (size_t)b * d.Tc;
    float* L = (float*)c.lds;
    float *Q = L, *K = L + MSZ, *C = L + 2 * MSZ, *Sm = L + 3 * MSZ, *QC = L + 4 * MSZ, *vec = L + 5 * MSZ;
    float *nv = vec, *ig = vec + 64, *lf = vec + 128, *bc = vec + 192, *lw = vec + 256, *wint = vec + 320, *rden = vec + 384, *scal = vec + 448, *npart = vec + 512, *cosT = vec + 1024, *sinT = vec + 2048, *ksv = vec + 3072;
    bf16_t* Bb = (bf16_t*)(vec + 3200); bf16_t *Qb = Bb, *Kb = Bb + 64 * 72, *VbT = Bb + 2 * 64 * 72, *CbT = Bb + 3 * 64 * 72, *Smb = Bb + 4 * 64 * 72, *KsT = Bb + 5 * 64 * 72;
    const bf16_t* cols = c.ws<bf16_t>(d.w_cols); const float* small = c.ws<float>(d.w_small); bf16_t* scr = c.ws<bf16_t>(d.w_scr);
    __syncthreads();
    if (pass) build_rope(cosT, sinT, tid);
    if (pass) { const float* C0 = c.in(I_SC) + ((((size_t)b * DEPTH + l) * 2 + dir) * NH + h) * HD * HD;
        _Pragma("unroll 2") for (int i = tid; i < 4096; i += NTHREADS) { const float cv = C0[i]; C[(i >> 6) * S65 + (i & 63)] = cv; CbT[(i & 63) * 72 + (i >> 6)] = (bf16_t)f2bf(cv); }
        if (tid < 64) nv[tid] = c.in(I_SN)[((((size_t)b * DEPTH + l) * 2 + dir) * NH + h) * HD + tid];
        if (tid == 0) scal[0] = c.in(I_SM)[(((size_t)b * DEPTH + l) * 2 + dir) * NH + h];
    } else { _Pragma("unroll 2") for (int i = tid; i < 4096; i += NTHREADS) { C[(i >> 6) * S65 + (i & 63)] = 0.0f; CbT[(i & 63) * 72 + (i >> 6)] = 0; } if (tid < 64) nv[tid] = 0.0f; if (tid == 0) scal[0] = 0.0f; }
    const float big = c.in(I_BIG)[((size_t)l * 2 + dir) * NH + h], bfg = c.in(I_BFG)[((size_t)l * 2 + dir) * NH + h];
    ChunkRegs R; float rig = 0.0f, rlf = 0.0f;
    chunk_load(R, cols, tok0, T, dir, 0, h, CB_MQ, tid);
    if (tid < 64) { const int t = dir ? T - 1 - tid : tid; const float* rp = small + (tok0 + t) * NSM; rig = rp[SM_MI + dir * 4 + h]; rlf = rp[SM_MF + dir * 4 + h]; }
    __syncthreads();
    chunk_store_ml(R, Q, K, Qb, Kb, VbT, T, dir, 0, pass, cosT, sinT, tid);
    if (tid < 64) { ig[tid] = rig + big; lf[tid] = logsigmoidf_(rlf + bfg); }
    for (int ci = 0; ci < nc; ++ci) {
        const int tid_ = opqv(tid), lane_ = tid_ & 63;
        if (ci + 1 < nc) {
            chunk_load(R, cols, tok0, T, dir, ci + 1, h, CB_MQ, tid_);
            if (tid_ < 64) { const int t = dir ? T - 1 - ((ci + 1) * 64 + tid_) : (ci + 1) * 64 + tid_; const float* rp = small + (tok0 + t) * NSM; rig = rp[SM_MI + dir * 4 + h]; rlf = rp[SM_MF + dir * 4 + h]; }
        }
        LDS_BARRIER();
        if (wave == 0) { float run = lf[lane_];
            UNR for (int o = 1; o < 64; o <<= 1) { const float up = __shfl(run, lane_ >= o ? lane_ - o : lane_); run += lane_ >= o ? up : 0.0f; }
            const float bend = __shfl(run, 63), m = scal[0], w = bend - run + ig[lane_]; float mx = w;
            mx = fmaxf(mx, x1(mx)); mx = fmaxf(mx, x2(mx)); mx = fmaxf(mx, x4m(mx)); mx = fmaxf(mx, x8m(mx)); mx = fmaxf(mx, __shfl_xor(mx, 16)); mx = fmaxf(mx, __shfl_xor(mx, 32));
            const float mnew = fmaxf(bend + m, mx); bc[lane_] = run; lw[lane_] = w; if (lane_ == 0) { scal[1] = mnew; scal[2] = fexp(bend + m - mnew); } }
        { const int ti = (wave >> 1) & 1, tj = wave & 1; f32x16 acc = zero16();
          if (wave < 4) { acc = mmb(lane_, acc, Qb + ti * 32 * 72, 72, Kb + tj * 32 * 72, 72, 64); UNR for (int r = 0; r < 16; ++r) Sm[(ti * 32 + ACC_ROW(r, lane_)) * S65 + tj * 32 + (lane_ & 31)] = acc[r]; }
          else { acc = mmb(lane_, acc, Qb + ti * 32 * 72, 72, CbT + tj * 32 * 72, 72, 64); UNR for (int r = 0; r < 16; ++r) QC[(ti * 32 + ACC_ROW(r, lane_)) * S65 + tj * 32 + (lane_ & 31)] = acc[r]; } }
        LDS_BARRIER();
        { const int t = tid_ >> 3, g = tid_ & 7; const float m = scal[0], mnew = scal[1], bt = bc[t]; float mx = -3.0e38f;
          UNR for (int e = 0; e < 8; ++e) { const int s = g * 8 + e; if (s <= t) mx = fmaxf(mx, bt - bc[s] + ig[s]); }
          mx = fmaxf(mx, x1(mx)); mx = fmaxf(mx, x2(mx)); mx = fmaxf(mx, x4m(mx));
          const float minter = bt + m, mt = fmaxf(minter, mx); float den = 0.0f, qn = 0.0f, sv[8];
          UNR for (int e = 0; e < 8; ++e) { const int s = g * 8 + e; sv[e] = 0.0f; if (s <= t) sv[e] = Sm[t * S65 + s] * fexp(bt - bc[s] + ig[s] - mt); den += sv[e]; qn += Q[t * S65 + s] * nv[s]; }
          { u32x4 w; w.x = cvtpk(sv[0], sv[1]); w.y = cvtpk(sv[2], sv[3]); w.z = cvtpk(sv[4], sv[5]); w.w = cvtpk(sv[6], sv[7]); *(u32x4*)(Smb + t * 72 + 8 * g) = w; }
          den += x1(den); den += x2(den); den += x4m(den); qn += x1(qn); qn += x2(qn); qn += x4m(qn);
          const float wi = fexp(minter - mt); den += wi * qn;
          const float ks = fexp(lw[t] - mnew);
          if (g == 0) { wint[t] = wi; rden[t] = 1.0f / fmaxf(fabsf(den), fexp(-mt)); ksv[t] = ks; }
          UNR for (int e = 0; e < 8; ++e) KsT[tsw(g * 8 + e, t)] = (bf16_t)f2bf(K[t * S65 + g * 8 + e] * ks); }
        LDS_BARRIER();
        { const int ti = (wave >> 1) & 1, tj = wave & 1;
          if (wave < 4) { f32x16 acc = zero16(); acc = mmb64<false, true>(lane_, acc, Smb, ti * 32, VbT, tj * 32);
              UNR for (int r = 0; r < 16; ++r) { const int row = ti * 32 + ACC_ROW(r, lane_), o = row * S65 + tj * 32 + (lane_ & 31); QC[o] = (acc[r] + wint[row] * QC[o]) * rden[row]; } }
          else { const float carry = scal[2]; f32x16 acc; UNR for (int r = 0; r < 16; ++r) acc[r] = carry * C[(ti * 32 + ACC_ROW(r, lane_)) * S65 + tj * 32 + (lane_ & 31)];
              acc = mmb64<true, true>(lane_, acc, KsT, ti * 32, VbT, tj * 32);
              UNR for (int r = 0; r < 16; ++r) C[(ti * 32 + ACC_ROW(r, lane_)) * S65 + tj * 32 + (lane_ & 31)] = acc[r];
              UNR for (int q4 = 0; q4 < 4; ++q4) { u32x2 w; w.x = cvtpk(acc[4 * q4], acc[4 * q4 + 1]); w.y = cvtpk(acc[4 * q4 + 2], acc[4 * q4 + 3]); *(u32x2*)(CbT + (tj * 32 + (lane_ & 31)) * 72 + ti * 32 + 8 * q4 + 4 * (lane_ >> 5)) = w; } }
          float s = 0.0f; UNR for (int e = 0; e < 8; ++e) s += K[(wave * 8 + e) * S65 + lane_] * ksv[wave * 8 + e]; npart[wave * 64 + lane_] = s; }
        LDS_BARRIER();
        if (tid_ < 64) { float s = 0.0f; UNR for (int e = 0; e < 8; ++e) s += npart[e * 64 + tid_]; nv[tid_] = scal[2] * nv[tid_] + s; }
        { const int j = tid_ >> 3, g = tid_ & 7, t = dir ? T - 1 - (ci * 64 + j) : ci * 64 + j; bf16_t* sp = scr + ((tok0 + t) * NSLOT + (dir ? SL_MB : SL_MF)) * MIXW + h * 64 + g * 8; const float* hp = QC + j * S65 + g * 8;
          u32x4 w; w.x = cvtpk(hp[0], hp[1]); w.y = cvtpk(hp[2], hp[3]); w.z = cvtpk(hp[4], hp[5]); w.w = cvtpk(hp[6], hp[7]); *(u32x4*)sp = w; }
        if (ci + 1 < nc) { chunk_store_ml(R, Q, K, Qb, Kb, VbT, T, dir, ci + 1, pass, cosT, sinT, tid_); if (tid_ < 64) { ig[tid_] = rig + big; lf[tid_] = logsigmoidf_(rlf + bfg); } }
        if (tid_ == 0) scal[0] = scal[1];
    }
    LDS_BARRIER();
    if (!pass) {
        float* Co = c.p->out + d.o_C + ((((size_t)b * DEPTH + l) * 2 + dir) * NH + h) * HD * HD;
        _Pragma("unroll 2") for (int i = tid; i < 4096; i += NTHREADS) Co[i] = C[(i >> 6) * S65 + (i & 63)];
        if (tid < 64) c.p->out[d.o_n + ((((size_t)b * DEPTH + l) * 2 + dir) * NH + h) * HD + tid] = nv[tid];
        if (tid == 0) c.p->out[d.o_m + (((size_t)b * DEPTH + l) * 2 + dir) * NH + h] = scal[0];
    }
    __syncthreads();
}

__device__ __forceinline__ void chunk_store_gl(const ChunkRegs& R, float* Q, float* K, bf16_t* VbT, int T, int dir, int ci, int pass, const float* cosT, const float* sinT, int tid) {
    const int j = tid >> 3, g = tid & 7, t = dir ? T - 1 - (ci * 64 + j) : ci * 64 + j, second = (g >> 1) & 1, pos = g < 4 ? (t / GRIDW) : (t % GRIDW), o = j * S65 + 8 * g;
    UNR for (int e = 0; e < 8; ++e) { float q = bfel(R.q, e), k = bfel(R.k, e);
        if (pass) { const float qp = bfel(R.qp, e), kp = bfel(R.kp, e), cs = cosT[pos * 16 + 8 * (g & 1) + e], sn = sinT[pos * 16 + 8 * (g & 1) + e];
            q = second ? qp * sn + q * cs : q * cs - qp * sn; k = second ? kp * sn + k * cs : k * cs - kp * sn; }
        Q[o + e] = q * 0.125f; K[o + e] = k; }
    UNR for (int e = 0; e < 8; ++e) VbT[tsw(8 * g + e, j)] = (bf16_t)(R.v[e >> 1] >> (16 * (e & 1)));
}
__device__ __forceinline__ void mix_gla(const Ctx& c0, int l, int pass, int b, int h, int dir) {
    const Ctx c = fresh(c0);
    const Dims& d = c.d; const int T = pass ? d.Tl : d.Tc, nc = T / 64, tid = c.tid, lane = c.lane, wave = c.wave; const size_t tok0 = pass ? d.NTc + (size_t)b * d.Tl : (size_t)b * d.Tc;
    float* L = (float*)c.lds;
    float *Q = L, *K = L + MSZ, *S = L + 2 * MSZ, *O2 = L + 3 * MSZ, *vec = L + 4 * MSZ;
    float *gend = vec, *bA = vec + 64, *gpart = vec + 128, *GA = vec + 640, *wA = vec + 640 + 1024, *cosT = vec + 640 + 2048, *sinT = vec + 640 + 3072;
    bf16_t* Bb = (bf16_t*)(vec + 4736); bf16_t *Qb = Bb, *Kb = Bb + 64 * 72, *KbT = Bb + 2 * 64 * 72, *VbT = Bb + 3 * 64 * 72, *SbT = Bb + 4 * 64 * 72, *Ab = Bb + 5 * 64 * 72;
    const bf16_t* cols = c.ws<bf16_t>(d.w_cols); const float* small = c.ws<float>(d.w_small); bf16_t* scr = c.ws<bf16_t>(d.w_scr);
    __syncthreads();
    if (pass) build_rope(cosT, sinT, tid);
    if (pass) { const float* S0 = c.in(I_SG) + ((((size_t)b * DEPTH + l) * 2 + dir) * NH + h) * HD * HD; _Pragma("unroll 2") for (int i = tid; i < 4096; i += NTHREADS) { const float sv = S0[i]; S[(i >> 6) * S65 + (i & 63)] = sv; SbT[(i & 63) * 72 + (i >> 6)] = (bf16_t)f2bf(sv); } }
    else { _Pragma("unroll 2") for (int i = tid; i < 4096; i += NTHREADS) { S[(i >> 6) * S65 + (i & 63)] = 0.0f; SbT[(i & 63) * 72 + (i >> 6)] = 0; } }
    for (int i = tid; i < 1024; i += NTHREADS) wA[i] = c.in(I_WGLA)[(((size_t)l * 2 + dir) * 16 + (i >> 6)) * MIXW + h * 64 + (i & 63)];
    if (tid < 64) bA[tid] = c.in(I_BGLA)[((size_t)l * 2 + dir) * MIXW + h * 64 + tid];
    ChunkRegs R; f32x4 rga = (f32x4){0.f, 0.f, 0.f, 0.f};
    chunk_load(R, cols, tok0, T, dir, 0, h, CB_GQ, tid);
    if (tid < 256) { const int j = tid >> 2, t = dir ? T - 1 - j : j; rga = *(const f32x4*)(small + (tok0 + t) * NSM + SM_GA + dir * 16 + (tid & 3) * 4); }
    __syncthreads();
    chunk_store_gl(R, Q, K, VbT, T, dir, 0, pass, cosT, sinT, tid);
    if (tid < 256) *(f32x4*)(GA + (tid >> 2) * 16 + (tid & 3) * 4) = rga;
    for (int ci = 0; ci < nc; ++ci) {
        const int tid_ = opqv(tid), lane_ = tid_ & 63;
        if (ci + 1 < nc) {
            chunk_load(R, cols, tok0, T, dir, ci + 1, h, CB_GQ, tid_);
            if (tid_ < 256) { const int j = tid_ >> 2, t = dir ? T - 1 - ((ci + 1) * 64 + j) : (ci + 1) * 64 + j; rga = *(const f32x4*)(small + (tok0 + t) * NSM + SM_GA + dir * 16 + (tid_ & 3) * 4); }
        }
        LDS_BARRIER();
        float gl[8];
        { float run = 0.0f;
          UNR for (int e = 0; e < 8; ++e) { const float* ga = GA + (wave * 8 + e) * 16; float a = bA[lane_];
              UNR for (int r = 0; r < 16; ++r) a += ga[r] * wA[r * 64 + lane_];
              run += logsigmoidf_(a) * (1.0f / 16.0f); gl[e] = run; }
          gpart[wave * 64 + lane_] = run; }
        LDS_BARRIER();
        { float pre = 0.0f; UNR for (int e = 0; e < 8; ++e) pre += (e < wave) ? gpart[e * 64 + lane_] : 0.0f;
          float kv8[8];
          UNR for (int e = 0; e < 8; ++e) { const float g = gl[e] + pre; const int row = wave * 8 + e; const float qv = Q[row * S65 + lane_] * fexp(g); kv8[e] = K[row * S65 + lane_] * fexp(-g);
              Qb[row * 72 + lane_] = (bf16_t)f2bf(qv); Kb[row * 72 + lane_] = (bf16_t)f2bf(kv8[e]); if (wave == 7 && e == 7) gend[lane_] = g; }
          { u32x4 w; w.x = cvtpk(kv8[0], kv8[1]); w.y = cvtpk(kv8[2], kv8[3]); w.z = cvtpk(kv8[4], kv8[5]); w.w = cvtpk(kv8[6], kv8[7]); *(u32x4*)(KbT + lane_ * 72 + 8 * wave) = w; } }
        LDS_BARRIER();
        { const int ti = (wave >> 1) & 1, tj = wave & 1; f32x16 acc = zero16();
          if (wave < 4) { acc = mmb(lane_, acc, Qb + ti * 32 * 72, 72, Kb + tj * 32 * 72, 72, 64);
              UNR for (int r = 0; r < 16; ++r) { const int row = ti * 32 + ACC_ROW(r, lane_), col = tj * 32 + (lane_ & 31); Ab[row * 72 + col] = (bf16_t)f2bf(col <= row ? acc[r] : 0.0f); } }
          else { acc = mmb(lane_, acc, Qb + ti * 32 * 72, 72, SbT + tj * 32 * 72, 72, 64); UNR for (int r = 0; r < 16; ++r) O2[(ti * 32 + ACC_ROW(r, lane_)) * S65 + tj * 32 + (lane_ & 31)] = acc[r]; } }
        LDS_BARRIER();
        { const int ti = (wave >> 1) & 1, tj = wave & 1;
          if (wave < 4) { f32x16 acc; UNR for (int r = 0; r < 16; ++r) acc[r] = O2[(ti * 32 + ACC_ROW(r, lane_)) * S65 + tj * 32 + (lane_ & 31)];
              acc = mmb64<false, true>(lane_, acc, Ab, ti * 32, VbT, tj * 32);
              UNR for (int r = 0; r < 16; ++r) O2[(ti * 32 + ACC_ROW(r, lane_)) * S65 + tj * 32 + (lane_ & 31)] = acc[r]; }
          else { f32x16 acc; UNR for (int r = 0; r < 16; ++r) acc[r] = S[(ti * 32 + ACC_ROW(r, lane_)) * S65 + tj * 32 + (lane_ & 31)];
              acc = mmb64<false, true>(lane_, acc, KbT, ti * 32, VbT, tj * 32);
              UNR for (int r = 0; r < 16; ++r) { const int kr = ti * 32 + ACC_ROW(r, lane_); acc[r] *= fexp(gend[kr]); S[kr * S65 + tj * 32 + (lane_ & 31)] = acc[r]; }
              UNR for (int q4 = 0; q4 < 4; ++q4) { u32x2 w; w.x = cvtpk(acc[4 * q4], acc[4 * q4 + 1]); w.y = cvtpk(acc[4 * q4 + 2], acc[4 * q4 + 3]); *(u32x2*)(SbT + (tj * 32 + (lane_ & 31)) * 72 + ti * 32 + 8 * q4 + 4 * (lane_ >> 5)) = w; } } }
        LDS_BARRIER();
        { const int j = tid_ >> 3, g = tid_ & 7, t = dir ? T - 1 - (ci * 64 + j) : ci * 64 + j; bf16_t* sp = scr + ((tok0 + t) * NSLOT + (dir ? SL_GB : SL_GF)) * MIXW + h * 64 + g * 8; const float* hp = O2 + j * S65 + g * 8;
          u32x4 w; w.x = cvtpk(hp[0], hp[1]); w.y = cvtpk(hp[2], hp[3]); w.z = cvtpk(hp[4], hp[5]); w.w = cvtpk(hp[6], hp[7]); *(u32x4*)sp = w; }
        if (ci + 1 < nc) { chunk_store_gl(R, Q, K, VbT, T, dir, ci + 1, pass, cosT, sinT, tid_); if (tid_ < 256) *(f32x4*)(GA + (tid_ >> 2) * 16 + (tid_ & 3) * 4) = rga; }
    }
    LDS_BARRIER();
    if (!pass) { float* So = c.p->out + d.o_g + ((((size_t)b * DEPTH + l) * 2 + dir) * NH + h) * HD * HD; _Pragma("unroll 2") for (int i = tid; i < 4096; i += NTHREADS) So[i] = S[(i >> 6) * S65 + (i & 63)]; }
    __syncthreads();
}

__device__ __forceinline__ void phase_rwprep(const Ctx& c0, int l) {
    const Ctx c = fresh(c0);
    const Dims& d = c.d; const int tid = c.tid, lane = c.lane, wave = c.wave;
    float* L = (float*)c.lds;
    float *TWs = L, *RAs = L + 2 * 64 * 33, *W2s = L + 4 * 64 * 33, *A2s = W2s + 4096, *LWo = A2s + 4096;
    const bf16_t* cols = c.ws<bf16_t>(d.w_cols); const float* small = c.ws<float>(d.w_small); float* vecs = c.ws<float>(d.w_vecs); bf16_t* scr = c.ws<bf16_t>(d.w_scr);
    for (int blk = c.vcu; blk < d.NT / 64; blk += c.G) {
        const int tb = blk * 64, pass = tb >= d.NTc, T = pass ? d.Tl : d.Tc, tl0 = (tb - (pass ? d.NTc : 0)) % T;
        __syncthreads();
        UNR for (int u = 0; u < 2; ++u) { const int i = tid + NTHREADS * u, j = i >> 4, r4 = (i & 15) * 4, dir = r4 >> 5, r = r4 & 31; const float* sp = small + (size_t)(tb + j) * NSM;
            const f32x4 rw = *(const f32x4*)(sp + SM_RW + r4), ra = *(const f32x4*)(sp + SM_RA + r4); float* tp = TWs + (dir * 64 + j) * 33 + r; float* ap = RAs + (dir * 64 + j) * 33 + r;
            tp[0] = tanhf_(rw[0]); tp[1] = tanhf_(rw[1]); tp[2] = tanhf_(rw[2]); tp[3] = tanhf_(rw[3]); ap[0] = ra[0]; ap[1] = ra[1]; ap[2] = ra[2]; ap[3] = ra[3]; }
        for (int h = 0; h < NH; ++h) {
            UNR for (int u = 0; u < 8; ++u) { const int i = tid + NTHREADS * u, dir = i >> 11, r = (i >> 6) & 31, cc = i & 63; const size_t o = (((size_t)l * 2 + dir) * 32 + r) * MIXW + h * 64 + cc; W2s[i] = c.in(I_WW2)[o]; A2s[i] = c.in(I_WA2)[o]; }
            __syncthreads();
            UNR for (int u = 0; u < 2; ++u) { const int job = wave * 2 + u, dir = job >> 3, kind = (job >> 2) & 1, ti = (job >> 1) & 1, tj = job & 1; f32x16 acc = zero16();
                acc = mm32(lane, acc, (kind ? RAs : TWs) + (dir * 64 + ti * 32) * 33, 33, 1, (kind ? A2s : W2s) + dir * 2048 + tj * 32, 64, 1, 32);
                float* lo = LWo + (dir * 2 + kind) * MSZ + (ti * 32) * S65 + tj * 32 + (lane & 31);
                UNR for (int r = 0; r < 16; ++r) lo[ACC_ROW(r, lane) * S65] = acc[r]; }
            __syncthreads();
            { const int j = tid >> 3, g = tid & 7, ch = h * 64 + 8 * g, tl = tl0 + j; const size_t tok = (size_t)tb + j;
              const bf16_t* rp = cols + tok * NCB + ch; const u32x4 z4 = (u32x4){0u, 0u, 0u, 0u};
              const u32x4 rm = tl > 0 ? *(const u32x4*)(rp - NCB + CB_RR * 256) : z4, r0 = *(const u32x4*)(rp + CB_RR * 256), rq = tl + 1 < T ? *(const u32x4*)(rp + NCB + CB_RR * 256) : z4;
              const u32x4 km = tl > 0 ? *(const u32x4*)(rp - NCB + CB_RK * 256) : z4, k0 = *(const u32x4*)(rp + CB_RK * 256), kq = tl + 1 < T ? *(const u32x4*)(rp + NCB + CB_RK * 256) : z4;
              const u32x4 vm = tl > 0 ? *(const u32x4*)(rp - NCB + CB_RV * 256) : z4, v0 = *(const u32x4*)(rp + CB_RV * 256), vq = tl + 1 < T ? *(const u32x4*)(rp + NCB + CB_RV * 256) : z4;
              const float* tp = c.in(I_SHIFT) + (size_t)l * 3 * 768 + ch;
              float rr[8], kk[8], vv[8], kp[8]; float ss = 0.0f, bn = 0.0f;
              UNR for (int e = 0; e < 8; ++e) {
                  rr[e] = tp[e] * bfel(rm, e) + tp[768 + e] * bfel(r0, e) + tp[1536 + e] * bfel(rq, e);
                  kk[e] = tp[256 + e] * bfel(km, e) + tp[768 + 256 + e] * bfel(k0, e) + tp[1536 + 256 + e] * bfel(kq, e);
                  vv[e] = tp[512 + e] * bfel(vm, e) + tp[768 + 512 + e] * bfel(v0, e) + tp[1536 + 512 + e] * bfel(vq, e);
                  kp[e] = kk[e] * c.in(I_KK)[(size_t)l * MIXW + ch + e]; ss += kp[e] * kp[e]; bn += rr[e] * kk[e] * c.in(I_RKK)[(size_t)l * MIXW + ch + e]; }
              ss = oct_sum(ss); bn = oct_sum(bn); const float rs = frsq(ss + LN_EPS);
              float* vp = vecs + (tok * NH + h) * 576 + 8 * g;
              UNR for (int e = 0; e < 8; ++e) kp[e] *= rs;
              *(f32x4*)(vp) = (f32x4){rr[0], rr[1], rr[2], rr[3]}; *(f32x4*)(vp + 4) = (f32x4){rr[4], rr[5], rr[6], rr[7]};
              *(f32x4*)(vp + 64) = (f32x4){kp[0], kp[1], kp[2], kp[3]}; *(f32x4*)(vp + 68) = (f32x4){kp[4], kp[5], kp[6], kp[7]};
              *(f32x4*)(vp + 128) = (f32x4){vv[0], vv[1], vv[2], vv[3]}; *(f32x4*)(vp + 132) = (f32x4){vv[4], vv[5], vv[6], vv[7]};
              { u32x4 w; w.x = cvtpk(bn * vv[0], bn * vv[1]); w.y = cvtpk(bn * vv[2], bn * vv[3]); w.z = cvtpk(bn * vv[4], bn * vv[5]); w.w = cvtpk(bn * vv[6], bn * vv[7]); *(u32x4*)(scr + (tok * NSLOT + SL_RBONUS) * MIXW + ch) = w; }
              UNR for (int dir = 0; dir < 2; ++dir) { float wv[8], ak[8], kh[8]; const float* lwp = LWo + (dir * 2) * MSZ + j * S65 + 8 * g; const float* lap = lwp + MSZ;
                  UNR for (int e = 0; e < 8; ++e) { const float w0c = c.in(I_W0)[((size_t)l * 2 + dir) * MIXW + ch + e], a0c = c.in(I_A0)[((size_t)l * 2 + dir) * MIXW + ch + e], kac = c.in(I_KA)[(size_t)l * MIXW + ch + e];
                      wv[e] = -fexp(-softplusf_(-(w0c + lwp[e])) - 0.5f);     const float a = sigmoidf_(a0c + lap[e]); ak[e] = a * kp[e]; kh[e] = kk[e] * (1.0f + (a - 1.0f) * kac); }
                  float* dp = vp + (3 + 3 * dir) * 64;
                  *(f32x4*)(dp) = (f32x4){wv[0], wv[1], wv[2], wv[3]}; *(f32x4*)(dp + 4) = (f32x4){wv[4], wv[5], wv[6], wv[7]};
                  *(f32x4*)(dp + 64) = (f32x4){ak[0], ak[1], ak[2], ak[3]}; *(f32x4*)(dp + 68) = (f32x4){ak[4], ak[5], ak[6], ak[7]};
                  *(f32x4*)(dp + 128) = (f32x4){kh[0], kh[1], kh[2], kh[3]}; *(f32x4*)(dp + 132) = (f32x4){kh[4], kh[5], kh[6], kh[7]}; } }
            __syncthreads();
        }
    }
}

template <int J> struct SolveCol {
    static __device__ __forceinline__ void run(float (&u)[32], const float* La, const f32x4 (&lc)[8]) {
        f32x4 ln[8];
#pragma unroll
        for (int t4 = (J + 2) / 4; t4 < 8; ++t4) ln[t4] = *(const f32x4*)(La + (J + 1) * 36 + 4 * t4);
        const float uj = u[J];
#pragma unroll
        for (int t4 = (J + 1) / 4; t4 < 8; ++t4) {
#pragma unroll
            for (int e = 0; e < 4; ++e) if (4 * t4 + e > J) u[4 * t4 + e] -= lc[t4][e] * uj; }
#ifndef CPU_EMU
        asm volatile("" ::: "memory");
#endif
        SolveCol<J + 1>::run(u, La, ln);
    }
};
template <> struct SolveCol<31> { static __device__ __forceinline__ void run(float (&)[32], const float*, const f32x4 (&)[8]) {} };
__device__ __forceinline__ void mix_rwkv(const Ctx& c0, int l, int pass, int b, int h, int dir) {
    const Ctx c = fresh(c0);
    const Dims& d = c.d; const int T = pass ? d.Tl : d.Tc, tid = c.tid, lane = c.lane, wave = c.wave; const size_t tok0 = pass ? d.NTc + (size_t)b * d.Tl : (size_t)b * d.Tc;
    unsigned char* LB = c.lds;
    constexpr int OPS = 4 * 4608 + 3 * 5120 + 512;
    float* Gp = (float*)(LB + 2 * OPS);
    bf16_t *Lk = (bf16_t*)(LB + 2 * OPS + 4096), *T3 = Lk + 32 * 40, *T4 = T3 + 32 * 40, *UT = T4 + 32 * 40;
    float* La = (float*)(LB + 2 * OPS + 4096 + 3 * 2560 + 5120);
    float* RHS = La + 32 * 36;
    bf16_t* Sb = (bf16_t*)(RHS + 32 * 65);
    const float* vecs = c.ws<float>(d.w_vecs); bf16_t* scr = c.ws<bf16_t>(d.w_scr);
    const int nck = T / 32, vt = (wave >> 1) & 1, kt = wave & 1, ql = lane & 31;
    const int nr = wave < 4 ? 5 : 4, r0 = wave < 4 ? 5 * wave : (wave == 4 ? 0 : 20 + 4 * (wave - 5)), gslot = wave < 4 ? wave : wave - 1;
    __syncthreads();
    f32x16 Sacc = zero16();
    if (wave < 4) {
        if (pass) { const float* S0 = c.in(I_SR) + ((((size_t)b * DEPTH + l) * 2 + dir) * NH + h) * HD * HD; UNR for (int r = 0; r < 16; ++r) Sacc[r] = S0[(32 * vt + ACC_ROW(r, lane)) * 64 + 32 * kt + ql]; }
        UNR for (int r = 0; r < 16; ++r) Sb[(32 * vt + ACC_ROW(r, lane)) * 72 + 32 * kt + ql] = (bf16_t)f2bf(Sacc[r]);
    }
    float rw[5][6];
#define RC_LOADRAW(m_) do { if (wave != 4) { UNR for (int e_ = 0; e_ < 5; ++e_) if (e_ < nr) { const int pi_ = (m_) * 32 + r0 + e_, t_ = dir ? T - 1 - pi_ : pi_; const float* vp_ = vecs + ((tok0 + t_) * NH + h) * 576 + lane; \
        rw[e_][0] = vp_[0]; rw[e_][1] = vp_[64]; rw[e_][2] = vp_[128]; rw[e_][3] = vp_[(3 + 3 * dir) * 64]; rw[e_][4] = vp_[(4 + 3 * dir) * 64]; rw[e_][5] = vp_[(5 + 3 * dir) * 64]; } } } while (0)
#define RC_S1A(m_, cs_) do { if (wave != 4) { float run_ = 0.0f; UNR for (int e_ = 0; e_ < 5; ++e_) if (e_ < nr) { run_ += rw[e_][3]; cs_[e_] = run_; } Gp[(((m_) & 1) * 8 + gslot) * 64 + lane] = run_; } } while (0)
#define RC_S1B(m_, cs_) do { if (wave != 4) { unsigned char* ob_ = LB + ((m_) & 1) * OPS; bf16_t *Km_ = (bf16_t*)ob_, *Am_ = Km_ + 32 * 72, *Hm_ = Am_ + 32 * 72, *Rm_ = Hm_ + 32 * 72, *AmT_ = Rm_ + 32 * 72, *HmT_ = AmT_ + 64 * 40, *VT_ = HmT_ + 64 * 40; float* ge_ = (float*)(VT_ + 64 * 40); \
        float pre_ = 0.0f; UNR for (int p_ = 0; p_ < 7; ++p_) pre_ += (p_ < gslot) ? Gp[(((m_) & 1) * 8 + p_) * 64 + lane] : 0.0f; \
        UNR for (int e_ = 0; e_ < 5; ++e_) if (e_ < nr) { const int i_ = r0 + e_; const float g_ = pre_ + cs_[e_], gp_ = e_ == 0 ? pre_ : pre_ + cs_[e_ - 1], eg_ = fexp(g_), eng_ = fexp(-g_); \
            const float kv_ = rw[e_][1] * fexp(gp_), av_ = rw[e_][4] * eng_, hv_ = rw[e_][5] * eng_, rv_ = rw[e_][0] * eg_; \
            Km_[i_ * 72 + lane] = (bf16_t)f2bf(kv_); Am_[i_ * 72 + lane] = (bf16_t)f2bf(av_); Hm_[i_ * 72 + lane] = (bf16_t)f2bf(hv_); Rm_[i_ * 72 + lane] = (bf16_t)f2bf(rv_); \
            AmT_[lane * 40 + i_] = (bf16_t)f2bf(av_); HmT_[lane * 40 + i_] = (bf16_t)f2bf(hv_); VT_[lane * 40 + i_] = (bf16_t)f2bf(rw[e_][2]); if (i_ == 31) ge_[lane] = g_; } } } while (0)
    float cs[5];
    RC_LOADRAW(0); RC_S1A(0, cs);
    __syncthreads();
    RC_S1B(0, cs);
    if (nck > 1) { RC_LOADRAW(1); }
    __syncthreads();
    for (int ck = 0; ck < nck; ++ck) {
        const int tid_ = opqv(tid), lane_ = tid_ & 63, ql_ = lane_ & 31;
        unsigned char* ob = LB + (ck & 1) * OPS; const bf16_t *Km = (const bf16_t*)ob, *Am = Km + 32 * 72, *Hm = Am + 32 * 72, *Rm = Hm + 32 * 72, *AmT = Rm + 32 * 72, *HmT = AmT + 64 * 40, *VT = HmT + 64 * 40; const float* gend = (const float*)(VT + 64 * 40);
        f32x16 pacc = zero16();
        if (wave < 4) { const bf16_t* A = (wave & 2) ? Rm : Km; const bf16_t* Bt = (wave & 1) ? Hm : Am; f32x16 m = zero16(); m = mmb(lane_, m, A, 72, Bt, 72, 64);
            UNR for (int r = 0; r < 16; ++r) { const int i = ACC_ROW(r, lane_), j = ql_;
                if (wave == 0) La[j * 36 + i] = j < i ? m[r] : 0.0f; else if (wave == 1) Lk[i * 40 + j] = (bf16_t)f2bf(j < i ? m[r] : 0.0f);
                else if (wave == 2) T3[i * 40 + j] = (bf16_t)f2bf(j <= i ? m[r] : 0.0f); else T4[i * 40 + j] = (bf16_t)f2bf(j <= i ? m[r] : 0.0f); } }
        else { pacc = mmb(lane_, pacc, (wave & 2) ? Rm : Km, 72, Sb + (32 * (wave & 1)) * 72, 72, 64); }
        LDS_BARRIER();
        if (wave == 4 || wave == 5) { pacc = mmb(lane_, pacc, Lk, 40, VT + (32 * (wave & 1)) * 40, 40, 32); UNR for (int r = 0; r < 16; ++r) RHS[ACC_ROW(r, lane_) * 65 + 32 * (wave & 1) + ql_] = -pacc[r]; }
        else if (wave >= 6) { pacc = mmb(lane_, pacc, T4, 40, VT + (32 * (wave & 1)) * 40, 40, 32); }
        if (ck + 1 < nck) RC_S1A(ck + 1, cs);
        LDS_BARRIER();
        if (wave == 4) { float u[32];
            UNR for (int t = 0; t < 32; ++t) u[t] = RHS[t * 65 + lane_];
            { f32x4 l0[8]; UNR for (int t4 = 0; t4 < 8; ++t4) l0[t4] = *(const f32x4*)(La + 4 * t4); SolveCol<0>::run(u, La, l0); }
            UNR for (int p = 0; p < 16; ++p) *(unsigned*)(UT + lane_ * 40 + 2 * p) = cvtpk(u[2 * p], u[2 * p + 1]); }
        else if (ck + 1 < nck) { RC_S1B(ck + 1, cs); if (ck + 2 < nck) { RC_LOADRAW(ck + 2); } }
        LDS_BARRIER();
        if (wave >= 6) { pacc = mmb(lane_, pacc, T3, 40, UT + (32 * (wave & 1)) * 40, 40, 32);
            UNR for (int r = 0; r < 16; ++r) { const int pi = ck * 32 + ACC_ROW(r, lane_), t = dir ? T - 1 - pi : pi; scr[((tok0 + t) * NSLOT + (dir ? SL_RB : SL_RF)) * MIXW + h * 64 + 32 * (wave & 1) + ql_] = (bf16_t)f2bf(pacc[r]); } }
        else if (wave < 4) { Sacc = mmb(lane_, Sacc, UT + (32 * vt) * 40, 40, AmT + (32 * kt) * 40, 40, 32); Sacc = mmb(lane_, Sacc, VT + (32 * vt) * 40, 40, HmT + (32 * kt) * 40, 40, 32);
            const float gs = fexp(gend[32 * kt + ql_]);
            UNR for (int r = 0; r < 16; ++r) { Sacc[r] *= gs; Sb[(32 * vt + ACC_ROW(r, lane_)) * 72 + 32 * kt + ql_] = (bf16_t)f2bf(Sacc[r]); } }
        LDS_BARRIER();
    }
#undef RC_LOADRAW
#undef RC_S1A
#undef RC_S1B
    if (!pass && wave < 4) { float* So = c.p->out + d.o_r + ((((size_t)b * DEPTH + l) * 2 + dir) * NH + h) * HD * HD; UNR for (int r = 0; r < 16; ++r) So[(32 * vt + ACC_ROW(r, lane)) * 64 + 32 * kt + ql] = Sacc[r]; }
    __syncthreads();
}

#define SCR8(p_, lo_, hi_) do { const u32x4 w_ = *(const u32x4*)(p_); lo_ = (f32x4){bflo(w_.x), bfhi(w_.x), bflo(w_.y), bfhi(w_.y)}; hi_ = (f32x4){bflo(w_.z), bfhi(w_.z), bflo(w_.w), bfhi(w_.w)}; } while (0)
__device__ __forceinline__ void phase_combine(const Ctx& c0, int l) {
    const Ctx c = fresh(c0);
    const Dims& d = c.d; const int tid = c.tid, lane = c.lane, wave = c.wave;
    float* L = (float*)c.lds; float *SG = L, *G2 = L + MSZ, *GT = L + MSZ + 64 * 256;
    const bf16_t* cols = c.ws<bf16_t>(d.w_cols); const float* small = c.ws<float>(d.w_small); const bf16_t* scr = c.ws<bf16_t>(d.w_scr); bf16_t* br = c.ws<bf16_t>(d.w_br);
    __syncthreads();
    for (int i = tid; i < 64 * 256; i += NTHREADS) G2[i] = c.in(I_WG2)[(size_t)l * 64 * MIXW + i];
    for (int blk = c.vcu; blk < d.NT / 64; blk += c.G) {
        const size_t tb = (size_t)blk * 64;
        __syncthreads();
        { const int j = tid >> 3, g = tid & 7; const float* rp = small + (tb + j) * NSM + SM_RG + g * 8; const f32x4 a = *(const f32x4*)rp, b2 = *(const f32x4*)(rp + 4); float* sp = SG + j * S65 + g * 8;
          sp[0] = sigmoidf_(a[0]); sp[1] = sigmoidf_(a[1]); sp[2] = sigmoidf_(a[2]); sp[3] = sigmoidf_(a[3]); sp[4] = sigmoidf_(b2[0]); sp[5] = sigmoidf_(b2[1]); sp[6] = sigmoidf_(b2[2]); sp[7] = sigmoidf_(b2[3]); }
        __syncthreads();
        UNR for (int u = 0; u < 2; ++u) { const int tl = wave * 2 + u, ti = tl >> 3, tj = tl & 7; f32x16 acc = zero16();
            acc = mm32(lane, acc, SG + ti * 32 * S65, S65, 1, G2 + tj * 32, 256, 1, 64);
            UNR for (int r = 0; r < 16; ++r) GT[(ti * 32 + ACC_ROW(r, lane)) * 257 + tj * 32 + (lane & 31)] = acc[r]; }
        __syncthreads();
        for (int hh = 0; hh < NH; ++hh) {
            const int j = tid >> 3, g = tid & 7; const size_t tok = tb + j; const int cb = hh * 64 + g * 8; const bf16_t* sp = scr + tok * NSLOT * MIXW + cb;
            {
              f32x4 a0, a1, b0, b1; SCR8(sp + SL_MF * MIXW, a0, a1); SCR8(sp + SL_MB * MIXW, b0, b1);
              float x[8]; float s = 0.0f; UNR for (int e = 0; e < 4; ++e) { x[e] = a0[e] + b0[e]; x[4 + e] = a1[e] + b1[e]; } UNR for (int e = 0; e < 8; ++e) s += x[e];
              s += x1(s); s += x2(s); s += x4m(s); const float mean = s * (1.0f / 64.0f); float qv = 0.0f;
              UNR for (int e = 0; e < 8; ++e) { x[e] -= mean; qv += x[e] * x[e]; }
              qv += x1(qv); qv += x2(qv); qv += x4m(qv); const float rs = frsq(qv * (1.0f / 64.0f) + LN_EPS);
              const u32x4 ow = *(const u32x4*)(cols + tok * NCB + CB_MO * 256 + cb); const f32x4 o0 = (f32x4){bflo(ow.x), bfhi(ow.x), bflo(ow.y), bfhi(ow.y)}, o1 = (f32x4){bflo(ow.z), bfhi(ow.z), bflo(ow.w), bfhi(ow.w)};
              u32x4 w; w.x = pk2(x[0] * rs * sigmoidf_(o0[0]), x[1] * rs * sigmoidf_(o0[1])); w.y = pk2(x[2] * rs * sigmoidf_(o0[2]), x[3] * rs * sigmoidf_(o0[3]));
              w.z = pk2(x[4] * rs * sigmoidf_(o1[0]), x[5] * rs * sigmoidf_(o1[1])); w.w = pk2(x[6] * rs * sigmoidf_(o1[2]), x[7] * rs * sigmoidf_(o1[3])); *(u32x4*)(br + tok * D + 0 * MIXW + cb) = w; }
            {
              f32x4 a0, a1, b0, b1; SCR8(sp + SL_GF * MIXW, a0, a1); SCR8(sp + SL_GB * MIXW, b0, b1);
              float x[8]; float qv = 0.0f; UNR for (int e = 0; e < 4; ++e) { x[e] = a0[e] + b0[e]; x[4 + e] = a1[e] + b1[e]; } UNR for (int e = 0; e < 8; ++e) qv += x[e] * x[e];
              qv += x1(qv); qv += x2(qv); qv += x4m(qv); const float rs = frsq(qv * (1.0f / 64.0f) + LN_EPS);
              const u32x4 ow = *(const u32x4*)(cols + tok * NCB + CB_GG * 256 + cb); const f32x4 o0 = (f32x4){bflo(ow.x), bfhi(ow.x), bflo(ow.y), bfhi(ow.y)}, o1 = (f32x4){bflo(ow.z), bfhi(ow.z), bflo(ow.w), bfhi(ow.w)};
              u32x4 w; w.x = pk2(x[0] * rs * siluf_(o0[0]), x[1] * rs * siluf_(o0[1])); w.y = pk2(x[2] * rs * siluf_(o0[2]), x[3] * rs * siluf_(o0[3]));
              w.z = pk2(x[4] * rs * siluf_(o1[0]), x[5] * rs * siluf_(o1[1])); w.w = pk2(x[6] * rs * siluf_(o1[2]), x[7] * rs * siluf_(o1[3])); *(u32x4*)(br + tok * D + 1 * MIXW + cb) = w; }
            {
              f32x4 a0, a1, b0, b1, n0, n1; SCR8(sp + SL_RF * MIXW, a0, a1); SCR8(sp + SL_RB * MIXW, b0, b1); SCR8(sp + SL_RBONUS * MIXW, n0, n1);
              float x[8]; float s = 0.0f; UNR for (int e = 0; e < 4; ++e) { x[e] = a0[e] + b0[e]; x[4 + e] = a1[e] + b1[e]; } UNR for (int e = 0; e < 8; ++e) s += x[e];
              s += x1(s); s += x2(s); s += x4m(s); const float mean = s * (1.0f / 64.0f); float qv = 0.0f;
              UNR for (int e = 0; e < 8; ++e) { x[e] -= mean; qv += x[e] * x[e]; }
              qv += x1(qv); qv += x2(qv); qv += x4m(qv); const float rs = frsq(qv * (1.0f / 64.0f) + LN_EPS);
              const float* gp = GT + j * 257 + cb;
              u32x4 w; w.x = pk2((x[0] * rs + n0[0]) * gp[0], (x[1] * rs + n0[1]) * gp[1]); w.y = pk2((x[2] * rs + n0[2]) * gp[2], (x[3] * rs + n0[3]) * gp[3]);
              w.z = pk2((x[4] * rs + n1[0]) * gp[4], (x[5] * rs + n1[1]) * gp[5]); w.w = pk2((x[6] * rs + n1[2]) * gp[6], (x[7] * rs + n1[3]) * gp[7]); *(u32x4*)(br + tok * D + 2 * MIXW + cb) = w; }
        }
    }
    __syncthreads();
}

__device__ __forceinline__ void mix_na(const Ctx& c0, int l, int pass, int b, int h, int qb) {
    const Ctx c = fresh(c0);
    const Dims& d = c.d; const int tid = c.tid, lane = c.lane, wave = c.wave; const size_t tok0 = pass ? d.NTc + (size_t)b * d.Tl : (size_t)b * d.Tc;
    constexpr int KST = 72, VST_ = 136;
    unsigned char* LB = c.lds;
    bf16_t* Kt = (bf16_t*)LB;
    bf16_t* Vt = (bf16_t*)(LB + 2 * 128 * KST * 2);
    float* rpbs = (float*)(LB + 2 * 128 * KST * 2 + 2 * 64 * VST_ * 2);
    float* Om = (float*)LB;
    float* Lm = Om + 8 * 32 * 64;
    const bf16_t* cols = c.ws<bf16_t>(d.w_cols); bf16_t* br = c.ws<bf16_t>(d.w_br);
    const int rows = d.Tl / GRIDW, kr = rows < 8 ? rows : 8; int rs = qb - kr / 2; rs = rs < 0 ? 0 : (rs > rows - kr ? rows - kr : rs);
    const int nloc = pass ? kr / 2 : 0, ntile = pass ? nloc + PAST / 128 : d.Tc / 128;
    const int qt = wave & 1, kq = wave >> 1, hh = lane >> 5, ql = lane & 31;
    __syncthreads();
    if (pass) for (int i = tid; i < 15 * 31; i += NTHREADS) rpbs[i] = c.in(I_RPB)[((size_t)l * NH + h) * 15 * 31 + i];
    bf16x8 qf[4];
    { const bf16_t* qp = cols + (tok0 + qb * 64 + qt * 32 + ql) * NCB + CB_NQ * 256 + h * 64 + 8 * hh;
      UNR for (int s4 = 0; s4 < 4; ++s4) qf[s4] = *(const bf16x8*)(qp + 16 * s4); }
    const int jp = tid >> 3, d8 = (tid & 7) * 8;
    u32x4 pk[2], pv[2];
#define NA_LOAD(kt_) do { UNR for (int u_ = 0; u_ < 2; ++u_) { const int j_ = 2 * jp + u_; \
        if (pass && (kt_) >= nloc) { const size_t o_ = ((((size_t)b * DEPTH + l) * NH + h) * PAST + ((kt_) - nloc) * 128 + j_) * HD + d8; const float* kp_ = c.in(I_CK) + o_; const float* vp_ = c.in(I_CV) + o_; \
            pk[u_] = pk8(*(const f32x4*)kp_, *(const f32x4*)(kp_ + 4)); pv[u_] = pk8(*(const f32x4*)vp_, *(const f32x4*)(vp_ + 4)); } \
        else { const size_t tk_ = pass ? tok0 + (size_t)(rs + 2 * (kt_) + (j_ >> 6)) * 64 + (j_ & 63) : tok0 + (kt_) * 128 + j_; const bf16_t* rp_ = cols + tk_ * NCB + h * 64 + d8; \
            pk[u_] = *(const u32x4*)(rp_ + CB_NK * 256); pv[u_] = *(const u32x4*)(rp_ + CB_NV * 256); } } } while (0)
#define NA_STORE(buf_) do { bf16_t* kb_ = Kt + (buf_) * 128 * KST; bf16_t* vb_ = Vt + (buf_) * 64 * VST_; \
        UNR for (int u_ = 0; u_ < 2; ++u_) *(u32x4*)(kb_ + (2 * jp + u_) * KST + d8) = pk[u_]; \
        UNR for (int e_ = 0; e_ < 8; ++e_) { const unsigned a_ = pv[0][e_ >> 1], b_ = pv[1][e_ >> 1]; \
            *(unsigned*)(vb_ + (d8 + e_) * VST_ + 2 * ((jp + 4 * (tid & 7)) & 63)) = (e_ & 1) ? ((a_ >> 16) | (b_ & 0xffff0000u)) : ((a_ & 0xffffu) | (b_ << 16)); } } while (0)
    NA_LOAD(0);
    NA_STORE(0);
    f32x16 o0 = zero16(), o1 = zero16(); float lsum = 0.0f;
    __syncthreads();
    for (int kt = 0; kt < ntile; ++kt) {
        if (kt + 1 < ntile) NA_LOAD(kt + 1);
        const bf16_t* kb = Kt + (kt & 1) * 128 * KST + (32 * kq + ql) * KST + 8 * hh; const bf16_t* vb = Vt + (kt & 1) * 64 * VST_; const int d0 = 16 * kq + 2 * hh, kx0 = 4 * (ql >> 3), kx1 = kx0 + 16;
        f32x16 sc = zero16();
        UNR for (int s4 = 0; s4 < 4; ++s4) sc = __builtin_amdgcn_mfma_f32_32x32x16_bf16(*(const bf16x8*)(kb + 16 * s4), qf[s4], sc, 0, 0, 0);
        if (pass && kt < nloc) {
            const int qc = 32 * qt + ql; int cs = qc - 8; cs = cs < 0 ? 0 : (cs > 48 ? 48 : cs);
            UNR for (int r = 0; r < 16; ++r) { const int jj = 32 * kq + ACC_ROW(r, lane), krow = rs + 2 * kt + (jj >> 6), kc = jj & 63; const bool ok = kc >= cs && kc < cs + 16;
                const float bias = rpbs[ok ? (krow - qb + 7) * 31 + (kc - qc + 15) : 0]; sc[r] = ok ? fexp(fminf(sc[r] * 0.125f + bias, 80.0f)) : 0.0f; }
        } else { UNR for (int r = 0; r < 16; ++r) sc[r] = fexp(fminf(sc[r] * 0.125f, 80.0f)); }
        UNR for (int r = 0; r < 16; ++r) lsum += sc[r];
        UNR for (int s2 = 0; s2 < 2; ++s2) { u32x4 w; w.x = cvtpk(sc[8 * s2], sc[8 * s2 + 1]); w.y = cvtpk(sc[8 * s2 + 2], sc[8 * s2 + 3]); w.z = cvtpk(sc[8 * s2 + 4], sc[8 * s2 + 5]); w.w = cvtpk(sc[8 * s2 + 6], sc[8 * s2 + 7]);
            const bf16x8 pf = __builtin_bit_cast(bf16x8, w);
            { const u32x2 v0 = *(const u32x2*)(vb + ql * VST_ + 2 * ((d0 + 8 * s2 + kx0) & 63)), v1 = *(const u32x2*)(vb + ql * VST_ + 2 * ((d0 + 8 * s2 + 4 + kx0) & 63)); u32x4 vw; vw.x = v0.x; vw.y = v0.y; vw.z = v1.x; vw.w = v1.y;
              o0 = __builtin_amdgcn_mfma_f32_32x32x16_bf16(pf, __builtin_bit_cast(bf16x8, vw), o0, 0, 0, 0); }
            { const u32x2 v0 = *(const u32x2*)(vb + (32 + ql) * VST_ + 2 * ((d0 + 8 * s2 + kx1) & 63)), v1 = *(const u32x2*)(vb + (32 + ql) * VST_ + 2 * ((d0 + 8 * s2 + 4 + kx1) & 63)); u32x4 vw; vw.x = v0.x; vw.y = v0.y; vw.z = v1.x; vw.w = v1.y;
              o1 = __builtin_amdgcn_mfma_f32_32x32x16_bf16(pf, __builtin_bit_cast(bf16x8, vw), o1, 0, 0, 0); } }
        if (kt + 1 < ntile) NA_STORE((kt + 1) & 1);
        LDS_BARRIER();
    }
#undef NA_LOAD
#undef NA_STORE
    { float* om = Om + wave * 32 * 64; UNR for (int r = 0; r < 16; ++r) { om[ACC_ROW(r, lane) * 64 + ql] = o0[r]; om[ACC_ROW(r, lane) * 64 + 32 + ql] = o1[r]; }
      const float lt = lsum + __shfl_xor(lsum, 32); if (lane < 32) Lm[wave * 32 + lane] = lt; }
    __syncthreads();
    { const int q = tid >> 3, g = tid & 7, qt2 = q >> 5, q2 = q & 31; float ls = 0.0f; f32x4 a0 = (f32x4){0.f, 0.f, 0.f, 0.f}, a1 = a0;
      UNR for (int kq2 = 0; kq2 < 4; ++kq2) { const int w = kq2 * 2 + qt2; ls += Lm[w * 32 + q2]; const float* op = Om + w * 32 * 64 + q2 * 64 + g * 8; a0 += *(const f32x4*)op; a1 += *(const f32x4*)(op + 4); }
      const float il = 1.0f / ls; const size_t tok = tok0 + qb * 64 + q; bf16_t* bp = br + tok * D + 3 * MIXW + h * 64 + g * 8;
      u32x4 w; w.x = pk2(a0[0] * il, a0[1] * il); w.y = pk2(a0[2] * il, a0[3] * il); w.z = pk2(a1[0] * il, a1[1] * il); w.w = pk2(a1[2] * il, a1[3] * il); *(u32x4*)bp = w; }
    __syncthreads();
}

__device__ __forceinline__ void phase_mixers(const Ctx& c0, int l, int rep) {
    const Ctx c = fresh(c0);
    const Dims& d = c.d; const int rows = d.Tl / GRIDW;
    const int nL = d.Bl * NH, nC = d.Bc * NH, nNAl = nL * rows, nq = d.Tc / 64, nNAc = nC * nq;
    unsigned* qctr = c.ws<unsigned>(c.d.w_ctl) + CW_QUEUE + 64 * (l + DEPTH * rep);
    int* slot = (int*)(c.lds + 163840 - 128);
#ifndef MIX_MASK
#define MIX_MASK 15
#endif
#ifndef MIX_DUP
#define MIX_DUP 15
#endif
#define MIX_ISSUE() do { if (c.tid == 0) nxt = (int)atomicAdd(qctr, 1u); } while (0)
#define MIX_TAKE() do { __syncthreads(); if (c.tid == 0) *slot = nxt; __syncthreads(); it = __builtin_amdgcn_readfirstlane(*slot); } while (0)
#define MIX_FETCH() do { MIX_TAKE(); MIX_ISSUE(); } while (0)
    int it, nxt = 0; MIX_ISSUE(); MIX_FETCH();
    int base = 0;
    for (int pp = 1; pp >= 0; --pp) {
        const int ps = opqs(__builtin_amdgcn_readfirstlane(pp)), nBH = ps ? nL : nC, nNA = ps ? nNAl : nNAc, nr = ps ? rows : nq;
        const int e0 = base + 2 * nBH, e1 = e0 + 2 * nBH, e2 = e1 + 2 * nBH, e3 = e2 + nNA;
        while (it < e0) { const int q = it - base; if ((MIX_MASK & 1) && (rep == 0 || (MIX_DUP & 1))) mix_rwkv(c, l, ps, (q >> 1) / NH, (q >> 1) % NH, q & 1); MIX_FETCH(); }
        while (it < e1) { const int q = it - e0; if ((MIX_MASK & 2) && (rep == 0 || (MIX_DUP & 2))) mix_mlstm(c, l, ps, (q >> 1) / NH, (q >> 1) % NH, q & 1); MIX_FETCH(); }
        while (it < e2) { const int q = it - e1; if ((MIX_MASK & 4) && (rep == 0 || (MIX_DUP & 4))) mix_gla(c, l, ps, (q >> 1) / NH, (q >> 1) % NH, q & 1); MIX_FETCH(); }
        while (it < e3) { const int q = it - e2; if ((MIX_MASK & 8) && (rep == 0 || (MIX_DUP & 8))) mix_na(c, l, ps, q / (NH * nr), (q / nr) % NH, q % nr); MIX_FETCH(); }
        base = e3;
    }
#undef MIX_ISSUE
#undef MIX_TAKE
#undef MIX_FETCH
}

__device__ __forceinline__ void phase_ln1(const Ctx& c0, int l) {
    const Ctx c = fresh(c0);
    const Dims& d = c.d; const float* mods = c.mods(l); const float* v = c.ws<float>(d.w_v); bf16_t* hb = c.ws<bf16_t>(d.w_hb); float* aff = c.ws<float>(d.w_aff);
    const float* lg = c.in(I_LNG) + ((size_t)l * 2 + 0) * D; const float* lb = c.in(I_LNB) + ((size_t)l * 2 + 0) * D;
    constexpr int WRS = D + 4;
    float* WR = (float*)c.lds;
    __syncthreads();
    for (int i = c.tid; i < D * NEXP; i += NTHREADS) WR[(i & 15) * WRS + (i >> 4)] = c.in(I_WROUTER)[(size_t)l * D * NEXP + i];
    __syncthreads();
    f32x4 g4[4], b4[4];
#pragma unroll
    for (int j = 0; j < 4; ++j) { g4[j] = *(const f32x4*)(lg + 4 * c.lane + 256 * j); b4[j] = *(const f32x4*)(lb + 4 * c.lane + 256 * j); }
    for (int blk = c.vcu * NWAVES + c.wave; blk < d.NT / 8; blk += c.G * NWAVES) {
        const int tokb = blk * 8; const float* mr = mods + (size_t)c.modrow(tokb) * NMOD;
        f32x4 sh4[4], sc4[4], xn[4];
#pragma unroll
        for (int j = 0; j < 4; ++j) { sh4[j] = *(const f32x4*)(mr + 3 * D + 4 * c.lane + 256 * j); sc4[j] = *(const f32x4*)(mr + 4 * D + 4 * c.lane + 256 * j); xn[j] = *(const f32x4*)(v + (size_t)tokb * D + 4 * c.lane + 256 * j); }
        for (int ti = 0; ti < 8; ++ti) {
            const int tok = tokb + ti; f32x4 x[4]; float s = 0.0f;
#pragma unroll
            for (int j = 0; j < 4; ++j) { x[j] = xn[j]; s += (x[j][0] + x[j][1]) + (x[j][2] + x[j][3]); }
            if (ti + 1 < 8) {
#pragma unroll
                for (int j = 0; j < 4; ++j) xn[j] = *(const f32x4*)(v + (size_t)(tok + 1) * D + 4 * c.lane + 256 * j); }
            const float mean = wave_sum(s) * (1.0f / D); float q = 0.0f;
#pragma unroll
            for (int j = 0; j < 4; ++j) { x[j] = x[j] - mean; q += (x[j][0] * x[j][0] + x[j][1] * x[j][1]) + (x[j][2] * x[j][2] + x[j][3] * x[j][3]); }
            const float rstd = frsq(wave_sum(q) * (1.0f / D) + LN_EPS);
            f32x4 hh[4];
#pragma unroll
            for (int j = 0; j < 4; ++j) { const int col = 4 * c.lane + 256 * j; const f32x4 x1 = x[j] * rstd * g4[j] + b4[j]; *(f32x4*)(c.X() + (size_t)tok * D + col) = x1;
                hh[j] = x1 * (1.0f + sc4[j]) + sh4[j]; u32x2 w; w.x = pk2(hh[j][0], hh[j][1]); w.y = pk2(hh[j][2], hh[j][3]); *(u32x2*)(hb + (size_t)tok * D + col) = w; }
            float lg16[16];
#pragma unroll
            for (int e = 0; e < 16; ++e) { float a = 0.0f;
#pragma unroll
                for (int j = 0; j < 4; ++j) { const f32x4 wv = *(const f32x4*)(WR + e * WRS + 4 * c.lane + 256 * j); a += (hh[j][0] * wv[0] + hh[j][1] * wv[1]) + (hh[j][2] * wv[2] + hh[j][3] * wv[3]); }
                lg16[e] = a;
#ifndef CPU_EMU
                asm volatile("" ::: "memory");
#endif
            }
            float mx = -3.0e38f;
#pragma unroll
            for (int e = 0; e < 16; ++e) { lg16[e] = wave_sum(lg16[e]); mx = fmaxf(mx, lg16[e]); }
            float se = 0.0f;
#pragma unroll
            for (int e = 0; e < 16; ++e) { lg16[e] = expf(lg16[e] - mx); se += lg16[e]; }
            const float inv = 1.0f / se; float mine = 0.0f;
#pragma unroll
            for (int e = 0; e < 16; ++e) mine = (c.lane == e) ? lg16[e] * inv : mine;
            if (c.lane < 16) aff[(size_t)tok * NEXP + c.lane] = mine;
        }
    }
}

__device__ __forceinline__ void phase_select(const Ctx& c0) {
    const Ctx c = fresh(c0);
    const Dims& d = c.d; const float* aff = c.ws<float>(d.w_aff); int* inv = c.ws<int>(d.w_inv); float* pgate = c.ws<float>(d.w_pgate);
    const bf16_t* hb = c.ws<bf16_t>(d.w_hb); bf16_t* xe = c.ws<bf16_t>(d.w_xe);
    unsigned long long* KEY = (unsigned long long*)c.lds; int* sel = (int*)(KEY + 1024);
    const int nitems = (d.Bc + d.Bl) * NEXP, nlat = d.Bl * NEXP, nctx = d.Bc * NEXP;
    const bool latw = c.vcu < nlat && nlat < c.G; const int gctx = nlat < c.G ? c.G - nlat : c.G;
    for (int k = 0;; ++k) {
        int it;
        if (nlat >= c.G) { it = c.vcu + k * c.G; if (it >= nitems) break; it = it < nlat ? nctx + it : it - nlat; }
        else if (latw) { if (k > 0) break; it = nctx + c.vcu; }
        else { it = (c.vcu - nlat) + k * gctx; if (it >= nctx) break; }
        const int e = it % NEXP, bb = it / NEXP, pass = bb >= d.Bc, b = pass ? bb - d.Bc : bb, T = pass ? d.Tl : d.Tc, cap = pass ? d.capl : d.capc;
        const int tok0 = pass ? d.NTc + b * d.Tl : b * d.Tc, row0 = e * d.RPE + (pass ? d.Bc * d.capc + b * d.capl : b * d.capc);
        __syncthreads();
        for (int t = c.tid; t < T; t += NTHREADS) KEY[t] = ((unsigned long long)__builtin_bit_cast(unsigned, aff[(size_t)(tok0 + t) * NEXP + e]) << 32) | (unsigned)(~t);
        __syncthreads();
        { const int t0 = c.tid, t1 = c.tid + NTHREADS; const bool h0 = t0 < T, h1 = t1 < T; const unsigned long long k0 = h0 ? KEY[t0] : ~0ull, k1 = h1 ? KEY[t1] : ~0ull; int rank0 = 0, rank1 = 0;
#pragma unroll 4
          for (int s2 = 0; s2 < T; s2 += 2) { const unsigned long long o0 = KEY[s2], o1 = KEY[s2 + 1];
              rank0 += (o0 > k0 ? 1 : 0) + (o1 > k0 ? 1 : 0); rank1 += (o0 > k1 ? 1 : 0) + (o1 > k1 ? 1 : 0); }
          if (h0) { if (rank0 < cap) { sel[rank0] = t0; pgate[row0 + rank0] = __builtin_bit_cast(float, (unsigned)(k0 >> 32)); inv[(size_t)e * d.NT + tok0 + t0] = row0 + rank0; } else inv[(size_t)e * d.NT + tok0 + t0] = -1; }
          if (h1) { if (rank1 < cap) { sel[rank1] = t1; pgate[row0 + rank1] = __builtin_bit_cast(float, (unsigned)(k1 >> 32)); inv[(size_t)e * d.NT + tok0 + t1] = row0 + rank1; } else inv[(size_t)e * d.NT + tok0 + t1] = -1; } }
        __syncthreads();
        for (int r0 = c.wave * 4; r0 < cap; r0 += NWAVES * 4) {
            u32x4 v[4][2];
            UNR for (int u = 0; u < 4; ++u) { const int r = r0 + u < cap ? r0 + u : cap - 1; const u32x4* src = (const u32x4*)(hb + (size_t)(tok0 + sel[r]) * D); v[u][0] = src[c.lane]; v[u][1] = src[c.lane + 64]; }
            UNR for (int u = 0; u < 4; ++u) { if (r0 + u < cap) { u32x4* dst = (u32x4*)(xe + (size_t)(row0 + r0 + u) * D); dst[c.lane] = v[u][0]; dst[c.lane + 64] = v[u][1]; } }
        }
    }
}

__device__ __forceinline__ void phase_ln2(const Ctx& c0, int l) {
    const Ctx c = fresh(c0);
    const Dims& d = c.d; const float* mods = c.mods(l); const bf16_t* y = c.ws<bf16_t>(d.w_y); const int* inv = c.ws<int>(d.w_inv); bf16_t* hb = c.ws<bf16_t>(d.w_hb);
    const float* lg = c.in(I_LNG) + ((size_t)l * 2 + 1) * D; const float* lb = c.in(I_LNB) + ((size_t)l * 2 + 1) * D;
    const float* modn = (l + 1 < DEPTH) ? c.mods(l + 1) : nullptr;
    const int gw = c.vcu * NWAVES + c.wave, NGW = c.G * NWAVES;
    for (int tok = gw; tok < d.NT; tok += NGW) {
        const int mrow = c.modrow(tok); const float* mr = mods + (size_t)mrow * NMOD; f32x4 ff[4];
#pragma unroll
        for (int j = 0; j < 4; ++j) ff[j] = (f32x4){0.f, 0.f, 0.f, 0.f};
        for (int e = 0; e < NEXP; ++e) { const int row = inv[(size_t)e * d.NT + tok]; if (row >= 0) {
#pragma unroll
            for (int j = 0; j < 4; ++j) { const u32x2 w = *(const u32x2*)(y + (size_t)row * D + 4 * c.lane + 256 * j); ff[j] += (f32x4){bflo(w.x), bfhi(w.x), bflo(w.y), bfhi(w.y)}; } } }
        f32x4 x[4]; float s = 0.0f;
#pragma unroll
        for (int j = 0; j < 4; ++j) { const int col = 4 * c.lane + 256 * j; const f32x4 x1 = *(const f32x4*)(c.X() + (size_t)tok * D + col), g2 = *(const f32x4*)(mr + 5 * D + col);
            x[j] = ALPHA * x1 + g2 * ff[j]; s += (x[j][0] + x[j][1]) + (x[j][2] + x[j][3]); }
        const float mean = wave_sum(s) * (1.0f / D); float q = 0.0f;
#pragma unroll
        for (int j = 0; j < 4; ++j) { x[j] = x[j] - mean; q += (x[j][0] * x[j][0] + x[j][1] * x[j][1]) + (x[j][2] * x[j][2] + x[j][3] * x[j][3]); }
        const float rstd = frsq(wave_sum(q) * (1.0f / D) + LN_EPS);
#pragma unroll
        for (int j = 0; j < 4; ++j) { const int col = 4 * c.lane + 256 * j; const f32x4 g = *(const f32x4*)(lg + col), bb = *(const f32x4*)(lb + col);
            const f32x4 x2 = x[j] * rstd * g + bb; *(f32x4*)(c.X() + (size_t)tok * D + col) = x2;
            if (modn) { const float* mn = modn + (size_t)mrow * NMOD; const f32x4 sh = *(const f32x4*)(mn + col), sc = *(const f32x4*)(mn + D + col); const f32x4 hh = x2 * (1.0f + sc) + sh;
                u32x2 w; w.x = pk2(hh[0], hh[1]); w.y = pk2(hh[2], hh[3]); *(u32x2*)(hb + (size_t)tok * D + col) = w; } }
    }
}

constexpr int N_PHASES = 2 + 11 * DEPTH;
__device__ __forceinline__ void run_phase(const Ctx& c0, int ph, int rep) {
    const Ctx c = fresh(c0); const Dims& d = c.d;
#ifndef PHASE_MASK
#define PHASE_MASK 0xFFFF
#endif
    if (ph == 0) { if (PHASE_MASK & 0x800) phase_prep(c); return; }
    if (ph == 1) { if (PHASE_MASK & 0x1000) phase_init(c); return; }
    const int l = (ph - 2) / 11, s = (ph - 2) % 11;
    LAS unsigned char* ldsp = (LAS unsigned char*)c.lds;
    if (!((PHASE_MASK >> s) & 1)) return;
    switch (s) {
    case 0: { pg8::Gemm g{c.ws<bf16_t>(d.w_hb), c.ws<bf16_t>(d.w_win) + (size_t)l * NINP * D, D}; pg8::StaticOrder S; S.init(d.NT, NINP, c.G, (int)blockIdx.x);
              EpiCols E{c.ws<bf16_t>(d.w_cols), c.ws<float>(d.w_small), c.ws<unsigned char>(d.w_gates), c.p->out + d.o_nk, c.p->out + d.o_nv, l, d.NTc, d.Tc}; pg8::gemm_phase<EpiCols, pg8::StaticOrder>(ldsp, g, S, E); } break;
    case 1: phase_rwprep(c, l); break;
    case 2: phase_mixers(c, l, rep); break;
    case 3: phase_combine(c, l); break;
    case 4: { pg8::Gemm g{c.ws<bf16_t>(d.w_br), c.ws<bf16_t>(d.w_wbr) + (size_t)l * D * D, D}; pg8::StaticOrder S; S.init(d.NT, D, c.G, (int)blockIdx.x);
              EpiWiden E{c.ws<unsigned char>(d.w_gates), c.ws<bf16_t>(d.w_merged)}; pg8::gemm_phase<EpiWiden, pg8::StaticOrder>(ldsp, g, S, E); } break;
    case 5: { pg8::Gemm g{c.ws<bf16_t>(d.w_merged), c.ws<bf16_t>(d.w_wout) + (size_t)l * D * D, D}; pg8::StaticOrder S; S.init(d.NT, D, c.G, (int)blockIdx.x);
              EpiPreLN E{l == 0 ? c.in(I_XP) : c.X(), l == 0 ? c.in(I_XS) - (size_t)d.NTc * D : c.X(), c.mods(l), c.ws<float>(d.w_v), d.NTc, d.Tl}; pg8::gemm_phase<EpiPreLN, pg8::StaticOrder>(ldsp, g, S, E); } break;
    case 6: phase_ln1(c, l); break;
    case 7: phase_select(c); break;
    case 8: { pg8::Gemm g{c.ws<bf16_t>(d.w_xe), c.ws<bf16_t>(d.w_wup) + (size_t)l * NEXP * 2 * FF * D, D}; pg8::GroupOrder S; S.init(d.TPE, 2 * FF / 256, NEXP, c.G, c.vcu);
              EpiSwiGLU E{c.ws<bf16_t>(d.w_act)}; pg8::gemm_phase<EpiSwiGLU, pg8::GroupOrder>(ldsp, g, S, E); } break;
    case 9: { pg8::Gemm g{c.ws<bf16_t>(d.w_act), c.ws<bf16_t>(d.w_wdn) + (size_t)l * NEXP * D * FF, FF}; pg8::GroupOrder S; S.init(d.TPE, D / 256, NEXP, c.G, c.vcu);
              EpiDown E{c.ws<float>(d.w_pgate), c.ws<bf16_t>(d.w_y)}; pg8::gemm_phase<EpiDown, pg8::GroupOrder>(ldsp, g, S, E); } break;
    default: phase_ln2(c, l); break;
    }
}

#ifndef CPU_EMU
#define XB_TMO      128
#define XB_XCNT(j)  (256  + 64 * (j))
#define XB_XSUB(j)  (1280 + 64 * (j))
#define XB_XGEN(j)  (2304 + 64 * (j))
#define XB_TOP      3328
#define XB_TOPGEN   3392
#define XB_SPIN_CAP (1u << 20)
__device__ __forceinline__ unsigned xb_ld(unsigned* p)              { return __hip_atomic_load(p, __ATOMIC_RELAXED, __HIP_MEMORY_SCOPE_AGENT); }
__device__ __forceinline__ unsigned xb_add(unsigned* p, unsigned v) { return __hip_atomic_fetch_add(p, v, __ATOMIC_RELAXED, __HIP_MEMORY_SCOPE_AGENT); }
__device__ __forceinline__ unsigned xb_xcc_id() { return (unsigned)__builtin_amdgcn_s_getreg((3 << 11) | 20) & 0xFu; }
#define XB_SPIN(cond, bar) do { unsigned _sp = 0; while (cond) { __builtin_amdgcn_s_sleep(1); \
    if ((++_sp & 255u) == 0u) { if (xb_ld(&(bar)[XB_TMO])) break; if (_sp > XB_SPIN_CAP) { atomicAdd(&(bar)[XB_TMO], 1u); break; } } } } while (0)
struct XcdBarrier { unsigned* bar; unsigned x; volatile LAS unsigned* st; };
__device__ __forceinline__ XcdBarrier xcd_barrier_post(unsigned* bar, volatile LAS unsigned* st) {
    XcdBarrier b; b.bar = bar; b.x = xb_xcc_id(); b.st = st;
    if (threadIdx.x == 0) (void)xb_add(&bar[XB_XCNT(b.x)], 1u);
    return b;
}
__device__ __forceinline__ void xcd_barrier_complete(unsigned* bar, unsigned x, unsigned& nloc, unsigned& nx) {
    const unsigned G = gridDim.x * gridDim.y * gridDim.z;
    unsigned sum, cnt, mine, sp = 0u;
    for (;;) {
        sum = 0u; cnt = 0u; mine = 0u;
#pragma unroll
        for (unsigned j = 0; j < 16; ++j) { const unsigned cc = xb_ld(&bar[XB_XCNT(j)]); sum += cc; cnt += (cc > 0u) ? 1u : 0u; mine = (j == x) ? cc : mine; }
        if (sum == G) break;
        __builtin_amdgcn_s_sleep(1);
        if ((++sp & 255u) == 0u) { if (xb_ld(&bar[XB_TMO])) break; if (sp > XB_SPIN_CAP) { atomicAdd(&bar[XB_TMO], 1u); break; } }
    }
    nloc = mine > 0u ? mine : 1u; nx = cnt > 0u ? cnt : 1u;
}
__device__ __forceinline__ void xcd_barrier(const XcdBarrier& b) {
    asm volatile("s_waitcnt vmcnt(0)" ::: "memory");
    __syncthreads();
    if (threadIdx.x == 0) {
        unsigned* bar = b.bar;
        __builtin_amdgcn_s_waitcnt(0);
        unsigned nloc = b.st[0], nx = b.st[1];
        if (nloc == 0u) { xcd_barrier_complete(bar, b.x, nloc, nx); b.st[0] = nloc; b.st[1] = nx; }
        const unsigned old = xb_add(&bar[XB_XSUB(b.x)], 1u);
        const unsigned gen = old / nloc;
        if (old + 1u == (gen + 1u) * nloc) {
            __builtin_amdgcn_fence(__ATOMIC_RELEASE, "agent");
            asm volatile("s_waitcnt vmcnt(0)" ::: "memory");
            const unsigned og = xb_add(&bar[XB_TOP], 1u);
            const unsigned tg = og / nx;
            if (og + 1u == (tg + 1u) * nx) xb_add(&bar[XB_TOPGEN], 1u);
            else XB_SPIN(xb_ld(&bar[XB_TOPGEN]) == tg, bar);
            __builtin_amdgcn_fence(__ATOMIC_ACQUIRE, "agent");
            xb_add(&bar[XB_XGEN(b.x)], 1u);
            asm volatile("s_waitcnt vmcnt(0)" ::: "memory");
        } else {
            XB_SPIN(xb_ld(&bar[XB_XGEN(b.x)]) == gen, bar);
            __builtin_amdgcn_fence(__ATOMIC_ACQUIRE, "agent");
            asm volatile("s_waitcnt vmcnt(0)" ::: "memory");
        }
    }
    __syncthreads();
}

#ifndef PROBE_DUP
#define PROBE_DUP 0
#endif
constexpr int LDS_BYTES = 163840;
__global__ void __launch_bounds__(NTHREADS, 2) trunk_fwd(Params p) {
    extern __shared__ __attribute__((aligned(16))) unsigned char lds[];
    Ctx c; c.p = &p; c.d = make_dims(p.Bc, p.Tc, p.Bl, p.Tl); c.lds = lds;
    c.tid = threadIdx.x; c.lane = c.tid & 63; c.wave = __builtin_amdgcn_readfirstlane(c.tid >> 6);
    c.G = gridDim.x; { const int bx = blockIdx.x; c.vcu = (c.G % 8 == 0) ? (bx % 8) * (c.G / 8) + bx / 8 : bx; }
    volatile LAS unsigned* st = (volatile LAS unsigned*)((LAS unsigned char*)lds + LDS_BYTES - 64);
    XcdBarrier bar; bar.bar = nullptr; bar.x = 0; bar.st = st;
    if (p.use_bar) { if (c.tid < 2) st[c.tid] = 0u; __syncthreads(); bar = xcd_barrier_post((unsigned*)(p.ws) + CW_BAR, st); }
    for (int ph = p.ph_lo; ph < p.ph_hi; ++ph) {
#if PROBE_DUP
        { const int kind = ph == 0 ? 11 : (ph == 1 ? 12 : (ph - 2) % 11); const int nrep = ((PROBE_DUP >> kind) & 1) ? 2 : 1;
          for (int rep = 0; rep < nrep; ++rep) { run_phase(c, ph, rep); if (rep + 1 < nrep) xcd_barrier(bar); } }
#else
        run_phase(c, ph, 0);
#endif
        if (ph + 1 < p.ph_hi) xcd_barrier(bar);
    }
}

#ifndef N_LAUNCH_MODE
#define N_LAUNCH_MODE 1
#endif
extern "C" void kernel_launch(void* const* d_in, const int* in_sizes, int n_in, void* d_out, int out_size, void* d_ws, size_t ws_size, hipStream_t stream) {
    static int grid = 0;
    const Dims d = make_dims(32, 256, 8, 1024);
    if (grid == 0) {
        int dev = 0, cus = 0;
        if (n_in != N_INPUTS || (size_t)out_size != d.o_end || ws_size < ((size_t)d.w_end << 8)) { fprintf(stderr, "kernel_launch: unexpected sizes: n_in %d out %d ws %zu (need %zu / %zu)\n", n_in, out_size, ws_size, (size_t)d.o_end, (size_t)d.w_end << 8); grid = -1; return; }
        if (hipGetDevice(&dev) != hipSuccess || hipDeviceGetAttribute(&cus, hipDeviceAttributeMultiprocessorCount, dev) != hipSuccess) { grid = -1; return; }
        if (hipFuncSetAttribute((const void*)trunk_fwd, hipFuncAttributeMaxDynamicSharedMemorySize, LDS_BYTES) != hipSuccess) { fprintf(stderr, "kernel_launch: hipFuncSetAttribute failed\n"); grid = -1; return; }
        int per_cu = 0;
        if (hipOccupancyMaxActiveBlocksPerMultiprocessor(&per_cu, (const void*)trunk_fwd, NTHREADS, LDS_BYTES) != hipSuccess || per_cu < 1) fprintf(stderr, "kernel_launch: occupancy query says %d\n", per_cu);
        (void)hipGetLastError();
        grid = cus;
    }
    if (grid < 0) return;
    (void)hipMemsetAsync((char*)d_ws, 0, CTL_BYTES, stream);
    Params p{};
    for (int i = 0; i < N_INPUTS; ++i) p.in[i] = (const float*)d_in[i];
    p.out = (float*)d_out; p.ws = (unsigned char*)d_ws; p.Bc = 32; p.Tc = 256; p.Bl = 8; p.Tl = 1024;
#if N_LAUNCH_MODE == 1
    p.ph_lo = 0; p.ph_hi = N_PHASES; p.use_bar = 1;
    hipLaunchKernelGGL(trunk_fwd, dim3(grid), dim3(NTHREADS), LDS_BYTES, stream, p);
#else
    for (int ph = 0; ph < N_PHASES; ++ph) { p.ph_lo = ph; p.ph_hi = ph + 1; p.use_bar = 0; hipLaunchKernelGGL(trunk_fwd, dim3(grid), dim3(NTHREADS), LDS_BYTES, stream, p); }
#endif
}
#endif
```

```cpp
#ifndef CPU_EMU
#include <hip/hip_runtime.h>
#include <cstdio>
typedef float f32x16 __attribute__((ext_vector_type(16)));
typedef float f32x4 __attribute__((ext_vector_type(4)));
typedef float f32x2 __attribute__((ext_vector_type(2)));
typedef unsigned u32x4 __attribute__((ext_vector_type(4)));
typedef unsigned u32x2 __attribute__((ext_vector_type(2)));
#define LAS __attribute__((address_space(3)))
#define WAVE_SYNC() asm volatile("s_waitcnt lgkmcnt(0)" ::: "memory")
#else
#define LAS
#define WAVE_SYNC() emu::wave_sync()
#endif
#define UNR _Pragma("unroll")
#ifndef CPU_EMU
#define LDS_BARRIER() do { asm volatile("s_waitcnt lgkmcnt(0)\n\ts_barrier" ::: "memory"); } while (0)
#else
#define LDS_BARRIER() __syncthreads()
#endif
typedef short bf16x8 __attribute__((ext_vector_type(8)));
typedef unsigned short bf16_t;

constexpr int D = 1024, NH = 4, HD = 64, MIXW = 256, NEXP = 16, FF = 2048, DEPTH = 2, PAST = 256, GRIDW = 64;
constexpr int NIN = 7920, NINP = 7936, NCB = 3584, NSM = 256, NGATE = 4096, NMOD = 6 * D;
constexpr float ALPHA = 1.4142135623730951f, LN_EPS = 1e-5f;
constexpr int NTHREADS = 512, NWAVES = 8;
constexpr int CB_MQ = 0, CB_MK = 1, CB_MV = 2, CB_MO = 3, CB_GQ = 4, CB_GK = 5, CB_GV = 6, CB_GG = 7, CB_RR = 8, CB_RK = 9, CB_RV = 10, CB_NQ = 11, CB_NK = 12, CB_NV = 13;
constexpr int SM_MI = 0, SM_MF = 8, SM_GA = 16, SM_RW = 48, SM_RA = 112, SM_RG = 176;
enum { I_XP = 0, I_XS, I_SC, I_SN, I_SM, I_SG, I_SR, I_CK, I_CV, I_C, I_CCTX, I_WADA, I_BADA, I_WIN, I_BIG, I_BFG, I_WGLA, I_BGLA, I_SHIFT, I_W0, I_WW2, I_A0, I_WA2, I_WG2, I_KK, I_KA, I_RKK,
       I_RPB, I_WBR, I_WOUT, I_LNG, I_LNB, I_WROUTER, I_WUP, I_WDOWN, N_INPUTS };

__host__ __device__ __forceinline__ int prow(int n) { const int rho = n & 31; return (n & ~31) + 8 * ((rho & 15) >> 2) + 4 * (rho >> 4) + (rho & 3); }
__host__ __device__ __forceinline__ int win_col(int p) {
    if (p < 3584) { const int b = p >> 8, w = p & 255; const int base = b < 4 ? b * 256 : (b < 8 ? 1040 + (b - 4) * 256 : (b < 11 ? 2096 + (b - 8) * 256 : 3056 + (b - 11) * 256)); return base + w; }
    if (p < 3840) { const int s = p - 3584; return s < 16 ? 1024 + s : (s < 48 ? 2064 + (s - 16) : (s < 240 ? 2864 + (s - 48) : -1)); }
    return p - 16;
}

struct Params {
    const float* in[N_INPUTS];
    float* out; unsigned char* ws;
    int Bc, Tc, Bl, Tl;
    int ph_lo, ph_hi;
    int use_bar, pad;
};
struct Dims {
    int Bc, Tc, Bl, Tl, NTc, NTl, NT, capc, capl, RPE, TPE, NPR;
    unsigned o_yp, o_ys, o_C, o_n, o_m, o_g, o_r, o_nk, o_nv, o_end;
    unsigned w_ctl, w_win, w_wbr, w_wout, w_wup, w_wdn, w_mods, w_hb, w_cols, w_small, w_vecs, w_gates, w_br, w_scr, w_merged, w_v, w_aff, w_inv, w_pgate, w_xe, w_act, w_y, w_end;
};
constexpr size_t CTL_BYTES = 1u << 20;
constexpr int CW_BAR = 4096, CW_QUEUE = 1024;
__host__ __device__ __forceinline__ unsigned al256(size_t x) { return (unsigned)((x + 255) >> 8); }
__host__ __device__ __forceinline__ Dims make_dims(int Bc, int Tc, int Bl, int Tl) {
    Dims d; d.Bc = Bc; d.Tc = Tc; d.Bl = Bl; d.Tl = Tl; d.NTc = Bc * Tc; d.NTl = Bl * Tl; d.NT = d.NTc + d.NTl;
    d.capc = Tc / 8; d.capl = Tl / 8; d.RPE = ((Bc * d.capc + Bl * d.capl + 255) / 256) * 256; d.TPE = d.RPE / 256; d.NPR = NEXP * d.RPE;
    unsigned o = 0; d.o_yp = o; o += (unsigned)d.NTc * D; d.o_ys = o; o += (unsigned)d.NTl * D;
    d.o_C = o; o += (unsigned)Bc * DEPTH * 2 * NH * HD * HD; d.o_n = o; o += (unsigned)Bc * DEPTH * 2 * NH * HD; d.o_m = o; o += (unsigned)Bc * DEPTH * 2 * NH;
    d.o_g = o; o += (unsigned)Bc * DEPTH * 2 * NH * HD * HD; d.o_r = o; o += (unsigned)Bc * DEPTH * 2 * NH * HD * HD;
    d.o_nk = o; o += (unsigned)Bc * DEPTH * NH * Tc * HD; d.o_nv = o; o += (unsigned)Bc * DEPTH * NH * Tc * HD; d.o_end = o;
    unsigned w = 0; d.w_ctl = w; w += (unsigned)(CTL_BYTES >> 8);
    d.w_win = w; w += al256((size_t)DEPTH * NINP * D * 2); d.w_wbr = w; w += al256((size_t)DEPTH * D * D * 2); d.w_wout = w; w += al256((size_t)DEPTH * D * D * 2);
    d.w_wup = w; w += al256((size_t)DEPTH * NEXP * 2 * FF * D * 2); d.w_wdn = w; w += al256((size_t)DEPTH * NEXP * D * FF * 2);
    d.w_mods = w; w += al256((size_t)DEPTH * (1 + Bl) * NMOD * 4);
    d.w_hb = w; w += al256((size_t)d.NT * D * 2); d.w_cols = w; w += al256((size_t)d.NT * NCB * 2); d.w_small = w; w += al256((size_t)d.NT * NSM * 4); d.w_vecs = w; w += al256((size_t)d.NT * NH * 576 * 4); d.w_gates = w; w += al256((size_t)d.NT * NGATE);
    d.w_br = w; w += al256((size_t)d.NT * D * 2); d.w_scr = w; w += al256((size_t)d.NT * 7 * MIXW * 2); d.w_merged = w; w += al256((size_t)d.NT * D * 2);
    d.w_v = w; w += al256((size_t)d.NT * D * 4); d.w_aff = w; w += al256((size_t)d.NT * NEXP * 4); d.w_inv = w; w += al256((size_t)d.NT * NEXP * 4);
    d.w_pgate = w; w += al256((size_t)d.NPR * 4); d.w_xe = w; w += al256((size_t)d.NPR * D * 2); d.w_act = w; w += al256((size_t)d.NPR * FF * 2); d.w_y = w; w += al256((size_t)d.NPR * D * 2);
    d.w_end = w; return d;
}

__device__ __forceinline__ unsigned f2bf(float f) { unsigned u = __builtin_bit_cast(unsigned, f); return (u + 0x7fffu + ((u >> 16) & 1u)) >> 16; }
#ifndef CPU_EMU
__device__ __forceinline__ unsigned cvtpk(float lo, float hi) { unsigned r; asm("v_cvt_pk_bf16_f32 %0, %1, %2" : "=v"(r) : "v"(lo), "v"(hi)); return r; }
__device__ __forceinline__ unsigned pk2(float lo, float hi) { return cvtpk(lo, hi); }
#else
inline unsigned pk2(float lo, float hi) { return f2bf(lo) | (f2bf(hi) << 16); }
inline unsigned cvtpk(float lo, float hi) { return pk2(lo, hi); }
#endif

#ifndef CPU_EMU
template <int CTRL> __device__ __forceinline__ float dppf(float v) { return __builtin_bit_cast(float, __builtin_amdgcn_update_dpp(0, __builtin_bit_cast(int, v), CTRL, 0xF, 0xF, true)); }
__device__ __forceinline__ float x1(float v) { return dppf<0xB1>(v); }
__device__ __forceinline__ float x2(float v) { return dppf<0x4E>(v); }
__device__ __forceinline__ float x4m(float v) { return dppf<0x141>(v); }
__device__ __forceinline__ float x8m(float v) { return dppf<0x140>(v); }
__device__ __forceinline__ float fexp(float x) { return __expf(x); }
__device__ __forceinline__ float flog(float x) { return __logf(x); }
__device__ __forceinline__ float frsq(float x) { return __builtin_amdgcn_rsqf(x); }
#else
inline float x1(float v) { return __shfl_xor(v, 1); }
inline float x2(float v) { return __shfl_xor(v, 2); }
inline float x4m(float v) { return __shfl_xor(v, 4); }
inline float x8m(float v) { return __shfl_xor(v, 8); }
inline float fexp(float x) { return expf(x); }
inline float flog(float x) { return logf(x); }
inline float frsq(float x) { return 1.0f / sqrtf(x); }
#endif
__device__ __forceinline__ float quad_sum(float v) { v += x1(v); v += x2(v); return v; }
__device__ __forceinline__ float oct_sum(float v) { v += x1(v); v += x2(v); v += x4m(v); return v; }
__device__ __forceinline__ float oct_max(float v) { v = fmaxf(v, x1(v)); v = fmaxf(v, x2(v)); v = fmaxf(v, x4m(v)); return v; }
__device__ __forceinline__ float sigmoidf_(float x) { return __builtin_amdgcn_rcpf(1.0f + fexp(-x)); }
__device__ __forceinline__ float logsigmoidf_(float x) { return fminf(x, 0.0f) - flog(1.0f + fexp(-fabsf(x))); }
__device__ __forceinline__ float softplusf_(float x) { return fmaxf(x, 0.0f) + flog(1.0f + fexp(-fabsf(x))); }
__device__ __forceinline__ float tanhf_(float x) { const float e = fexp(-2.0f * fabsf(x)); const float t = (1.0f - e) * __builtin_amdgcn_rcpf(1.0f + e); return x < 0.0f ? -t : t; }
__device__ __forceinline__ float siluf_(float x) { return x * __builtin_amdgcn_rcpf(1.0f + fexp(-x)); }
#ifndef CPU_EMU
__device__ __forceinline__ float rlane(float v, int l) { return __builtin_bit_cast(float, __builtin_amdgcn_readlane(__builtin_bit_cast(int, v), l)); }
__device__ __forceinline__ float wave_sum(float v) {
    v += x1(v); v += x2(v); v += x4m(v); v += x8m(v);
    return (rlane(v, 0) + rlane(v, 16)) + (rlane(v, 32) + rlane(v, 48));
}
#else
inline float wave_sum(float v) { for (int o = 1; o < 64; o <<= 1) v += __shfl_xor(v, o); return v; }
#endif
__device__ __forceinline__ unsigned pkh2(float a, float b) { const _Float16 x = (_Float16)a, y = (_Float16)b; return (unsigned)__builtin_bit_cast(unsigned short, x) | ((unsigned)__builtin_bit_cast(unsigned short, y) << 16); }
#ifndef CPU_EMU
__device__ __forceinline__ float frcp(float x) { return __builtin_amdgcn_rcpf(x); }
#else
inline float frcp(float x) { return 1.0f / x; }
#endif
__device__ __forceinline__ float bf2f(unsigned v) { return __builtin_bit_cast(float, v << 16); }
__device__ __forceinline__ float bflo(unsigned w) { return __builtin_bit_cast(float, w << 16); }
__device__ __forceinline__ float bfhi(unsigned w) { return __builtin_bit_cast(float, w & 0xffff0000u); }
__device__ __forceinline__ float h2f(unsigned short h) { return (float)__builtin_bit_cast(_Float16, h); }

#ifndef CPU_EMU
__device__ __forceinline__ int opqv(int x) { asm volatile("" : "+v"(x)); return x; }
__device__ __forceinline__ int opqs(int x) { asm volatile("" : "+s"(x)); return x; }
#else
inline int opqv(int x) { return x; }
inline int opqs(int x) { return x; }
#endif
namespace pg8 {
constexpr int BM = 256, BK = 64, HALF = 128, HTB = HALF * BK * 2, STAGE_BYTES = 8 * HTB, NXCD = 8, WGM = 8;
__host__ __device__ __forceinline__ int lds_byte(int r, int c) { const int st = (r >> 4) * 2 + (c >> 5), rr = r & 15, cc = c & 31, ob = rr * 64 + cc * 2; return st * 1024 + (ob ^ (((ob >> 9) & 1) << 5)); }
__host__ __device__ __forceinline__ void stage_rc(int b, int& R, int& C) { const int st = b / 1024, sb = b % 1024, swz = sb ^ (((sb >> 9) & 1) << 5); R = (st >> 1) * 16 + swz / 64; C = (st & 1) * 32 + (swz % 64) / 2; }
struct Unit { int pm, pn, ta, tb; };
struct Gemm { const bf16_t* A; const bf16_t* Bt; int K; };
struct StaticOrder {
    int nM, nN, nwg, G, c;
    __device__ __forceinline__ void init(int M, int N, int G_, int c_) { nM = M / BM; nN = N / BM; nwg = nM * nN; G = G_; c = c_; }
    __device__ __forceinline__ bool next(int i, Unit& u) const {
        const long L = (long)i * G + c; if (L >= nwg) return false;
        int wgid = (int)L; { const int q = nwg / NXCD, r = nwg % NXCD, xcd = wgid % NXCD, off = wgid / NXCD; wgid = (xcd < r ? xcd * (q + 1) : r * (q + 1) + (xcd - r) * q) + off; }
        const int nig = WGM * nN, gid = wgid / nig, fm = gid * WGM, gsz = (nM - fm) < WGM ? (nM - fm) : WGM;
        u.pm = fm + ((wgid % nig) % gsz); u.pn = (wgid % nig) / gsz; u.ta = u.pm; u.tb = u.pn; return true;
    }
};
struct GroupOrder {
    int tpe, nN, nE, G, c;
    __device__ __forceinline__ void init(int tpe_, int nN_, int nE_, int G_, int c_) { tpe = tpe_; nN = nN_; nE = nE_; G = G_; c = c_; }
    __device__ __forceinline__ bool next(int i, Unit& u) const {
        const long L = (long)i * G + c; if (L >= (long)nE * tpe * nN) return false;
        const int per = tpe * nN, e = (int)(L / per), r = (int)(L % per), pn = r / tpe, pm = r % tpe;
        u.ta = e * tpe + pm; u.tb = e * nN + pn; u.pm = u.ta; u.pn = pn; return true;
    }
};
#ifndef CPU_EMU
template <class Epi, class Sched>
__device__ __forceinline__ void gemm_phase(LAS unsigned char* lds, const Gemm g, const Sched& S, const Epi& E) {
    const int tid = opqv((int)threadIdx.x), wid = __builtin_amdgcn_readfirstlane(tid >> 6), lane = tid & 63, wr = wid >> 2, wc = wid & 3, fr = lane & 15, fq = lane >> 4;
    const int K = g.K, nt = K / BK;
    unsigned voffA[2];
#pragma unroll
    for (int i = 0; i < 2; ++i) { int R, C; stage_rc(tid * 16 + i * 8192, R, C); voffA[i] = (unsigned)(R * K + C) * 2u; }
    const size_t kstep = (size_t)(BK * 2), hstep = (size_t)HALF * K * 2, tstep = 2 * hstep;
    const unsigned ldsw = (unsigned)wid * 1024u;
    const int aoff = lds_byte(wr * 64 + fr, fq * 8), boff = lds_byte(wc * 32 + fr, fq * 8);
#define PG8_SA(b, h) (((b) * 2 + (h)) * HTB)
#define PG8_SB(b, h) ((4 + (b) * 2 + (h)) * HTB)
#define PG8_STAGE(bufoff, gbase) do { _Pragma("unroll") for (int _i = 0; _i < 2; ++_i) \
        __builtin_amdgcn_global_load_lds((const unsigned*)((const char*)(gbase) + voffA[_i]), (LAS unsigned*)(lds + (bufoff) + ldsw + _i * 8192), 16, 0, 0); } while (0)
#define PG8_LDA(dst, b, h) do { _Pragma("unroll") for (int m = 0; m < 4; ++m) _Pragma("unroll") for (int k = 0; k < 2; ++k) dst[m][k] = *(const LAS bf16x8*)(lds + PG8_SA(b, h) + aoff + m * 2048 + k * 1024); } while (0)
#define PG8_LDB(dst, b, h) do { _Pragma("unroll") for (int n = 0; n < 2; ++n) _Pragma("unroll") for (int k = 0; k < 2; ++k) dst[n][k] = *(const LAS bf16x8*)(lds + PG8_SB(b, h) + boff + n * 2048 + k * 1024); } while (0)
#define PG8_MMA(ai, bj, At, Bt) do { __builtin_amdgcn_s_setprio(1); _Pragma("unroll") for (int m = 0; m < 4; ++m) _Pragma("unroll") for (int n = 0; n < 2; ++n) _Pragma("unroll") for (int k = 0; k < 2; ++k) \
        acc[ai][bj][m][n] = __builtin_amdgcn_mfma_f32_16x16x32_bf16(Bt[n][k], At[m][k], acc[ai][bj][m][n], 0, 0, 0); __builtin_amdgcn_s_setprio(0); } while (0)
#define PG8_WAIT_V(n) asm volatile("s_waitcnt vmcnt(" #n ")" ::: "memory")
#define PG8_WAIT_L(n) asm volatile("s_waitcnt lgkmcnt(" #n ")" ::: "memory")
#define PG8_BAR __builtin_amdgcn_s_barrier()
#define PG8_SCHED __builtin_amdgcn_sched_barrier(0)
    Unit cur, nxt; int ui = 0;
    if (!S.next(0, cur)) return;
    f32x4 acc[2][2][4][2];
#pragma unroll
    for (int a = 0; a < 2; ++a)
#pragma unroll
        for (int b = 0; b < 2; ++b)
#pragma unroll
            for (int m = 0; m < 4; ++m)
#pragma unroll
                for (int n = 0; n < 2; ++n) acc[a][b][m][n] = (f32x4){0.f, 0.f, 0.f, 0.f};
    bf16x8 At[4][2], B0[2][2], B1[2][2];
    const char* cA = (const char*)g.A + (size_t)cur.ta * tstep; const char* cB = (const char*)g.Bt + (size_t)cur.tb * tstep;
    PG8_STAGE(PG8_SB(0, 0), cB); PG8_STAGE(PG8_SB(0, 1), cB + hstep); PG8_STAGE(PG8_SA(0, 0), cA); PG8_STAGE(PG8_SA(0, 1), cA + hstep);
    if (wr == 1) PG8_BAR;
    PG8_WAIT_V(2); PG8_BAR;
    PG8_STAGE(PG8_SB(1, 0), cB + kstep); PG8_STAGE(PG8_SA(1, 0), cA + kstep); PG8_STAGE(PG8_SB(1, 1), cB + hstep + kstep);
    PG8_WAIT_V(6); PG8_BAR;
    for (;;) {
        const bool has_next = S.next(ui + 1, nxt);
        const char* nA = has_next ? (const char*)g.A + (size_t)nxt.ta * tstep : cA; const char* nB = has_next ? (const char*)g.Bt + (size_t)nxt.tb * tstep : cB;
        for (int t = 0; t < nt; t += 2) {
            const bool last = (t == nt - 2);
            const char* a1 = cA + (size_t)(t + 1) * kstep;
            const char* a2 = last ? nA : cA + (size_t)(t + 2) * kstep; const char* b2 = last ? nB : cB + (size_t)(t + 2) * kstep;
            const char* a3 = a2 + kstep; const char* b3 = b2 + kstep;
            if constexpr (Epi::MID) { if (t != 0 && (t & 3) == 0) E.mid(acc, cur, t >> 2, wr, wc, fr, fq); }
            PG8_LDB(B0, 0, 0); PG8_LDB(B1, 0, 1); PG8_SCHED; PG8_LDA(At, 0, 0); PG8_STAGE(PG8_SA(1, 1), a1 + hstep);
            PG8_WAIT_V(8); PG8_WAIT_L(0); PG8_BAR; PG8_MMA(0, 0, At, B0); PG8_MMA(0, 1, At, B1); PG8_BAR; PG8_SCHED;
            PG8_LDA(At, 0, 1); PG8_STAGE(PG8_SB(0, 0), b2); PG8_STAGE(PG8_SB(0, 1), b2 + hstep); PG8_STAGE(PG8_SA(0, 0), a2);
            PG8_WAIT_V(8); PG8_WAIT_L(0); PG8_BAR; PG8_MMA(1, 0, At, B0); PG8_MMA(1, 1, At, B1); PG8_BAR; PG8_SCHED;
            PG8_LDB(B0, 1, 0); PG8_LDB(B1, 1, 1); PG8_SCHED; PG8_LDA(At, 1, 0); PG8_STAGE(PG8_SA(0, 1), a2 + hstep);
            PG8_WAIT_V(8); PG8_WAIT_L(0); PG8_BAR; PG8_MMA(0, 0, At, B0); PG8_MMA(0, 1, At, B1); PG8_BAR; PG8_SCHED;
            PG8_LDA(At, 1, 1); PG8_STAGE(PG8_SB(1, 0), b3); PG8_STAGE(PG8_SB(1, 1), b3 + hstep); PG8_STAGE(PG8_SA(1, 0), a3);
            PG8_WAIT_V(8); PG8_WAIT_L(0); PG8_BAR; PG8_MMA(1, 0, At, B0); PG8_MMA(1, 1, At, B1); PG8_BAR; PG8_SCHED;
        }
        if (wr == 0) PG8_BAR;
        E(acc, cur, wr, wc, fr, fq);
        if (!has_next) break;
#pragma unroll
        for (int a = 0; a < 2; ++a)
#pragma unroll
            for (int b = 0; b < 2; ++b)
#pragma unroll
                for (int m = 0; m < 4; ++m)
#pragma unroll
                    for (int n = 0; n < 2; ++n) acc[a][b][m][n] = (f32x4){0.f, 0.f, 0.f, 0.f};
        cur = nxt; cA = nA; cB = nB; ++ui;
        if (wr == 1) PG8_BAR;
    }
    PG8_WAIT_V(0);
    PG8_BAR;
#undef PG8_SA
#undef PG8_SB
#undef PG8_STAGE
#undef PG8_LDA
#undef PG8_LDB
#undef PG8_MMA
#undef PG8_WAIT_V
#undef PG8_WAIT_L
#undef PG8_BAR
#undef PG8_SCHED
}
#else
template <class Epi, class Sched> void gemm_phase(unsigned char* lds, const Gemm g, const Sched& S, const Epi& E);
#endif
}
typedef f32x4 AccT[2][2][4][2];

struct Ctx {
    const Params* p; Dims d; unsigned char* lds; int tid, lane, wave, G, vcu;
    template <class T> __device__ __forceinline__ T* ws(unsigned off) const { return (T*)(p->ws + ((size_t)off << 8)); }
    __device__ __forceinline__ const float* in(int i) const { return p->in[i]; }
    __device__ __forceinline__ int modrow(int tok) const { return tok < d.NTc ? 0 : 1 + (tok - d.NTc) / d.Tl; }
    __device__ __forceinline__ const float* mods(int l) const { return ws<float>(d.w_mods) + (size_t)l * (1 + d.Bl) * NMOD; }
    __device__ __forceinline__ float* X() const { return p->out; }
};

__device__ __forceinline__ Ctx fresh(const Ctx& c0) {
    Ctx c; c.p = c0.p; c.lds = c0.lds; c.tid = opqv(c0.tid); c.lane = c.tid & 63; c.wave = opqs(c0.wave); c.G = opqs(c0.G); c.vcu = opqs(c0.vcu);
    c.d = make_dims(opqs(c0.p->Bc), opqs(c0.p->Tc), opqs(c0.p->Bl), opqs(c0.p->Tl)); return c;
}

__device__ __forceinline__ u32x4 pk8(const f32x4 a, const f32x4 b) { u32x4 w; w.x = pk2(a[0], a[1]); w.y = pk2(a[2], a[3]); w.z = pk2(b[0], b[1]); w.w = pk2(b[2], b[3]); return w; }
__device__ __forceinline__ unsigned gq(float x) { const float g = sigmoidf_(x) * 255.0f + 0.5f; const unsigned q = (unsigned)g; return q < 1u ? 1u : (q > 255u ? 255u : q); }
__device__ __forceinline__ float ub(unsigned w, int i) { return (float)((w >> (8 * i)) & 0xffu); }
struct EpiCols {
    static constexpr bool MID = false;
    bf16_t* cols; float* small; unsigned char* gates; float* onk; float* onv; int l, NTc, Tc;
    __device__ __forceinline__ void operator()(const AccT& acc, const pg8::Unit& u, int wr, int wc, int fr, int fq) const {
        const int row0 = u.pm * 256 + wr * 64 + fr, cw = wc * 32 + 8 * fq;
        if (u.pn < 14) {
            float* okv = u.pn == 12 ? onk : (u.pn == 13 ? onv : nullptr);
#pragma unroll
            for (int ai = 0; ai < 2; ++ai)
#pragma unroll
                for (int m = 0; m < 4; ++m) { const int row = row0 + ai * 128 + m * 16; bf16_t* rp = cols + (size_t)row * NCB + u.pn * 256 + cw;
#pragma unroll
                    for (int bj = 0; bj < 2; ++bj) { *(u32x4*)(rp + bj * 128) = pk8(acc[ai][bj][m][0], acc[ai][bj][m][1]);
                        if (okv && row < NTc) { const int cc = bj * 128 + cw, b = row / Tc, t = row - b * Tc; float* op = okv + ((((size_t)b * DEPTH + l) * NH + (cc >> 6)) * Tc + t) * HD + (cc & 63);
                            *(f32x4*)op = acc[ai][bj][m][0]; *(f32x4*)(op + 4) = acc[ai][bj][m][1]; } } }
        } else if (u.pn == 14) {
#pragma unroll
            for (int ai = 0; ai < 2; ++ai)
#pragma unroll
                for (int m = 0; m < 4; ++m) { float* rp = small + (size_t)(row0 + ai * 128 + m * 16) * NSM + cw;
#pragma unroll
                    for (int bj = 0; bj < 2; ++bj) { *(f32x4*)(rp + bj * 128) = acc[ai][bj][m][0]; *(f32x4*)(rp + bj * 128 + 4) = acc[ai][bj][m][1]; } }
        } else {
#pragma unroll
            for (int ai = 0; ai < 2; ++ai)
#pragma unroll
                for (int m = 0; m < 4; ++m) { unsigned char* rp = gates + (size_t)(row0 + ai * 128 + m * 16) * NGATE + (u.pn - 15) * 256 + cw;
#pragma unroll
                    for (int bj = 0; bj < 2; ++bj) { const f32x4 a = acc[ai][bj][m][0], b = acc[ai][bj][m][1]; u32x2 w;
                        w.x = gq(a[0]) | (gq(a[1]) << 8) | (gq(a[2]) << 16) | (gq(a[3]) << 24); w.y = gq(b[0]) | (gq(b[1]) << 8) | (gq(b[2]) << 16) | (gq(b[3]) << 24);
                        *(u32x2*)(rp + bj * 128) = w; } }
        }
    }
};
struct EpiWiden {
    static constexpr bool MID = true;
    const unsigned char* gates; bf16_t* merged;
    __device__ __forceinline__ void mid(AccT& acc, const pg8::Unit& u, int z1, int wr, int wc, int fr, int fq) const {
        const int row0 = opqv(u.pm * 256 + wr * 64 + fr), col0 = opqv(u.pn * 256 + wc * 32 + 8 * fq);
#pragma unroll
        for (int ai = 0; ai < 2; ++ai)
#pragma unroll
            for (int m = 0; m < 4; ++m) { const unsigned char* rp = gates + (size_t)(row0 + ai * 128 + m * 16) * NGATE + col0;
#pragma unroll
                for (int bj = 0; bj < 2; ++bj) { const u32x2 a = *(const u32x2*)(rp + (z1 - 1) * 1024 + bj * 128), b = *(const u32x2*)(rp + z1 * 1024 + bj * 128);
                    f32x4 r0, r1;
                    UNR for (int e = 0; e < 4; ++e) { r0[e] = ub(a.x, e) * frcp(ub(b.x, e)); r1[e] = ub(a.y, e) * frcp(ub(b.y, e)); }
                    acc[ai][bj][m][0] *= r0; acc[ai][bj][m][1] *= r1;
#ifndef CPU_EMU
                    asm volatile("" ::: "memory");
#endif
                } }
    }
    __device__ __forceinline__ void operator()(const AccT& acc, const pg8::Unit& u, int wr, int wc, int fr, int fq) const {
        const int row0 = u.pm * 256 + wr * 64 + fr, col0 = u.pn * 256 + wc * 32 + 8 * fq;
#pragma unroll
        for (int ai = 0; ai < 2; ++ai)
#pragma unroll
            for (int m = 0; m < 4; ++m) { const size_t ro = (size_t)(row0 + ai * 128 + m * 16);
#pragma unroll
                for (int bj = 0; bj < 2; ++bj) { const u32x2 b = *(const u32x2*)(gates + ro * NGATE + 3 * 1024 + col0 + bj * 128); f32x4 a0 = acc[ai][bj][m][0], a1 = acc[ai][bj][m][1];
                    UNR for (int e = 0; e < 4; ++e) { a0[e] *= ub(b.x, e) * (1.0f / 255.0f); a1[e] *= ub(b.y, e) * (1.0f / 255.0f); }
                    *(u32x4*)(merged + ro * D + col0 + bj * 128) = pk8(a0, a1); } }
    }
};
struct EpiPreLN {
    static constexpr bool MID = false;
    const float* xa; const float* xb; const float* mods; float* v; int NTc, Tl;
    __device__ __forceinline__ void operator()(const AccT& acc, const pg8::Unit& u, int wr, int wc, int fr, int fq) const {
        const int row0 = u.pm * 256 + wr * 64 + fr, col0 = u.pn * 256 + wc * 32 + 8 * fq;
#pragma unroll
        for (int ai = 0; ai < 2; ++ai)
#pragma unroll
            for (int m = 0; m < 4; ++m) { const int row = row0 + ai * 128 + m * 16; const int mr = row < NTc ? 0 : 1 + (row - NTc) / Tl; const float* g1 = mods + (size_t)mr * NMOD + 2 * D + col0;
                const size_t ro = (size_t)row * D + col0; const float* x = row < NTc ? xa : xb;
#pragma unroll
                for (int bj = 0; bj < 2; ++bj)
#pragma unroll
                    for (int n = 0; n < 2; ++n) { const int o = bj * 128 + n * 4; const f32x4 xv = *(const f32x4*)(x + ro + o), gv = *(const f32x4*)(g1 + o);
                        *(f32x4*)(v + ro + o) = ALPHA * xv + gv * acc[ai][bj][m][n]; } }
    }
};
struct EpiSwiGLU {
    static constexpr bool MID = false;
    bf16_t* act;
    __device__ __forceinline__ void operator()(const AccT& acc, const pg8::Unit& u, int wr, int wc, int fr, int fq) const {
        const int row0 = u.pm * 256 + wr * 64 + fr, col0 = u.pn * 128 + wc * 32 + 8 * fq;
#pragma unroll
        for (int ai = 0; ai < 2; ++ai)
#pragma unroll
            for (int m = 0; m < 4; ++m) { bf16_t* rp = act + (size_t)(row0 + ai * 128 + m * 16) * FF + col0; f32x4 o[2];
#pragma unroll
                for (int n = 0; n < 2; ++n) { const f32x4 a = acc[ai][0][m][n], b = acc[ai][1][m][n]; o[n][0] = siluf_(a[0]) * b[0]; o[n][1] = siluf_(a[1]) * b[1]; o[n][2] = siluf_(a[2]) * b[2]; o[n][3] = siluf_(a[3]) * b[3]; }
                *(u32x4*)rp = pk8(o[0], o[1]); }
    }
};
struct EpiDown {
    static constexpr bool MID = false;
    const float* pgate; bf16_t* y;
    __device__ __forceinline__ void operator()(const AccT& acc, const pg8::Unit& u, int wr, int wc, int fr, int fq) const {
        const int row0 = u.pm * 256 + wr * 64 + fr, col0 = u.pn * 256 + wc * 32 + 8 * fq;
#pragma unroll
        for (int ai = 0; ai < 2; ++ai)
#pragma unroll
            for (int m = 0; m < 4; ++m) { const int row = row0 + ai * 128 + m * 16; const float gt = pgate[row]; bf16_t* rp = y + (size_t)row * D + col0;
#pragma unroll
                for (int bj = 0; bj < 2; ++bj) *(u32x4*)(rp + bj * 128) = pk8(gt * acc[ai][bj][m][0], gt * acc[ai][bj][m][1]); }
    }
};

template <class ColMap>
__device__ __forceinline__ void tr_item(const float* src, int src_ld, const ColMap& cm, bf16_t* dst, int dst_ld, int dst_koff, int n0, int k0, float* scr, int lane) {
    const int r = lane >> 4, c4 = (lane & 15) * 4; const int sc = cm(prow(n0 + c4));
    f32x4 v[16];
    UNR for (int i = 0; i < 16; ++i) v[i] = sc >= 0 ? *(const f32x4*)(src + (size_t)(k0 + i * 4 + r) * src_ld + sc) : (f32x4){0.f, 0.f, 0.f, 0.f};
    UNR for (int i = 0; i < 16; ++i) { float* p = scr + (i * 4 + r) * 65 + c4; p[0] = v[i][0]; p[1] = v[i][1]; p[2] = v[i][2]; p[3] = v[i][3]; }
    WAVE_SYNC();
    const int kc = lane & 7;
    UNR for (int j = 0; j < 8; ++j) { const int n = (lane >> 3) + 8 * j; const float* p = scr + (8 * kc) * 65 + n;
        u32x4 o; o.x = pk2(p[0 * 65], p[1 * 65]); o.y = pk2(p[2 * 65], p[3 * 65]); o.z = pk2(p[4 * 65], p[5 * 65]); o.w = pk2(p[6 * 65], p[7 * 65]);
        *(u32x4*)(dst + (size_t)(n0 + n) * dst_ld + dst_koff + k0 + 8 * kc) = o; }
    WAVE_SYNC();
}
struct CmId { __device__ __forceinline__ int operator()(int n) const { return n; } };
struct CmWin { __device__ __forceinline__ int operator()(int n) const { return win_col(n); } };
struct CmUp { __device__ __forceinline__ int operator()(int n) const { const int u = n >> 8, w = n & 255; return (w < 128 ? 0 : FF) + u * 128 + (w & 127); } };

__device__ __forceinline__ void phase_prep(const Ctx& c0) {
    const Ctx c = fresh(c0);
    const Dims& d = c.d;
    float* L = (float*)c.lds;
    const int nrow = 1 + d.Bl;
    const int gw = c.vcu * NWAVES + c.wave, NGW = c.G * NWAVES;
    const int nmod_items = DEPTH * (NMOD / 64);
    if (c.vcu < nmod_items) {
        const int l = c.vcu / (NMOD / 64), j = (c.vcu % (NMOD / 64)) * 64 + c.lane, kw = c.wave * 128;
        const float* w = c.in(I_WADA) + ((size_t)l * D + kw) * NMOD + j;
        float* cond = L + c.wave * 4160;
        for (int i = c.lane; i < 9 * 128; i += 64) { const int r = i >> 7, k = kw + (i & 127); const float v = r == 0 ? c.in(I_CCTX)[k] : (r < nrow ? c.in(I_C)[(size_t)(r - 1) * D + k] : 0.0f); cond[i] = siluf_(v); }
        WAVE_SYNC();
        float a[9];
        UNR for (int r = 0; r < 9; ++r) a[r] = 0.0f;
#pragma unroll 8
        for (int k = 0; k < 128; ++k) { const float wv = w[(size_t)k * NMOD]; UNR for (int r = 0; r < 9; ++r) a[r] += cond[r * 128 + k] * wv; }
        UNR for (int r = 0; r < 9; ++r) cond[1152 + r * 64 + c.lane] = a[r];
        __syncthreads();
        if (c.wave == 0) { const float bias = c.in(I_BADA)[(size_t)l * NMOD + j]; float* mo = c.ws<float>(d.w_mods) + (size_t)l * nrow * NMOD + j;
            UNR for (int r = 0; r < 9; ++r) { float t = bias; UNR for (int ww = 0; ww < 8; ++ww) t += L[ww * 4160 + 1152 + r * 64 + c.lane]; if (r < nrow) mo[(size_t)r * NMOD] = t; } }
        __syncthreads();
    }
    float* scr = L + c.wave * 4160;
    const int I_IN = (D / 64) * (NINP / 64), I_BR = 4 * (MIXW / 64) * (D / 64), I_OUT = (D / 64) * (D / 64), I_UP = NEXP * (D / 64) * (2 * FF / 64), I_DN = NEXP * (FF / 64) * (D / 64);
    const int PER_L = I_IN + I_BR + I_OUT + I_UP + I_DN;
    for (int it = gw; it < DEPTH * PER_L; it += NGW) {
        const int l = it / PER_L; int r = it % PER_L;
        if (r < I_IN) { const int nb = NINP / 64, kb = r / nb, n0 = (r % nb) * 64;
            tr_item(c.in(I_WIN) + (size_t)l * D * NIN, NIN, CmWin(), c.ws<bf16_t>(d.w_win) + (size_t)l * NINP * D, D, 0, n0, kb * 64, scr, c.lane); continue; } r -= I_IN;
        if (r < I_BR) { const int per = (MIXW / 64) * (D / 64), z = r / per, q = r % per, kb = q / (D / 64), n0 = (q % (D / 64)) * 64;
            tr_item(c.in(I_WBR) + ((size_t)l * 4 + z) * MIXW * D, D, CmId(), c.ws<bf16_t>(d.w_wbr) + (size_t)l * D * D, D, z * MIXW, n0, kb * 64, scr, c.lane); continue; } r -= I_BR;
        if (r < I_OUT) { const int kb = r / (D / 64), n0 = (r % (D / 64)) * 64;
            tr_item(c.in(I_WOUT) + (size_t)l * D * D, D, CmId(), c.ws<bf16_t>(d.w_wout) + (size_t)l * D * D, D, 0, n0, kb * 64, scr, c.lane); continue; } r -= I_OUT;
        if (r < I_UP) { const int per = (D / 64) * (2 * FF / 64), e = r / per, q = r % per, kb = q / (2 * FF / 64), n0 = (q % (2 * FF / 64)) * 64;
            tr_item(c.in(I_WUP) + ((size_t)l * NEXP + e) * D * 2 * FF, 2 * FF, CmUp(), c.ws<bf16_t>(d.w_wup) + ((size_t)l * NEXP + e) * 2 * FF * D, D, 0, n0, kb * 64, scr, c.lane); continue; } r -= I_UP;
        { const int per = (FF / 64) * (D / 64), e = r / per, q = r % per, kb = q / (D / 64), n0 = (q % (D / 64)) * 64;
            tr_item(c.in(I_WDOWN) + ((size_t)l * NEXP + e) * FF * D, D, CmId(), c.ws<bf16_t>(d.w_wdn) + ((size_t)l * NEXP + e) * D * FF, FF, 0, n0, kb * 64, scr, c.lane); }
    }
}

__device__ __forceinline__ void phase_init(const Ctx& c0) {
    const Ctx c = fresh(c0);
    const Dims& d = c.d; const float* mods = c.mods(0); bf16_t* hb = c.ws<bf16_t>(d.w_hb);
    const int gw = c.vcu * NWAVES + c.wave, NGW = c.G * NWAVES;
    for (int tok = gw; tok < d.NT; tok += NGW) {
        const float* xr = tok < d.NTc ? c.in(I_XP) + (size_t)tok * D : c.in(I_XS) + (size_t)(tok - d.NTc) * D;
        const float* mr = mods + (size_t)c.modrow(tok) * NMOD;
#pragma unroll
        for (int j = 0; j < 4; ++j) { const int col = 4 * c.lane + 256 * j; const f32x4 x = *(const f32x4*)(xr + col), sh = *(const f32x4*)(mr + col), sc = *(const f32x4*)(mr + D + col);
            const f32x4 h = x * (1.0f + sc) + sh;
            u32x2 w; w.x = pk2(h[0], h[1]); w.y = pk2(h[2], h[3]); *(u32x2*)(hb + (size_t)tok * D + col) = w; }
    }
}

__device__ __forceinline__ f32x16 mm32(int lane, f32x16 acc, const float* A, int sai, int sak, const float* Bm, int sbk, int sbj, int K) {
    const int i = lane & 31, kk = lane >> 5;
    const float* ap = A + i * sai + kk * sak; const float* bp = Bm + kk * sbk + i * sbj;
#pragma unroll 8
    for (int k = 0; k < K; k += 2) acc = __builtin_amdgcn_mfma_f32_32x32x2f32(ap[k * sak], bp[k * sbk], acc, 0, 0, 0);
    return acc;
}
__device__ __forceinline__ f32x16 mmb(int lane, f32x16 acc, const bf16_t* A, int sa, const bf16_t* Bt, int sb, int K) {
    const bf16_t* ap = A + (lane & 31) * sa + 8 * (lane >> 5); const bf16_t* bp = Bt + (lane & 31) * sb + 8 * (lane >> 5);
    for (int k = 0; k < K; k += 16) acc = __builtin_amdgcn_mfma_f32_32x32x16_bf16(*(const bf16x8*)(ap + k), *(const bf16x8*)(bp + k), acc, 0, 0, 0);
    return acc;
}
__device__ __forceinline__ int tsw(int row, int col) { return row * 72 + ((col + 8 * ((row >> 3) & 7)) & 63); }
template <bool SWA, bool SWB>
__device__ __forceinline__ f32x16 mmb64(int lane, f32x16 acc, const bf16_t* A, int arow0, const bf16_t* Bt, int brow0) {
    const int ra = arow0 + (lane & 31), rb = brow0 + (lane & 31), h8 = 8 * (lane >> 5), sa = SWA ? 8 * ((ra >> 3) & 7) : 0, sb = SWB ? 8 * ((rb >> 3) & 7) : 0;
#pragma unroll
    for (int k = 0; k < 64; k += 16) acc = __builtin_amdgcn_mfma_f32_32x32x16_bf16(*(const bf16x8*)(A + ra * 72 + ((h8 + k + sa) & 63)), *(const bf16x8*)(Bt + rb * 72 + ((h8 + k + sb) & 63)), acc, 0, 0, 0);
    return acc;
}
#define ACC_ROW(r, lane) (((r) & 3) + 8 * ((r) >> 2) + 4 * ((lane) >> 5))
__device__ __forceinline__ f32x16 zero16() { f32x16 z; UNR for (int r = 0; r < 16; ++r) z[r] = 0.0f; return z; }
constexpr int S65 = 65, MSZ = 64 * 65;

__device__ __forceinline__ void build_rope(float* cosT, float* sinT, int tid) {
    for (int i = tid; i < 1024; i += NTHREADS) { const int pos = i >> 4, f = i & 15; const float inv = powf(10000.0f, -(float)f / 16.0f); const float ang = (float)pos * inv; cosT[i] = cosf(ang); sinT[i] = sinf(ang); }
}
__device__ __forceinline__ float rope_elem(const float* rowp, int dd, int t, const float* cosT, const float* sinT) {
    const int f = dd & 15, second = (dd >> 4) & 1, pos = (dd < 32) ? (t / GRIDW) : (t % GRIDW);
    const float x = rowp[dd], xp = rowp[second ? dd - 16 : dd + 16], cs = cosT[pos * 16 + f], sn = sinT[pos * 16 + f];
    return second ? (xp * sn + x * cs) : (x * cs - xp * sn);
}

constexpr int SL_MF = 0, SL_MB = 1, SL_GF = 2, SL_GB = 3, SL_RF = 4, SL_RB = 5, SL_RBONUS = 6, NSLOT = 7;

struct ChunkRegs { u32x4 q, qp, k, kp, v; };
__device__ __forceinline__ float bfel(const u32x4 w, int e) { const unsigned x = w[e >> 1]; return (e & 1) ? bfhi(x) : bflo(x); }
__device__ __forceinline__ void chunk_load(ChunkRegs& R, const bf16_t* cols, size_t tok0, int T, int dir, int ci, int h, int cbq, int tid) {
    const int j = tid >> 3, g = tid & 7, t = dir ? T - 1 - (ci * 64 + j) : ci * 64 + j; const bf16_t* rp = cols + (tok0 + t) * NCB + cbq * 256 + h * 64;
    R.q = *(const u32x4*)(rp + 8 * g); R.qp = *(const u32x4*)(rp + 8 * (g ^ 2)); R.k = *(const u32x4*)(rp + 256 + 8 * g); R.kp = *(const u32x4*)(rp + 256 + 8 * (g ^ 2)); R.v = *(const u32x4*)(rp + 512 + 8 * g);
}
__device__ __forceinline__ void chunk_store(const ChunkRegs& R, float* Q, float* K, float* V, int T, int dir, int ci, int pass, float qs, float ks, const float* cosT, const float* sinT, int tid) {
    const int j = tid >> 3, g = tid & 7, t = dir ? T - 1 - (ci * 64 + j) : ci * 64 + j, second = (g >> 1) & 1, pos = g < 4 ? (t / GRIDW) : (t % GRIDW), o = j * S65 + 8 * g;
    UNR for (int e = 0; e < 8; ++e) { float q = bfel(R.q, e), k = bfel(R.k, e);
        if (pass) { const float qp = bfel(R.qp, e), kp = bfel(R.kp, e), cs = cosT[pos * 16 + 8 * (g & 1) + e], sn = sinT[pos * 16 + 8 * (g & 1) + e];
            q = second ? qp * sn + q * cs : q * cs - qp * sn; k = second ? kp * sn + k * cs : k * cs - kp * sn; }
        Q[o + e] = q * qs; K[o + e] = k * ks; V[o + e] = bfel(R.v, e); }
}

__device__ __forceinline__ void chunk_store_ml(const ChunkRegs& R, float* Q, float* K, bf16_t* Qb, bf16_t* Kb, bf16_t* VbT, int T, int dir, int ci, int pass, const float* cosT, const float* sinT, int tid) {
    const int j = tid >> 3, g = tid & 7, t = dir ? T - 1 - (ci * 64 + j) : ci * 64 + j, second = (g >> 1) & 1, pos = g < 4 ? (t / GRIDW) : (t % GRIDW), o = j * S65 + 8 * g;
    float qv[8], kv[8];
    UNR for (int e = 0; e < 8; ++e) { float q = bfel(R.q, e), k = bfel(R.k, e);
        if (pass) { const float qp = bfel(R.qp, e), kp = bfel(R.kp, e), cs = cosT[pos * 16 + 8 * (g & 1) + e], sn = sinT[pos * 16 + 8 * (g & 1) + e];
            q = second ? qp * sn + q * cs : q * cs - qp * sn; k = second ? kp * sn + k * cs : k * cs - kp * sn; }
        qv[e] = q; kv[e] = k * 0.125f; Q[o + e] = qv[e]; K[o + e] = kv[e]; }
    u32x4 w; w.x = cvtpk(qv[0], qv[1]); w.y = cvtpk(qv[2], qv[3]); w.z = cvtpk(qv[4], qv[5]); w.w = cvtpk(qv[6], qv[7]); *(u32x4*)(Qb + j * 72 + 8 * g) = w;
    w.x = cvtpk(kv[0], kv[1]); w.y = cvtpk(kv[2], kv[3]); w.z = cvtpk(kv[4], kv[5]); w.w = cvtpk(kv[6], kv[7]); *(u32x4*)(Kb + j * 72 + 8 * g) = w;
    UNR for (int e = 0; e < 8; ++e) VbT[tsw(8 * g + e, j)] = (bf16_t)(R.v[e >> 1] >> (16 * (e & 1)));
}
__device__ __forceinline__ void mix_mlstm(const Ctx& c0, int l, int pass, int b, int h, int dir) {
    const Ctx c = fresh(c0);
    const Dims& d = c.d; const int T = pass ? d.Tl : d.Tc, nc = T / 64, tid = c.tid, lane = c.lane, wave = c.wave; const size_t tok0 = pass ? d.NTc + (size_t)b * d.Tl : (size_t)b * d.Tc;
    float* L = (float*)c.lds;
    float *Q = L, *K = L + MSZ, *C = L + 2 * MSZ, *Sm = L + 3 * MSZ, *QC = L + 4 * MSZ, *vec = L + 5 * MSZ;
    float *nv = vec, *ig = vec + 64, *lf = vec + 128, *bc = vec + 192, *lw = vec + 256, *wint = vec + 320, *rden = vec + 384, *scal = vec + 448, *npart = vec + 512, *cosT = vec + 1024, *sinT = vec + 2048, *ksv = vec + 3072;
    bf16_t* Bb = (bf16_t*)(vec + 3200); bf16_t *Qb = Bb, *Kb = Bb + 64 * 72, *VbT = Bb + 2 * 64 * 72, *CbT = Bb + 3 * 64 * 72, *Smb = Bb + 4 * 64 * 72, *KsT = Bb + 5 * 64 * 72;
    const bf16_t* cols = c.ws<bf16_t>(d.w_cols); const float* small = c.ws<float>(d.w_small); bf16_t* scr = c.ws<bf16_t>(d.w_scr);
    __syncthreads();
    if (pass) build_rope(cosT, sinT, tid);
    if (pass) { const float* C0 = c.in(I_SC) + ((((size_t)b * DEPTH + l) * 2 + dir) * NH + h) * HD * HD;
        _Pragma("unroll 2") for (int i = tid; i < 4096; i += NTHREADS) { const float cv = C0[i]; C[(i >> 6) * S65 + (i & 63)] = cv; CbT[(i & 63) * 72 + (i >> 6)] = (bf16_t)f2bf(cv); }
        if (tid < 64) nv[tid] = c.in(I_SN)[((((size_t)b * DEPTH + l) * 2 + dir) * NH + h) * HD + tid];
        if (tid == 0) scal[0] = c.in(I_SM)[(((size_t)b * DEPTH + l) * 2 + dir) * NH + h];
    } else { _Pragma("unroll 2") for (int i = tid; i < 4096; i += NTHREADS) { C[(i >> 6) * S65 + (i & 63)] = 0.0f; CbT[(i & 63) * 72 + (i >> 6)] = 0; } if (tid < 64) nv[tid] = 0.0f; if (tid == 0) scal[0] = 0.0f; }
    const float big = c.in(I_BIG)[((size_t)l * 2 + dir) * NH + h], bfg = c.in(I_BFG)[((size_t)l * 2 + dir) * NH + h];
    ChunkRegs R; float rig = 0.0f, rlf = 0.0f;
    chunk_load(R, cols, tok0, T, dir, 0, h, CB_MQ, tid);
    if (tid < 64) { const int t = dir ? T - 1 - tid : tid; const float* rp = small + (tok0 + t) * NSM; rig = rp[SM_MI + dir * 4 + h]; rlf = rp[SM_MF + dir * 4 + h]; }
    __syncthreads();
    chunk_store_ml(R, Q, K, Qb, Kb, VbT, T, dir, 0, pass, cosT, sinT, tid);
    if (tid < 64) { ig[tid] = rig + big; lf[tid] = logsigmoidf_(rlf + bfg); }
    for (int ci = 0; ci < nc; ++ci) {
        const int tid_ = opqv(tid), lane_ = tid_ & 63;
        if (ci + 1 < nc) {
            chunk_load(R, cols, tok0, T, dir, ci + 1, h, CB_MQ, tid_);
            if (tid_ < 64) { const int t = dir ? T - 1 - ((ci + 1) * 64 + tid_) : (ci + 1) * 64 + tid_; const float* rp = small + (tok0 + t) * NSM; rig = rp[SM_MI + dir * 4 + h]; rlf = rp[SM_MF + dir * 4 + h]; }
        }
        LDS_BARRIER();
        if (wave == 0) { float run = lf[lane_];
            UNR for (int o = 1; o < 64; o <<= 1) { const float up = __shfl(run, lane_ >= o ? lane_ - o : lane_); run += lane_ >= o ? up : 0.0f; }
            const float bend = __shfl(run, 63), m = scal[0], w = bend - run + ig[lane_]; float mx = w;
            mx = fmaxf(mx, x1(mx)); mx = fmaxf(mx, x2(mx)); mx = fmaxf(mx, x4m(mx)); mx = fmaxf(mx, x8m(mx)); mx = fmaxf(mx, __shfl_xor(mx, 16)); mx = fmaxf(mx, __shfl_xor(mx, 32));
            const float mnew = fmaxf(bend + m, mx); bc[lane_] = run; lw[lane_] = w; if (lane_ == 0) { scal[1] = mnew; scal[2] = fexp(bend + m - mnew); } }
        { const int ti = (wave >> 1) & 1, tj = wave & 1; f32x16 acc = zero16();
          if (wave < 4) { acc = mmb(lane_, acc, Qb + ti * 32 * 72, 72, Kb + tj * 32 * 72, 72, 64); UNR for (int r = 0; r < 16; ++r) Sm[(ti * 32 + ACC_ROW(r, lane_)) * S65 + tj * 32 + (lane_ & 31)] = acc[r]; }
          else { acc = mmb(lane_, acc, Qb + ti * 32 * 72, 72, CbT + tj * 32 * 72, 72, 64); UNR for (int r = 0; r < 16; ++r) QC[(ti * 32 + ACC_ROW(r, lane_)) * S65 + tj * 32 + (lane_ & 31)] = acc[r]; } }
        LDS_BARRIER();
        { const int t = tid_ >> 3, g = tid_ & 7; const float m = scal[0], mnew = scal[1], bt = bc[t]; float mx = -3.0e38f;
          UNR for (int e = 0; e < 8; ++e) { const int s = g * 8 + e; if (s <= t) mx = fmaxf(mx, bt - bc[s] + ig[s]); }
          mx = fmaxf(mx, x1(mx)); mx = fmaxf(mx, x2(mx)); mx = fmaxf(mx, x4m(mx));
          const float minter = bt + m, mt = fmaxf(minter, mx); float den = 0.0f, qn = 0.0f, sv[8];
          UNR for (int e = 0; e < 8; ++e) { const int s = g * 8 + e; sv[e] = 0.0f; if (s <= t) sv[e] = Sm[t * S65 + s] * fexp(bt - bc[s] + ig[s] - mt); den += sv[e]; qn += Q[t * S65 + s] * nv[s]; }
          { u32x4 w; w.x = cvtpk(sv[0], sv[1]); w.y = cvtpk(sv[2], sv[3]); w.z = cvtpk(sv[4], sv[5]); w.w = cvtpk(sv[6], sv[7]); *(u32x4*)(Smb + t * 72 + 8 * g) = w; }
          den += x1(den); den += x2(den); den += x4m(den); qn += x1(qn); qn += x2(qn); qn += x4m(qn);
          const float wi = fexp(minter - mt); den += wi * qn;
          const float ks = fexp(lw[t] - mnew);
          if (g == 0) { wint[t] = wi; rden[t] = 1.0f / fmaxf(fabsf(den), fexp(-mt)); ksv[t] = ks; }
          UNR for (int e = 0; e < 8; ++e) KsT[tsw(g * 8 + e, t)] = (bf16_t)f2bf(K[t * S65 + g * 8 + e] * ks); }
        LDS_BARRIER();
        { const int ti = (wave >> 1) & 1, tj = wave & 1;
          if (wave < 4) { f32x16 acc = zero16(); acc = mmb64<false, true>(lane_, acc, Smb, ti * 32, VbT, tj * 32);
              UNR for (int r = 0; r < 16; ++r) { const int row = ti * 32 + ACC_ROW(r, lane_), o = row * S65 + tj * 32 + (lane_ & 31); QC[o] = (acc[r] + wint[row] * QC[o]) * rden[row]; } }
          else { const float carry = scal[2]; f32x16 acc; UNR for (int r = 0; r < 16; ++r) acc[r] = carry * C[(ti * 32 + ACC_ROW(r, lane_)) * S65 + tj * 32 + (lane_ & 31)];
              acc = mmb64<true, true>(lane_, acc, KsT, ti * 32, VbT, tj * 32);
              UNR for (int r = 0; r < 16; ++r) C[(ti * 32 + ACC_ROW(r, lane_)) * S65 + tj * 32 + (lane_ & 31)] = acc[r];
              UNR for (int q4 = 0; q4 < 4; ++q4) { u32x2 w; w.x = cvtpk(acc[4 * q4], acc[4 * q4 + 1]); w.y = cvtpk(acc[4 * q4 + 2], acc[4 * q4 + 3]); *(u32x2*)(CbT + (tj * 32 + (lane_ & 31)) * 72 + ti * 32 + 8 * q4 + 4 * (lane_ >> 5)) = w; } }
          float s = 0.0f; UNR for (int e = 0; e < 8; ++e) s += K[(wave * 8 + e) * S65 + lane_] * ksv[wave * 8 + e]; npart[wave * 64 + lane_] = s; }
        LDS_BARRIER();
        if (tid_ < 64) { float s = 0.0f; UNR for (int e = 0; e < 8; ++e) s += npart[e * 64 + tid_]; nv[tid_] = scal[2] * nv[tid_] + s; }
        { const int j = tid_ >> 3, g = tid_ & 7, t = dir ? T - 1 - (ci * 64 + j) : ci * 64 + j; bf16_t* sp = scr + ((tok0 + t) * NSLOT + (dir ? SL_MB : SL_MF)) * MIXW + h * 64 + g * 8; const float* hp = QC + j * S65 + g * 8;
          u32x4 w; w.x = cvtpk(hp[0], hp[1]); w.y = cvtpk(hp[2], hp[3]); w.z = cvtpk(hp[4], hp[5]); w.w = cvtpk(hp[6], hp[7]); *(u32x4*)sp = w; }
        if (ci + 1 < nc) { chunk_store_ml(R, Q, K, Qb, Kb, VbT, T, dir, ci + 1, pass, cosT, sinT, tid_); if (tid_ < 64) { ig[tid_] = rig + big; lf[tid_] = logsigmoidf_(rlf + bfg); } }
        if (tid_ == 0) scal[0] = scal[1];
    }
    LDS_BARRIER();
    if (!pass) {
        float* Co = c.p->out + d.o_C + ((((size_t)b * DEPTH + l) * 2 + dir) * NH + h) * HD * HD;
        _Pragma("unroll 2") for (int i = tid; i < 4096; i += NTHREADS) Co[i] = C[(i >> 6) * S65 + (i & 63)];
        if (tid < 64) c.p->out[d.o_n + ((((size_t)b * DEPTH + l) * 2 + dir) * NH + h) * HD + tid] = nv[tid];
        if (tid == 0) c.p->out[d.o_m + (((size_t)b * DEPTH + l) * 2 + dir) * NH + h] = scal[0];
    }
    __syncthreads();
}

__device__ __forceinline__ void chunk_store_gl(const ChunkRegs& R, float* Q, float* K, bf16_t* VbT, int T, int dir, int ci, int pass, const float* cosT, const float* sinT, int tid) {
    const int j = tid >> 3, g = tid & 7, t = dir ? T - 1 - (ci * 64 + j) : ci * 64 + j, second = (g >> 1) & 1, pos = g < 4 ? (t / GRIDW) : (t % GRIDW), o = j * S65 + 8 * g;
    UNR for (int e = 0; e < 8; ++e) { float q = bfel(R.q, e), k = bfel(R.k, e);
        if (pass) { const float qp = bfel(R.qp, e), kp = bfel(R.kp, e), cs = cosT[pos * 16 + 8 * (g & 1) + e], sn = sinT[pos * 16 + 8 * (g & 1) + e];
            q = second ? qp * sn + q * cs : q * cs - qp * sn; k = second ? kp * sn + k * cs : k * cs - kp * sn; }
        Q[o + e] = q * 0.125f; K[o + e] = k; }
    UNR for (int e = 0; e < 8; ++e) VbT[tsw(8 * g + e, j)] = (bf16_t)(R.v[e >> 1] >> (16 * (e & 1)));
}
__device__ __forceinline__ void mix_gla(const Ctx& c0, int l, int pass, int b, int h, int dir) {
    const Ctx c = fresh(c0);
    const Dims& d = c.d; const int T = pass ? d.Tl : d.Tc, nc = T / 64, tid = c.tid, lane = c.lane, wave = c.wave; const size_t tok0 = pass ? d.NTc + (size_t)b * d.Tl : (size_t)b * d.Tc;
    float* L = (float*)c.lds;
    float *Q = L, *K = L + MSZ, *S = L + 2 * MSZ, *O2 = L + 3 * MSZ, *vec = L + 4 * MSZ;
    float *gend = vec, *bA = vec + 64, *gpart = vec + 128, *GA = vec + 640, *wA = vec + 640 + 1024, *cosT = vec + 640 + 2048, *sinT = vec + 640 + 3072;
    bf16_t* Bb = (bf16_t*)(vec + 4736); bf16_t *Qb = Bb, *Kb = Bb + 64 * 72, *KbT = Bb + 2 * 64 * 72, *VbT = Bb + 3 * 64 * 72, *SbT = Bb + 4 * 64 * 72, *Ab = Bb + 5 * 64 * 72;
    const bf16_t* cols = c.ws<bf16_t>(d.w_cols); const float* small = c.ws<float>(d.w_small); bf16_t* scr = c.ws<bf16_t>(d.w_scr);
    __syncthreads();
    if (pass) build_rope(cosT, sinT, tid);
    if (pass) { const float* S0 = c.in(I_SG) + ((((size_t)b * DEPTH + l) * 2 + dir) * NH + h) * HD * HD; _Pragma("unroll 2") for (int i = tid; i < 4096; i += NTHREADS) { const float sv = S0[i]; S[(i >> 6) * S65 + (i & 63)] = sv; SbT[(i & 63) * 72 + (i >> 6)] = (bf16_t)f2bf(sv); } }
    else { _Pragma("unroll 2") for (int i = tid; i < 4096; i += NTHREADS) { S[(i >> 6) * S65 + (i & 63)] = 0.0f; SbT[(i & 63) * 72 + (i >> 6)] = 0; } }
    for (int i = tid; i < 1024; i += NTHREADS) wA[i] = c.in(I_WGLA)[(((size_t)l * 2 + dir) * 16 + (i >> 6)) * MIXW + h * 64 + (i & 63)];
    if (tid < 64) bA[tid] = c.in(I_BGLA)[((size_t)l * 2 + dir) * MIXW + h * 64 + tid];
    ChunkRegs R; f32x4 rga = (f32x4){0.f, 0.f, 0.f, 0.f};
    chunk_load(R, cols, tok0, T, dir, 0, h, CB_GQ, tid);
    if (tid < 256) { const int j = tid >> 2, t = dir ? T - 1 - j : j; rga = *(const f32x4*)(small + (tok0 + t) * NSM + SM_GA + dir * 16 + (tid & 3) * 4); }
    __syncthreads();
    chunk_store_gl(R, Q, K, VbT, T, dir, 0, pass, cosT, sinT, tid);
    if (tid < 256) *(f32x4*)(GA + (tid >> 2) * 16 + (tid & 3) * 4) = rga;
    for (int ci = 0; ci < nc; ++ci) {
        const int tid_ = opqv(tid), lane_ = tid_ & 63;
        if (ci + 1 < nc) {
            chunk_load(R, cols, tok0, T, dir, ci + 1, h, CB_GQ, tid_);
            if (tid_ < 256) { const int j = tid_ >> 2, t = dir ? T - 1 - ((ci + 1) * 64 + j) : (ci + 1) * 64 + j; rga = *(const f32x4*)(small + (tok0 + t) * NSM + SM_GA + dir * 16 + (tid_ & 3) * 4); }
        }
        LDS_BARRIER();
        float gl[8];
        { float run = 0.0f;
          UNR for (int e = 0; e < 8; ++e) { const float* ga = GA + (wave * 8 + e) * 16; float a = bA[lane_];
              UNR for (int r = 0; r < 16; ++r) a += ga[r] * wA[r * 64 + lane_];
              run += logsigmoidf_(a) * (1.0f / 16.0f); gl[e] = run; }
          gpart[wave * 64 + lane_] = run; }
        LDS_BARRIER();
        { float pre = 0.0f; UNR for (int e = 0; e < 8; ++e) pre += (e < wave) ? gpart[e * 64 + lane_] : 0.0f;
          float kv8[8];
          UNR for (int e = 0; e < 8; ++e) { const float g = gl[e] + pre; const int row = wave * 8 + e; const float qv = Q[row * S65 + lane_] * fexp(g); kv8[e] = K[row * S65 + lane_] * fexp(-g);
              Qb[row * 72 + lane_] = (bf16_t)f2bf(qv); Kb[row * 72 + lane_] = (bf16_t)f2bf(kv8[e]); if (wave == 7 && e == 7) gend[lane_] = g; }
          { u32x4 w; w.x = cvtpk(kv8[0], kv8[1]); w.y = cvtpk(kv8[2], kv8[3]); w.z = cvtpk(kv8[4], kv8[5]); w.w = cvtpk(kv8[6], kv8[7]); *(u32x4*)(KbT + lane_ * 72 + 8 * wave) = w; } }
        LDS_BARRIER();
        { const int ti = (wave >> 1) & 1, tj = wave & 1; f32x16 acc = zero16();
          if (wave < 4) { acc = mmb(lane_, acc, Qb + ti * 32 * 72, 72, Kb + tj * 32 * 72, 72, 64);
              UNR for (int r = 0; r < 16; ++r) { const int row = ti * 32 + ACC_ROW(r, lane_), col = tj * 32 + (lane_ & 31); Ab[row * 72 + col] = (bf16_t)f2bf(col <= row ? acc[r] : 0.0f); } }
          else { acc = mmb(lane_, acc, Qb + ti * 32 * 72, 72, SbT + tj * 32 * 72, 72, 64); UNR for (int r = 0; r < 16; ++r) O2[(ti * 32 + ACC_ROW(r, lane_)) * S65 + tj * 32 + (lane_ & 31)] = acc[r]; } }
        LDS_BARRIER();
        { const int ti = (wave >> 1) & 1, tj = wave & 1;
          if (wave < 4) { f32x16 acc; UNR for (int r = 0; r < 16; ++r) acc[r] = O2[(ti * 32 + ACC_ROW(r, lane_)) * S65 + tj * 32 + (lane_ & 31)];
              acc = mmb64<false, true>(lane_, acc, Ab, ti * 32, VbT, tj * 32);
              UNR for (int r = 0; r < 16; ++r) O2[(ti * 32 + ACC_ROW(r, lane_)) * S65 + tj * 32 + (lane_ & 31)] = acc[r]; }
          else { f32x16 acc; UNR for (int r = 0; r < 16; ++r) acc[r] = S[(ti * 32 + ACC_ROW(r, lane_)) * S65 + tj * 32 + (lane_ & 31)];
              acc = mmb64<false, true>(lane_, acc, KbT, ti * 32, VbT, tj * 32);
              UNR for (int r = 0; r < 16; ++r) { const int kr = ti * 32 + ACC_ROW(r, lane_); acc[r] *= fexp(gend[kr]); S[kr * S65 + tj * 32 + (lane_ & 31)] = acc[r]; }
              UNR for (int q4 = 0; q4 < 4; ++q4) { u32x2 w; w.x = cvtpk(acc[4 * q4], acc[4 * q4 + 1]); w.y = cvtpk(acc[4 * q4 + 2], acc[4 * q4 + 3]); *(u32x2*)(SbT + (tj * 32 + (lane_ & 31)) * 72 + ti * 32 + 8 * q4 + 4 * (lane_ >> 5)) = w; } } }
        LDS_BARRIER();
        { const int j = tid_ >> 3, g = tid_ & 7, t = dir ? T - 1 - (ci * 64 + j) : ci * 64 + j; bf16_t* sp = scr + ((tok0 + t) * NSLOT + (dir ? SL_GB : SL_GF)) * MIXW + h * 64 + g * 8; const float* hp = O2 + j * S65 + g * 8;
          u32x4 w; w.x = cvtpk(hp[0], hp[1]); w.y = cvtpk(hp[2], hp[3]); w.z = cvtpk(hp[4], hp[5]); w.w = cvtpk(hp[6], hp[7]); *(u32x4*)sp = w; }
        if (ci + 1 < nc) { chunk_store_gl(R, Q, K, VbT, T, dir, ci + 1, pass, cosT, sinT, tid_); if (tid_ < 256) *(f32x4*)(GA + (tid_ >> 2) * 16 + (tid_ & 3) * 4) = rga; }
    }
    LDS_BARRIER();
    if (!pass) { float* So = c.p->out + d.o_g + ((((size_t)b * DEPTH + l) * 2 + dir) * NH + h) * HD * HD; _Pragma("unroll 2") for (int i = tid; i < 4096; i += NTHREADS) So[i] = S[(i >> 6) * S65 + (i & 63)]; }
    __syncthreads();
}

__device__ __forceinline__ void phase_rwprep(const Ctx& c0, int l) {
    const Ctx c = fresh(c0);
    const Dims& d = c.d; const int tid = c.tid, lane = c.lane, wave = c.wave;
    float* L = (float*)c.lds;
    float *TWs = L, *RAs = L + 2 * 64 * 33, *W2s = L + 4 * 64 * 33, *A2s = W2s + 4096, *LWo = A2s + 4096;
    const bf16_t* cols = c.ws<bf16_t>(d.w_cols); const float* small = c.ws<float>(d.w_small); float* vecs = c.ws<float>(d.w_vecs); bf16_t* scr = c.ws<bf16_t>(d.w_scr);
    for (int blk = c.vcu; blk < d.NT / 64; blk += c.G) {
        const int tb = blk * 64, pass = tb >= d.NTc, T = pass ? d.Tl : d.Tc, tl0 = (tb - (pass ? d.NTc : 0)) % T;
        __syncthreads();
        UNR for (int u = 0; u < 2; ++u) { const int i = tid + NTHREADS * u, j = i >> 4, r4 = (i & 15) * 4, dir = r4 >> 5, r = r4 & 31; const float* sp = small + (size_t)(tb + j) * NSM;
            const f32x4 rw = *(const f32x4*)(sp + SM_RW + r4), ra = *(const f32x4*)(sp + SM_RA + r4); float* tp = TWs + (dir * 64 + j) * 33 + r; float* ap = RAs + (dir * 64 + j) * 33 + r;
            tp[0] = tanhf_(rw[0]); tp[1] = tanhf_(rw[1]); tp[2] = tanhf_(rw[2]); tp[3] = tanhf_(rw[3]); ap[0] = ra[0]; ap[1] = ra[1]; ap[2] = ra[2]; ap[3] = ra[3]; }
        for (int h = 0; h < NH; ++h) {
            UNR for (int u = 0; u < 8; ++u) { const int i = tid + NTHREADS * u, dir = i >> 11, r = (i >> 6) & 31, cc = i & 63; const size_t o = (((size_t)l * 2 + dir) * 32 + r) * MIXW + h * 64 + cc; W2s[i] = c.in(I_WW2)[o]; A2s[i] = c.in(I_WA2)[o]; }
            __syncthreads();
            UNR for (int u = 0; u < 2; ++u) { const int job = wave * 2 + u, dir = job >> 3, kind = (job >> 2) & 1, ti = (job >> 1) & 1, tj = job & 1; f32x16 acc = zero16();
                acc = mm32(lane, acc, (kind ? RAs : TWs) + (dir * 64 + ti * 32) * 33, 33, 1, (kind ? A2s : W2s) + dir * 2048 + tj * 32, 64, 1, 32);
                float* lo = LWo + (dir * 2 + kind) * MSZ + (ti * 32) * S65 + tj * 32 + (lane & 31);
                UNR for (int r = 0; r < 16; ++r) lo[ACC_ROW(r, lane) * S65] = acc[r]; }
            __syncthreads();
            { const int j = tid >> 3, g = tid & 7, ch = h * 64 + 8 * g, tl = tl0 + j; const size_t tok = (size_t)tb + j;
              const bf16_t* rp = cols + tok * NCB + ch; const u32x4 z4 = (u32x4){0u, 0u, 0u, 0u};
              const u32x4 rm = tl > 0 ? *(const u32x4*)(rp - NCB + CB_RR * 256) : z4, r0 = *(const u32x4*)(rp + CB_RR * 256), rq = tl + 1 < T ? *(const u32x4*)(rp + NCB + CB_RR * 256) : z4;
              const u32x4 km = tl > 0 ? *(const u32x4*)(rp - NCB + CB_RK * 256) : z4, k0 = *(const u32x4*)(rp + CB_RK * 256), kq = tl + 1 < T ? *(const u32x4*)(rp + NCB + CB_RK * 256) : z4;
              const u32x4 vm = tl > 0 ? *(const u32x4*)(rp - NCB + CB_RV * 256) : z4, v0 = *(const u32x4*)(rp + CB_RV * 256), vq = tl + 1 < T ? *(const u32x4*)(rp + NCB + CB_RV * 256) : z4;
              const float* tp = c.in(I_SHIFT) + (size_t)l * 3 * 768 + ch;
              float rr[8], kk[8], vv[8], kp[8]; float ss = 0.0f, bn = 0.0f;
              UNR for (int e = 0; e < 8; ++e) {
                  rr[e] = tp[e] * bfel(rm, e) + tp[768 + e] * bfel(r0, e) + tp[1536 + e] * bfel(rq, e);
                  kk[e] = tp[256 + e] * bfel(km, e) + tp[768 + 256 + e] * bfel(k0, e) + tp[1536 + 256 + e] * bfel(kq, e);
                  vv[e] = tp[512 + e] * bfel(vm, e) + tp[768 + 512 + e] * bfel(v0, e) + tp[1536 + 512 + e] * bfel(vq, e);
                  kp[e] = kk[e] * c.in(I_KK)[(size_t)l * MIXW + ch + e]; ss += kp[e] * kp[e]; bn += rr[e] * kk[e] * c.in(I_RKK)[(size_t)l * MIXW + ch + e]; }
              ss = oct_sum(ss); bn = oct_sum(bn); const float rs = frsq(ss + LN_EPS);
              float* vp = vecs + (tok * NH + h) * 576 + 8 * g;
              UNR for (int e = 0; e < 8; ++e) kp[e] *= rs;
              *(f32x4*)(vp) = (f32x4){rr[0], rr[1], rr[2], rr[3]}; *(f32x4*)(vp + 4) = (f32x4){rr[4], rr[5], rr[6], rr[7]};
              *(f32x4*)(vp + 64) = (f32x4){kp[0], kp[1], kp[2], kp[3]}; *(f32x4*)(vp + 68) = (f32x4){kp[4], kp[5], kp[6], kp[7]};
              *(f32x4*)(vp + 128) = (f32x4){vv[0], vv[1], vv[2], vv[3]}; *(f32x4*)(vp + 132) = (f32x4){vv[4], vv[5], vv[6], vv[7]};
              { u32x4 w; w.x = cvtpk(bn * vv[0], bn * vv[1]); w.y = cvtpk(bn * vv[2], bn * vv[3]); w.z = cvtpk(bn * vv[4], bn * vv[5]); w.w = cvtpk(bn * vv[6], bn * vv[7]); *(u32x4*)(scr + (tok * NSLOT + SL_RBONUS) * MIXW + ch) = w; }
              UNR for (int dir = 0; dir < 2; ++dir) { float wv[8], ak[8], kh[8]; const float* lwp = LWo + (dir * 2) * MSZ + j * S65 + 8 * g; const float* lap = lwp + MSZ;
                  UNR for (int e = 0; e < 8; ++e) { const float w0c = c.in(I_W0)[((size_t)l * 2 + dir) * MIXW + ch + e], a0c = c.in(I_A0)[((size_t)l * 2 + dir) * MIXW + ch + e], kac = c.in(I_KA)[(size_t)l * MIXW + ch + e];
                      wv[e] = -fexp(-softplusf_(-(w0c + lwp[e])) - 0.5f);     const float a = sigmoidf_(a0c + lap[e]); ak[e] = a * kp[e]; kh[e] = kk[e] * (1.0f + (a - 1.0f) * kac); }
                  float* dp = vp + (3 + 3 * dir) * 64;
                  *(f32x4*)(dp) = (f32x4){wv[0], wv[1], wv[2], wv[3]}; *(f32x4*)(dp + 4) = (f32x4){wv[4], wv[5], wv[6], wv[7]};
                  *(f32x4*)(dp + 64) = (f32x4){ak[0], ak[1], ak[2], ak[3]}; *(f32x4*)(dp + 68) = (f32x4){ak[4], ak[5], ak[6], ak[7]};
                  *(f32x4*)(dp + 128) = (f32x4){kh[0], kh[1], kh[2], kh[3]}; *(f32x4*)(dp + 132) = (f32x4){kh[4], kh[5], kh[6], kh[7]}; } }
            __syncthreads();
        }
    }
}

template <int J> struct SolveCol {
    static __device__ __forceinline__ void run(float (&u)[32], const float* La, const f32x4 (&lc)[8]) {
        f32x4 ln[8];
#pragma unroll
        for (int t4 = (J + 2) / 4; t4 < 8; ++t4) ln[t4] = *(const f32x4*)(La + (J + 1) * 36 + 4 * t4);
        const float uj = u[J];
#pragma unroll
        for (int t4 = (J + 1) / 4; t4 < 8; ++t4) {
#pragma unroll
            for (int e = 0; e < 4; ++e) if (4 * t4 + e > J) u[4 * t4 + e] -= lc[t4][e] * uj; }
#ifndef CPU_EMU
        asm volatile("" ::: "memory");
#endif
        SolveCol<J + 1>::run(u, La, ln);
    }
};
template <> struct SolveCol<31> { static __device__ __forceinline__ void run(float (&)[32], const float*, const f32x4 (&)[8]) {} };
__device__ __forceinline__ void mix_rwkv(const Ctx& c0, int l, int pass, int b, int h, int dir) {
    const Ctx c = fresh(c0);
    const Dims& d = c.d; const int T = pass ? d.Tl : d.Tc, tid = c.tid, lane = c.lane, wave = c.wave; const size_t tok0 = pass ? d.NTc + (size_t)b * d.Tl : (size_t)b * d.Tc;
    unsigned char* LB = c.lds;
    constexpr int OPS = 4 * 4608 + 3 * 5120 + 512;
    float* Gp = (float*)(LB + 2 * OPS);
    bf16_t *Lk = (bf16_t*)(LB + 2 * OPS + 4096), *T3 = Lk + 32 * 40, *T4 = T3 + 32 * 40, *UT = T4 + 32 * 40;
    float* La = (float*)(LB + 2 * OPS + 4096 + 3 * 2560 + 5120);
    float* RHS = La + 32 * 36;
    bf16_t* Sb = (bf16_t*)(RHS + 32 * 65);
    const float* vecs = c.ws<float>(d.w_vecs); bf16_t* scr = c.ws<bf16_t>(d.w_scr);
    const int nck = T / 32, vt = (wave >> 1) & 1, kt = wave & 1, ql = lane & 31;
    const int nr = wave < 4 ? 5 : 4, r0 = wave < 4 ? 5 * wave : (wave == 4 ? 0 : 20 + 4 * (wave - 5)), gslot = wave < 4 ? wave : wave - 1;
    __syncthreads();
    f32x16 Sacc = zero16();
    if (wave < 4) {
        if (pass) { const float* S0 = c.in(I_SR) + ((((size_t)b * DEPTH + l) * 2 + dir) * NH + h) * HD * HD; UNR for (int r = 0; r < 16; ++r) Sacc[r] = S0[(32 * vt + ACC_ROW(r, lane)) * 64 + 32 * kt + ql]; }
        UNR for (int r = 0; r < 16; ++r) Sb[(32 * vt + ACC_ROW(r, lane)) * 72 + 32 * kt + ql] = (bf16_t)f2bf(Sacc[r]);
    }
    float rw[5][6];
#define RC_LOADRAW(m_) do { if (wave != 4) { UNR for (int e_ = 0; e_ < 5; ++e_) if (e_ < nr) { const int pi_ = (m_) * 32 + r0 + e_, t_ = dir ? T - 1 - pi_ : pi_; const float* vp_ = vecs + ((tok0 + t_) * NH + h) * 576 + lane; \
        rw[e_][0] = vp_[0]; rw[e_][1] = vp_[64]; rw[e_][2] = vp_[128]; rw[e_][3] = vp_[(3 + 3 * dir) * 64]; rw[e_][4] = vp_[(4 + 3 * dir) * 64]; rw[e_][5] = vp_[(5 + 3 * dir) * 64]; } } } while (0)
#define RC_S1A(m_, cs_) do { if (wave != 4) { float run_ = 0.0f; UNR for (int e_ = 0; e_ < 5; ++e_) if (e_ < nr) { run_ += rw[e_][3]; cs_[e_] = run_; } Gp[(((m_) & 1) * 8 + gslot) * 64 + lane] = run_; } } while (0)
#define RC_S1B(m_, cs_) do { if (wave != 4) { unsigned char* ob_ = LB + ((m_) & 1) * OPS; bf16_t *Km_ = (bf16_t*)ob_, *Am_ = Km_ + 32 * 72, *Hm_ = Am_ + 32 * 72, *Rm_ = Hm_ + 32 * 72, *AmT_ = Rm_ + 32 * 72, *HmT_ = AmT_ + 64 * 40, *VT_ = HmT_ + 64 * 40; float* ge_ = (float*)(VT_ + 64 * 40); \
        float pre_ = 0.0f; UNR for (int p_ = 0; p_ < 7; ++p_) pre_ += (p_ < gslot) ? Gp[(((m_) & 1) * 8 + p_) * 64 + lane] : 0.0f; \
        UNR for (int e_ = 0; e_ < 5; ++e_) if (e_ < nr) { const int i_ = r0 + e_; const float g_ = pre_ + cs_[e_], gp_ = e_ == 0 ? pre_ : pre_ + cs_[e_ - 1], eg_ = fexp(g_), eng_ = fexp(-g_); \
            const float kv_ = rw[e_][1] * fexp(gp_), av_ = rw[e_][4] * eng_, hv_ = rw[e_][5] * eng_, rv_ = rw[e_][0] * eg_; \
            Km_[i_ * 72 + lane] = (bf16_t)f2bf(kv_); Am_[i_ * 72 + lane] = (bf16_t)f2bf(av_); Hm_[i_ * 72 + lane] = (bf16_t)f2bf(hv_); Rm_[i_ * 72 + lane] = (bf16_t)f2bf(rv_); \
            AmT_[lane * 40 + i_] = (bf16_t)f2bf(av_); HmT_[lane * 40 + i_] = (bf16_t)f2bf(hv_); VT_[lane * 40 + i_] = (bf16_t)f2bf(rw[e_][2]); if (i_ == 31) ge_[lane] = g_; } } } while (0)
    float cs[5];
    RC_LOADRAW(0); RC_S1A(0, cs);
    __syncthreads();
    RC_S1B(0, cs);
    if (nck > 1) { RC_LOADRAW(1); }
    __syncthreads();
    for (int ck = 0; ck < nck; ++ck) {
        const int tid_ = opqv(tid), lane_ = tid_ & 63, ql_ = lane_ & 31;
        unsigned char* ob = LB + (ck & 1) * OPS; const bf16_t *Km = (const bf16_t*)ob, *Am = Km + 32 * 72, *Hm = Am + 32 * 72, *Rm = Hm + 32 * 72, *AmT = Rm + 32 * 72, *HmT = AmT + 64 * 40, *VT = HmT + 64 * 40; const float* gend = (const float*)(VT + 64 * 40);
        f32x16 pacc = zero16();
        if (wave < 4) { const bf16_t* A = (wave & 2) ? Rm : Km; const bf16_t* Bt = (wave & 1) ? Hm : Am; f32x16 m = zero16(); m = mmb(lane_, m, A, 72, Bt, 72, 64);
            UNR for (int r = 0; r < 16; ++r) { const int i = ACC_ROW(r, lane_), j = ql_;
                if (wave == 0) La[j * 36 + i] = j < i ? m[r] : 0.0f; else if (wave == 1) Lk[i * 40 + j] = (bf16_t)f2bf(j < i ? m[r] : 0.0f);
                else if (wave == 2) T3[i * 40 + j] = (bf16_t)f2bf(j <= i ? m[r] : 0.0f); else T4[i * 40 + j] = (bf16_t)f2bf(j <= i ? m[r] : 0.0f); } }
        else { pacc = mmb(lane_, pacc, (wave & 2) ? Rm : Km, 72, Sb + (32 * (wave & 1)) * 72, 72, 64); }
        LDS_BARRIER();
        if (wave == 4 || wave == 5) { pacc = mmb(lane_, pacc, Lk, 40, VT + (32 * (wave & 1)) * 40, 40, 32); UNR for (int r = 0; r < 16; ++r) RHS[ACC_ROW(r, lane_) * 65 + 32 * (wave & 1) + ql_] = -pacc[r]; }
        else if (wave >= 6) { pacc = mmb(lane_, pacc, T4, 40, VT + (32 * (wave & 1)) * 40, 40, 32); }
        if (ck + 1 < nck) RC_S1A(ck + 1, cs);
        LDS_BARRIER();
        if (wave == 4) { float u[32];
            UNR for (int t = 0; t < 32; ++t) u[t] = RHS[t * 65 + lane_];
            { f32x4 l0[8]; UNR for (int t4 = 0; t4 < 8; ++t4) l0[t4] = *(const f32x4*)(La + 4 * t4); SolveCol<0>::run(u, La, l0); }
            UNR for (int p = 0; p < 16; ++p) *(unsigned*)(UT + lane_ * 40 + 2 * p) = cvtpk(u[2 * p], u[2 * p + 1]); }
        else if (ck + 1 < nck) { RC_S1B(ck + 1, cs); if (ck + 2 < nck) { RC_LOADRAW(ck + 2); } }
        LDS_BARRIER();
        if (wave >= 6) { pacc = mmb(lane_, pacc, T3, 40, UT + (32 * (wave & 1)) * 40, 40, 32);
            UNR for (int r = 0; r < 16; ++r) { const int pi = ck * 32 + ACC_ROW(r, lane_), t = dir ? T - 1 - pi : pi; scr[((tok0 + t) * NSLOT + (dir ? SL_RB : SL_RF)) * MIXW + h * 64 + 32 * (wave & 1) + ql_] = (bf16_t)f2bf(pacc[r]); } }
        else if (wave < 4) { Sacc = mmb(lane_, Sacc, UT + (32 * vt) * 40, 40, AmT + (32 * kt) * 40, 40, 32); Sacc = mmb(lane_, Sacc, VT + (32 * vt) * 40, 40, HmT + (32 * kt) * 40, 40, 32);
            const float gs = fexp(gend[32 * kt + ql_]);
            UNR for (int r = 0; r < 16; ++r) { Sacc[r] *= gs; Sb[(32 * vt + ACC_ROW(r, lane_)) * 72 + 32 * kt + ql_] = (bf16_t)f2bf(Sacc[r]); } }
        LDS_BARRIER();
    }
#undef RC_LOADRAW
#undef RC_S1A
#undef RC_S1B
    if (!pass && wave < 4) { float* So = c.p->out + d.o_r + ((((size_t)b * DEPTH + l) * 2 + dir) * NH + h) * HD * HD; UNR for (int r = 0; r < 16; ++r) So[(32 * vt + ACC_ROW(r, lane)) * 64 + 32 * kt + ql] = Sacc[r]; }
    __syncthreads();
}

#define SCR8(p_, lo_, hi_) do { const u32x4 w_ = *(const u32x4*)(p_); lo_ = (f32x4){bflo(w_.x), bfhi(w_.x), bflo(w_.y), bfhi(w_.y)}; hi_ = (f32x4){bflo(w_.z), bfhi(w_.z), bflo(w_.w), bfhi(w_.w)}; } while (0)
__device__ __forceinline__ void phase_combine(const Ctx& c0, int l) {
    const Ctx c = fresh(c0);
    const Dims& d = c.d; const int tid = c.tid, lane = c.lane, wave = c.wave;
    float* L = (float*)c.lds; float *SG = L, *G2 = L + MSZ, *GT = L + MSZ + 64 * 256;
    const bf16_t* cols = c.ws<bf16_t>(d.w_cols); const float* small = c.ws<float>(d.w_small); const bf16_t* scr = c.ws<bf16_t>(d.w_scr); bf16_t* br = c.ws<bf16_t>(d.w_br);
    __syncthreads();
    for (int i = tid; i < 64 * 256; i += NTHREADS) G2[i] = c.in(I_WG2)[(size_t)l * 64 * MIXW + i];
    for (int blk = c.vcu; blk < d.NT / 64; blk += c.G) {
        const size_t tb = (size_t)blk * 64;
        __syncthreads();
        { const int j = tid >> 3, g = tid & 7; const float* rp = small + (tb + j) * NSM + SM_RG + g * 8; const f32x4 a = *(const f32x4*)rp, b2 = *(const f32x4*)(rp + 4); float* sp = SG + j * S65 + g * 8;
          sp[0] = sigmoidf_(a[0]); sp[1] = sigmoidf_(a[1]); sp[2] = sigmoidf_(a[2]); sp[3] = sigmoidf_(a[3]); sp[4] = sigmoidf_(b2[0]); sp[5] = sigmoidf_(b2[1]); sp[6] = sigmoidf_(b2[2]); sp[7] = sigmoidf_(b2[3]); }
        __syncthreads();
        UNR for (int u = 0; u < 2; ++u) { const int tl = wave * 2 + u, ti = tl >> 3, tj = tl & 7; f32x16 acc = zero16();
            acc = mm32(lane, acc, SG + ti * 32 * S65, S65, 1, G2 + tj * 32, 256, 1, 64);
            UNR for (int r = 0; r < 16; ++r) GT[(ti * 32 + ACC_ROW(r, lane)) * 257 + tj * 32 + (lane & 31)] = acc[r]; }
        __syncthreads();
        for (int hh = 0; hh < NH; ++hh) {
            const int j = tid >> 3, g = tid & 7; const size_t tok = tb + j; const int cb = hh * 64 + g * 8; const bf16_t* sp = scr + tok * NSLOT * MIXW + cb;
            {
              f32x4 a0, a1, b0, b1; SCR8(sp + SL_MF * MIXW, a0, a1); SCR8(sp + SL_MB * MIXW, b0, b1);
              float x[8]; float s = 0.0f; UNR for (int e = 0; e < 4; ++e) { x[e] = a0[e] + b0[e]; x[4 + e] = a1[e] + b1[e]; } UNR for (int e = 0; e < 8; ++e) s += x[e];
              s += x1(s); s += x2(s); s += x4m(s); const float mean = s * (1.0f / 64.0f); float qv = 0.0f;
              UNR for (int e = 0; e < 8; ++e) { x[e] -= mean; qv += x[e] * x[e]; }
              qv += x1(qv); qv += x2(qv); qv += x4m(qv); const float rs = frsq(qv * (1.0f / 64.0f) + LN_EPS);
              const u32x4 ow = *(const u32x4*)(cols + tok * NCB + CB_MO * 256 + cb); const f32x4 o0 = (f32x4){bflo(ow.x), bfhi(ow.x), bflo(ow.y), bfhi(ow.y)}, o1 = (f32x4){bflo(ow.z), bfhi(ow.z), bflo(ow.w), bfhi(ow.w)};
              u32x4 w; w.x = pk2(x[0] * rs * sigmoidf_(o0[0]), x[1] * rs * sigmoidf_(o0[1])); w.y = pk2(x[2] * rs * sigmoidf_(o0[2]), x[3] * rs * sigmoidf_(o0[3]));
              w.z = pk2(x[4] * rs * sigmoidf_(o1[0]), x[5] * rs * sigmoidf_(o1[1])); w.w = pk2(x[6] * rs * sigmoidf_(o1[2]), x[7] * rs * sigmoidf_(o1[3])); *(u32x4*)(br + tok * D + 0 * MIXW + cb) = w; }
            {
              f32x4 a0, a1, b0, b1; SCR8(sp + SL_GF * MIXW, a0, a1); SCR8(sp + SL_GB * MIXW, b0, b1);
              float x[8]; float qv = 0.0f; UNR for (int e = 0; e < 4; ++e) { x[e] = a0[e] + b0[e]; x[4 + e] = a1[e] + b1[e]; } UNR for (int e = 0; e < 8; ++e) qv += x[e] * x[e];
              qv += x1(qv); qv += x2(qv); qv += x4m(qv); const float rs = frsq(qv * (1.0f / 64.0f) + LN_EPS);
              const u32x4 ow = *(const u32x4*)(cols + tok * NCB + CB_GG * 256 + cb); const f32x4 o0 = (f32x4){bflo(ow.x), bfhi(ow.x), bflo(ow.y), bfhi(ow.y)}, o1 = (f32x4){bflo(ow.z), bfhi(ow.z), bflo(ow.w), bfhi(ow.w)};
              u32x4 w; w.x = pk2(x[0] * rs * siluf_(o0[0]), x[1] * rs * siluf_(o0[1])); w.y = pk2(x[2] * rs * siluf_(o0[2]), x[3] * rs * siluf_(o0[3]));
              w.z = pk2(x[4] * rs * siluf_(o1[0]), x[5] * rs * siluf_(o1[1])); w.w = pk2(x[6] * rs * siluf_(o1[2]), x[7] * rs * siluf_(o1[3])); *(u32x4*)(br + tok * D + 1 * MIXW + cb) = w; }
            {
              f32x4 a0, a1, b0, b1, n0, n1; SCR8(sp + SL_RF * MIXW, a0, a1); SCR8(sp + SL_RB * MIXW, b0, b1); SCR8(sp + SL_RBONUS * MIXW, n0, n1);
              float x[8]; float s = 0.0f; UNR for (int e = 0; e < 4; ++e) { x[e] = a0[e] + b0[e]; x[4 + e] = a1[e] + b1[e]; } UNR for (int e = 0; e < 8; ++e) s += x[e];
              s += x1(s); s += x2(s); s += x4m(s); const float mean = s * (1.0f / 64.0f); float qv = 0.0f;
              UNR for (int e = 0; e < 8; ++e) { x[e] -= mean; qv += x[e] * x[e]; }
              qv += x1(qv); qv += x2(qv); qv += x4m(qv); const float rs = frsq(qv * (1.0f / 64.0f) + LN_EPS);
              const float* gp = GT + j * 257 + cb;
              u32x4 w; w.x = pk2((x[0] * rs + n0[0]) * gp[0], (x[1] * rs + n0[1]) * gp[1]); w.y = pk2((x[2] * rs + n0[2]) * gp[2], (x[3] * rs + n0[3]) * gp[3]);
              w.z = pk2((x[4] * rs + n1[0]) * gp[4], (x[5] * rs + n1[1]) * gp[5]); w.w = pk2((x[6] * rs + n1[2]) * gp[6], (x[7] * rs + n1[3]) * gp[7]); *(u32x4*)(br + tok * D + 2 * MIXW + cb) = w; }
        }
    }
    __syncthreads();
}

__device__ __forceinline__ void mix_na(const Ctx& c0, int l, int pass, int b, int h, int qb) {
    const Ctx c = fresh(c0);
    const Dims& d = c.d; const int tid = c.tid, lane = c.lane, wave = c.wave; const size_t tok0 = pass ? d.NTc + (size_t)b * d.Tl : (size_t)b * d.Tc;
    constexpr int KST = 72, VST_ = 136;
    unsigned char* LB = c.lds;
    bf16_t* Kt = (bf16_t*)LB;
    bf16_t* Vt = (bf16_t*)(LB + 2 * 128 * KST * 2);
    float* rpbs = (float*)(LB + 2 * 128 * KST * 2 + 2 * 64 * VST_ * 2);
    float* Om = (float*)LB;
    float* Lm = Om + 8 * 32 * 64;
    const bf16_t* cols = c.ws<bf16_t>(d.w_cols); bf16_t* br = c.ws<bf16_t>(d.w_br);
    const int rows = d.Tl / GRIDW, kr = rows < 8 ? rows : 8; int rs = qb - kr / 2; rs = rs < 0 ? 0 : (rs > rows - kr ? rows - kr : rs);
    const int nloc = pass ? kr / 2 : 0, ntile = pass ? nloc + PAST / 128 : d.Tc / 128;
    const int qt = wave & 1, kq = wave >> 1, hh = lane >> 5, ql = lane & 31;
    __syncthreads();
    if (pass) for (int i = tid; i < 15 * 31; i += NTHREADS) rpbs[i] = c.in(I_RPB)[((size_t)l * NH + h) * 15 * 31 + i];
    bf16x8 qf[4];
    { const bf16_t* qp = cols + (tok0 + qb * 64 + qt * 32 + ql) * NCB + CB_NQ * 256 + h * 64 + 8 * hh;
      UNR for (int s4 = 0; s4 < 4; ++s4) qf[s4] = *(const bf16x8*)(qp + 16 * s4); }
    const int jp = tid >> 3, d8 = (tid & 7) * 8;
    u32x4 pk[2], pv[2];
#define NA_LOAD(kt_) do { UNR for (int u_ = 0; u_ < 2; ++u_) { const int j_ = 2 * jp + u_; \
        if (pass && (kt_) >= nloc) { const size_t o_ = ((((size_t)b * DEPTH + l) * NH + h) * PAST + ((kt_) - nloc) * 128 + j_) * HD + d8; const float* kp_ = c.in(I_CK) + o_; const float* vp_ = c.in(I_CV) + o_; \
            pk[u_] = pk8(*(const f32x4*)kp_, *(const f32x4*)(kp_ + 4)); pv[u_] = pk8(*(const f32x4*)vp_, *(const f32x4*)(vp_ + 4)); } \
        else { const size_t tk_ = pass ? tok0 + (size_t)(rs + 2 * (kt_) + (j_ >> 6)) * 64 + (j_ & 63) : tok0 + (kt_) * 128 + j_; const bf16_t* rp_ = cols + tk_ * NCB + h * 64 + d8; \
            pk[u_] = *(const u32x4*)(rp_ + CB_NK * 256); pv[u_] = *(const u32x4*)(rp_ + CB_NV * 256); } } } while (0)
#define NA_STORE(buf_) do { bf16_t* kb_ = Kt + (buf_) * 128 * KST; bf16_t* vb_ = Vt + (buf_) * 64 * VST_; \
        UNR for (int u_ = 0; u_ < 2; ++u_) *(u32x4*)(kb_ + (2 * jp + u_) * KST + d8) = pk[u_]; \
        UNR for (int e_ = 0; e_ < 8; ++e_) { const unsigned a_ = pv[0][e_ >> 1], b_ = pv[1][e_ >> 1]; \
            *(unsigned*)(vb_ + (d8 + e_) * VST_ + 2 * ((jp + 4 * (tid & 7)) & 63)) = (e_ & 1) ? ((a_ >> 16) | (b_ & 0xffff0000u)) : ((a_ & 0xffffu) | (b_ << 16)); } } while (0)
    NA_LOAD(0);
    NA_STORE(0);
    f32x16 o0 = zero16(), o1 = zero16(); float lsum = 0.0f;
    __syncthreads();
    for (int kt = 0; kt < ntile; ++kt) {
        if (kt + 1 < ntile) NA_LOAD(kt + 1);
        const bf16_t* kb = Kt + (kt & 1) * 128 * KST + (32 * kq + ql) * KST + 8 * hh; const bf16_t* vb = Vt + (kt & 1) * 64 * VST_; const int d0 = 16 * kq + 2 * hh, kx0 = 4 * (ql >> 3), kx1 = kx0 + 16;
        f32x16 sc = zero16();
        UNR for (int s4 = 0; s4 < 4; ++s4) sc = __builtin_amdgcn_mfma_f32_32x32x16_bf16(*(const bf16x8*)(kb + 16 * s4), qf[s4], sc, 0, 0, 0);
        if (pass && kt < nloc) {
            const int qc = 32 * qt + ql; int cs = qc - 8; cs = cs < 0 ? 0 : (cs > 48 ? 48 : cs);
            UNR for (int r = 0; r < 16; ++r) { const int jj = 32 * kq + ACC_ROW(r, lane), krow = rs + 2 * kt + (jj >> 6), kc = jj & 63; const bool ok = kc >= cs && kc < cs + 16;
                const float bias = rpbs[ok ? (krow - qb + 7) * 31 + (kc - qc + 15) : 0]; sc[r] = ok ? fexp(fminf(sc[r] * 0.125f + bias, 80.0f)) : 0.0f; }
        } else { UNR for (int r = 0; r < 16; ++r) sc[r] = fexp(fminf(sc[r] * 0.125f, 80.0f)); }
        UNR for (int r = 0; r < 16; ++r) lsum += sc[r];
        UNR for (int s2 = 0; s2 < 2; ++s2) { u32x4 w; w.x = cvtpk(sc[8 * s2], sc[8 * s2 + 1]); w.y = cvtpk(sc[8 * s2 + 2], sc[8 * s2 + 3]); w.z = cvtpk(sc[8 * s2 + 4], sc[8 * s2 + 5]); w.w = cvtpk(sc[8 * s2 + 6], sc[8 * s2 + 7]);
            const bf16x8 pf = __builtin_bit_cast(bf16x8, w);
            { const u32x2 v0 = *(const u32x2*)(vb + ql * VST_ + 2 * ((d0 + 8 * s2 + kx0) & 63)), v1 = *(const u32x2*)(vb + ql * VST_ + 2 * ((d0 + 8 * s2 + 4 + kx0) & 63)); u32x4 vw; vw.x = v0.x; vw.y = v0.y; vw.z = v1.x; vw.w = v1.y;
              o0 = __builtin_amdgcn_mfma_f32_32x32x16_bf16(pf, __builtin_bit_cast(bf16x8, vw), o0, 0, 0, 0); }
            { const u32x2 v0 = *(const u32x2*)(vb + (32 + ql) * VST_ + 2 * ((d0 + 8 * s2 + kx1) & 63)), v1 = *(const u32x2*)(vb + (32 + ql) * VST_ + 2 * ((d0 + 8 * s2 + 4 + kx1) & 63)); u32x4 vw; vw.x = v0.x; vw.y = v0.y; vw.z = v1.x; vw.w = v1.y;
              o1 = __builtin_amdgcn_mfma_f32_32x32x16_bf16(pf, __builtin_bit_cast(bf16x8, vw), o1, 0, 0, 0); } }
        if (kt + 1 < ntile) NA_STORE((kt + 1) & 1);
        LDS_BARRIER();
    }
#undef NA_LOAD
#undef NA_STORE
    { float* om = Om + wave * 32 * 64; UNR for (int r = 0; r < 16; ++r) { om[ACC_ROW(r, lane) * 64 + ql] = o0[r]; om[ACC_ROW(r, lane) * 64 + 32 + ql] = o1[r]; }
      const float lt = lsum + __shfl_xor(lsum, 32); if (lane < 32) Lm[wave * 32 + lane] = lt; }
    __syncthreads();
    { const int q = tid >> 3, g = tid & 7, qt2 = q >> 5, q2 = q & 31; float ls = 0.0f; f32x4 a0 = (f32x4){0.f, 0.f, 0.f, 0.f}, a1 = a0;
      UNR for (int kq2 = 0; kq2 < 4; ++kq2) { const int w = kq2 * 2 + qt2; ls += Lm[w * 32 + q2]; const float* op = Om + w * 32 * 64 + q2 * 64 + g * 8; a0 += *(const f32x4*)op; a1 += *(const f32x4*)(op + 4); }
      const float il = 1.0f / ls; const size_t tok = tok0 + qb * 64 + q; bf16_t* bp = br + tok * D + 3 * MIXW + h * 64 + g * 8;
      u32x4 w; w.x = pk2(a0[0] * il, a0[1] * il); w.y = pk2(a0[2] * il, a0[3] * il); w.z = pk2(a1[0] * il, a1[1] * il); w.w = pk2(a1[2] * il, a1[3] * il); *(u32x4*)bp = w; }
    __syncthreads();
}

__device__ __forceinline__ void phase_mixers(const Ctx& c0, int l, int rep) {
    const Ctx c = fresh(c0);
    const Dims& d = c.d; const int rows = d.Tl / GRIDW;
    const int nL = d.Bl * NH, nC = d.Bc * NH, nNAl = nL * rows, nq = d.Tc / 64, nNAc = nC * nq;
    unsigned* qctr = c.ws<unsigned>(c.d.w_ctl) + CW_QUEUE + 64 * (l + DEPTH * rep);
    int* slot = (int*)(c.lds + 163840 - 128);
#ifndef MIX_MASK
#define MIX_MASK 15
#endif
#ifndef MIX_DUP
#define MIX_DUP 15
#endif
#define MIX_FETCH() do { __syncthreads(); if (c.tid == 0) *slot = (int)atomicAdd(qctr, 1u); __syncthreads(); it = __builtin_amdgcn_readfirstlane(*slot); } while (0)
    int it; MIX_FETCH();
    int base = 0;
    for (int pp = 1; pp >= 0; --pp) {
        const int ps = opqs(__builtin_amdgcn_readfirstlane(pp)), nBH = ps ? nL : nC, nNA = ps ? nNAl : nNAc, nr = ps ? rows : nq;
        const int e0 = base + 2 * nBH, e1 = e0 + 2 * nBH, e2 = e1 + 2 * nBH, e3 = e2 + nNA;
        while (it < e0) { const int q = it - base; if ((MIX_MASK & 1) && (rep == 0 || (MIX_DUP & 1))) mix_rwkv(c, l, ps, (q >> 1) / NH, (q >> 1) % NH, q & 1); MIX_FETCH(); }
        while (it < e1) { const int q = it - e0; if ((MIX_MASK & 2) && (rep == 0 || (MIX_DUP & 2))) mix_mlstm(c, l, ps, (q >> 1) / NH, (q >> 1) % NH, q & 1); MIX_FETCH(); }
        while (it < e2) { const int q = it - e1; if ((MIX_MASK & 4) && (rep == 0 || (MIX_DUP & 4))) mix_gla(c, l, ps, (q >> 1) / NH, (q >> 1) % NH, q & 1); MIX_FETCH(); }
        while (it < e3) { const int q = it - e2; if ((MIX_MASK & 8) && (rep == 0 || (MIX_DUP & 8))) mix_na(c, l, ps, q / (NH * nr), (q / nr) % NH, q % nr); MIX_FETCH(); }
        base = e3;
    }
#undef MIX_FETCH
}

__device__ __forceinline__ void phase_ln1(const Ctx& c0, int l) {
    const Ctx c = fresh(c0);
    const Dims& d = c.d; const float* mods = c.mods(l); const float* v = c.ws<float>(d.w_v); bf16_t* hb = c.ws<bf16_t>(d.w_hb); float* aff = c.ws<float>(d.w_aff);
    const float* lg = c.in(I_LNG) + ((size_t)l * 2 + 0) * D; const float* lb = c.in(I_LNB) + ((size_t)l * 2 + 0) * D;
    constexpr int WRS = D + 4;
    float* WR = (float*)c.lds;
    __syncthreads();
    for (int i = c.tid; i < D * NEXP; i += NTHREADS) WR[(i & 15) * WRS + (i >> 4)] = c.in(I_WROUTER)[(size_t)l * D * NEXP + i];
    __syncthreads();
    f32x4 g4[4], b4[4];
#pragma unroll
    for (int j = 0; j < 4; ++j) { g4[j] = *(const f32x4*)(lg + 4 * c.lane + 256 * j); b4[j] = *(const f32x4*)(lb + 4 * c.lane + 256 * j); }
    for (int blk = c.vcu * NWAVES + c.wave; blk < d.NT / 8; blk += c.G * NWAVES) {
        const int tokb = blk * 8; const float* mr = mods + (size_t)c.modrow(tokb) * NMOD;
        f32x4 sh4[4], sc4[4], xn[4];
#pragma unroll
        for (int j = 0; j < 4; ++j) { sh4[j] = *(const f32x4*)(mr + 3 * D + 4 * c.lane + 256 * j); sc4[j] = *(const f32x4*)(mr + 4 * D + 4 * c.lane + 256 * j); xn[j] = *(const f32x4*)(v + (size_t)tokb * D + 4 * c.lane + 256 * j); }
        for (int ti = 0; ti < 8; ++ti) {
            const int tok = tokb + ti; f32x4 x[4]; float s = 0.0f;
#pragma unroll
            for (int j = 0; j < 4; ++j) { x[j] = xn[j]; s += (x[j][0] + x[j][1]) + (x[j][2] + x[j][3]); }
            if (ti + 1 < 8) {
#pragma unroll
                for (int j = 0; j < 4; ++j) xn[j] = *(const f32x4*)(v + (size_t)(tok + 1) * D + 4 * c.lane + 256 * j); }
            const float mean = wave_sum(s) * (1.0f / D); float q = 0.0f;
#pragma unroll
            for (int j = 0; j < 4; ++j) { x[j] = x[j] - mean; q += (x[j][0] * x[j][0] + x[j][1] * x[j][1]) + (x[j][2] * x[j][2] + x[j][3] * x[j][3]); }
            const float rstd = frsq(wave_sum(q) * (1.0f / D) + LN_EPS);
            f32x4 hh[4];
#pragma unroll
            for (int j = 0; j < 4; ++j) { const int col = 4 * c.lane + 256 * j; const f32x4 x1 = x[j] * rstd * g4[j] + b4[j]; *(f32x4*)(c.X() + (size_t)tok * D + col) = x1;
                hh[j] = x1 * (1.0f + sc4[j]) + sh4[j]; u32x2 w; w.x = pk2(hh[j][0], hh[j][1]); w.y = pk2(hh[j][2], hh[j][3]); *(u32x2*)(hb + (size_t)tok * D + col) = w; }
            float lg16[16];
#pragma unroll
            for (int e = 0; e < 16; ++e) { float a = 0.0f;
#pragma unroll
                for (int j = 0; j < 4; ++j) { const f32x4 wv = *(const f32x4*)(WR + e * WRS + 4 * c.lane + 256 * j); a += (hh[j][0] * wv[0] + hh[j][1] * wv[1]) + (hh[j][2] * wv[2] + hh[j][3] * wv[3]); }
                lg16[e] = a;
#ifndef CPU_EMU
                asm volatile("" ::: "memory");
#endif
            }
            float mx = -3.0e38f;
#pragma unroll
            for (int e = 0; e < 16; ++e) { lg16[e] = wave_sum(lg16[e]); mx = fmaxf(mx, lg16[e]); }
            float se = 0.0f;
#pragma unroll
            for (int e = 0; e < 16; ++e) { lg16[e] = expf(lg16[e] - mx); se += lg16[e]; }
            const float inv = 1.0f / se; float mine = 0.0f;
#pragma unroll
            for (int e = 0; e < 16; ++e) mine = (c.lane == e) ? lg16[e] * inv : mine;
            if (c.lane < 16) aff[(size_t)tok * NEXP + c.lane] = mine;
        }
    }
}

__device__ __forceinline__ void phase_select(const Ctx& c0) {
    const Ctx c = fresh(c0);
    const Dims& d = c.d; const float* aff = c.ws<float>(d.w_aff); int* inv = c.ws<int>(d.w_inv); float* pgate = c.ws<float>(d.w_pgate);
    const bf16_t* hb = c.ws<bf16_t>(d.w_hb); bf16_t* xe = c.ws<bf16_t>(d.w_xe);
    unsigned long long* KEY = (unsigned long long*)c.lds; int* sel = (int*)(KEY + 1024);
    const int nitems = (d.Bc + d.Bl) * NEXP, nlat = d.Bl * NEXP, nctx = d.Bc * NEXP;
    const bool latw = c.vcu < nlat && nlat < c.G; const int gctx = nlat < c.G ? c.G - nlat : c.G;
    for (int k = 0;; ++k) {
        int it;
        if (nlat >= c.G) { it = c.vcu + k * c.G; if (it >= nitems) break; it = it < nlat ? nctx + it : it - nlat; }
        else if (latw) { if (k > 0) break; it = nctx + c.vcu; }
        else { it = (c.vcu - nlat) + k * gctx; if (it >= nctx) break; }
        const int e = it % NEXP, bb = it / NEXP, pass = bb >= d.Bc, b = pass ? bb - d.Bc : bb, T = pass ? d.Tl : d.Tc, cap = pass ? d.capl : d.capc;
        const int tok0 = pass ? d.NTc + b * d.Tl : b * d.Tc, row0 = e * d.RPE + (pass ? d.Bc * d.capc + b * d.capl : b * d.capc);
        __syncthreads();
        for (int t = c.tid; t < T; t += NTHREADS) KEY[t] = ((unsigned long long)__builtin_bit_cast(unsigned, aff[(size_t)(tok0 + t) * NEXP + e]) << 32) | (unsigned)(~t);
        __syncthreads();
        { const int t0 = c.tid, t1 = c.tid + NTHREADS; const bool h0 = t0 < T, h1 = t1 < T; const unsigned long long k0 = h0 ? KEY[t0] : ~0ull, k1 = h1 ? KEY[t1] : ~0ull; int rank0 = 0, rank1 = 0;
#pragma unroll 4
          for (int s2 = 0; s2 < T; s2 += 2) { const unsigned long long o0 = KEY[s2], o1 = KEY[s2 + 1];
              rank0 += (o0 > k0 ? 1 : 0) + (o1 > k0 ? 1 : 0); rank1 += (o0 > k1 ? 1 : 0) + (o1 > k1 ? 1 : 0); }
          if (h0) { if (rank0 < cap) { sel[rank0] = t0; pgate[row0 + rank0] = __builtin_bit_cast(float, (unsigned)(k0 >> 32)); inv[(size_t)e * d.NT + tok0 + t0] = row0 + rank0; } else inv[(size_t)e * d.NT + tok0 + t0] = -1; }
          if (h1) { if (rank1 < cap) { sel[rank1] = t1; pgate[row0 + rank1] = __builtin_bit_cast(float, (unsigned)(k1 >> 32)); inv[(size_t)e * d.NT + tok0 + t1] = row0 + rank1; } else inv[(size_t)e * d.NT + tok0 + t1] = -1; } }
        __syncthreads();
        for (int r0 = c.wave * 4; r0 < cap; r0 += NWAVES * 4) {
            u32x4 v[4][2];
            UNR for (int u = 0; u < 4; ++u) { const int r = r0 + u < cap ? r0 + u : cap - 1; const u32x4* src = (const u32x4*)(hb + (size_t)(tok0 + sel[r]) * D); v[u][0] = src[c.lane]; v[u][1] = src[c.lane + 64]; }
            UNR for (int u = 0; u < 4; ++u) { if (r0 + u < cap) { u32x4* dst = (u32x4*)(xe + (size_t)(row0 + r0 + u) * D); dst[c.lane] = v[u][0]; dst[c.lane + 64] = v[u][1]; } }
        }
    }
}

__device__ __forceinline__ void phase_ln2(const Ctx& c0, int l) {
    const Ctx c = fresh(c0);
    const Dims& d = c.d; const float* mods = c.mods(l); const bf16_t* y = c.ws<bf16_t>(d.w_y); const int* inv = c.ws<int>(d.w_inv); bf16_t* hb = c.ws<bf16_t>(d.w_hb);
    const float* lg = c.in(I_LNG) + ((size_t)l * 2 + 1) * D; const float* lb = c.in(I_LNB) + ((size_t)l * 2 + 1) * D;
    const float* modn = (l + 1 < DEPTH) ? c.mods(l + 1) : nullptr;
    const int gw = c.vcu * NWAVES + c.wave, NGW = c.G * NWAVES;
    for (int tok = gw; tok < d.NT; tok += NGW) {
        const int mrow = c.modrow(tok); const float* mr = mods + (size_t)mrow * NMOD; f32x4 ff[4];
#pragma unroll
        for (int j = 0; j < 4; ++j) ff[j] = (f32x4){0.f, 0.f, 0.f, 0.f};
        for (int e = 0; e < NEXP; ++e) { const int row = inv[(size_t)e * d.NT + tok]; if (row >= 0) {
#pragma unroll
            for (int j = 0; j < 4; ++j) { const u32x2 w = *(const u32x2*)(y + (size_t)row * D + 4 * c.lane + 256 * j); ff[j] += (f32x4){bflo(w.x), bfhi(w.x), bflo(w.y), bfhi(w.y)}; } } }
        f32x4 x[4]; float s = 0.0f;
#pragma unroll
        for (int j = 0; j < 4; ++j) { const int col = 4 * c.lane + 256 * j; const f32x4 x1 = *(const f32x4*)(c.X() + (size_t)tok * D + col), g2 = *(const f32x4*)(mr + 5 * D + col);
            x[j] = ALPHA * x1 + g2 * ff[j]; s += (x[j][0] + x[j][1]) + (x[j][2] + x[j][3]); }
        const float mean = wave_sum(s) * (1.0f / D); float q = 0.0f;
#pragma unroll
        for (int j = 0; j < 4; ++j) { x[j] = x[j] - mean; q += (x[j][0] * x[j][0] + x[j][1] * x[j][1]) + (x[j][2] * x[j][2] + x[j][3] * x[j][3]); }
        const float rstd = frsq(wave_sum(q) * (1.0f / D) + LN_EPS);
#pragma unroll
        for (int j = 0; j < 4; ++j) { const int col = 4 * c.lane + 256 * j; const f32x4 g = *(const f32x4*)(lg + col), bb = *(const f32x4*)(lb + col);
            const f32x4 x2 = x[j] * rstd * g + bb; *(f32x4*)(c.X() + (size_t)tok * D + col) = x2;
            if (modn) { const float* mn = modn + (size_t)mrow * NMOD; const f32x4 sh = *(const f32x4*)(mn + col), sc = *(const f32x4*)(mn + D + col); const f32x4 hh = x2 * (1.0f + sc) + sh;
                u32x2 w; w.x = pk2(hh[0], hh[1]); w.y = pk2(hh[2], hh[3]); *(u32x2*)(hb + (size_t)tok * D + col) = w; } }
    }
}

constexpr int N_PHASES = 2 + 11 * DEPTH;
__device__ __forceinline__ void run_phase(const Ctx& c0, int ph, int rep) {
    const Ctx c = fresh(c0); const Dims& d = c.d;
#ifndef PHASE_MASK
#define PHASE_MASK 0xFFFF
#endif
    if (ph == 0) { if (PHASE_MASK & 0x800) phase_prep(c); return; }
    if (ph == 1) { if (PHASE_MASK & 0x1000) phase_init(c); return; }
    const int l = (ph - 2) / 11, s = (ph - 2) % 11;
    LAS unsigned char* ldsp = (LAS unsigned char*)c.lds;
    if (!((PHASE_MASK >> s) & 1)) return;
    switch (s) {
    case 0: { pg8::Gemm g{c.ws<bf16_t>(d.w_hb), c.ws<bf16_t>(d.w_win) + (size_t)l * NINP * D, D}; pg8::StaticOrder S; S.init(d.NT, NINP, c.G, (int)blockIdx.x);
              EpiCols E{c.ws<bf16_t>(d.w_cols), c.ws<float>(d.w_small), c.ws<unsigned char>(d.w_gates), c.p->out + d.o_nk, c.p->out + d.o_nv, l, d.NTc, d.Tc}; pg8::gemm_phase<EpiCols, pg8::StaticOrder>(ldsp, g, S, E); } break;
    case 1: phase_rwprep(c, l); break;
    case 2: phase_mixers(c, l, rep); break;
    case 3: phase_combine(c, l); break;
    case 4: { pg8::Gemm g{c.ws<bf16_t>(d.w_br), c.ws<bf16_t>(d.w_wbr) + (size_t)l * D * D, D}; pg8::StaticOrder S; S.init(d.NT, D, c.G, (int)blockIdx.x);
              EpiWiden E{c.ws<unsigned char>(d.w_gates), c.ws<bf16_t>(d.w_merged)}; pg8::gemm_phase<EpiWiden, pg8::StaticOrder>(ldsp, g, S, E); } break;
    case 5: { pg8::Gemm g{c.ws<bf16_t>(d.w_merged), c.ws<bf16_t>(d.w_wout) + (size_t)l * D * D, D}; pg8::StaticOrder S; S.init(d.NT, D, c.G, (int)blockIdx.x);
              EpiPreLN E{l == 0 ? c.in(I_XP) : c.X(), l == 0 ? c.in(I_XS) - (size_t)d.NTc * D : c.X(), c.mods(l), c.ws<float>(d.w_v), d.NTc, d.Tl}; pg8::gemm_phase<EpiPreLN, pg8::StaticOrder>(ldsp, g, S, E); } break;
    case 6: phase_ln1(c, l); break;
    case 7: phase_select(c); break;
    case 8: { pg8::Gemm g{c.ws<bf16_t>(d.w_xe), c.ws<bf16_t>(d.w_wup) + (size_t)l * NEXP * 2 * FF * D, D}; pg8::GroupOrder S; S.init(d.TPE, 2 * FF / 256, NEXP, c.G, c.vcu);
              EpiSwiGLU E{c.ws<bf16_t>(d.w_act)}; pg8::gemm_phase<EpiSwiGLU, pg8::GroupOrder>(ldsp, g, S, E); } break;
    case 9: { pg8::Gemm g{c.ws<bf16_t>(d.w_act), c.ws<bf16_t>(d.w_wdn) + (size_t)l * NEXP * D * FF, FF}; pg8::GroupOrder S; S.init(d.TPE, D / 256, NEXP, c.G, c.vcu);
              EpiDown E{c.ws<float>(d.w_pgate), c.ws<bf16_t>(d.w_y)}; pg8::gemm_phase<EpiDown, pg8::GroupOrder>(ldsp, g, S, E); } break;
    default: phase_ln2(c, l); break;
    }
}

#ifndef CPU_EMU
#define XB_TMO      128
#define XB_XCNT(j)  (256  + 64 * (j))
#define XB_XSUB(j)  (1280 + 64 * (j))
#define XB_XGEN(j)  (2304 + 64 * (j))
#define XB_TOP      3328
#define XB_TOPGEN   3392
#define XB_SPIN_CAP (1u << 20)
__device__ __forceinline__ unsigned xb_ld(unsigned* p)              { return __hip_atomic_load(p, __ATOMIC_RELAXED, __HIP_MEMORY_SCOPE_AGENT); }
__device__ __forceinline__ unsigned xb_add(unsigned* p, unsigned v) { return __hip_atomic_fetch_add(p, v, __ATOMIC_RELAXED, __HIP_MEMORY_SCOPE_AGENT); }
__device__ __forceinline__ unsigned xb_xcc_id() { return (unsigned)__builtin_amdgcn_s_getreg((3 << 11) | 20) & 0xFu; }
#define XB_SPIN(cond, bar) do { unsigned _sp = 0; while (cond) { __builtin_amdgcn_s_sleep(1); \
    if ((++_sp & 255u) == 0u) { if (xb_ld(&(bar)[XB_TMO])) break; if (_sp > XB_SPIN_CAP) { atomicAdd(&(bar)[XB_TMO], 1u); break; } } } } while (0)
struct XcdBarrier { unsigned* bar; unsigned x; volatile LAS unsigned* st; };
__device__ __forceinline__ XcdBarrier xcd_barrier_post(unsigned* bar, volatile LAS unsigned* st) {
    XcdBarrier b; b.bar = bar; b.x = xb_xcc_id(); b.st = st;
    if (threadIdx.x == 0) (void)xb_add(&bar[XB_XCNT(b.x)], 1u);
    return b;
}
__device__ __forceinline__ void xcd_barrier_complete(unsigned* bar, unsigned x, unsigned& nloc, unsigned& nx) {
    const unsigned G = gridDim.x * gridDim.y * gridDim.z;
    unsigned sum, cnt, mine, sp = 0u;
    for (;;) {
        sum = 0u; cnt = 0u; mine = 0u;
#pragma unroll
        for (unsigned j = 0; j < 16; ++j) { const unsigned cc = xb_ld(&bar[XB_XCNT(j)]); sum += cc; cnt += (cc > 0u) ? 1u : 0u; mine = (j == x) ? cc : mine; }
        if (sum == G) break;
        __builtin_amdgcn_s_sleep(1);
        if ((++sp & 255u) == 0u) { if (xb_ld(&bar[XB_TMO])) break; if (sp > XB_SPIN_CAP) { atomicAdd(&bar[XB_TMO], 1u); break; } }
    }
    nloc = mine > 0u ? mine : 1u; nx = cnt > 0u ? cnt : 1u;
}
__device__ __forceinline__ void xcd_barrier(const XcdBarrier& b) {
    asm volatile("s_waitcnt vmcnt(0)" ::: "memory");
    __syncthreads();
    if (threadIdx.x == 0) {
        unsigned* bar = b.bar;
        __builtin_amdgcn_s_waitcnt(0);
        unsigned nloc = b.st[0], nx = b.st[1];
        if (nloc == 0u) { xcd_barrier_complete(bar, b.x, nloc, nx); b.st[0] = nloc; b.st[1] = nx; }
        const unsigned old = xb_add(&bar[XB_XSUB(b.x)], 1u);
        const unsigned gen = old / nloc;
        if (old + 1u == (gen + 1u) * nloc) {
            __builtin_amdgcn_fence(__ATOMIC_RELEASE, "agent");
            asm volatile("s_waitcnt vmcnt(0)" ::: "memory");
            const unsigned og = xb_add(&bar[XB_TOP], 1u);
            const unsigned tg = og / nx;
            if (og + 1u == (tg + 1u) * nx) xb_add(&bar[XB_TOPGEN], 1u);
            else XB_SPIN(xb_ld(&bar[XB_TOPGEN]) == tg, bar);
            __builtin_amdgcn_fence(__ATOMIC_ACQUIRE, "agent");
            xb_add(&bar[XB_XGEN(b.x)], 1u);
            asm volatile("s_waitcnt vmcnt(0)" ::: "memory");
        } else {
            XB_SPIN(xb_ld(&bar[XB_XGEN(b.x)]) == gen, bar);
            __builtin_amdgcn_fence(__ATOMIC_ACQUIRE, "agent");
            asm volatile("s_waitcnt vmcnt(0)" ::: "memory");
        }
    }
    __syncthreads();
}

#ifndef PROBE_DUP
#define PROBE_DUP 0
#endif
constexpr int LDS_BYTES = 163840;
__global__ void __launch_bounds__(NTHREADS, 2) trunk_fwd(Params p) {
    extern __shared__ __attribute__((aligned(16))) unsigned char lds[];
    Ctx c; c.p = &p; c.d = make_dims(p.Bc, p.Tc, p.Bl, p.Tl); c.lds = lds;
    c.tid = threadIdx.x; c.lane = c.tid & 63; c.wave = __builtin_amdgcn_readfirstlane(c.tid >> 6);
    c.G = gridDim.x; { const int bx = blockIdx.x; c.vcu = (c.G % 8 == 0) ? (bx % 8) * (c.G / 8) + bx / 8 : bx; }
    volatile LAS unsigned* st = (volatile LAS unsigned*)((LAS unsigned char*)lds + LDS_BYTES - 64);
    XcdBarrier bar; bar.bar = nullptr; bar.x = 0; bar.st = st;
    if (p.use_bar) { if (c.tid < 2) st[c.tid] = 0u; __syncthreads(); bar = xcd_barrier_post((unsigned*)(p.ws) + CW_BAR, st); }
    for (int ph = p.ph_lo; ph < p.ph_hi; ++ph) {
#if PROBE_DUP
        { const int kind = ph == 0 ? 11 : (ph == 1 ? 12 : (ph - 2) % 11); const int nrep = ((PROBE_DUP >> kind) & 1) ? 2 : 1;
          for (int rep = 0; rep < nrep; ++rep) { run_phase(c, ph, rep); if (rep + 1 < nrep) xcd_barrier(bar); } }
#else
        run_phase(c, ph, 0);
#endif
        if (ph + 1 < p.ph_hi) xcd_barrier(bar);
    }
}

#ifndef N_LAUNCH_MODE
#define N_LAUNCH_MODE 1
#endif
extern "C" void kernel_launch(void* const* d_in, const int* in_sizes, int n_in, void* d_out, int out_size, void* d_ws, size_t ws_size, hipStream_t stream) {
    static int grid = 0, resident = 0;
    const Dims d = make_dims(32, 256, 8, 1024);
    if (grid == 0) {
        int dev = 0, cus = 0;
        if (n_in != N_INPUTS || (size_t)out_size != d.o_end || ws_size < ((size_t)d.w_end << 8)) { fprintf(stderr, "kernel_launch: unexpected sizes: n_in %d out %d ws %zu (need %zu / %zu)\n", n_in, out_size, ws_size, (size_t)d.o_end, (size_t)d.w_end << 8); grid = -1; return; }
        if (hipGetDevice(&dev) != hipSuccess || hipDeviceGetAttribute(&cus, hipDeviceAttributeMultiprocessorCount, dev) != hipSuccess) { grid = -1; return; }
        if (hipFuncSetAttribute((const void*)trunk_fwd, hipFuncAttributeMaxDynamicSharedMemorySize, LDS_BYTES) != hipSuccess) { fprintf(stderr, "kernel_launch: hipFuncSetAttribute failed\n"); grid = -1; return; }
        int per_cu = 0;
        if (hipOccupancyMaxActiveBlocksPerMultiprocessor(&per_cu, (const void*)trunk_fwd, NTHREADS, LDS_BYTES) != hipSuccess) per_cu = 0;
        (void)hipGetLastError();
        grid = cus;
        resident = per_cu >= 1;
        if (!resident) fprintf(stderr, "kernel_launch: occupancy query says %d blocks/CU: falling back to one launch per phase\n", per_cu);
    }
    if (grid < 0) return;
    (void)hipMemsetAsync((char*)d_ws, 0, CTL_BYTES, stream);
    Params p{};
    for (int i = 0; i < N_INPUTS; ++i) p.in[i] = (const float*)d_in[i];
    p.out = (float*)d_out; p.ws = (unsigned char*)d_ws; p.Bc = 32; p.Tc = 256; p.Bl = 8; p.Tl = 1024;
    if (N_LAUNCH_MODE == 1 && resident) {
        p.ph_lo = 0; p.ph_hi = N_PHASES; p.use_bar = 1;
        hipLaunchKernelGGL(trunk_fwd, dim3(grid), dim3(NTHREADS), LDS_BYTES, stream, p);
    } else {
        for (int ph = 0; ph < N_PHASES; ++ph) { p.ph_lo = ph; p.ph_hi = ph + 1; p.use_bar = 0; hipLaunchKernelGGL(trunk_fwd, dim3(grid), dim3(NTHREADS), LDS_BYTES, stream, p); }
    }
}
#endif
```

```cpp
#ifndef CPU_EMU
#include <hip/hip_runtime.h>
#include <cstdio>
typedef float f32x16 __attribute__((ext_vector_type(16)));
typedef float f32x4 __attribute__((ext_vector_type(4)));
typedef float f32x2 __attribute__((ext_vector_type(2)));
typedef unsigned u32x4 __attribute__((ext_vector_type(4)));
typedef unsigned u32x2 __attribute__((ext_vector_type(2)));
#define LAS __attribute__((address_space(3)))
#define WAVE_SYNC() asm volatile("s_waitcnt lgkmcnt(0)" ::: "memory")
#else
#define LAS
#define WAVE_SYNC() emu::wave_sync()
#endif
#define UNR _Pragma("unroll")
#ifndef CPU_EMU
#define LDS_BARRIER() do { asm volatile("s_waitcnt lgkmcnt(0)\n\ts_barrier" ::: "memory"); } while (0)
#else
#define LDS_BARRIER() __syncthreads()
#endif
typedef short bf16x8 __attribute__((ext_vector_type(8)));
typedef unsigned short bf16_t;

constexpr int D = 1024, NH = 4, HD = 64, MIXW = 256, NEXP = 16, FF = 2048, DEPTH = 2, PAST = 256, GRIDW = 64;
constexpr int NIN = 7920, NINP = 7936, NCB = 3584, NSM = 256, NGATE = 4096, NMOD = 6 * D;
constexpr float ALPHA = 1.4142135623730951f, LN_EPS = 1e-5f;
constexpr int NTHREADS = 512, NWAVES = 8;
constexpr int CB_MQ = 0, CB_MK = 1, CB_MV = 2, CB_MO = 3, CB_GQ = 4, CB_GK = 5, CB_GV = 6, CB_GG = 7, CB_RR = 8, CB_RK = 9, CB_RV = 10, CB_NQ = 11, CB_NK = 12, CB_NV = 13;
constexpr int SM_MI = 0, SM_MF = 8, SM_GA = 16, SM_RW = 48, SM_RA = 112, SM_RG = 176;
enum { I_XP = 0, I_XS, I_SC, I_SN, I_SM, I_SG, I_SR, I_CK, I_CV, I_C, I_CCTX, I_WADA, I_BADA, I_WIN, I_BIG, I_BFG, I_WGLA, I_BGLA, I_SHIFT, I_W0, I_WW2, I_A0, I_WA2, I_WG2, I_KK, I_KA, I_RKK,
       I_RPB, I_WBR, I_WOUT, I_LNG, I_LNB, I_WROUTER, I_WUP, I_WDOWN, N_INPUTS };

__host__ __device__ __forceinline__ int prow(int n) { const int rho = n & 31; return (n & ~31) + 8 * ((rho & 15) >> 2) + 4 * (rho >> 4) + (rho & 3); }
__host__ __device__ __forceinline__ int win_col(int p) {
    if (p < 3584) { const int b = p >> 8, w = p & 255; const int base = b < 4 ? b * 256 : (b < 8 ? 1040 + (b - 4) * 256 : (b < 11 ? 2096 + (b - 8) * 256 : 3056 + (b - 11) * 256)); return base + w; }
    if (p < 3840) { const int s = p - 3584; return s < 16 ? 1024 + s : (s < 48 ? 2064 + (s - 16) : (s < 240 ? 2864 + (s - 48) : -1)); }
    return p - 16;
}

struct Params {
    const float* in[N_INPUTS];
    float* out; unsigned char* ws;
    int Bc, Tc, Bl, Tl;
    int ph_lo, ph_hi;
    int use_bar, pad;
};
struct Dims {
    int Bc, Tc, Bl, Tl, NTc, NTl, NT, capc, capl, RPE, TPE, NPR;
    unsigned o_yp, o_ys, o_C, o_n, o_m, o_g, o_r, o_nk, o_nv, o_end;
    unsigned w_ctl, w_win, w_wbr, w_wout, w_wup, w_wdn, w_mods, w_hb, w_cols, w_small, w_vecs, w_gates, w_br, w_scr, w_merged, w_v, w_aff, w_inv, w_pgate, w_xe, w_act, w_y, w_end;
};
constexpr size_t CTL_BYTES = 1u << 20;
constexpr int CW_BAR = 4096, CW_QUEUE = 1024;
__host__ __device__ __forceinline__ unsigned al256(size_t x) { return (unsigned)((x + 255) >> 8); }
__host__ __device__ __forceinline__ Dims make_dims(int Bc, int Tc, int Bl, int Tl) {
    Dims d; d.Bc = Bc; d.Tc = Tc; d.Bl = Bl; d.Tl = Tl; d.NTc = Bc * Tc; d.NTl = Bl * Tl; d.NT = d.NTc + d.NTl;
    d.capc = Tc / 8; d.capl = Tl / 8; d.RPE = ((Bc * d.capc + Bl * d.capl + 255) / 256) * 256; d.TPE = d.RPE / 256; d.NPR = NEXP * d.RPE;
    unsigned o = 0; d.o_yp = o; o += (unsigned)d.NTc * D; d.o_ys = o; o += (unsigned)d.NTl * D;
    d.o_C = o; o += (unsigned)Bc * DEPTH * 2 * NH * HD * HD; d.o_n = o; o += (unsigned)Bc * DEPTH * 2 * NH * HD; d.o_m = o; o += (unsigned)Bc * DEPTH * 2 * NH;
    d.o_g = o; o += (unsigned)Bc * DEPTH * 2 * NH * HD * HD; d.o_r = o; o += (unsigned)Bc * DEPTH * 2 * NH * HD * HD;
    d.o_nk = o; o += (unsigned)Bc * DEPTH * NH * Tc * HD; d.o_nv = o; o += (unsigned)Bc * DEPTH * NH * Tc * HD; d.o_end = o;
    unsigned w = 0; d.w_ctl = w; w += (unsigned)(CTL_BYTES >> 8);
    d.w_win = w; w += al256((size_t)DEPTH * NINP * D * 2); d.w_wbr = w; w += al256((size_t)DEPTH * D * D * 2); d.w_wout = w; w += al256((size_t)DEPTH * D * D * 2);
    d.w_wup = w; w += al256((size_t)DEPTH * NEXP * 2 * FF * D * 2); d.w_wdn = w; w += al256((size_t)DEPTH * NEXP * D * FF * 2);
    d.w_mods = w; w += al256((size_t)DEPTH * (1 + Bl) * NMOD * 4);
    d.w_hb = w; w += al256((size_t)d.NT * D * 2); d.w_cols = w; w += al256((size_t)d.NT * NCB * 2); d.w_small = w; w += al256((size_t)d.NT * NSM * 4); d.w_vecs = w; w += al256((size_t)d.NT * NH * 576 * 4); d.w_gates = w; w += al256((size_t)d.NT * NGATE);
    d.w_br = w; w += al256((size_t)d.NT * D * 2); d.w_scr = w; w += al256((size_t)d.NT * 7 * MIXW * 2); d.w_merged = w; w += al256((size_t)d.NT * D * 2);
    d.w_v = w; w += al256((size_t)d.NT * D * 4); d.w_aff = w; w += al256((size_t)d.NT * NEXP * 4); d.w_inv = w; w += al256((size_t)d.NT * NEXP * 4);
    d.w_pgate = w; w += al256((size_t)d.NPR * 4); d.w_xe = w; w += al256((size_t)d.NPR * D * 2); d.w_act = w; w += al256((size_t)d.NPR * FF * 2); d.w_y = w; w += al256((size_t)d.NPR * D * 2);
    d.w_end = w; return d;
}

__device__ __forceinline__ unsigned f2bf(float f) { unsigned u = __builtin_bit_cast(unsigned, f); return (u + 0x7fffu + ((u >> 16) & 1u)) >> 16; }
#ifndef CPU_EMU
__device__ __forceinline__ unsigned cvtpk(float lo, float hi) { unsigned r; asm("v_cvt_pk_bf16_f32 %0, %1, %2" : "=v"(r) : "v"(lo), "v"(hi)); return r; }
__device__ __forceinline__ unsigned pk2(float lo, float hi) { return cvtpk(lo, hi); }
#else
inline unsigned pk2(float lo, float hi) { return f2bf(lo) | (f2bf(hi) << 16); }
inline unsigned cvtpk(float lo, float hi) { return pk2(lo, hi); }
#endif

#ifndef CPU_EMU
template <int CTRL> __device__ __forceinline__ float dppf(float v) { return __builtin_bit_cast(float, __builtin_amdgcn_update_dpp(0, __builtin_bit_cast(int, v), CTRL, 0xF, 0xF, true)); }
__device__ __forceinline__ float x1(float v) { return dppf<0xB1>(v); }
__device__ __forceinline__ float x2(float v) { return dppf<0x4E>(v); }
__device__ __forceinline__ float x4m(float v) { return dppf<0x141>(v); }
__device__ __forceinline__ float x8m(float v) { return dppf<0x140>(v); }
__device__ __forceinline__ float fexp(float x) { return __expf(x); }
__device__ __forceinline__ float flog(float x) { return __logf(x); }
__device__ __forceinline__ float frsq(float x) { return __builtin_amdgcn_rsqf(x); }
#else
inline float x1(float v) { return __shfl_xor(v, 1); }
inline float x2(float v) { return __shfl_xor(v, 2); }
inline float x4m(float v) { return __shfl_xor(v, 4); }
inline float x8m(float v) { return __shfl_xor(v, 8); }
inline float fexp(float x) { return expf(x); }
inline float flog(float x) { return logf(x); }
inline float frsq(float x) { return 1.0f / sqrtf(x); }
#endif
__device__ __forceinline__ float quad_sum(float v) { v += x1(v); v += x2(v); return v; }
__device__ __forceinline__ float oct_sum(float v) { v += x1(v); v += x2(v); v += x4m(v); return v; }
__device__ __forceinline__ float oct_max(float v) { v = fmaxf(v, x1(v)); v = fmaxf(v, x2(v)); v = fmaxf(v, x4m(v)); return v; }
__device__ __forceinline__ float sigmoidf_(float x) { return __builtin_amdgcn_rcpf(1.0f + fexp(-x)); }
__device__ __forceinline__ float logsigmoidf_(float x) { return fminf(x, 0.0f) - flog(1.0f + fexp(-fabsf(x))); }
__device__ __forceinline__ float softplusf_(float x) { return fmaxf(x, 0.0f) + flog(1.0f + fexp(-fabsf(x))); }
__device__ __forceinline__ float tanhf_(float x) { const float e = fexp(-2.0f * fabsf(x)); const float t = (1.0f - e) * __builtin_amdgcn_rcpf(1.0f + e); return x < 0.0f ? -t : t; }
__device__ __forceinline__ float siluf_(float x) { return x * __builtin_amdgcn_rcpf(1.0f + fexp(-x)); }
#ifndef CPU_EMU
__device__ __forceinline__ float rlane(float v, int l) { return __builtin_bit_cast(float, __builtin_amdgcn_readlane(__builtin_bit_cast(int, v), l)); }
__device__ __forceinline__ float wave_sum(float v) {
    v += x1(v); v += x2(v); v += x4m(v); v += x8m(v);
    return (rlane(v, 0) + rlane(v, 16)) + (rlane(v, 32) + rlane(v, 48));
}
#else
inline float wave_sum(float v) { for (int o = 1; o < 64; o <<= 1) v += __shfl_xor(v, o); return v; }
#endif
__device__ __forceinline__ unsigned pkh2(float a, float b) { const _Float16 x = (_Float16)a, y = (_Float16)b; return (unsigned)__builtin_bit_cast(unsigned short, x) | ((unsigned)__builtin_bit_cast(unsigned short, y) << 16); }
#ifndef CPU_EMU
__device__ __forceinline__ float frcp(float x) { return __builtin_amdgcn_rcpf(x); }
#else
inline float frcp(float x) { return 1.0f / x; }
#endif
__device__ __forceinline__ float bf2f(unsigned v) { return __builtin_bit_cast(float, v << 16); }
__device__ __forceinline__ float bflo(unsigned w) { return __builtin_bit_cast(float, w << 16); }
__device__ __forceinline__ float bfhi(unsigned w) { return __builtin_bit_cast(float, w & 0xffff0000u); }
__device__ __forceinline__ float h2f(unsigned short h) { return (float)__builtin_bit_cast(_Float16, h); }

#ifndef CPU_EMU
__device__ __forceinline__ int opqv(int x) { asm volatile("" : "+v"(x)); return x; }
__device__ __forceinline__ int opqs(int x) { asm volatile("" : "+s"(x)); return x; }
#else
inline int opqv(int x) { return x; }
inline int opqs(int x) { return x; }
#endif
namespace pg8 {
constexpr int BM = 256, BK = 64, HALF = 128, HTB = HALF * BK * 2, STAGE_BYTES = 8 * HTB, NXCD = 8, WGM = 8;
__host__ __device__ __forceinline__ int lds_byte(int r, int c) { const int st = (r >> 4) * 2 + (c >> 5), rr = r & 15, cc = c & 31, ob = rr * 64 + cc * 2; return st * 1024 + (ob ^ (((ob >> 9) & 1) << 5)); }
__host__ __device__ __forceinline__ void stage_rc(int b, int& R, int& C) { const int st = b / 1024, sb = b % 1024, swz = sb ^ (((sb >> 9) & 1) << 5); R = (st >> 1) * 16 + swz / 64; C = (st & 1) * 32 + (swz % 64) / 2; }
struct Unit { int pm, pn, ta, tb; };
struct Gemm { const bf16_t* A; const bf16_t* Bt; int K; };
struct StaticOrder {
    int nM, nN, nwg, G, c;
    __device__ __forceinline__ void init(int M, int N, int G_, int c_) { nM = M / BM; nN = N / BM; nwg = nM * nN; G = G_; c = c_; }
    __device__ __forceinline__ bool next(int i, Unit& u) const {
        const long L = (long)i * G + c; if (L >= nwg) return false;
        int wgid = (int)L; { const int q = nwg / NXCD, r = nwg % NXCD, xcd = wgid % NXCD, off = wgid / NXCD; wgid = (xcd < r ? xcd * (q + 1) : r * (q + 1) + (xcd - r) * q) + off; }
        const int nig = WGM * nN, gid = wgid / nig, fm = gid * WGM, gsz = (nM - fm) < WGM ? (nM - fm) : WGM;
        u.pm = fm + ((wgid % nig) % gsz); u.pn = (wgid % nig) / gsz; u.ta = u.pm; u.tb = u.pn; return true;
    }
};
struct GroupOrder {
    int tpe, nN, nE, G, c;
    __device__ __forceinline__ void init(int tpe_, int nN_, int nE_, int G_, int c_) { tpe = tpe_; nN = nN_; nE = nE_; G = G_; c = c_; }
    __device__ __forceinline__ bool next(int i, Unit& u) const {
        const long L = (long)i * G + c; if (L >= (long)nE * tpe * nN) return false;
        const int per = tpe * nN, e = (int)(L / per), r = (int)(L % per), pn = r / tpe, pm = r % tpe;
        u.ta = e * tpe + pm; u.tb = e * nN + pn; u.pm = u.ta; u.pn = pn; return true;
    }
};
#ifndef CPU_EMU
template <class Epi, class Sched>
__device__ __forceinline__ void gemm_phase(LAS unsigned char* lds, const Gemm g, const Sched& S, const Epi& E) {
    const int tid = opqv((int)threadIdx.x), wid = __builtin_amdgcn_readfirstlane(tid >> 6), lane = tid & 63, wr = wid >> 2, wc = wid & 3, fr = lane & 15, fq = lane >> 4;
    const int K = g.K, nt = K / BK;
    unsigned voffA[2];
#pragma unroll
    for (int i = 0; i < 2; ++i) { int R, C; stage_rc(tid * 16 + i * 8192, R, C); voffA[i] = (unsigned)(R * K + C) * 2u; }
    const size_t kstep = (size_t)(BK * 2), hstep = (size_t)HALF * K * 2, tstep = 2 * hstep;
    const unsigned ldsw = (unsigned)wid * 1024u;
    const int aoff = lds_byte(wr * 64 + fr, fq * 8), boff = lds_byte(wc * 32 + fr, fq * 8);
#define PG8_SA(b, h) (((b) * 2 + (h)) * HTB)
#define PG8_SB(b, h) ((4 + (b) * 2 + (h)) * HTB)
#define PG8_STAGE(bufoff, gbase) do { _Pragma("unroll") for (int _i = 0; _i < 2; ++_i) \
        __builtin_amdgcn_global_load_lds((const unsigned*)((const char*)(gbase) + voffA[_i]), (LAS unsigned*)(lds + (bufoff) + ldsw + _i * 8192), 16, 0, 0); } while (0)
#define PG8_LDA(dst, b, h) do { _Pragma("unroll") for (int m = 0; m < 4; ++m) _Pragma("unroll") for (int k = 0; k < 2; ++k) dst[m][k] = *(const LAS bf16x8*)(lds + PG8_SA(b, h) + aoff + m * 2048 + k * 1024); } while (0)
#define PG8_LDB(dst, b, h) do { _Pragma("unroll") for (int n = 0; n < 2; ++n) _Pragma("unroll") for (int k = 0; k < 2; ++k) dst[n][k] = *(const LAS bf16x8*)(lds + PG8_SB(b, h) + boff + n * 2048 + k * 1024); } while (0)
#define PG8_MMA(ai, bj, At, Bt) do { __builtin_amdgcn_s_setprio(1); _Pragma("unroll") for (int m = 0; m < 4; ++m) _Pragma("unroll") for (int n = 0; n < 2; ++n) _Pragma("unroll") for (int k = 0; k < 2; ++k) \
        acc[ai][bj][m][n] = __builtin_amdgcn_mfma_f32_16x16x32_bf16(Bt[n][k], At[m][k], acc[ai][bj][m][n], 0, 0, 0); __builtin_amdgcn_s_setprio(0); } while (0)
#define PG8_WAIT_V(n) asm volatile("s_waitcnt vmcnt(" #n ")" ::: "memory")
#define PG8_WAIT_L(n) asm volatile("s_waitcnt lgkmcnt(" #n ")" ::: "memory")
#define PG8_BAR __builtin_amdgcn_s_barrier()
#define PG8_SCHED __builtin_amdgcn_sched_barrier(0)
    Unit cur, nxt; int ui = 0;
    if (!S.next(0, cur)) return;
    f32x4 acc[2][2][4][2];
#pragma unroll
    for (int a = 0; a < 2; ++a)
#pragma unroll
        for (int b = 0; b < 2; ++b)
#pragma unroll
            for (int m = 0; m < 4; ++m)
#pragma unroll
                for (int n = 0; n < 2; ++n) acc[a][b][m][n] = (f32x4){0.f, 0.f, 0.f, 0.f};
    bf16x8 At[4][2], B0[2][2], B1[2][2];
    const char* cA = (const char*)g.A + (size_t)cur.ta * tstep; const char* cB = (const char*)g.Bt + (size_t)cur.tb * tstep;
    PG8_STAGE(PG8_SB(0, 0), cB); PG8_STAGE(PG8_SB(0, 1), cB + hstep); PG8_STAGE(PG8_SA(0, 0), cA); PG8_STAGE(PG8_SA(0, 1), cA + hstep);
    if (wr == 1) PG8_BAR;
    PG8_WAIT_V(2); PG8_BAR;
    PG8_STAGE(PG8_SB(1, 0), cB + kstep); PG8_STAGE(PG8_SA(1, 0), cA + kstep); PG8_STAGE(PG8_SB(1, 1), cB + hstep + kstep);
    PG8_WAIT_V(6); PG8_BAR;
    for (;;) {
        const bool has_next = S.next(ui + 1, nxt);
        const char* nA = has_next ? (const char*)g.A + (size_t)nxt.ta * tstep : cA; const char* nB = has_next ? (const char*)g.Bt + (size_t)nxt.tb * tstep : cB;
        for (int t = 0; t < nt; t += 2) {
            const bool last = (t == nt - 2);
            const char* a1 = cA + (size_t)(t + 1) * kstep;
            const char* a2 = last ? nA : cA + (size_t)(t + 2) * kstep; const char* b2 = last ? nB : cB + (size_t)(t + 2) * kstep;
            const char* a3 = a2 + kstep; const char* b3 = b2 + kstep;
            if constexpr (Epi::MID) { if (t != 0 && (t & 3) == 0) E.mid(acc, cur, t >> 2, wr, wc, fr, fq); }
            PG8_LDB(B0, 0, 0); PG8_LDB(B1, 0, 1); PG8_SCHED; PG8_LDA(At, 0, 0); PG8_STAGE(PG8_SA(1, 1), a1 + hstep);
            PG8_WAIT_V(8); PG8_WAIT_L(0); PG8_BAR; PG8_MMA(0, 0, At, B0); PG8_MMA(0, 1, At, B1); PG8_BAR; PG8_SCHED;
            PG8_LDA(At, 0, 1); PG8_STAGE(PG8_SB(0, 0), b2); PG8_STAGE(PG8_SB(0, 1), b2 + hstep); PG8_STAGE(PG8_SA(0, 0), a2);
            PG8_WAIT_V(8); PG8_WAIT_L(0); PG8_BAR; PG8_MMA(1, 0, At, B0); PG8_MMA(1, 1, At, B1); PG8_BAR; PG8_SCHED;
            PG8_LDB(B0, 1, 0); PG8_LDB(B1, 1, 1); PG8_SCHED; PG8_LDA(At, 1, 0); PG8_STAGE(PG8_SA(0, 1), a2 + hstep);
            PG8_WAIT_V(8); PG8_WAIT_L(0); PG8_BAR; PG8_MMA(0, 0, At, B0); PG8_MMA(0, 1, At, B1); PG8_BAR; PG8_SCHED;
            PG8_LDA(At, 1, 1); PG8_STAGE(PG8_SB(1, 0), b3); PG8_STAGE(PG8_SB(1, 1), b3 + hstep); PG8_STAGE(PG8_SA(1, 0), a3);
            PG8_WAIT_V(8); PG8_WAIT_L(0); PG8_BAR; PG8_MMA(1, 0, At, B0); PG8_MMA(1, 1, At, B1); PG8_BAR; PG8_SCHED;
        }
        if (wr == 0) PG8_BAR;
        E(acc, cur, wr, wc, fr, fq);
        if (!has_next) break;
#pragma unroll
        for (int a = 0; a < 2; ++a)
#pragma unroll
            for (int b = 0; b < 2; ++b)
#pragma unroll
                for (int m = 0; m < 4; ++m)
#pragma unroll
                    for (int n = 0; n < 2; ++n) acc[a][b][m][n] = (f32x4){0.f, 0.f, 0.f, 0.f};
        cur = nxt; cA = nA; cB = nB; ++ui;
        if (wr == 1) PG8_BAR;
    }
    PG8_WAIT_V(0);
    PG8_BAR;
#undef PG8_SA
#undef PG8_SB
#undef PG8_STAGE
#undef PG8_LDA
#undef PG8_LDB
#undef PG8_MMA
#undef PG8_WAIT_V
#undef PG8_WAIT_L
#undef PG8_BAR
#undef PG8_SCHED
}
#else
template <class Epi, class Sched> void gemm_phase(unsigned char* lds, const Gemm g, const Sched& S, const Epi& E);
#endif
}
typedef f32x4 AccT[2][2][4][2];

struct Ctx {
    const Params* p; Dims d; unsigned char* lds; int tid, lane, wave, G, vcu;
    template <class T> __device__ __forceinline__ T* ws(unsigned off) const { return (T*)(p->ws + ((size_t)off << 8)); }
    __device__ __forceinline__ const float* in(int i) const { return p->in[i]; }
    __device__ __forceinline__ int modrow(int tok) const { return tok < d.NTc ? 0 : 1 + (tok - d.NTc) / d.Tl; }
    __device__ __forceinline__ const float* mods(int l) const { return ws<float>(d.w_mods) + (size_t)l * (1 + d.Bl) * NMOD; }
    __device__ __forceinline__ float* X() const { return p->out; }
};

__device__ __forceinline__ Ctx fresh(const Ctx& c0) {
    Ctx c; c.p = c0.p; c.lds = c0.lds; c.tid = opqv(c0.tid); c.lane = c.tid & 63; c.wave = opqs(c0.wave); c.G = opqs(c0.G); c.vcu = opqs(c0.vcu);
    c.d = make_dims(opqs(c0.p->Bc), opqs(c0.p->Tc), opqs(c0.p->Bl), opqs(c0.p->Tl)); return c;
}

__device__ __forceinline__ u32x4 pk8(const f32x4 a, const f32x4 b) { u32x4 w; w.x = pk2(a[0], a[1]); w.y = pk2(a[2], a[3]); w.z = pk2(b[0], b[1]); w.w = pk2(b[2], b[3]); return w; }
__device__ __forceinline__ unsigned gq(float x) { const float g = sigmoidf_(x) * 255.0f + 0.5f; const unsigned q = (unsigned)g; return q < 1u ? 1u : (q > 255u ? 255u : q); }
__device__ __forceinline__ float ub(unsigned w, int i) { return (float)((w >> (8 * i)) & 0xffu); }
struct EpiCols {
    static constexpr bool MID = false;
    bf16_t* cols; float* small; unsigned char* gates; float* onk; float* onv; int l, NTc, Tc;
    __device__ __forceinline__ void operator()(const AccT& acc, const pg8::Unit& u, int wr, int wc, int fr, int fq) const {
        const int row0 = u.pm * 256 + wr * 64 + fr, cw = wc * 32 + 8 * fq;
        if (u.pn < 14) {
            float* okv = u.pn == 12 ? onk : (u.pn == 13 ? onv : nullptr);
#pragma unroll
            for (int ai = 0; ai < 2; ++ai)
#pragma unroll
                for (int m = 0; m < 4; ++m) { const int row = row0 + ai * 128 + m * 16; bf16_t* rp = cols + (size_t)row * NCB + u.pn * 256 + cw;
#pragma unroll
                    for (int bj = 0; bj < 2; ++bj) { *(u32x4*)(rp + bj * 128) = pk8(acc[ai][bj][m][0], acc[ai][bj][m][1]);
                        if (okv && row < NTc) { const int cc = bj * 128 + cw, b = row / Tc, t = row - b * Tc; float* op = okv + ((((size_t)b * DEPTH + l) * NH + (cc >> 6)) * Tc + t) * HD + (cc & 63);
                            *(f32x4*)op = acc[ai][bj][m][0]; *(f32x4*)(op + 4) = acc[ai][bj][m][1]; } } }
        } else if (u.pn == 14) {
#pragma unroll
            for (int ai = 0; ai < 2; ++ai)
#pragma unroll
                for (int m = 0; m < 4; ++m) { float* rp = small + (size_t)(row0 + ai * 128 + m * 16) * NSM + cw;
#pragma unroll
                    for (int bj = 0; bj < 2; ++bj) { *(f32x4*)(rp + bj * 128) = acc[ai][bj][m][0]; *(f32x4*)(rp + bj * 128 + 4) = acc[ai][bj][m][1]; } }
        } else {
#pragma unroll
            for (int ai = 0; ai < 2; ++ai)
#pragma unroll
                for (int m = 0; m < 4; ++m) { unsigned char* rp = gates + (size_t)(row0 + ai * 128 + m * 16) * NGATE + (u.pn - 15) * 256 + cw;
#pragma unroll
                    for (int bj = 0; bj < 2; ++bj) { const f32x4 a = acc[ai][bj][m][0], b = acc[ai][bj][m][1]; u32x2 w;
                        w.x = gq(a[0]) | (gq(a[1]) << 8) | (gq(a[2]) << 16) | (gq(a[3]) << 24); w.y = gq(b[0]) | (gq(b[1]) << 8) | (gq(b[2]) << 16) | (gq(b[3]) << 24);
                        *(u32x2*)(rp + bj * 128) = w; } }
        }
    }
};
struct EpiWiden {
    static constexpr bool MID = true;
    const unsigned char* gates; bf16_t* merged;
    __device__ __forceinline__ void mid(AccT& acc, const pg8::Unit& u, int z1, int wr, int wc, int fr, int fq) const {
        const int row0 = opqv(u.pm * 256 + wr * 64 + fr), col0 = opqv(u.pn * 256 + wc * 32 + 8 * fq);
#pragma unroll
        for (int ai = 0; ai < 2; ++ai)
#pragma unroll
            for (int m = 0; m < 4; ++m) { const unsigned char* rp = gates + (size_t)(row0 + ai * 128 + m * 16) * NGATE + col0;
#pragma unroll
                for (int bj = 0; bj < 2; ++bj) { const u32x2 a = *(const u32x2*)(rp + (z1 - 1) * 1024 + bj * 128), b = *(const u32x2*)(rp + z1 * 1024 + bj * 128);
                    f32x4 r0, r1;
                    UNR for (int e = 0; e < 4; ++e) { r0[e] = ub(a.x, e) * frcp(ub(b.x, e)); r1[e] = ub(a.y, e) * frcp(ub(b.y, e)); }
                    acc[ai][bj][m][0] *= r0; acc[ai][bj][m][1] *= r1;
#ifndef CPU_EMU
                    asm volatile("" ::: "memory");
#endif
                } }
    }
    __device__ __forceinline__ void operator()(const AccT& acc, const pg8::Unit& u, int wr, int wc, int fr, int fq) const {
        const int row0 = u.pm * 256 + wr * 64 + fr, col0 = u.pn * 256 + wc * 32 + 8 * fq;
#pragma unroll
        for (int ai = 0; ai < 2; ++ai)
#pragma unroll
            for (int m = 0; m < 4; ++m) { const size_t ro = (size_t)(row0 + ai * 128 + m * 16);
#pragma unroll
                for (int bj = 0; bj < 2; ++bj) { const u32x2 b = *(const u32x2*)(gates + ro * NGATE + 3 * 1024 + col0 + bj * 128); f32x4 a0 = acc[ai][bj][m][0], a1 = acc[ai][bj][m][1];
                    UNR for (int e = 0; e < 4; ++e) { a0[e] *= ub(b.x, e) * (1.0f / 255.0f); a1[e] *= ub(b.y, e) * (1.0f / 255.0f); }
                    *(u32x4*)(merged + ro * D + col0 + bj * 128) = pk8(a0, a1); } }
    }
};
struct EpiPreLN {
    static constexpr bool MID = false;
    const float* xa; const float* xb; const float* mods; float* v; int NTc, Tl;
    __device__ __forceinline__ void operator()(const AccT& acc, const pg8::Unit& u, int wr, int wc, int fr, int fq) const {
        const int row0 = u.pm * 256 + wr * 64 + fr, col0 = u.pn * 256 + wc * 32 + 8 * fq;
#pragma unroll
        for (int ai = 0; ai < 2; ++ai)
#pragma unroll
            for (int m = 0; m < 4; ++m) { const int row = row0 + ai * 128 + m * 16; const int mr = row < NTc ? 0 : 1 + (row - NTc) / Tl; const float* g1 = mods + (size_t)mr * NMOD + 2 * D + col0;
                const size_t ro = (size_t)row * D + col0; const float* x = row < NTc ? xa : xb;
#pragma unroll
                for (int bj = 0; bj < 2; ++bj)
#pragma unroll
                    for (int n = 0; n < 2; ++n) { const int o = bj * 128 + n * 4; const f32x4 xv = *(const f32x4*)(x + ro + o), gv = *(const f32x4*)(g1 + o);
                        *(f32x4*)(v + ro + o) = ALPHA * xv + gv * acc[ai][bj][m][n]; } }
    }
};
struct EpiSwiGLU {
    static constexpr bool MID = false;
    bf16_t* act;
    __device__ __forceinline__ void operator()(const AccT& acc, const pg8::Unit& u, int wr, int wc, int fr, int fq) const {
        const int row0 = u.pm * 256 + wr * 64 + fr, col0 = u.pn * 128 + wc * 32 + 8 * fq;
#pragma unroll
        for (int ai = 0; ai < 2; ++ai)
#pragma unroll
            for (int m = 0; m < 4; ++m) { bf16_t* rp = act + (size_t)(row0 + ai * 128 + m * 16) * FF + col0; f32x4 o[2];
#pragma unroll
                for (int n = 0; n < 2; ++n) { const f32x4 a = acc[ai][0][m][n], b = acc[ai][1][m][n]; o[n][0] = siluf_(a[0]) * b[0]; o[n][1] = siluf_(a[1]) * b[1]; o[n][2] = siluf_(a[2]) * b[2]; o[n][3] = siluf_(a[3]) * b[3]; }
                *(u32x4*)rp = pk8(o[0], o[1]); }
    }
};
struct EpiDown {
    static constexpr bool MID = false;
    const float* pgate; bf16_t* y;
    __device__ __forceinline__ void operator()(const AccT& acc, const pg8::Unit& u, int wr, int wc, int fr, int fq) const {
        const int row0 = u.pm * 256 + wr * 64 + fr, col0 = u.pn * 256 + wc * 32 + 8 * fq;
#pragma unroll
        for (int ai = 0; ai < 2; ++ai)
#pragma unroll
            for (int m = 0; m < 4; ++m) { const int row = row0 + ai * 128 + m * 16; const float gt = pgate[row]; bf16_t* rp = y + (size_t)row * D + col0;
#pragma unroll
                for (int bj = 0; bj < 2; ++bj) *(u32x4*)(rp + bj * 128) = pk8(gt * acc[ai][bj][m][0], gt * acc[ai][bj][m][1]); }
    }
};

template <class ColMap>
__device__ __forceinline__ void tr_item(const float* src, int src_ld, const ColMap& cm, bf16_t* dst, int dst_ld, int dst_koff, int n0, int k0, float* scr, int lane) {
    const int r = lane >> 4, c4 = (lane & 15) * 4; const int sc = cm(prow(n0 + c4));
    f32x4 v[16];
    UNR for (int i = 0; i < 16; ++i) v[i] = sc >= 0 ? *(const f32x4*)(src + (size_t)(k0 + i * 4 + r) * src_ld + sc) : (f32x4){0.f, 0.f, 0.f, 0.f};
    UNR for (int i = 0; i < 16; ++i) { float* p = scr + (i * 4 + r) * 65 + c4; p[0] = v[i][0]; p[1] = v[i][1]; p[2] = v[i][2]; p[3] = v[i][3]; }
    WAVE_SYNC();
    const int kc = lane & 7;
    UNR for (int j = 0; j < 8; ++j) { const int n = (lane >> 3) + 8 * j; const float* p = scr + (8 * kc) * 65 + n;
        u32x4 o; o.x = pk2(p[0 * 65], p[1 * 65]); o.y = pk2(p[2 * 65], p[3 * 65]); o.z = pk2(p[4 * 65], p[5 * 65]); o.w = pk2(p[6 * 65], p[7 * 65]);
        *(u32x4*)(dst + (size_t)(n0 + n) * dst_ld + dst_koff + k0 + 8 * kc) = o; }
    WAVE_SYNC();
}
struct CmId { __device__ __forceinline__ int operator()(int n) const { return n; } };
struct CmWin { __device__ __forceinline__ int operator()(int n) const { return win_col(n); } };
struct CmUp { __device__ __forceinline__ int operator()(int n) const { const int u = n >> 8, w = n & 255; return (w < 128 ? 0 : FF) + u * 128 + (w & 127); } };

#ifndef NCONV
#define NCONV 64
#endif
__device__ __forceinline__ void conv_weights(const Ctx& c, int l_lo, int l_hi, int part, int idx, int n) {
    const Dims& d = c.d;
    float* scr = (float*)c.lds + c.wave * 4160;
    const int I_IN = (D / 64) * (NINP / 64), I_BR = 4 * (MIXW / 64) * (D / 64), I_OUT = (D / 64) * (D / 64), I_UP = NEXP * (D / 64) * (2 * FF / 64), I_DN = NEXP * (FF / 64) * (D / 64);
    const int PER_S = I_IN + I_BR + I_OUT, PER_E = I_UP + I_DN;
    const int per = part ? PER_E : PER_S, total = (l_hi - l_lo) * per;
    for (int it = idx * NWAVES + c.wave; it < total; it += n * NWAVES) {
        const int l = l_lo + it / per; int r = it % per + (part ? PER_S : 0);
        if (r < I_IN) { const int nb = NINP / 64, kb = r / nb, n0 = (r % nb) * 64;
            tr_item(c.in(I_WIN) + (size_t)l * D * NIN, NIN, CmWin(), c.ws<bf16_t>(d.w_win) + (size_t)l * NINP * D, D, 0, n0, kb * 64, scr, c.lane); continue; } r -= I_IN;
        if (r < I_BR) { const int pr = (MIXW / 64) * (D / 64), z = r / pr, q = r % pr, kb = q / (D / 64), n0 = (q % (D / 64)) * 64;
            tr_item(c.in(I_WBR) + ((size_t)l * 4 + z) * MIXW * D, D, CmId(), c.ws<bf16_t>(d.w_wbr) + (size_t)l * D * D, D, z * MIXW, n0, kb * 64, scr, c.lane); continue; } r -= I_BR;
        if (r < I_OUT) { const int kb = r / (D / 64), n0 = (r % (D / 64)) * 64;
            tr_item(c.in(I_WOUT) + (size_t)l * D * D, D, CmId(), c.ws<bf16_t>(d.w_wout) + (size_t)l * D * D, D, 0, n0, kb * 64, scr, c.lane); continue; } r -= I_OUT;
        if (r < I_UP) { const int pr = (D / 64) * (2 * FF / 64), e = r / pr, q = r % pr, kb = q / (2 * FF / 64), n0 = (q % (2 * FF / 64)) * 64;
            tr_item(c.in(I_WUP) + ((size_t)l * NEXP + e) * D * 2 * FF, 2 * FF, CmUp(), c.ws<bf16_t>(d.w_wup) + ((size_t)l * NEXP + e) * 2 * FF * D, D, 0, n0, kb * 64, scr, c.lane); continue; } r -= I_UP;
        { const int pr = (FF / 64) * (D / 64), e = r / pr, q = r % pr, kb = q / (D / 64), n0 = (q % (D / 64)) * 64;
            tr_item(c.in(I_WDOWN) + ((size_t)l * NEXP + e) * FF * D, D, CmId(), c.ws<bf16_t>(d.w_wdn) + ((size_t)l * NEXP + e) * D * FF, FF, 0, n0, kb * 64, scr, c.lane); }
    }
}

__device__ __forceinline__ void phase_prep(const Ctx& c0) {
    const Ctx c = fresh(c0);
    const Dims& d = c.d;
    float* L = (float*)c.lds;
    const int nrow = 1 + d.Bl;
    const int gw = c.vcu * NWAVES + c.wave, NGW = c.G * NWAVES;
    const int nmod_items = DEPTH * (NMOD / 64);
    if (c.vcu < nmod_items) {
        const int l = c.vcu / (NMOD / 64), j = (c.vcu % (NMOD / 64)) * 64 + c.lane, kw = c.wave * 128;
        const float* w = c.in(I_WADA) + ((size_t)l * D + kw) * NMOD + j;
        float* cond = L + c.wave * 4160;
        for (int i = c.lane; i < 9 * 128; i += 64) { const int r = i >> 7, k = kw + (i & 127); const float v = r == 0 ? c.in(I_CCTX)[k] : (r < nrow ? c.in(I_C)[(size_t)(r - 1) * D + k] : 0.0f); cond[i] = siluf_(v); }
        WAVE_SYNC();
        float a[9];
        UNR for (int r = 0; r < 9; ++r) a[r] = 0.0f;
#pragma unroll 8
        for (int k = 0; k < 128; ++k) { const float wv = w[(size_t)k * NMOD]; UNR for (int r = 0; r < 9; ++r) a[r] += cond[r * 128 + k] * wv; }
        UNR for (int r = 0; r < 9; ++r) cond[1152 + r * 64 + c.lane] = a[r];
        __syncthreads();
        if (c.wave == 0) { const float bias = c.in(I_BADA)[(size_t)l * NMOD + j]; float* mo = c.ws<float>(d.w_mods) + (size_t)l * nrow * NMOD + j;
            UNR for (int r = 0; r < 9; ++r) { float t = bias; UNR for (int ww = 0; ww < 8; ++ww) t += L[ww * 4160 + 1152 + r * 64 + c.lane]; if (r < nrow) mo[(size_t)r * NMOD] = t; } }
        __syncthreads();
    }
    conv_weights(c, 0, DEPTH, 0, c.vcu, c.G);
}

__device__ __forceinline__ void phase_init(const Ctx& c0) {
    const Ctx c = fresh(c0);
    const Dims& d = c.d; const float* mods = c.mods(0); bf16_t* hb = c.ws<bf16_t>(d.w_hb);
    const int gw = c.vcu * NWAVES + c.wave, NGW = c.G * NWAVES;
    for (int tok = gw; tok < d.NT; tok += NGW) {
        const float* xr = tok < d.NTc ? c.in(I_XP) + (size_t)tok * D : c.in(I_XS) + (size_t)(tok - d.NTc) * D;
        const float* mr = mods + (size_t)c.modrow(tok) * NMOD;
#pragma unroll
        for (int j = 0; j < 4; ++j) { const int col = 4 * c.lane + 256 * j; const f32x4 x = *(const f32x4*)(xr + col), sh = *(const f32x4*)(mr + col), sc = *(const f32x4*)(mr + D + col);
            const f32x4 h = x * (1.0f + sc) + sh;
            u32x2 w; w.x = pk2(h[0], h[1]); w.y = pk2(h[2], h[3]); *(u32x2*)(hb + (size_t)tok * D + col) = w; }
    }
}

__device__ __forceinline__ f32x16 mm32(int lane, f32x16 acc, const float* A, int sai, int sak, const float* Bm, int sbk, int sbj, int K) {
    const int i = lane & 31, kk = lane >> 5;
    const float* ap = A + i * sai + kk * sak; const float* bp = Bm + kk * sbk + i * sbj;
#pragma unroll 8
    for (int k = 0; k < K; k += 2) acc = __builtin_amdgcn_mfma_f32_32x32x2f32(ap[k * sak], bp[k * sbk], acc, 0, 0, 0);
    return acc;
}
__device__ __forceinline__ f32x16 mmb(int lane, f32x16 acc, const bf16_t* A, int sa, const bf16_t* Bt, int sb, int K) {
    const bf16_t* ap = A + (lane & 31) * sa + 8 * (lane >> 5); const bf16_t* bp = Bt + (lane & 31) * sb + 8 * (lane >> 5);
    for (int k = 0; k < K; k += 16) acc = __builtin_amdgcn_mfma_f32_32x32x16_bf16(*(const bf16x8*)(ap + k), *(const bf16x8*)(bp + k), acc, 0, 0, 0);
    return acc;
}
__device__ __forceinline__ int tsw(int row, int col) { return row * 72 + ((col + 8 * ((row >> 3) & 7)) & 63); }
template <bool SWA, bool SWB>
__device__ __forceinline__ f32x16 mmb64(int lane, f32x16 acc, const bf16_t* A, int arow0, const bf16_t* Bt, int brow0) {
    const int ra = arow0 + (lane & 31), rb = brow0 + (lane & 31), h8 = 8 * (lane >> 5), sa = SWA ? 8 * ((ra >> 3) & 7) : 0, sb = SWB ? 8 * ((rb >> 3) & 7) : 0;
#pragma unroll
    for (int k = 0; k < 64; k += 16) acc = __builtin_amdgcn_mfma_f32_32x32x16_bf16(*(const bf16x8*)(A + ra * 72 + ((h8 + k + sa) & 63)), *(const bf16x8*)(Bt + rb * 72 + ((h8 + k + sb) & 63)), acc, 0, 0, 0);
    return acc;
}
#define ACC_ROW(r, lane) (((r) & 3) + 8 * ((r) >> 2) + 4 * ((lane) >> 5))
__device__ __forceinline__ f32x16 zero16() { f32x16 z; UNR for (int r = 0; r < 16; ++r) z[r] = 0.0f; return z; }
constexpr int S65 = 65, MSZ = 64 * 65;

__device__ __forceinline__ void build_rope(float* cosT, float* sinT, int tid) {
    for (int i = tid; i < 1024; i += NTHREADS) { const int pos = i >> 4, f = i & 15; const float inv = powf(10000.0f, -(float)f / 16.0f); const float ang = (float)pos * inv; cosT[i] = cosf(ang); sinT[i] = sinf(ang); }
}
__device__ __forceinline__ float rope_elem(const float* rowp, int dd, int t, const float* cosT, const float* sinT) {
    const int f = dd & 15, second = (dd >> 4) & 1, pos = (dd < 32) ? (t / GRIDW) : (t % GRIDW);
    const float x = rowp[dd], xp = rowp[second ? dd - 16 : dd + 16], cs = cosT[pos * 16 + f], sn = sinT[pos * 16 + f];
    return second ? (xp * sn + x * cs) : (x * cs - xp * sn);
}

constexpr int SL_MF = 0, SL_MB = 1, SL_GF = 2, SL_GB = 3, SL_RF = 4, SL_RB = 5, SL_RBONUS = 6, NSLOT = 7;

struct ChunkRegs { u32x4 q, qp, k, kp, v; };
__device__ __forceinline__ float bfel(const u32x4 w, int e) { const unsigned x = w[e >> 1]; return (e & 1) ? bfhi(x) : bflo(x); }
__device__ __forceinline__ void chunk_load(ChunkRegs& R, const bf16_t* cols, size_t tok0, int T, int dir, int ci, int h, int cbq, int tid) {
    const int j = tid >> 3, g = tid & 7, t = dir ? T - 1 - (ci * 64 + j) : ci * 64 + j; const bf16_t* rp = cols + (tok0 + t) * NCB + cbq * 256 + h * 64;
    R.q = *(const u32x4*)(rp + 8 * g); R.qp = *(const u32x4*)(rp + 8 * (g ^ 2)); R.k = *(const u32x4*)(rp + 256 + 8 * g); R.kp = *(const u32x4*)(rp + 256 + 8 * (g ^ 2)); R.v = *(const u32x4*)(rp + 512 + 8 * g);
}
__device__ __forceinline__ void chunk_store(const ChunkRegs& R, float* Q, float* K, float* V, int T, int dir, int ci, int pass, float qs, float ks, const float* cosT, const float* sinT, int tid) {
    const int j = tid >> 3, g = tid & 7, t = dir ? T - 1 - (ci * 64 + j) : ci * 64 + j, second = (g >> 1) & 1, pos = g < 4 ? (t / GRIDW) : (t % GRIDW), o = j * S65 + 8 * g;
    UNR for (int e = 0; e < 8; ++e) { float q = bfel(R.q, e), k = bfel(R.k, e);
        if (pass) { const float qp = bfel(R.qp, e), kp = bfel(R.kp, e), cs = cosT[pos * 16 + 8 * (g & 1) + e], sn = sinT[pos * 16 + 8 * (g & 1) + e];
            q = second ? qp * sn + q * cs : q * cs - qp * sn; k = second ? kp * sn + k * cs : k * cs - kp * sn; }
        Q[o + e] = q * qs; K[o + e] = k * ks; V[o + e] = bfel(R.v, e); }
}

__device__ __forceinline__ void chunk_store_ml(const ChunkRegs& R, float* Q, float* K, bf16_t* Qb, bf16_t* Kb, bf16_t* VbT, int T, int dir, int ci, int pass, const float* cosT, const float* sinT, int tid) {
    const int j = tid >> 3, g = tid & 7, t = dir ? T - 1 - (ci * 64 + j) : ci * 64 + j, second = (g >> 1) & 1, pos = g < 4 ? (t / GRIDW) : (t % GRIDW), o = j * S65 + 8 * g;
    float qv[8], kv[8];
    UNR for (int e = 0; e < 8; ++e) { float q = bfel(R.q, e), k = bfel(R.k, e);
        if (pass) { const float qp = bfel(R.qp, e), kp = bfel(R.kp, e), cs = cosT[pos * 16 + 8 * (g & 1) + e], sn = sinT[pos * 16 + 8 * (g & 1) + e];
            q = second ? qp * sn + q * cs : q * cs - qp * sn; k = second ? kp * sn + k * cs : k * cs - kp * sn; }
        qv[e] = q; kv[e] = k * 0.125f; Q[o + e] = qv[e]; K[o + e] = kv[e]; }
    u32x4 w; w.x = cvtpk(qv[0], qv[1]); w.y = cvtpk(qv[2], qv[3]); w.z = cvtpk(qv[4], qv[5]); w.w = cvtpk(qv[6], qv[7]); *(u32x4*)(Qb + j * 72 + 8 * g) = w;
    w.x = cvtpk(kv[0], kv[1]); w.y = cvtpk(kv[2], kv[3]); w.z = cvtpk(kv[4], kv[5]); w.w = cvtpk(kv[6], kv[7]); *(u32x4*)(Kb + j * 72 + 8 * g) = w;
    UNR for (int e = 0; e < 8; ++e) VbT[tsw(8 * g + e, j)] = (bf16_t)(R.v[e >> 1] >> (16 * (e & 1)));
}
__device__ __forceinline__ void mix_mlstm(const Ctx& c0, int l, int pass, int b, int h, int dir) {
    const Ctx c = fresh(c0);
    const Dims& d = c.d; const int T = pass ? d.Tl : d.Tc, nc = T / 64, tid = c.tid, lane = c.lane, wave = c.wave; const size_t tok0 = pass ? d.NTc + (size_t)b * d.Tl : (size_t)b * d.Tc;
    float* L = (float*)c.lds;
    float *Q = L, *K = L + MSZ, *C = L + 2 * MSZ, *Sm = L + 3 * MSZ, *QC = L + 4 * MSZ, *vec = L + 5 * MSZ;
    float *nv = vec, *ig = vec + 64, *lf = vec + 128, *bc = vec + 192, *lw = vec + 256, *wint = vec + 320, *rden = vec + 384, *scal = vec + 448, *npart = vec + 512, *cosT = vec + 1024, *sinT = vec + 2048, *ksv = vec + 3072;
    bf16_t* Bb = (bf16_t*)(vec + 3200); bf16_t *Qb = Bb, *Kb = Bb + 64 * 72, *VbT = Bb + 2 * 64 * 72, *CbT = Bb + 3 * 64 * 72, *Smb = Bb + 4 * 64 * 72, *KsT = Bb + 5 * 64 * 72;
    const bf16_t* cols = c.ws<bf16_t>(d.w_cols); const float* small = c.ws<float>(d.w_small); bf16_t* scr = c.ws<bf16_t>(d.w_scr);
    __syncthreads();
    if (pass) build_rope(cosT, sinT, tid);
    if (pass) { const float* C0 = c.in(I_SC) + ((((size_t)b * DEPTH + l) * 2 + dir) * NH + h) * HD * HD;
        _Pragma("unroll 2") for (int i = tid; i < 4096; i += NTHREADS) { const float cv = C0[i]; C[(i >> 6) * S65 + (i & 63)] = cv; CbT[(i & 63) * 72 + (i >> 6)] = (bf16_t)f2bf(cv); }
        if (tid < 64) nv[tid] = c.in(I_SN)[((((size_t)b * DEPTH + l) * 2 + dir) * NH + h) * HD + tid];
        if (tid == 0) scal[0] = c.in(I_SM)[(((size_t)b * DEPTH + l) * 2 + dir) * NH + h];
    } else { _Pragma("unroll 2") for (int i = tid; i < 4096; i += NTHREADS) { C[(i >> 6) * S65 + (i & 63)] = 0.0f; CbT[(i & 63) * 72 + (i >> 6)] = 0; } if (tid < 64) nv[tid] = 0.0f; if (tid == 0) scal[0] = 0.0f; }
    const float big = c.in(I_BIG)[((size_t)l * 2 + dir) * NH + h], bfg = c.in(I_BFG)[((size_t)l * 2 + dir) * NH + h];
    ChunkRegs R; float rig = 0.0f, rlf = 0.0f;
    chunk_load(R, cols, tok0, T, dir, 0, h, CB_MQ, tid);
    if (tid < 64) { const int t = dir ? T - 1 - tid : tid; const float* rp = small + (tok0 + t) * NSM; rig = rp[SM_MI + dir * 4 + h]; rlf = rp[SM_MF + dir * 4 + h]; }
    __syncthreads();
    chunk_store_ml(R, Q, K, Qb, Kb, VbT, T, dir, 0, pass, cosT, sinT, tid);
    if (tid < 64) { ig[tid] = rig + big; lf[tid] = logsigmoidf_(rlf + bfg); }
    for (int ci = 0; ci < nc; ++ci) {
        const int tid_ = opqv(tid), lane_ = tid_ & 63;
        if (ci + 1 < nc) {
            chunk_load(R, cols, tok0, T, dir, ci + 1, h, CB_MQ, tid_);
            if (tid_ < 64) { const int t = dir ? T - 1 - ((ci + 1) * 64 + tid_) : (ci + 1) * 64 + tid_; const float* rp = small + (tok0 + t) * NSM; rig = rp[SM_MI + dir * 4 + h]; rlf = rp[SM_MF + dir * 4 + h]; }
        }
        LDS_BARRIER();
        if (wave == 0) { float run = lf[lane_];
            UNR for (int o = 1; o < 64; o <<= 1) { const float up = __shfl(run, lane_ >= o ? lane_ - o : lane_); run += lane_ >= o ? up : 0.0f; }
            const float bend = __shfl(run, 63), m = scal[0], w = bend - run + ig[lane_]; float mx = w;
            mx = fmaxf(mx, x1(mx)); mx = fmaxf(mx, x2(mx)); mx = fmaxf(mx, x4m(mx)); mx = fmaxf(mx, x8m(mx)); mx = fmaxf(mx, __shfl_xor(mx, 16)); mx = fmaxf(mx, __shfl_xor(mx, 32));
            const float mnew = fmaxf(bend + m, mx); bc[lane_] = run; lw[lane_] = w; if (lane_ == 0) { scal[1] = mnew; scal[2] = fexp(bend + m - mnew); } }
        { const int ti = (wave >> 1) & 1, tj = wave & 1; f32x16 acc = zero16();
          if (wave < 4) { acc = mmb(lane_, acc, Qb + ti * 32 * 72, 72, Kb + tj * 32 * 72, 72, 64); UNR for (int r = 0; r < 16; ++r) Sm[(ti * 32 + ACC_ROW(r, lane_)) * S65 + tj * 32 + (lane_ & 31)] = acc[r]; }
          else { acc = mmb(lane_, acc, Qb + ti * 32 * 72, 72, CbT + tj * 32 * 72, 72, 64); UNR for (int r = 0; r < 16; ++r) QC[(ti * 32 + ACC_ROW(r, lane_)) * S65 + tj * 32 + (lane_ & 31)] = acc[r]; } }
        LDS_BARRIER();
        { const int t = tid_ >> 3, g = tid_ & 7; const float m = scal[0], mnew = scal[1], bt = bc[t]; float mx = -3.0e38f;
          UNR for (int e = 0; e < 8; ++e) { const int s = g * 8 + e; if (s <= t) mx = fmaxf(mx, bt - bc[s] + ig[s]); }
          mx = fmaxf(mx, x1(mx)); mx = fmaxf(mx, x2(mx)); mx = fmaxf(mx, x4m(mx));
          const float minter = bt + m, mt = fmaxf(minter, mx); float den = 0.0f, qn = 0.0f, sv[8];
          UNR for (int e = 0; e < 8; ++e) { const int s = g * 8 + e; sv[e] = 0.0f; if (s <= t) sv[e] = Sm[t * S65 + s] * fexp(bt - bc[s] + ig[s] - mt); den += sv[e]; qn += Q[t * S65 + s] * nv[s]; }
          { u32x4 w; w.x = cvtpk(sv[0], sv[1]); w.y = cvtpk(sv[2], sv[3]); w.z = cvtpk(sv[4], sv[5]); w.w = cvtpk(sv[6], sv[7]); *(u32x4*)(Smb + t * 72 + 8 * g) = w; }
          den += x1(den); den += x2(den); den += x4m(den); qn += x1(qn); qn += x2(qn); qn += x4m(qn);
          const float wi = fexp(minter - mt); den += wi * qn;
          const float ks = fexp(lw[t] - mnew);
          if (g == 0) { wint[t] = wi; rden[t] = 1.0f / fmaxf(fabsf(den), fexp(-mt)); ksv[t] = ks; }
          UNR for (int e = 0; e < 8; ++e) KsT[tsw(g * 8 + e, t)] = (bf16_t)f2bf(K[t * S65 + g * 8 + e] * ks); }
        LDS_BARRIER();
        { const int ti = (wave >> 1) & 1, tj = wave & 1;
          if (wave < 4) { f32x16 acc = zero16(); acc = mmb64<false, true>(lane_, acc, Smb, ti * 32, VbT, tj * 32);
              UNR for (int r = 0; r < 16; ++r) { const int row = ti * 32 + ACC_ROW(r, lane_), o = row * S65 + tj * 32 + (lane_ & 31); QC[o] = (acc[r] + wint[row] * QC[o]) * rden[row]; } }
          else { const float carry = scal[2]; f32x16 acc; UNR for (int r = 0; r < 16; ++r) acc[r] = carry * C[(ti * 32 + ACC_ROW(r, lane_)) * S65 + tj * 32 + (lane_ & 31)];
              acc = mmb64<true, true>(lane_, acc, KsT, ti * 32, VbT, tj * 32);
              UNR for (int r = 0; r < 16; ++r) C[(ti * 32 + ACC_ROW(r, lane_)) * S65 + tj * 32 + (lane_ & 31)] = acc[r];
              UNR for (int q4 = 0; q4 < 4; ++q4) { u32x2 w; w.x = cvtpk(acc[4 * q4], acc[4 * q4 + 1]); w.y = cvtpk(acc[4 * q4 + 2], acc[4 * q4 + 3]); *(u32x2*)(CbT + (tj * 32 + (lane_ & 31)) * 72 + ti * 32 + 8 * q4 + 4 * (lane_ >> 5)) = w; } }
          float s = 0.0f; UNR for (int e = 0; e < 8; ++e) s += K[(wave * 8 + e) * S65 + lane_] * ksv[wave * 8 + e]; npart[wave * 64 + lane_] = s; }
        LDS_BARRIER();
        if (tid_ < 64) { float s = 0.0f; UNR for (int e = 0; e < 8; ++e) s += npart[e * 64 + tid_]; nv[tid_] = scal[2] * nv[tid_] + s; }
        { const int j = tid_ >> 3, g = tid_ & 7, t = dir ? T - 1 - (ci * 64 + j) : ci * 64 + j; bf16_t* sp = scr + ((tok0 + t) * NSLOT + (dir ? SL_MB : SL_MF)) * MIXW + h * 64 + g * 8; const float* hp = QC + j * S65 + g * 8;
          u32x4 w; w.x = cvtpk(hp[0], hp[1]); w.y = cvtpk(hp[2], hp[3]); w.z = cvtpk(hp[4], hp[5]); w.w = cvtpk(hp[6], hp[7]); *(u32x4*)sp = w; }
        if (ci + 1 < nc) { chunk_store_ml(R, Q, K, Qb, Kb, VbT, T, dir, ci + 1, pass, cosT, sinT, tid_); if (tid_ < 64) { ig[tid_] = rig + big; lf[tid_] = logsigmoidf_(rlf + bfg); } }
        if (tid_ == 0) scal[0] = scal[1];
    }
    LDS_BARRIER();
    if (!pass) {
        float* Co = c.p->out + d.o_C + ((((size_t)b * DEPTH + l) * 2 + dir) * NH + h) * HD * HD;
        _Pragma("unroll 2") for (int i = tid; i < 4096; i += NTHREADS) Co[i] = C[(i >> 6) * S65 + (i & 63)];
        if (tid < 64) c.p->out[d.o_n + ((((size_t)b * DEPTH + l) * 2 + dir) * NH + h) * HD + tid] = nv[tid];
        if (tid == 0) c.p->out[d.o_m + (((size_t)b * DEPTH + l) * 2 + dir) * NH + h] = scal[0];
    }
    __syncthreads();
}

__device__ __forceinline__ void chunk_store_gl(const ChunkRegs& R, float* Q, float* K, bf16_t* VbT, int T, int dir, int ci, int pass, const float* cosT, const float* sinT, int tid) {
    const int j = tid >> 3, g = tid & 7, t = dir ? T - 1 - (ci * 64 + j) : ci * 64 + j, second = (g >> 1) & 1, pos = g < 4 ? (t / GRIDW) : (t % GRIDW), o = j * S65 + 8 * g;
    UNR for (int e = 0; e < 8; ++e) { float q = bfel(R.q, e), k = bfel(R.k, e);
        if (pass) { const float qp = bfel(R.qp, e), kp = bfel(R.kp, e), cs = cosT[pos * 16 + 8 * (g & 1) + e], sn = sinT[pos * 16 + 8 * (g & 1) + e];
            q = second ? qp * sn + q * cs : q * cs - qp * sn; k = second ? kp * sn + k * cs : k * cs - kp * sn; }
        Q[o + e] = q * 0.125f; K[o + e] = k; }
    UNR for (int e = 0; e < 8; ++e) VbT[tsw(8 * g + e, j)] = (bf16_t)(R.v[e >> 1] >> (16 * (e & 1)));
}
__device__ __forceinline__ void mix_gla(const Ctx& c0, int l, int pass, int b, int h, int dir) {
    const Ctx c = fresh(c0);
    const Dims& d = c.d; const int T = pass ? d.Tl : d.Tc, nc = T / 64, tid = c.tid, lane = c.lane, wave = c.wave; const size_t tok0 = pass ? d.NTc + (size_t)b * d.Tl : (size_t)b * d.Tc;
    float* L = (float*)c.lds;
    float *Q = L, *K = L + MSZ, *S = L + 2 * MSZ, *O2 = L + 3 * MSZ, *vec = L + 4 * MSZ;
    float *gend = vec, *bA = vec + 64, *gpart = vec + 128, *GA = vec + 640, *wA = vec + 640 + 1024, *cosT = vec + 640 + 2048, *sinT = vec + 640 + 3072;
    bf16_t* Bb = (bf16_t*)(vec + 4736); bf16_t *Qb = Bb, *Kb = Bb + 64 * 72, *KbT = Bb + 2 * 64 * 72, *VbT = Bb + 3 * 64 * 72, *SbT = Bb + 4 * 64 * 72, *Ab = Bb + 5 * 64 * 72;
    const bf16_t* cols = c.ws<bf16_t>(d.w_cols); const float* small = c.ws<float>(d.w_small); bf16_t* scr = c.ws<bf16_t>(d.w_scr);
    __syncthreads();
    if (pass) build_rope(cosT, sinT, tid);
    if (pass) { const float* S0 = c.in(I_SG) + ((((size_t)b * DEPTH + l) * 2 + dir) * NH + h) * HD * HD; _Pragma("unroll 2") for (int i = tid; i < 4096; i += NTHREADS) { const float sv = S0[i]; S[(i >> 6) * S65 + (i & 63)] = sv; SbT[(i & 63) * 72 + (i >> 6)] = (bf16_t)f2bf(sv); } }
    else { _Pragma("unroll 2") for (int i = tid; i < 4096; i += NTHREADS) { S[(i >> 6) * S65 + (i & 63)] = 0.0f; SbT[(i & 63) * 72 + (i >> 6)] = 0; } }
    for (int i = tid; i < 1024; i += NTHREADS) wA[i] = c.in(I_WGLA)[(((size_t)l * 2 + dir) * 16 + (i >> 6)) * MIXW + h * 64 + (i & 63)];
    if (tid < 64) bA[tid] = c.in(I_BGLA)[((size_t)l * 2 + dir) * MIXW + h * 64 + tid];
    ChunkRegs R; f32x4 rga = (f32x4){0.f, 0.f, 0.f, 0.f};
    chunk_load(R, cols, tok0, T, dir, 0, h, CB_GQ, tid);
    if (tid < 256) { const int j = tid >> 2, t = dir ? T - 1 - j : j; rga = *(const f32x4*)(small + (tok0 + t) * NSM + SM_GA + dir * 16 + (tid & 3) * 4); }
    __syncthreads();
    chunk_store_gl(R, Q, K, VbT, T, dir, 0, pass, cosT, sinT, tid);
    if (tid < 256) *(f32x4*)(GA + (tid >> 2) * 16 + (tid & 3) * 4) = rga;
    for (int ci = 0; ci < nc; ++ci) {
        const int tid_ = opqv(tid), lane_ = tid_ & 63;
        if (ci + 1 < nc) {
            chunk_load(R, cols, tok0, T, dir, ci + 1, h, CB_GQ, tid_);
            if (tid_ < 256) { const int j = tid_ >> 2, t = dir ? T - 1 - ((ci + 1) * 64 + j) : (ci + 1) * 64 + j; rga = *(const f32x4*)(small + (tok0 + t) * NSM + SM_GA + dir * 16 + (tid_ & 3) * 4); }
        }
        LDS_BARRIER();
        float gl[8];
        { float run = 0.0f;
          UNR for (int e = 0; e < 8; ++e) { const float* ga = GA + (wave * 8 + e) * 16; float a = bA[lane_];
              UNR for (int r = 0; r < 16; ++r) a += ga[r] * wA[r * 64 + lane_];
              run += logsigmoidf_(a) * (1.0f / 16.0f); gl[e] = run; }
          gpart[wave * 64 + lane_] = run; }
        LDS_BARRIER();
        { float pre = 0.0f; UNR for (int e = 0; e < 8; ++e) pre += (e < wave) ? gpart[e * 64 + lane_] : 0.0f;
          float kv8[8];
          UNR for (int e = 0; e < 8; ++e) { const float g = gl[e] + pre; const int row = wave * 8 + e; const float qv = Q[row * S65 + lane_] * fexp(g); kv8[e] = K[row * S65 + lane_] * fexp(-g);
              Qb[row * 72 + lane_] = (bf16_t)f2bf(qv); Kb[row * 72 + lane_] = (bf16_t)f2bf(kv8[e]); if (wave == 7 && e == 7) gend[lane_] = g; }
          { u32x4 w; w.x = cvtpk(kv8[0], kv8[1]); w.y = cvtpk(kv8[2], kv8[3]); w.z = cvtpk(kv8[4], kv8[5]); w.w = cvtpk(kv8[6], kv8[7]); *(u32x4*)(KbT + lane_ * 72 + 8 * wave) = w; } }
        LDS_BARRIER();
        { const int ti = (wave >> 1) & 1, tj = wave & 1; f32x16 acc = zero16();
          if (wave < 4) { acc = mmb(lane_, acc, Qb + ti * 32 * 72, 72, Kb + tj * 32 * 72, 72, 64);
              UNR for (int r = 0; r < 16; ++r) { const int row = ti * 32 + ACC_ROW(r, lane_), col = tj * 32 + (lane_ & 31); Ab[row * 72 + col] = (bf16_t)f2bf(col <= row ? acc[r] : 0.0f); } }
          else { acc = mmb(lane_, acc, Qb + ti * 32 * 72, 72, SbT + tj * 32 * 72, 72, 64); UNR for (int r = 0; r < 16; ++r) O2[(ti * 32 + ACC_ROW(r, lane_)) * S65 + tj * 32 + (lane_ & 31)] = acc[r]; } }
        LDS_BARRIER();
        { const int ti = (wave >> 1) & 1, tj = wave & 1;
          if (wave < 4) { f32x16 acc; UNR for (int r = 0; r < 16; ++r) acc[r] = O2[(ti * 32 + ACC_ROW(r, lane_)) * S65 + tj * 32 + (lane_ & 31)];
              acc = mmb64<false, true>(lane_, acc, Ab, ti * 32, VbT, tj * 32);
              UNR for (int r = 0; r < 16; ++r) O2[(ti * 32 + ACC_ROW(r, lane_)) * S65 + tj * 32 + (lane_ & 31)] = acc[r]; }
          else { f32x16 acc; UNR for (int r = 0; r < 16; ++r) acc[r] = S[(ti * 32 + ACC_ROW(r, lane_)) * S65 + tj * 32 + (lane_ & 31)];
              acc = mmb64<false, true>(lane_, acc, KbT, ti * 32, VbT, tj * 32);
              UNR for (int r = 0; r < 16; ++r) { const int kr = ti * 32 + ACC_ROW(r, lane_); acc[r] *= fexp(gend[kr]); S[kr * S65 + tj * 32 + (lane_ & 31)] = acc[r]; }
              UNR for (int q4 = 0; q4 < 4; ++q4) { u32x2 w; w.x = cvtpk(acc[4 * q4], acc[4 * q4 + 1]); w.y = cvtpk(acc[4 * q4 + 2], acc[4 * q4 + 3]); *(u32x2*)(SbT + (tj * 32 + (lane_ & 31)) * 72 + ti * 32 + 8 * q4 + 4 * (lane_ >> 5)) = w; } } }
        LDS_BARRIER();
        { const int j = tid_ >> 3, g = tid_ & 7, t = dir ? T - 1 - (ci * 64 + j) : ci * 64 + j; bf16_t* sp = scr + ((tok0 + t) * NSLOT + (dir ? SL_GB : SL_GF)) * MIXW + h * 64 + g * 8; const float* hp = O2 + j * S65 + g * 8;
          u32x4 w; w.x = cvtpk(hp[0], hp[1]); w.y = cvtpk(hp[2], hp[3]); w.z = cvtpk(hp[4], hp[5]); w.w = cvtpk(hp[6], hp[7]); *(u32x4*)sp = w; }
        if (ci + 1 < nc) { chunk_store_gl(R, Q, K, VbT, T, dir, ci + 1, pass, cosT, sinT, tid_); if (tid_ < 256) *(f32x4*)(GA + (tid_ >> 2) * 16 + (tid_ & 3) * 4) = rga; }
    }
    LDS_BARRIER();
    if (!pass) { float* So = c.p->out + d.o_g + ((((size_t)b * DEPTH + l) * 2 + dir) * NH + h) * HD * HD; _Pragma("unroll 2") for (int i = tid; i < 4096; i += NTHREADS) So[i] = S[(i >> 6) * S65 + (i & 63)]; }
    __syncthreads();
}

__device__ __forceinline__ void phase_rwprep(const Ctx& c0, int l) {
    const Ctx c = fresh(c0);
    const Dims& d = c.d; const int tid = c.tid, lane = c.lane, wave = c.wave;
    float* L = (float*)c.lds;
    float *TWs = L, *RAs = L + 2 * 64 * 33, *W2s = L + 4 * 64 * 33, *A2s = W2s + 4096, *LWo = A2s + 4096;
    const bf16_t* cols = c.ws<bf16_t>(d.w_cols); const float* small = c.ws<float>(d.w_small); float* vecs = c.ws<float>(d.w_vecs); bf16_t* scr = c.ws<bf16_t>(d.w_scr);
    for (int blk = c.vcu; blk < d.NT / 64; blk += c.G) {
        const int tb = blk * 64, pass = tb >= d.NTc, T = pass ? d.Tl : d.Tc, tl0 = (tb - (pass ? d.NTc : 0)) % T;
        __syncthreads();
        UNR for (int u = 0; u < 2; ++u) { const int i = tid + NTHREADS * u, j = i >> 4, r4 = (i & 15) * 4, dir = r4 >> 5, r = r4 & 31; const float* sp = small + (size_t)(tb + j) * NSM;
            const f32x4 rw = *(const f32x4*)(sp + SM_RW + r4), ra = *(const f32x4*)(sp + SM_RA + r4); float* tp = TWs + (dir * 64 + j) * 33 + r; float* ap = RAs + (dir * 64 + j) * 33 + r;
            tp[0] = tanhf_(rw[0]); tp[1] = tanhf_(rw[1]); tp[2] = tanhf_(rw[2]); tp[3] = tanhf_(rw[3]); ap[0] = ra[0]; ap[1] = ra[1]; ap[2] = ra[2]; ap[3] = ra[3]; }
        for (int h = 0; h < NH; ++h) {
            UNR for (int u = 0; u < 8; ++u) { const int i = tid + NTHREADS * u, dir = i >> 11, r = (i >> 6) & 31, cc = i & 63; const size_t o = (((size_t)l * 2 + dir) * 32 + r) * MIXW + h * 64 + cc; W2s[i] = c.in(I_WW2)[o]; A2s[i] = c.in(I_WA2)[o]; }
            __syncthreads();
            UNR for (int u = 0; u < 2; ++u) { const int job = wave * 2 + u, dir = job >> 3, kind = (job >> 2) & 1, ti = (job >> 1) & 1, tj = job & 1; f32x16 acc = zero16();
                acc = mm32(lane, acc, (kind ? RAs : TWs) + (dir * 64 + ti * 32) * 33, 33, 1, (kind ? A2s : W2s) + dir * 2048 + tj * 32, 64, 1, 32);
                float* lo = LWo + (dir * 2 + kind) * MSZ + (ti * 32) * S65 + tj * 32 + (lane & 31);
                UNR for (int r = 0; r < 16; ++r) lo[ACC_ROW(r, lane) * S65] = acc[r]; }
            __syncthreads();
            { const int j = tid >> 3, g = tid & 7, ch = h * 64 + 8 * g, tl = tl0 + j; const size_t tok = (size_t)tb + j;
              const bf16_t* rp = cols + tok * NCB + ch; const u32x4 z4 = (u32x4){0u, 0u, 0u, 0u};
              const u32x4 rm = tl > 0 ? *(const u32x4*)(rp - NCB + CB_RR * 256) : z4, r0 = *(const u32x4*)(rp + CB_RR * 256), rq = tl + 1 < T ? *(const u32x4*)(rp + NCB + CB_RR * 256) : z4;
              const u32x4 km = tl > 0 ? *(const u32x4*)(rp - NCB + CB_RK * 256) : z4, k0 = *(const u32x4*)(rp + CB_RK * 256), kq = tl + 1 < T ? *(const u32x4*)(rp + NCB + CB_RK * 256) : z4;
              const u32x4 vm = tl > 0 ? *(const u32x4*)(rp - NCB + CB_RV * 256) : z4, v0 = *(const u32x4*)(rp + CB_RV * 256), vq = tl + 1 < T ? *(const u32x4*)(rp + NCB + CB_RV * 256) : z4;
              const float* tp = c.in(I_SHIFT) + (size_t)l * 3 * 768 + ch;
              float rr[8], kk[8], vv[8], kp[8]; float ss = 0.0f, bn = 0.0f;
              UNR for (int e = 0; e < 8; ++e) {
                  rr[e] = tp[e] * bfel(rm, e) + tp[768 + e] * bfel(r0, e) + tp[1536 + e] * bfel(rq, e);
                  kk[e] = tp[256 + e] * bfel(km, e) + tp[768 + 256 + e] * bfel(k0, e) + tp[1536 + 256 + e] * bfel(kq, e);
                  vv[e] = tp[512 + e] * bfel(vm, e) + tp[768 + 512 + e] * bfel(v0, e) + tp[1536 + 512 + e] * bfel(vq, e);
                  kp[e] = kk[e] * c.in(I_KK)[(size_t)l * MIXW + ch + e]; ss += kp[e] * kp[e]; bn += rr[e] * kk[e] * c.in(I_RKK)[(size_t)l * MIXW + ch + e]; }
              ss = oct_sum(ss); bn = oct_sum(bn); const float rs = frsq(ss + LN_EPS);
              float* vp = vecs + (tok * NH + h) * 576 + 8 * g;
              UNR for (int e = 0; e < 8; ++e) kp[e] *= rs;
              *(f32x4*)(vp) = (f32x4){rr[0], rr[1], rr[2], rr[3]}; *(f32x4*)(vp + 4) = (f32x4){rr[4], rr[5], rr[6], rr[7]};
              *(f32x4*)(vp + 64) = (f32x4){kp[0], kp[1], kp[2], kp[3]}; *(f32x4*)(vp + 68) = (f32x4){kp[4], kp[5], kp[6], kp[7]};
              *(f32x4*)(vp + 128) = (f32x4){vv[0], vv[1], vv[2], vv[3]}; *(f32x4*)(vp + 132) = (f32x4){vv[4], vv[5], vv[6], vv[7]};
              { u32x4 w; w.x = cvtpk(bn * vv[0], bn * vv[1]); w.y = cvtpk(bn * vv[2], bn * vv[3]); w.z = cvtpk(bn * vv[4], bn * vv[5]); w.w = cvtpk(bn * vv[6], bn * vv[7]); *(u32x4*)(scr + (tok * NSLOT + SL_RBONUS) * MIXW + ch) = w; }
              UNR for (int dir = 0; dir < 2; ++dir) { float wv[8], ak[8], kh[8]; const float* lwp = LWo + (dir * 2) * MSZ + j * S65 + 8 * g; const float* lap = lwp + MSZ;
                  UNR for (int e = 0; e < 8; ++e) { const float w0c = c.in(I_W0)[((size_t)l * 2 + dir) * MIXW + ch + e], a0c = c.in(I_A0)[((size_t)l * 2 + dir) * MIXW + ch + e], kac = c.in(I_KA)[(size_t)l * MIXW + ch + e];
                      wv[e] = -fexp(-softplusf_(-(w0c + lwp[e])) - 0.5f);     const float a = sigmoidf_(a0c + lap[e]); ak[e] = a * kp[e]; kh[e] = kk[e] * (1.0f + (a - 1.0f) * kac); }
                  float* dp = vp + (3 + 3 * dir) * 64;
                  *(f32x4*)(dp) = (f32x4){wv[0], wv[1], wv[2], wv[3]}; *(f32x4*)(dp + 4) = (f32x4){wv[4], wv[5], wv[6], wv[7]};
                  *(f32x4*)(dp + 64) = (f32x4){ak[0], ak[1], ak[2], ak[3]}; *(f32x4*)(dp + 68) = (f32x4){ak[4], ak[5], ak[6], ak[7]};
                  *(f32x4*)(dp + 128) = (f32x4){kh[0], kh[1], kh[2], kh[3]}; *(f32x4*)(dp + 132) = (f32x4){kh[4], kh[5], kh[6], kh[7]}; } }
            __syncthreads();
        }
    }
}

template <int J> struct SolveCol {
    static __device__ __forceinline__ void run(float (&u)[32], const float* La, const f32x4 (&lc)[8]) {
        f32x4 ln[8];
#pragma unroll
        for (int t4 = (J + 2) / 4; t4 < 8; ++t4) ln[t4] = *(const f32x4*)(La + (J + 1) * 36 + 4 * t4);
        const float uj = u[J];
#pragma unroll
        for (int t4 = (J + 1) / 4; t4 < 8; ++t4) {
#pragma unroll
            for (int e = 0; e < 4; ++e) if (4 * t4 + e > J) u[4 * t4 + e] -= lc[t4][e] * uj; }
#ifndef CPU_EMU
        asm volatile("" ::: "memory");
#endif
        SolveCol<J + 1>::run(u, La, ln);
    }
};
template <> struct SolveCol<31> { static __device__ __forceinline__ void run(float (&)[32], const float*, const f32x4 (&)[8]) {} };
__device__ __forceinline__ void mix_rwkv(const Ctx& c0, int l, int pass, int b, int h, int dir) {
    const Ctx c = fresh(c0);
    const Dims& d = c.d; const int T = pass ? d.Tl : d.Tc, tid = c.tid, lane = c.lane, wave = c.wave; const size_t tok0 = pass ? d.NTc + (size_t)b * d.Tl : (size_t)b * d.Tc;
    unsigned char* LB = c.lds;
    constexpr int OPS = 4 * 4608 + 3 * 5120 + 512;
    float* Gp = (float*)(LB + 2 * OPS);
    bf16_t *Lk = (bf16_t*)(LB + 2 * OPS + 4096), *T3 = Lk + 32 * 40, *T4 = T3 + 32 * 40, *UT = T4 + 32 * 40;
    float* La = (float*)(LB + 2 * OPS + 4096 + 3 * 2560 + 5120);
    float* RHS = La + 32 * 36;
    bf16_t* Sb = (bf16_t*)(RHS + 32 * 65);
    const float* vecs = c.ws<float>(d.w_vecs); bf16_t* scr = c.ws<bf16_t>(d.w_scr);
    const int nck = T / 32, vt = (wave >> 1) & 1, kt = wave & 1, ql = lane & 31;
    const int nr = wave < 4 ? 5 : 4, r0 = wave < 4 ? 5 * wave : (wave == 4 ? 0 : 20 + 4 * (wave - 5)), gslot = wave < 4 ? wave : wave - 1;
    __syncthreads();
    f32x16 Sacc = zero16();
    if (wave < 4) {
        if (pass) { const float* S0 = c.in(I_SR) + ((((size_t)b * DEPTH + l) * 2 + dir) * NH + h) * HD * HD; UNR for (int r = 0; r < 16; ++r) Sacc[r] = S0[(32 * vt + ACC_ROW(r, lane)) * 64 + 32 * kt + ql]; }
        UNR for (int r = 0; r < 16; ++r) Sb[(32 * vt + ACC_ROW(r, lane)) * 72 + 32 * kt + ql] = (bf16_t)f2bf(Sacc[r]);
    }
    float rw[5][6];
#define RC_LOADRAW(m_) do { if (wave != 4) { UNR for (int e_ = 0; e_ < 5; ++e_) if (e_ < nr) { const int pi_ = (m_) * 32 + r0 + e_, t_ = dir ? T - 1 - pi_ : pi_; const float* vp_ = vecs + ((tok0 + t_) * NH + h) * 576 + lane; \
        rw[e_][0] = vp_[0]; rw[e_][1] = vp_[64]; rw[e_][2] = vp_[128]; rw[e_][3] = vp_[(3 + 3 * dir) * 64]; rw[e_][4] = vp_[(4 + 3 * dir) * 64]; rw[e_][5] = vp_[(5 + 3 * dir) * 64]; } } } while (0)
#define RC_S1A(m_, cs_) do { if (wave != 4) { float run_ = 0.0f; UNR for (int e_ = 0; e_ < 5; ++e_) if (e_ < nr) { run_ += rw[e_][3]; cs_[e_] = run_; } Gp[(((m_) & 1) * 8 + gslot) * 64 + lane] = run_; } } while (0)
#define RC_S1B(m_, cs_) do { if (wave != 4) { unsigned char* ob_ = LB + ((m_) & 1) * OPS; bf16_t *Km_ = (bf16_t*)ob_, *Am_ = Km_ + 32 * 72, *Hm_ = Am_ + 32 * 72, *Rm_ = Hm_ + 32 * 72, *AmT_ = Rm_ + 32 * 72, *HmT_ = AmT_ + 64 * 40, *VT_ = HmT_ + 64 * 40; float* ge_ = (float*)(VT_ + 64 * 40); \
        float pre_ = 0.0f; UNR for (int p_ = 0; p_ < 7; ++p_) pre_ += (p_ < gslot) ? Gp[(((m_) & 1) * 8 + p_) * 64 + lane] : 0.0f; \
        UNR for (int e_ = 0; e_ < 5; ++e_) if (e_ < nr) { const int i_ = r0 + e_; const float g_ = pre_ + cs_[e_], gp_ = e_ == 0 ? pre_ : pre_ + cs_[e_ - 1], eg_ = fexp(g_), eng_ = fexp(-g_); \
            const float kv_ = rw[e_][1] * fexp(gp_), av_ = rw[e_][4] * eng_, hv_ = rw[e_][5] * eng_, rv_ = rw[e_][0] * eg_; \
            Km_[i_ * 72 + lane] = (bf16_t)f2bf(kv_); Am_[i_ * 72 + lane] = (bf16_t)f2bf(av_); Hm_[i_ * 72 + lane] = (bf16_t)f2bf(hv_); Rm_[i_ * 72 + lane] = (bf16_t)f2bf(rv_); \
            AmT_[lane * 40 + i_] = (bf16_t)f2bf(av_); HmT_[lane * 40 + i_] = (bf16_t)f2bf(hv_); VT_[lane * 40 + i_] = (bf16_t)f2bf(rw[e_][2]); if (i_ == 31) ge_[lane] = g_; } } } while (0)
    float cs[5];
    RC_LOADRAW(0); RC_S1A(0, cs);
    __syncthreads();
    RC_S1B(0, cs);
    if (nck > 1) { RC_LOADRAW(1); }
    __syncthreads();
    for (int ck = 0; ck < nck; ++ck) {
        const int tid_ = opqv(tid), lane_ = tid_ & 63, ql_ = lane_ & 31;
        unsigned char* ob = LB + (ck & 1) * OPS; const bf16_t *Km = (const bf16_t*)ob, *Am = Km + 32 * 72, *Hm = Am + 32 * 72, *Rm = Hm + 32 * 72, *AmT = Rm + 32 * 72, *HmT = AmT + 64 * 40, *VT = HmT + 64 * 40; const float* gend = (const float*)(VT + 64 * 40);
        f32x16 pacc = zero16();
        if (wave < 4) { const bf16_t* A = (wave & 2) ? Rm : Km; const bf16_t* Bt = (wave & 1) ? Hm : Am; f32x16 m = zero16(); m = mmb(lane_, m, A, 72, Bt, 72, 64);
            UNR for (int r = 0; r < 16; ++r) { const int i = ACC_ROW(r, lane_), j = ql_;
                if (wave == 0) La[j * 36 + i] = j < i ? m[r] : 0.0f; else if (wave == 1) Lk[i * 40 + j] = (bf16_t)f2bf(j < i ? m[r] : 0.0f);
                else if (wave == 2) T3[i * 40 + j] = (bf16_t)f2bf(j <= i ? m[r] : 0.0f); else T4[i * 40 + j] = (bf16_t)f2bf(j <= i ? m[r] : 0.0f); } }
        else { pacc = mmb(lane_, pacc, (wave & 2) ? Rm : Km, 72, Sb + (32 * (wave & 1)) * 72, 72, 64); }
        LDS_BARRIER();
        if (wave == 4 || wave == 5) { pacc = mmb(lane_, pacc, Lk, 40, VT + (32 * (wave & 1)) * 40, 40, 32); UNR for (int r = 0; r < 16; ++r) RHS[ACC_ROW(r, lane_) * 65 + 32 * (wave & 1) + ql_] = -pacc[r]; }
        else if (wave >= 6) { pacc = mmb(lane_, pacc, T4, 40, VT + (32 * (wave & 1)) * 40, 40, 32); }
        if (ck + 1 < nck) RC_S1A(ck + 1, cs);
        LDS_BARRIER();
        if (wave == 4) { float u[32];
            UNR for (int t = 0; t < 32; ++t) u[t] = RHS[t * 65 + lane_];
            { f32x4 l0[8]; UNR for (int t4 = 0; t4 < 8; ++t4) l0[t4] = *(const f32x4*)(La + 4 * t4); SolveCol<0>::run(u, La, l0); }
            UNR for (int p = 0; p < 16; ++p) *(unsigned*)(UT + lane_ * 40 + 2 * p) = cvtpk(u[2 * p], u[2 * p + 1]); }
        else if (ck + 1 < nck) { RC_S1B(ck + 1, cs); if (ck + 2 < nck) { RC_LOADRAW(ck + 2); } }
        LDS_BARRIER();
        if (wave >= 6) { pacc = mmb(lane_, pacc, T3, 40, UT + (32 * (wave & 1)) * 40, 40, 32);
            UNR for (int r = 0; r < 16; ++r) { const int pi = ck * 32 + ACC_ROW(r, lane_), t = dir ? T - 1 - pi : pi; scr[((tok0 + t) * NSLOT + (dir ? SL_RB : SL_RF)) * MIXW + h * 64 + 32 * (wave & 1) + ql_] = (bf16_t)f2bf(pacc[r]); } }
        else if (wave < 4) { Sacc = mmb(lane_, Sacc, UT + (32 * vt) * 40, 40, AmT + (32 * kt) * 40, 40, 32); Sacc = mmb(lane_, Sacc, VT + (32 * vt) * 40, 40, HmT + (32 * kt) * 40, 40, 32);
            const float gs = fexp(gend[32 * kt + ql_]);
            UNR for (int r = 0; r < 16; ++r) { Sacc[r] *= gs; Sb[(32 * vt + ACC_ROW(r, lane_)) * 72 + 32 * kt + ql_] = (bf16_t)f2bf(Sacc[r]); } }
        LDS_BARRIER();
    }
#undef RC_LOADRAW
#undef RC_S1A
#undef RC_S1B
    if (!pass && wave < 4) { float* So = c.p->out + d.o_r + ((((size_t)b * DEPTH + l) * 2 + dir) * NH + h) * HD * HD; UNR for (int r = 0; r < 16; ++r) So[(32 * vt + ACC_ROW(r, lane)) * 64 + 32 * kt + ql] = Sacc[r]; }
    __syncthreads();
}

#define SCR8(p_, lo_, hi_) do { const u32x4 w_ = *(const u32x4*)(p_); lo_ = (f32x4){bflo(w_.x), bfhi(w_.x), bflo(w_.y), bfhi(w_.y)}; hi_ = (f32x4){bflo(w_.z), bfhi(w_.z), bflo(w_.w), bfhi(w_.w)}; } while (0)
__device__ __forceinline__ void phase_combine(const Ctx& c0, int l) {
    const Ctx c = fresh(c0);
    const Dims& d = c.d; const int tid = c.tid, lane = c.lane, wave = c.wave;
    float* L = (float*)c.lds; float *SG = L, *G2 = L + MSZ, *GT = L + MSZ + 64 * 256;
    const bf16_t* cols = c.ws<bf16_t>(d.w_cols); const float* small = c.ws<float>(d.w_small); const bf16_t* scr = c.ws<bf16_t>(d.w_scr); bf16_t* br = c.ws<bf16_t>(d.w_br);
    __syncthreads();
    for (int i = tid; i < 64 * 256; i += NTHREADS) G2[i] = c.in(I_WG2)[(size_t)l * 64 * MIXW + i];
    for (int blk = c.vcu; blk < d.NT / 64; blk += c.G) {
        const size_t tb = (size_t)blk * 64;
        __syncthreads();
        { const int j = tid >> 3, g = tid & 7; const float* rp = small + (tb + j) * NSM + SM_RG + g * 8; const f32x4 a = *(const f32x4*)rp, b2 = *(const f32x4*)(rp + 4); float* sp = SG + j * S65 + g * 8;
          sp[0] = sigmoidf_(a[0]); sp[1] = sigmoidf_(a[1]); sp[2] = sigmoidf_(a[2]); sp[3] = sigmoidf_(a[3]); sp[4] = sigmoidf_(b2[0]); sp[5] = sigmoidf_(b2[1]); sp[6] = sigmoidf_(b2[2]); sp[7] = sigmoidf_(b2[3]); }
        __syncthreads();
        UNR for (int u = 0; u < 2; ++u) { const int tl = wave * 2 + u, ti = tl >> 3, tj = tl & 7; f32x16 acc = zero16();
            acc = mm32(lane, acc, SG + ti * 32 * S65, S65, 1, G2 + tj * 32, 256, 1, 64);
            UNR for (int r = 0; r < 16; ++r) GT[(ti * 32 + ACC_ROW(r, lane)) * 257 + tj * 32 + (lane & 31)] = acc[r]; }
        __syncthreads();
        for (int hh = 0; hh < NH; ++hh) {
            const int j = tid >> 3, g = tid & 7; const size_t tok = tb + j; const int cb = hh * 64 + g * 8; const bf16_t* sp = scr + tok * NSLOT * MIXW + cb;
            {
              f32x4 a0, a1, b0, b1; SCR8(sp + SL_MF * MIXW, a0, a1); SCR8(sp + SL_MB * MIXW, b0, b1);
              float x[8]; float s = 0.0f; UNR for (int e = 0; e < 4; ++e) { x[e] = a0[e] + b0[e]; x[4 + e] = a1[e] + b1[e]; } UNR for (int e = 0; e < 8; ++e) s += x[e];
              s += x1(s); s += x2(s); s += x4m(s); const float mean = s * (1.0f / 64.0f); float qv = 0.0f;
              UNR for (int e = 0; e < 8; ++e) { x[e] -= mean; qv += x[e] * x[e]; }
              qv += x1(qv); qv += x2(qv); qv += x4m(qv); const float rs = frsq(qv * (1.0f / 64.0f) + LN_EPS);
              const u32x4 ow = *(const u32x4*)(cols + tok * NCB + CB_MO * 256 + cb); const f32x4 o0 = (f32x4){bflo(ow.x), bfhi(ow.x), bflo(ow.y), bfhi(ow.y)}, o1 = (f32x4){bflo(ow.z), bfhi(ow.z), bflo(ow.w), bfhi(ow.w)};
              u32x4 w; w.x = pk2(x[0] * rs * sigmoidf_(o0[0]), x[1] * rs * sigmoidf_(o0[1])); w.y = pk2(x[2] * rs * sigmoidf_(o0[2]), x[3] * rs * sigmoidf_(o0[3]));
              w.z = pk2(x[4] * rs * sigmoidf_(o1[0]), x[5] * rs * sigmoidf_(o1[1])); w.w = pk2(x[6] * rs * sigmoidf_(o1[2]), x[7] * rs * sigmoidf_(o1[3])); *(u32x4*)(br + tok * D + 0 * MIXW + cb) = w; }
            {
              f32x4 a0, a1, b0, b1; SCR8(sp + SL_GF * MIXW, a0, a1); SCR8(sp + SL_GB * MIXW, b0, b1);
              float x[8]; float qv = 0.0f; UNR for (int e = 0; e < 4; ++e) { x[e] = a0[e] + b0[e]; x[4 + e] = a1[e] + b1[e]; } UNR for (int e = 0; e < 8; ++e) qv += x[e] * x[e];
              qv += x1(qv); qv += x2(qv); qv += x4m(qv); const float rs = frsq(qv * (1.0f / 64.0f) + LN_EPS);
              const u32x4 ow = *(const u32x4*)(cols + tok * NCB + CB_GG * 256 + cb); const f32x4 o0 = (f32x4){bflo(ow.x), bfhi(ow.x), bflo(ow.y), bfhi(ow.y)}, o1 = (f32x4){bflo(ow.z), bfhi(ow.z), bflo(ow.w), bfhi(ow.w)};
              u32x4 w; w.x = pk2(x[0] * rs * siluf_(o0[0]), x[1] * rs * siluf_(o0[1])); w.y = pk2(x[2] * rs * siluf_(o0[2]), x[3] * rs * siluf_(o0[3]));
              w.z = pk2(x[4] * rs * siluf_(o1[0]), x[5] * rs * siluf_(o1[1])); w.w = pk2(x[6] * rs * siluf_(o1[2]), x[7] * rs * siluf_(o1[3])); *(u32x4*)(br + tok * D + 1 * MIXW + cb) = w; }
            {
              f32x4 a0, a1, b0, b1, n0, n1; SCR8(sp + SL_RF * MIXW, a0, a1); SCR8(sp + SL_RB * MIXW, b0, b1); SCR8(sp + SL_RBONUS * MIXW, n0, n1);
              float x[8]; float s = 0.0f; UNR for (int e = 0; e < 4; ++e) { x[e] = a0[e] + b0[e]; x[4 + e] = a1[e] + b1[e]; } UNR for (int e = 0; e < 8; ++e) s += x[e];
              s += x1(s); s += x2(s); s += x4m(s); const float mean = s * (1.0f / 64.0f); float qv = 0.0f;
              UNR for (int e = 0; e < 8; ++e) { x[e] -= mean; qv += x[e] * x[e]; }
              qv += x1(qv); qv += x2(qv); qv += x4m(qv); const float rs = frsq(qv * (1.0f / 64.0f) + LN_EPS);
              const float* gp = GT + j * 257 + cb;
              u32x4 w; w.x = pk2((x[0] * rs + n0[0]) * gp[0], (x[1] * rs + n0[1]) * gp[1]); w.y = pk2((x[2] * rs + n0[2]) * gp[2], (x[3] * rs + n0[3]) * gp[3]);
              w.z = pk2((x[4] * rs + n1[0]) * gp[4], (x[5] * rs + n1[1]) * gp[5]); w.w = pk2((x[6] * rs + n1[2]) * gp[6], (x[7] * rs + n1[3]) * gp[7]); *(u32x4*)(br + tok * D + 2 * MIXW + cb) = w; }
        }
    }
    __syncthreads();
}

__device__ __forceinline__ void mix_na(const Ctx& c0, int l, int pass, int b, int h, int qb) {
    const Ctx c = fresh(c0);
    const Dims& d = c.d; const int tid = c.tid, lane = c.lane, wave = c.wave; const size_t tok0 = pass ? d.NTc + (size_t)b * d.Tl : (size_t)b * d.Tc;
    constexpr int KST = 72, VST_ = 136;
    unsigned char* LB = c.lds;
    bf16_t* Kt = (bf16_t*)LB;
    bf16_t* Vt = (bf16_t*)(LB + 2 * 128 * KST * 2);
    float* rpbs = (float*)(LB + 2 * 128 * KST * 2 + 2 * 64 * VST_ * 2);
    float* Om = (float*)LB;
    float* Lm = Om + 8 * 32 * 64;
    const bf16_t* cols = c.ws<bf16_t>(d.w_cols); bf16_t* br = c.ws<bf16_t>(d.w_br);
    const int rows = d.Tl / GRIDW, kr = rows < 8 ? rows : 8; int rs = qb - kr / 2; rs = rs < 0 ? 0 : (rs > rows - kr ? rows - kr : rs);
    const int nloc = pass ? kr / 2 : 0, ntile = pass ? nloc + PAST / 128 : d.Tc / 128;
    const int qt = wave & 1, kq = wave >> 1, hh = lane >> 5, ql = lane & 31;
    __syncthreads();
    if (pass) for (int i = tid; i < 15 * 31; i += NTHREADS) rpbs[i] = c.in(I_RPB)[((size_t)l * NH + h) * 15 * 31 + i];
    bf16x8 qf[4];
    { const bf16_t* qp = cols + (tok0 + qb * 64 + qt * 32 + ql) * NCB + CB_NQ * 256 + h * 64 + 8 * hh;
      UNR for (int s4 = 0; s4 < 4; ++s4) qf[s4] = *(const bf16x8*)(qp + 16 * s4); }
    const int jp = tid >> 3, d8 = (tid & 7) * 8;
    u32x4 pk[2], pv[2];
#define NA_LOAD(kt_) do { UNR for (int u_ = 0; u_ < 2; ++u_) { const int j_ = 2 * jp + u_; \
        if (pass && (kt_) >= nloc) { const size_t o_ = ((((size_t)b * DEPTH + l) * NH + h) * PAST + ((kt_) - nloc) * 128 + j_) * HD + d8; const float* kp_ = c.in(I_CK) + o_; const float* vp_ = c.in(I_CV) + o_; \
            pk[u_] = pk8(*(const f32x4*)kp_, *(const f32x4*)(kp_ + 4)); pv[u_] = pk8(*(const f32x4*)vp_, *(const f32x4*)(vp_ + 4)); } \
        else { const size_t tk_ = pass ? tok0 + (size_t)(rs + 2 * (kt_) + (j_ >> 6)) * 64 + (j_ & 63) : tok0 + (kt_) * 128 + j_; const bf16_t* rp_ = cols + tk_ * NCB + h * 64 + d8; \
            pk[u_] = *(const u32x4*)(rp_ + CB_NK * 256); pv[u_] = *(const u32x4*)(rp_ + CB_NV * 256); } } } while (0)
#define NA_STORE(buf_) do { bf16_t* kb_ = Kt + (buf_) * 128 * KST; bf16_t* vb_ = Vt + (buf_) * 64 * VST_; \
        UNR for (int u_ = 0; u_ < 2; ++u_) *(u32x4*)(kb_ + (2 * jp + u_) * KST + d8) = pk[u_]; \
        UNR for (int e_ = 0; e_ < 8; ++e_) { const unsigned a_ = pv[0][e_ >> 1], b_ = pv[1][e_ >> 1]; \
            *(unsigned*)(vb_ + (d8 + e_) * VST_ + 2 * ((jp + 4 * (tid & 7)) & 63)) = (e_ & 1) ? ((a_ >> 16) | (b_ & 0xffff0000u)) : ((a_ & 0xffffu) | (b_ << 16)); } } while (0)
    NA_LOAD(0);
    NA_STORE(0);
    f32x16 o0 = zero16(), o1 = zero16(); float lsum = 0.0f;
    __syncthreads();
    for (int kt = 0; kt < ntile; ++kt) {
        if (kt + 1 < ntile) NA_LOAD(kt + 1);
        const bf16_t* kb = Kt + (kt & 1) * 128 * KST + (32 * kq + ql) * KST + 8 * hh; const bf16_t* vb = Vt + (kt & 1) * 64 * VST_; const int d0 = 16 * kq + 2 * hh, kx0 = 4 * (ql >> 3), kx1 = kx0 + 16;
        f32x16 sc = zero16();
        UNR for (int s4 = 0; s4 < 4; ++s4) sc = __builtin_amdgcn_mfma_f32_32x32x16_bf16(*(const bf16x8*)(kb + 16 * s4), qf[s4], sc, 0, 0, 0);
        if (pass && kt < nloc) {
            const int qc = 32 * qt + ql; int cs = qc - 8; cs = cs < 0 ? 0 : (cs > 48 ? 48 : cs);
            UNR for (int r = 0; r < 16; ++r) { const int jj = 32 * kq + ACC_ROW(r, lane), krow = rs + 2 * kt + (jj >> 6), kc = jj & 63; const bool ok = kc >= cs && kc < cs + 16;
                const float bias = rpbs[ok ? (krow - qb + 7) * 31 + (kc - qc + 15) : 0]; sc[r] = ok ? fexp(fminf(sc[r] * 0.125f + bias, 80.0f)) : 0.0f; }
        } else { UNR for (int r = 0; r < 16; ++r) sc[r] = fexp(fminf(sc[r] * 0.125f, 80.0f)); }
        UNR for (int r = 0; r < 16; ++r) lsum += sc[r];
        UNR for (int s2 = 0; s2 < 2; ++s2) { u32x4 w; w.x = cvtpk(sc[8 * s2], sc[8 * s2 + 1]); w.y = cvtpk(sc[8 * s2 + 2], sc[8 * s2 + 3]); w.z = cvtpk(sc[8 * s2 + 4], sc[8 * s2 + 5]); w.w = cvtpk(sc[8 * s2 + 6], sc[8 * s2 + 7]);
            const bf16x8 pf = __builtin_bit_cast(bf16x8, w);
            { const u32x2 v0 = *(const u32x2*)(vb + ql * VST_ + 2 * ((d0 + 8 * s2 + kx0) & 63)), v1 = *(const u32x2*)(vb + ql * VST_ + 2 * ((d0 + 8 * s2 + 4 + kx0) & 63)); u32x4 vw; vw.x = v0.x; vw.y = v0.y; vw.z = v1.x; vw.w = v1.y;
              o0 = __builtin_amdgcn_mfma_f32_32x32x16_bf16(pf, __builtin_bit_cast(bf16x8, vw), o0, 0, 0, 0); }
            { const u32x2 v0 = *(const u32x2*)(vb + (32 + ql) * VST_ + 2 * ((d0 + 8 * s2 + kx1) & 63)), v1 = *(const u32x2*)(vb + (32 + ql) * VST_ + 2 * ((d0 + 8 * s2 + 4 + kx1) & 63)); u32x4 vw; vw.x = v0.x; vw.y = v0.y; vw.z = v1.x; vw.w = v1.y;
              o1 = __builtin_amdgcn_mfma_f32_32x32x16_bf16(pf, __builtin_bit_cast(bf16x8, vw), o1, 0, 0, 0); } }
        if (kt + 1 < ntile) NA_STORE((kt + 1) & 1);
        LDS_BARRIER();
    }
#undef NA_LOAD
#undef NA_STORE
    { float* om = Om + wave * 32 * 64; UNR for (int r = 0; r < 16; ++r) { om[ACC_ROW(r, lane) * 64 + ql] = o0[r]; om[ACC_ROW(r, lane) * 64 + 32 + ql] = o1[r]; }
      const float lt = lsum + __shfl_xor(lsum, 32); if (lane < 32) Lm[wave * 32 + lane] = lt; }
    __syncthreads();
    { const int q = tid >> 3, g = tid & 7, qt2 = q >> 5, q2 = q & 31; float ls = 0.0f; f32x4 a0 = (f32x4){0.f, 0.f, 0.f, 0.f}, a1 = a0;
      UNR for (int kq2 = 0; kq2 < 4; ++kq2) { const int w = kq2 * 2 + qt2; ls += Lm[w * 32 + q2]; const float* op = Om + w * 32 * 64 + q2 * 64 + g * 8; a0 += *(const f32x4*)op; a1 += *(const f32x4*)(op + 4); }
      const float il = 1.0f / ls; const size_t tok = tok0 + qb * 64 + q; bf16_t* bp = br + tok * D + 3 * MIXW + h * 64 + g * 8;
      u32x4 w; w.x = pk2(a0[0] * il, a0[1] * il); w.y = pk2(a0[2] * il, a0[3] * il); w.z = pk2(a1[0] * il, a1[1] * il); w.w = pk2(a1[2] * il, a1[3] * il); *(u32x4*)bp = w; }
    __syncthreads();
}

__device__ __forceinline__ void phase_mixers(const Ctx& c0, int l, int rep) {
    const Ctx c = fresh(c0);
    const Dims& d = c.d; const int rows = d.Tl / GRIDW;
    const int nL = d.Bl * NH, nC = d.Bc * NH, nNAl = nL * rows, nq = d.Tc / 64, nNAc = nC * nq;
    unsigned* qctr = c.ws<unsigned>(c.d.w_ctl) + CW_QUEUE + 64 * (l + DEPTH * rep);
    int* slot = (int*)(c.lds + 163840 - 128);
    if (rep == 0 && (int)blockIdx.x < NCONV) { conv_weights(fresh(c0), l, l + 1, 1, (int)blockIdx.x, NCONV); __syncthreads(); }
#ifndef MIX_MASK
#define MIX_MASK 15
#endif
#ifndef MIX_DUP
#define MIX_DUP 15
#endif
#define MIX_FETCH() do { __syncthreads(); if (c.tid == 0) *slot = (int)atomicAdd(qctr, 1u); __syncthreads(); it = __builtin_amdgcn_readfirstlane(*slot); } while (0)
    int it; MIX_FETCH();
    int base = 0;
    for (int pp = 1; pp >= 0; --pp) {
        const int ps = opqs(__builtin_amdgcn_readfirstlane(pp)), nBH = ps ? nL : nC, nNA = ps ? nNAl : nNAc, nr = ps ? rows : nq;
        const int e0 = base + 2 * nBH, e1 = e0 + 2 * nBH, e2 = e1 + 2 * nBH, e3 = e2 + nNA;
        while (it < e0) { const int q = it - base; if ((MIX_MASK & 1) && (rep == 0 || (MIX_DUP & 1))) mix_rwkv(c, l, ps, (q >> 1) / NH, (q >> 1) % NH, q & 1); MIX_FETCH(); }
        while (it < e1) { const int q = it - e0; if ((MIX_MASK & 2) && (rep == 0 || (MIX_DUP & 2))) mix_mlstm(c, l, ps, (q >> 1) / NH, (q >> 1) % NH, q & 1); MIX_FETCH(); }
        while (it < e2) { const int q = it - e1; if ((MIX_MASK & 4) && (rep == 0 || (MIX_DUP & 4))) mix_gla(c, l, ps, (q >> 1) / NH, (q >> 1) % NH, q & 1); MIX_FETCH(); }
        while (it < e3) { const int q = it - e2; if ((MIX_MASK & 8) && (rep == 0 || (MIX_DUP & 8))) mix_na(c, l, ps, q / (NH * nr), (q / nr) % NH, q % nr); MIX_FETCH(); }
        base = e3;
    }
#undef MIX_FETCH
}

__device__ __forceinline__ void phase_ln1(const Ctx& c0, int l) {
    const Ctx c = fresh(c0);
    const Dims& d = c.d; const float* mods = c.mods(l); const float* v = c.ws<float>(d.w_v); bf16_t* hb = c.ws<bf16_t>(d.w_hb); float* aff = c.ws<float>(d.w_aff);
    const float* lg = c.in(I_LNG) + ((size_t)l * 2 + 0) * D; const float* lb = c.in(I_LNB) + ((size_t)l * 2 + 0) * D;
    constexpr int WRS = D + 4;
    float* WR = (float*)c.lds;
    __syncthreads();
    for (int i = c.tid; i < D * NEXP; i += NTHREADS) WR[(i & 15) * WRS + (i >> 4)] = c.in(I_WROUTER)[(size_t)l * D * NEXP + i];
    __syncthreads();
    f32x4 g4[4], b4[4];
#pragma unroll
    for (int j = 0; j < 4; ++j) { g4[j] = *(const f32x4*)(lg + 4 * c.lane + 256 * j); b4[j] = *(const f32x4*)(lb + 4 * c.lane + 256 * j); }
    for (int blk = c.vcu * NWAVES + c.wave; blk < d.NT / 8; blk += c.G * NWAVES) {
        const int tokb = blk * 8; const float* mr = mods + (size_t)c.modrow(tokb) * NMOD;
        f32x4 sh4[4], sc4[4], xn[4];
#pragma unroll
        for (int j = 0; j < 4; ++j) { sh4[j] = *(const f32x4*)(mr + 3 * D + 4 * c.lane + 256 * j); sc4[j] = *(const f32x4*)(mr + 4 * D + 4 * c.lane + 256 * j); xn[j] = *(const f32x4*)(v + (size_t)tokb * D + 4 * c.lane + 256 * j); }
        for (int ti = 0; ti < 8; ++ti) {
            const int tok = tokb + ti; f32x4 x[4]; float s = 0.0f;
#pragma unroll
            for (int j = 0; j < 4; ++j) { x[j] = xn[j]; s += (x[j][0] + x[j][1]) + (x[j][2] + x[j][3]); }
            if (ti + 1 < 8) {
#pragma unroll
                for (int j = 0; j < 4; ++j) xn[j] = *(const f32x4*)(v + (size_t)(tok + 1) * D + 4 * c.lane + 256 * j); }
            const float mean = wave_sum(s) * (1.0f / D); float q = 0.0f;
#pragma unroll
            for (int j = 0; j < 4; ++j) { x[j] = x[j] - mean; q += (x[j][0] * x[j][0] + x[j][1] * x[j][1]) + (x[j][2] * x[j][2] + x[j][3] * x[j][3]); }
            const float rstd = frsq(wave_sum(q) * (1.0f / D) + LN_EPS);
            f32x4 hh[4];
#pragma unroll
            for (int j = 0; j < 4; ++j) { const int col = 4 * c.lane + 256 * j; const f32x4 x1 = x[j] * rstd * g4[j] + b4[j]; *(f32x4*)(c.X() + (size_t)tok * D + col) = x1;
                hh[j] = x1 * (1.0f + sc4[j]) + sh4[j]; u32x2 w; w.x = pk2(hh[j][0], hh[j][1]); w.y = pk2(hh[j][2], hh[j][3]); *(u32x2*)(hb + (size_t)tok * D + col) = w; }
            float lg16[16];
#pragma unroll
            for (int e = 0; e < 16; ++e) { float a = 0.0f;
#pragma unroll
                for (int j = 0; j < 4; ++j) { const f32x4 wv = *(const f32x4*)(WR + e * WRS + 4 * c.lane + 256 * j); a += (hh[j][0] * wv[0] + hh[j][1] * wv[1]) + (hh[j][2] * wv[2] + hh[j][3] * wv[3]); }
                lg16[e] = a;
#ifndef CPU_EMU
                asm volatile("" ::: "memory");
#endif
            }
            float mx = -3.0e38f;
#pragma unroll
            for (int e = 0; e < 16; ++e) { lg16[e] = wave_sum(lg16[e]); mx = fmaxf(mx, lg16[e]); }
            float se = 0.0f;
#pragma unroll
            for (int e = 0; e < 16; ++e) { lg16[e] = expf(lg16[e] - mx); se += lg16[e]; }
            const float inv = 1.0f / se; float mine = 0.0f;
#pragma unroll
            for (int e = 0; e < 16; ++e) mine = (c.lane == e) ? lg16[e] * inv : mine;
            if (c.lane < 16) aff[(size_t)tok * NEXP + c.lane] = mine;
        }
    }
}

__device__ __forceinline__ void phase_select(const Ctx& c0) {
    const Ctx c = fresh(c0);
    const Dims& d = c.d; const float* aff = c.ws<float>(d.w_aff); int* inv = c.ws<int>(d.w_inv); float* pgate = c.ws<float>(d.w_pgate);
    const bf16_t* hb = c.ws<bf16_t>(d.w_hb); bf16_t* xe = c.ws<bf16_t>(d.w_xe);
    unsigned long long* KEY = (unsigned long long*)c.lds; int* sel = (int*)(KEY + 1024);
    const int nitems = (d.Bc + d.Bl) * NEXP, nlat = d.Bl * NEXP, nctx = d.Bc * NEXP;
    const bool latw = c.vcu < nlat && nlat < c.G; const int gctx = nlat < c.G ? c.G - nlat : c.G;
    for (int k = 0;; ++k) {
        int it;
        if (nlat >= c.G) { it = c.vcu + k * c.G; if (it >= nitems) break; it = it < nlat ? nctx + it : it - nlat; }
        else if (latw) { if (k > 0) break; it = nctx + c.vcu; }
        else { it = (c.vcu - nlat) + k * gctx; if (it >= nctx) break; }
        const int e = it % NEXP, bb = it / NEXP, pass = bb >= d.Bc, b = pass ? bb - d.Bc : bb, T = pass ? d.Tl : d.Tc, cap = pass ? d.capl : d.capc;
        const int tok0 = pass ? d.NTc + b * d.Tl : b * d.Tc, row0 = e * d.RPE + (pass ? d.Bc * d.capc + b * d.capl : b * d.capc);
        __syncthreads();
        for (int t = c.tid; t < T; t += NTHREADS) KEY[t] = ((unsigned long long)__builtin_bit_cast(unsigned, aff[(size_t)(tok0 + t) * NEXP + e]) << 32) | (unsigned)(~t);
        __syncthreads();
        { const int t0 = c.tid, t1 = c.tid + NTHREADS; const bool h0 = t0 < T, h1 = t1 < T; const unsigned long long k0 = h0 ? KEY[t0] : ~0ull, k1 = h1 ? KEY[t1] : ~0ull; int rank0 = 0, rank1 = 0;
#pragma unroll 4
          for (int s2 = 0; s2 < T; s2 += 2) { const unsigned long long o0 = KEY[s2], o1 = KEY[s2 + 1];
              rank0 += (o0 > k0 ? 1 : 0) + (o1 > k0 ? 1 : 0); rank1 += (o0 > k1 ? 1 : 0) + (o1 > k1 ? 1 : 0); }
          if (h0) { if (rank0 < cap) { sel[rank0] = t0; pgate[row0 + rank0] = __builtin_bit_cast(float, (unsigned)(k0 >> 32)); inv[(size_t)e * d.NT + tok0 + t0] = row0 + rank0; } else inv[(size_t)e * d.NT + tok0 + t0] = -1; }
          if (h1) { if (rank1 < cap) { sel[rank1] = t1; pgate[row0 + rank1] = __builtin_bit_cast(float, (unsigned)(k1 >> 32)); inv[(size_t)e * d.NT + tok0 + t1] = row0 + rank1; } else inv[(size_t)e * d.NT + tok0 + t1] = -1; } }
        __syncthreads();
        for (int r0 = c.wave * 4; r0 < cap; r0 += NWAVES * 4) {
            u32x4 v[4][2];
            UNR for (int u = 0; u < 4; ++u) { const int r = r0 + u < cap ? r0 + u : cap - 1; const u32x4* src = (const u32x4*)(hb + (size_t)(tok0 + sel[r]) * D); v[u][0] = src[c.lane]; v[u][1] = src[c.lane + 64]; }
            UNR for (int u = 0; u < 4; ++u) { if (r0 + u < cap) { u32x4* dst = (u32x4*)(xe + (size_t)(row0 + r0 + u) * D); dst[c.lane] = v[u][0]; dst[c.lane + 64] = v[u][1]; } }
        }
    }
}

__device__ __forceinline__ void phase_ln2(const Ctx& c0, int l) {
    const Ctx c = fresh(c0);
    const Dims& d = c.d; const float* mods = c.mods(l); const bf16_t* y = c.ws<bf16_t>(d.w_y); const int* inv = c.ws<int>(d.w_inv); bf16_t* hb = c.ws<bf16_t>(d.w_hb);
    const float* lg = c.in(I_LNG) + ((size_t)l * 2 + 1) * D; const float* lb = c.in(I_LNB) + ((size_t)l * 2 + 1) * D;
    const float* modn = (l + 1 < DEPTH) ? c.mods(l + 1) : nullptr;
    const int gw = c.vcu * NWAVES + c.wave, NGW = c.G * NWAVES;
    for (int tok = gw; tok < d.NT; tok += NGW) {
        const int mrow = c.modrow(tok); const float* mr = mods + (size_t)mrow * NMOD; f32x4 ff[4];
#pragma unroll
        for (int j = 0; j < 4; ++j) ff[j] = (f32x4){0.f, 0.f, 0.f, 0.f};
        for (int e = 0; e < NEXP; ++e) { const int row = inv[(size_t)e * d.NT + tok]; if (row >= 0) {
#pragma unroll
            for (int j = 0; j < 4; ++j) { const u32x2 w = *(const u32x2*)(y + (size_t)row * D + 4 * c.lane + 256 * j); ff[j] += (f32x4){bflo(w.x), bfhi(w.x), bflo(w.y), bfhi(w.y)}; } } }
        f32x4 x[4]; float s = 0.0f;
#pragma unroll
        for (int j = 0; j < 4; ++j) { const int col = 4 * c.lane + 256 * j; const f32x4 x1 = *(const f32x4*)(c.X() + (size_t)tok * D + col), g2 = *(const f32x4*)(mr + 5 * D + col);
            x[j] = ALPHA * x1 + g2 * ff[j]; s += (x[j][0] + x[j][1]) + (x[j][2] + x[j][3]); }
        const float mean = wave_sum(s) * (1.0f / D); float q = 0.0f;
#pragma unroll
        for (int j = 0; j < 4; ++j) { x[j] = x[j] - mean; q += (x[j][0] * x[j][0] + x[j][1] * x[j][1]) + (x[j][2] * x[j][2] + x[j][3] * x[j][3]); }
        const float rstd = frsq(wave_sum(q) * (1.0f / D) + LN_EPS);
#pragma unroll
        for (int j = 0; j < 4; ++j) { const int col = 4 * c.lane + 256 * j; const f32x4 g = *(const f32x4*)(lg + col), bb = *(const f32x4*)(lb + col);
            const f32x4 x2 = x[j] * rstd * g + bb; *(f32x4*)(c.X() + (size_t)tok * D + col) = x2;
            if (modn) { const float* mn = modn + (size_t)mrow * NMOD; const f32x4 sh = *(const f32x4*)(mn + col), sc = *(const f32x4*)(mn + D + col); const f32x4 hh = x2 * (1.0f + sc) + sh;
                u32x2 w; w.x = pk2(hh[0], hh[1]); w.y = pk2(hh[2], hh[3]); *(u32x2*)(hb + (size_t)tok * D + col) = w; } }
    }
}

constexpr int N_PHASES = 2 + 11 * DEPTH;
__device__ __forceinline__ void run_phase(const Ctx& c0, int ph, int rep) {
    const Ctx c = fresh(c0); const Dims& d = c.d;
#ifndef PHASE_MASK
#define PHASE_MASK 0xFFFF
#endif
    if (ph == 0) { if (PHASE_MASK & 0x800) phase_prep(c); return; }
    if (ph == 1) { if (PHASE_MASK & 0x1000) phase_init(c); return; }
    const int l = (ph - 2) / 11, s = (ph - 2) % 11;
    LAS unsigned char* ldsp = (LAS unsigned char*)c.lds;
    if (!((PHASE_MASK >> s) & 1)) return;
    switch (s) {
    case 0: { pg8::Gemm g{c.ws<bf16_t>(d.w_hb), c.ws<bf16_t>(d.w_win) + (size_t)l * NINP * D, D}; pg8::StaticOrder S; S.init(d.NT, NINP, c.G, (int)blockIdx.x);
              EpiCols E{c.ws<bf16_t>(d.w_cols), c.ws<float>(d.w_small), c.ws<unsigned char>(d.w_gates), c.p->out + d.o_nk, c.p->out + d.o_nv, l, d.NTc, d.Tc}; pg8::gemm_phase<EpiCols, pg8::StaticOrder>(ldsp, g, S, E); } break;
    case 1: phase_rwprep(c, l); break;
    case 2: phase_mixers(c, l, rep); break;
    case 3: phase_combine(c, l); break;
    case 4: { pg8::Gemm g{c.ws<bf16_t>(d.w_br), c.ws<bf16_t>(d.w_wbr) + (size_t)l * D * D, D}; pg8::StaticOrder S; S.init(d.NT, D, c.G, (int)blockIdx.x);
              EpiWiden E{c.ws<unsigned char>(d.w_gates), c.ws<bf16_t>(d.w_merged)}; pg8::gemm_phase<EpiWiden, pg8::StaticOrder>(ldsp, g, S, E); } break;
    case 5: { pg8::Gemm g{c.ws<bf16_t>(d.w_merged), c.ws<bf16_t>(d.w_wout) + (size_t)l * D * D, D}; pg8::StaticOrder S; S.init(d.NT, D, c.G, (int)blockIdx.x);
              EpiPreLN E{l == 0 ? c.in(I_XP) : c.X(), l == 0 ? c.in(I_XS) - (size_t)d.NTc * D : c.X(), c.mods(l), c.ws<float>(d.w_v), d.NTc, d.Tl}; pg8::gemm_phase<EpiPreLN, pg8::StaticOrder>(ldsp, g, S, E); } break;
    case 6: phase_ln1(c, l); break;
    case 7: phase_select(c); break;
    case 8: { pg8::Gemm g{c.ws<bf16_t>(d.w_xe), c.ws<bf16_t>(d.w_wup) + (size_t)l * NEXP * 2 * FF * D, D}; pg8::GroupOrder S; S.init(d.TPE, 2 * FF / 256, NEXP, c.G, c.vcu);
              EpiSwiGLU E{c.ws<bf16_t>(d.w_act)}; pg8::gemm_phase<EpiSwiGLU, pg8::GroupOrder>(ldsp, g, S, E); } break;
    case 9: { pg8::Gemm g{c.ws<bf16_t>(d.w_act), c.ws<bf16_t>(d.w_wdn) + (size_t)l * NEXP * D * FF, FF}; pg8::GroupOrder S; S.init(d.TPE, D / 256, NEXP, c.G, c.vcu);
              EpiDown E{c.ws<float>(d.w_pgate), c.ws<bf16_t>(d.w_y)}; pg8::gemm_phase<EpiDown, pg8::GroupOrder>(ldsp, g, S, E); } break;
    default: phase_ln2(c, l); break;
    }
}

#ifndef CPU_EMU
#define XB_TMO      128
#define XB_XCNT(j)  (256  + 64 * (j))
#define XB_XSUB(j)  (1280 + 64 * (j))
#define XB_XGEN(j)  (2304 + 64 * (j))
#define XB_TOP      3328
#define XB_TOPGEN   3392
#define XB_SPIN_CAP (1u << 20)
__device__ __forceinline__ unsigned xb_ld(unsigned* p)              { return __hip_atomic_load(p, __ATOMIC_RELAXED, __HIP_MEMORY_SCOPE_AGENT); }
__device__ __forceinline__ unsigned xb_add(unsigned* p, unsigned v) { return __hip_atomic_fetch_add(p, v, __ATOMIC_RELAXED, __HIP_MEMORY_SCOPE_AGENT); }
__device__ __forceinline__ unsigned xb_xcc_id() { return (unsigned)__builtin_amdgcn_s_getreg((3 << 11) | 20) & 0xFu; }
#define XB_SPIN(cond, bar) do { unsigned _sp = 0; while (cond) { __builtin_amdgcn_s_sleep(1); \
    if ((++_sp & 255u) == 0u) { if (xb_ld(&(bar)[XB_TMO])) break; if (_sp > XB_SPIN_CAP) { atomicAdd(&(bar)[XB_TMO], 1u); break; } } } } while (0)
struct XcdBarrier { unsigned* bar; unsigned x; volatile LAS unsigned* st; };
__device__ __forceinline__ XcdBarrier xcd_barrier_post(unsigned* bar, volatile LAS unsigned* st) {
    XcdBarrier b; b.bar = bar; b.x = xb_xcc_id(); b.st = st;
    if (threadIdx.x == 0) (void)xb_add(&bar[XB_XCNT(b.x)], 1u);
    return b;
}
__device__ __forceinline__ void xcd_barrier_complete(unsigned* bar, unsigned x, unsigned& nloc, unsigned& nx) {
    const unsigned G = gridDim.x * gridDim.y * gridDim.z;
    unsigned sum, cnt, mine, sp = 0u;
    for (;;) {
        sum = 0u; cnt = 0u; mine = 0u;
#pragma unroll
        for (unsigned j = 0; j < 16; ++j) { const unsigned cc = xb_ld(&bar[XB_XCNT(j)]); sum += cc; cnt += (cc > 0u) ? 1u : 0u; mine = (j == x) ? cc : mine; }
        if (sum == G) break;
        __builtin_amdgcn_s_sleep(1);
        if ((++sp & 255u) == 0u) { if (xb_ld(&bar[XB_TMO])) break; if (sp > XB_SPIN_CAP) { atomicAdd(&bar[XB_TMO], 1u); break; } }
    }
    nloc = mine > 0u ? mine : 1u; nx = cnt > 0u ? cnt : 1u;
}
__device__ __forceinline__ void xcd_barrier(const XcdBarrier& b) {
    asm volatile("s_waitcnt vmcnt(0)" ::: "memory");
    __syncthreads();
    if (threadIdx.x == 0) {
        unsigned* bar = b.bar;
        __builtin_amdgcn_s_waitcnt(0);
        unsigned nloc = b.st[0], nx = b.st[1];
        if (nloc == 0u) { xcd_barrier_complete(bar, b.x, nloc, nx); b.st[0] = nloc; b.st[1] = nx; }
        const unsigned old = xb_add(&bar[XB_XSUB(b.x)], 1u);
        const unsigned gen = old / nloc;
        if (old + 1u == (gen + 1u) * nloc) {
            __builtin_amdgcn_fence(__ATOMIC_RELEASE, "agent");
            asm volatile("s_waitcnt vmcnt(0)" ::: "memory");
            const unsigned og = xb_add(&bar[XB_TOP], 1u);
            const unsigned tg = og / nx;
            if (og + 1u == (tg + 1u) * nx) xb_add(&bar[XB_TOPGEN], 1u);
            else XB_SPIN(xb_ld(&bar[XB_TOPGEN]) == tg, bar);
            __builtin_amdgcn_fence(__ATOMIC_ACQUIRE, "agent");
            xb_add(&bar[XB_XGEN(b.x)], 1u);
            asm volatile("s_waitcnt vmcnt(0)" ::: "memory");
        } else {
            XB_SPIN(xb_ld(&bar[XB_XGEN(b.x)]) == gen, bar);
            __builtin_amdgcn_fence(__ATOMIC_ACQUIRE, "agent");
            asm volatile("s_waitcnt vmcnt(0)" ::: "memory");
        }
    }
    __syncthreads();
}

#ifndef PROBE_DUP
#define PROBE_DUP 0
#endif
constexpr int LDS_BYTES = 163840;
__global__ void __launch_bounds__(NTHREADS, 2) trunk_fwd(Params p) {
    extern __shared__ __attribute__((aligned(16))) unsigned char lds[];
    Ctx c; c.p = &p; c.d = make_dims(p.Bc, p.Tc, p.Bl, p.Tl); c.lds = lds;
    c.tid = threadIdx.x; c.lane = c.tid & 63; c.wave = __builtin_amdgcn_readfirstlane(c.tid >> 6);
    c.G = gridDim.x; { const int bx = blockIdx.x; c.vcu = (c.G % 8 == 0) ? (bx % 8) * (c.G / 8) + bx / 8 : bx; }
    volatile LAS unsigned* st = (volatile LAS unsigned*)((LAS unsigned char*)lds + LDS_BYTES - 64);
    XcdBarrier bar; bar.bar = nullptr; bar.x = 0; bar.st = st;
    if (p.use_bar) { if (c.tid < 2) st[c.tid] = 0u; __syncthreads(); bar = xcd_barrier_post((unsigned*)(p.ws) + CW_BAR, st); }
    for (int ph = p.ph_lo; ph < p.ph_hi; ++ph) {
#if PROBE_DUP
        { const int kind = ph == 0 ? 11 : (ph == 1 ? 12 : (ph - 2) % 11); const int nrep = ((PROBE_DUP >> kind) & 1) ? 2 : 1;
          for (int rep = 0; rep < nrep; ++rep) { run_phase(c, ph, rep); if (rep + 1 < nrep) xcd_barrier(bar); } }
#else
        run_phase(c, ph, 0);
#endif
        if (ph + 1 < p.ph_hi) xcd_barrier(bar);
    }
}

#ifndef N_LAUNCH_MODE
#define N_LAUNCH_MODE 1
#endif
extern "C" void kernel_launch(void* const* d_in, const int* in_sizes, int n_in, void* d_out, int out_size, void* d_ws, size_t ws_size, hipStream_t stream) {
    static int grid = 0, resident = 0;
    const Dims d = make_dims(32, 256, 8, 1024);
    if (grid == 0) {
        int dev = 0, cus = 0;
        if (n_in != N_INPUTS || (size_t)out_size != d.o_end || ws_size < ((size_t)d.w_end << 8)) { fprintf(stderr, "kernel_launch: unexpected sizes: n_in %d out %d ws %zu (need %zu / %zu)\n", n_in, out_size, ws_size, (size_t)d.o_end, (size_t)d.w_end << 8); grid = -1; return; }
        if (hipGetDevice(&dev) != hipSuccess || hipDeviceGetAttribute(&cus, hipDeviceAttributeMultiprocessorCount, dev) != hipSuccess) { grid = -1; return; }
        if (hipFuncSetAttribute((const void*)trunk_fwd, hipFuncAttributeMaxDynamicSharedMemorySize, LDS_BYTES) != hipSuccess) { fprintf(stderr, "kernel_launch: hipFuncSetAttribute failed\n"); grid = -1; return; }
        int per_cu = 0;
        if (hipOccupancyMaxActiveBlocksPerMultiprocessor(&per_cu, (const void*)trunk_fwd, NTHREADS, LDS_BYTES) != hipSuccess) per_cu = 0;
        (void)hipGetLastError();
        grid = cus;
        resident = per_cu >= 1;
        if (!resident) fprintf(stderr, "kernel_launch: occupancy query says %d blocks/CU: falling back to one launch per phase\n", per_cu);
    }
    if (grid < 0) return;
    (void)hipMemsetAsync((char*)d_ws, 0, CTL_BYTES, stream);
    Params p{};
    for (int i = 0; i < N_INPUTS; ++i) p.in[i] = (const float*)d_in[i];
    p.out = (float*)d_out; p.ws = (unsigned char*)d_ws; p.Bc = 32; p.Tc = 256; p.Bl = 8; p.Tl = 1024;
    if (N_LAUNCH_MODE == 1 && resident) {
        p.ph_lo = 0; p.ph_hi = N_PHASES; p.use_bar = 1;
        hipLaunchKernelGGL(trunk_fwd, dim3(grid), dim3(NTHREADS), LDS_BYTES, stream, p);
    } else {
        for (int ph = 0; ph < N_PHASES; ++ph) { p.ph_lo = ph; p.ph_hi = ph + 1; p.use_bar = 0; hipLaunchKernelGGL(trunk_fwd, dim3(grid), dim3(NTHREADS), LDS_BYTES, stream, p); }
    }
}
#endif
```
